# Optimizing an MI355X kernel written in HIP

```python
import jax
import jax.numpy as jnp
from jax import lax
import numpy as np

D_MODEL = 4096
BATCH = 2
SEQ = 8192
DEPTH = 2

HEAD_DIM = 128
ROPE_THETA = 500000.0
PARTIAL_ROT = HEAD_DIM // 4
NORM_EPS = 1e-6
NEG_INF = -1e30

MLA_HEADS = 16
MLA_Q_RANK = 896
MLA_KV_RANK = 512
MLA_NOPE = 128
MLA_ROPE = 64
MLA_QK = MLA_NOPE + MLA_ROPE
MLA_V = 128
Q_BLOCK = 128

DIL_CONFIGS = ((128, 1), (512, 4), (2048, 16))
DIL_GROUPS = len(DIL_CONFIGS)
DIL_HPG = 8
DIL_HEADS = DIL_GROUPS * DIL_HPG

EVEN_IN = MLA_Q_RANK + MLA_KV_RANK + MLA_ROPE + 3 * DIL_HEADS * HEAD_DIM
EVEN_MIX = MLA_HEADS * MLA_V + DIL_HPG * HEAD_DIM

GRID_W = 64
NA_HEADS = D_MODEL // HEAD_DIM
NA_ROWS = 8
NA_COLS = 16
ODD_MIX = NA_HEADS * HEAD_DIM

D_FF = 11008
CONV_WIDTH = 3

N_EVEN = (DEPTH + 1) // 2
N_ODD = DEPTH // 2

kernel_name = 'hybrid_mla_dilated_natten_convffn_encoder'


def _rmsnorm(x, g):
    xf = x.astype(jnp.float32)
    y = xf * lax.rsqrt(jnp.mean(xf * xf, axis=-1, keepdims=True) + NORM_EPS)
    return (y * g.astype(jnp.float32)).astype(x.dtype)


def _rope(x, pos, rot_dim):
    half = rot_dim // 2
    inv_freq = 1.0 / (ROPE_THETA ** (jnp.arange(half, dtype=jnp.float32) * (2.0 / rot_dim)))
    ang = pos.astype(jnp.float32)[:, None] * inv_freq[None, :]
    cos = jnp.cos(ang)[:, None, :].astype(x.dtype)
    sin = jnp.sin(ang)[:, None, :].astype(x.dtype)
    x1 = x[..., :half]
    x2 = x[..., half:rot_dim]
    return jnp.concatenate([x1 * cos - x2 * sin, x2 * cos + x1 * sin, x[..., rot_dim:]], axis=-1)


def _dense_blocked_attention(q, k, v):
    B, S, H, Dq = q.shape
    nqb = S // Q_BLOCK
    scale = Dq ** -0.5
    qb = q.reshape(B, nqb, Q_BLOCK, H, Dq).transpose(1, 0, 2, 3, 4)

    def block(qi):
        s = jnp.einsum('bqhd,bkhd->bhqk', qi, k).astype(jnp.float32) * scale
        p = jax.nn.softmax(s, axis=-1).astype(v.dtype)
        return jnp.einsum('bhqk,bkhd->bqhd', p, v)

    o = lax.map(block, qb)
    return o.transpose(1, 0, 2, 3, 4).reshape(B, S, H * v.shape[-1])


def _banded(q, k, v, radius):
    N, L, H, Dh = q.shape
    blk = radius
    nb = -(-L // blk)
    Lp = nb * blk
    qb = jnp.pad(q, ((0, 0), (0, Lp - L), (0, 0), (0, 0))).reshape(N, nb, blk, H, Dh)
    kv_pad = ((0, 0), (blk, Lp - L + blk), (0, 0), (0, 0))
    kp = jnp.pad(k, kv_pad).reshape(N, nb + 2, blk, H, Dh)
    vp = jnp.pad(v, kv_pad).reshape(N, nb + 2, blk, H, Dh)
    kb = jnp.concatenate([kp[:, :-2], kp[:, 1:-1], kp[:, 2:]], axis=2)
    vb = jnp.concatenate([vp[:, :-2], vp[:, 1:-1], vp[:, 2:]], axis=2)
    qpos = jnp.arange(nb)[:, None] * blk + jnp.arange(blk)[None, :]
    kpos = jnp.arange(nb)[:, None] * blk - blk + jnp.arange(3 * blk)[None, :]
    valid = ((jnp.abs(qpos[:, :, None] - kpos[:, None, :]) <= radius)
             & (kpos[:, None, :] >= 0) & (kpos[:, None, :] < L))
    s = jnp.einsum('nbqhd,nbkhd->nbhqk', qb, kb).astype(jnp.float32) * (Dh ** -0.5)
    s = jnp.where(valid[None, :, None], s, NEG_INF)
    m = jnp.max(s, axis=-1)
    p = jnp.exp(s - m[..., None])
    l = jnp.sum(p, axis=-1)
    o = jnp.einsum('nbhqk,nbkhd->nbqhd', p.astype(v.dtype), vb)
    m_t = m.transpose(0, 1, 3, 2)
    l_t = l.transpose(0, 1, 3, 2)
    o = (o.astype(jnp.float32) / l_t[..., None]).astype(v.dtype)
    o = o.reshape(N, Lp, H, Dh)[:, :L]
    return o, m_t.reshape(N, Lp, H)[:, :L], l_t.reshape(N, Lp, H)[:, :L]


def _to_strided(t, d):
    B, S, H, Dh = t.shape
    return t.reshape(B, S // d, d, H, Dh).transpose(0, 2, 1, 3, 4).reshape(B * d, S // d, H, Dh)


def _from_strided(t, B, d):
    Ld = t.shape[1]
    t = t.reshape((B, d, Ld) + t.shape[2:])
    t = jnp.swapaxes(t, 1, 2)
    return t.reshape((B, Ld * d) + t.shape[3:])


def _dilated_mixture(q, k, v):
    B, S, _, Dh = q.shape
    outs, ms, ls = [], [], []
    for g, (window, dil) in enumerate(DIL_CONFIGS):
        sl = slice(g * DIL_HPG, (g + 1) * DIL_HPG)
        o, m, l = _banded(_to_strided(q[:, :, sl], dil), _to_strided(k[:, :, sl], dil),
                          _to_strided(v[:, :, sl], dil), window // (2 * dil))
        outs.append(_from_strided(o, B, dil).astype(jnp.float32))
        ms.append(_from_strided(m, B, dil))
        ls.append(_from_strided(l, B, dil))
    m_all = jnp.stack(ms)
    wts = jnp.exp(m_all - jnp.max(m_all, axis=0, keepdims=True)) * jnp.stack(ls)
    o = jnp.sum(wts[..., None] * jnp.stack(outs), axis=0) / jnp.sum(wts, axis=0)[..., None]
    return o.reshape(B, S, DIL_HPG * Dh).astype(q.dtype)


def _neighborhood_attention(q, k, v, rpb):
    B, S, H, Dh = q.shape
    rows = S // GRID_W
    kr = min(NA_ROWS, rows)
    qg = q.reshape(B, rows, GRID_W, H, Dh)
    kg = k.reshape(B, rows, GRID_W, H, Dh)
    vg = v.reshape(B, rows, GRID_W, H, Dh)
    row_start = jnp.clip(jnp.arange(rows) - kr // 2, 0, rows - kr)
    cols = jnp.arange(GRID_W)
    col_idx = jnp.clip(cols - NA_COLS // 2, 0, GRID_W - NA_COLS)[:, None] + jnp.arange(NA_COLS)[None, :]
    col_bias_idx = col_idx - cols[:, None] + (NA_COLS - 1)
    rpb_cols = rpb[:, :, col_bias_idx]
    scale = Dh ** -0.5

    def row(i):
        rs = row_start[i]
        kn = lax.dynamic_slice_in_dim(kg, rs, kr, axis=1)[:, :, col_idx]
        vn = lax.dynamic_slice_in_dim(vg, rs, kr, axis=1)[:, :, col_idx]
        qi = lax.dynamic_index_in_dim(qg, i, axis=1, keepdims=False)
        r_idx = rs + jnp.arange(kr) - i + (NA_ROWS - 1)
        bias = rpb_cols[:, r_idx].transpose(0, 2, 1, 3)
        s = (jnp.einsum('bchd,brckhd->bhcrk', qi, kn).astype(jnp.float32) * scale
             + bias[None].astype(jnp.float32))
        p = jax.nn.softmax(s.reshape(B, H, GRID_W, kr * NA_COLS), axis=-1)
        p = p.reshape(s.shape).astype(v.dtype)
        return jnp.einsum('bhcrk,brckhd->bchd', p, vn)

    o = lax.map(row, jnp.arange(rows))
    return o.transpose(1, 0, 2, 3, 4).reshape(B, S, H * Dh)


def _even_mixer(h, pos, w_in, q_lora_g, kv_lora_g, w_uq, w_ukv, mla_qn, mla_kn, dil_qn, dil_kn, w_out):
    B, S, _ = h.shape
    z = h @ w_in
    c1 = MLA_Q_RANK
    c2 = c1 + MLA_KV_RANK
    c3 = c2 + MLA_ROPE
    c_q, c_kv, k_pe, z_b = z[..., :c1], z[..., c1:c2], z[..., c2:c3], z[..., c3:]
    q = (_rmsnorm(c_q, q_lora_g) @ w_uq).reshape(B, S, MLA_HEADS, MLA_QK)
    kv = (_rmsnorm(c_kv, kv_lora_g) @ w_ukv).reshape(B, S, MLA_HEADS, MLA_NOPE + MLA_V)
    k = jnp.concatenate([kv[..., :MLA_NOPE],
                         jnp.broadcast_to(k_pe[:, :, None, :], (B, S, MLA_HEADS, MLA_ROPE))], axis=-1)
    q = _rmsnorm(q, mla_qn)
    k = _rmsnorm(k, mla_kn)
    q = jnp.concatenate([q[..., :MLA_NOPE], _rope(q[..., MLA_NOPE:], pos, MLA_ROPE)], axis=-1)
    k = jnp.concatenate([k[..., :MLA_NOPE], _rope(k[..., MLA_NOPE:], pos, MLA_ROPE)], axis=-1)
    o_a = _dense_blocked_attention(q, k, kv[..., MLA_NOPE:])
    qkv = z_b.reshape(B, S, 3, DIL_HEADS, HEAD_DIM)
    qb = _rope(_rmsnorm(qkv[:, :, 0], dil_qn), pos, PARTIAL_ROT)
    kb = _rope(_rmsnorm(qkv[:, :, 1], dil_kn), pos, PARTIAL_ROT)
    o_b = _dilated_mixture(qb, kb, qkv[:, :, 2])
    return jnp.concatenate([o_a, o_b], axis=-1) @ w_out


def _odd_mixer(h, w_qkv, qn, kn, rpb, w_out):
    B, S, _ = h.shape
    qkv = (h @ w_qkv).reshape(B, S, 3, NA_HEADS, HEAD_DIM)
    q = _rmsnorm(qkv[:, :, 0], qn)
    k = _rmsnorm(qkv[:, :, 1], kn)
    return _neighborhood_attention(q, k, qkv[:, :, 2], rpb) @ w_out


def _conv_ffn(h, w_gate, w_up, conv_w, conv_b, w_down):
    a = h @ w_gate
    ap = jnp.pad(a, ((0, 0), (1, 1), (0, 0)))
    a = ap[:, :-2] * conv_w[0] + ap[:, 1:-1] * conv_w[1] + ap[:, 2:] * conv_w[2] + conv_b
    return (jax.nn.silu(a) * (h @ w_up)) @ w_down


def setup_inputs(seed: int = 0) -> dict:
    key = jax.random.key(seed)
    ks = iter(jax.random.split(key, 32))
    f32 = jnp.float32

    def w(shape, fan_in):
        return jax.random.normal(next(ks), shape, f32) * (fan_in ** -0.5)

    def gain(shape):
        return 1.0 + 0.02 * jax.random.normal(next(ks), shape, f32)

    return {
        'x': jax.random.normal(next(ks), (BATCH, SEQ, D_MODEL), f32),
        'e_norm': gain((N_EVEN, D_MODEL)),
        'e_w_in': w((N_EVEN, D_MODEL, EVEN_IN), D_MODEL),
        'e_q_lora_norm': gain((N_EVEN, MLA_Q_RANK)),
        'e_kv_lora_norm': gain((N_EVEN, MLA_KV_RANK)),
        'e_w_uq': w((N_EVEN, MLA_Q_RANK, MLA_HEADS * MLA_QK), MLA_Q_RANK),
        'e_w_ukv': w((N_EVEN, MLA_KV_RANK, MLA_HEADS * (MLA_NOPE + MLA_V)), MLA_KV_RANK),
        'e_mla_q_norm': gain((N_EVEN, MLA_QK)),
        'e_mla_k_norm': gain((N_EVEN, MLA_QK)),
        'e_dil_q_norm': gain((N_EVEN, HEAD_DIM)),
        'e_dil_k_norm': gain((N_EVEN, HEAD_DIM)),
        'e_w_out': w((N_EVEN, EVEN_MIX, D_MODEL), EVEN_MIX),
        'o_norm': gain((N_ODD, D_MODEL)),
        'o_w_qkv': w((N_ODD, D_MODEL, 3 * ODD_MIX), D_MODEL),
        'o_q_norm': gain((N_ODD, HEAD_DIM)),
        'o_k_norm': gain((N_ODD, HEAD_DIM)),
        'o_rpb': 0.1 * jax.random.normal(next(ks), (N_ODD, NA_HEADS, 2 * NA_ROWS - 1, 2 * NA_COLS - 1), f32),
        'o_w_out': w((N_ODD, ODD_MIX, D_MODEL), ODD_MIX),
        'f_norm': gain((DEPTH, D_MODEL)),
        'f_w_gate': w((DEPTH, D_MODEL, D_FF), D_MODEL),
        'f_w_up': w((DEPTH, D_MODEL, D_FF), D_MODEL),
        'f_conv_w': w((DEPTH, CONV_WIDTH, D_FF), CONV_WIDTH),
        'f_conv_b': 0.02 * jax.random.normal(next(ks), (DEPTH, D_FF), f32),
        'f_w_down': w((DEPTH, D_FF, D_MODEL), D_FF),
    }


def reference(x, e_norm, e_w_in, e_q_lora_norm, e_kv_lora_norm, e_w_uq, e_w_ukv, e_mla_q_norm,
              e_mla_k_norm, e_dil_q_norm, e_dil_k_norm, e_w_out, o_norm, o_w_qkv, o_q_norm,
              o_k_norm, o_rpb, o_w_out, f_norm, f_w_gate, f_w_up, f_conv_w, f_conv_b, f_w_down):
    S = x.shape[1]
    pos = jnp.arange(S, dtype=jnp.int32)
    for layer in range(DEPTH):
        i = layer // 2
        if layer % 2 == 0:
            x = x + _even_mixer(_rmsnorm(x, e_norm[i]), pos, e_w_in[i], e_q_lora_norm[i],
                                e_kv_lora_norm[i], e_w_uq[i], e_w_ukv[i], e_mla_q_norm[i],
                                e_mla_k_norm[i], e_dil_q_norm[i], e_dil_k_norm[i], e_w_out[i])
        else:
            x = x + _odd_mixer(_rmsnorm(x, o_norm[i]), o_w_qkv[i], o_q_norm[i], o_k_norm[i],
                               o_rpb[i], o_w_out[i])
        x = x + _conv_ffn(_rmsnorm(x, f_norm[layer]), f_w_gate[layer], f_w_up[layer],
                          f_conv_w[layer], f_conv_b[layer], f_w_down[layer])
    return x
```

```cpp
#include <hip/hip_runtime.h>
#include <cstdio>
#include <cstdint>
#ifndef MK_CHECK
#define MK_CHECK 0
#endif
namespace pg8 {
#define PG8_LAS __attribute__((address_space(3)))
typedef unsigned short bf16_t;
typedef short bf16x8 __attribute__((ext_vector_type(8)));
typedef float f32x4 __attribute__((ext_vector_type(4)));
typedef unsigned u32x4 __attribute__((ext_vector_type(4)));
typedef unsigned u32x2 __attribute__((ext_vector_type(2)));
constexpr int BM = 256, BK = 64, HALF = 128, HTB = HALF * BK * 2  , STAGE_BYTES = 8 * HTB, NXCD = 8, WGM = 8;

__host__ __device__ __forceinline__ int lds_byte(int r, int c) { const int st = (r >> 4) * 2 + (c >> 5), rr = r & 15, cc = c & 31, ob = rr * 64 + cc * 2; return st * 1024 + (ob ^ (((ob >> 9) & 1) << 5)); }
__host__ __device__ __forceinline__ void stage_rc(int b, int& R, int& C) { const int st = b / 1024, sb = b % 1024, swz = sb ^ (((sb >> 9) & 1) << 5); R = (st >> 1) * 16 + swz / 64; C = (st & 1) * 32 + (swz % 64) / 2; }
__host__ __device__ __forceinline__ int perm32(int rho) { const int n = rho >> 4, i = rho & 15; return 8 * (i >> 2) + 4 * n + (i & 3); }

struct Unit { int pm, pn, kb, kn, role, slot; };
struct Gemm { const bf16_t* A; const bf16_t* Bt; int M, N, K, lda; };

struct StaticOrder {
    int nM, nN, nwg, G, c, ntk; float* scr; unsigned* flg;
    __host__ __device__ void init(int M, int N, int G_, int c_, int ntk_ = 0, float* scr_ = nullptr, unsigned* flg_ = nullptr) { nM = M / BM; nN = N / BM; nwg = nM * nN; G = G_; c = c_; ntk = ntk_; scr = scr_; flg = flg_; }
    __host__ __device__ bool next(int i, Unit& u) const {
        long L = (long)i * G + c; u.kb = 0; u.kn = ntk; u.role = 0; u.slot = 0;
        if (scr != nullptr) { const int full = nwg / G, rem = nwg - full * G;
            if (rem > 0 && 2 * rem <= G && i == full) {
                if (c < rem) { u.role = 1; u.kn = ntk / 2; u.slot = c; }
                else if (c < 2 * rem) { L -= rem; u.role = 2; u.kb = ntk / 2; u.kn = ntk - ntk / 2; u.slot = c - rem; }
                else return false; } }
        if (L >= nwg) return false;
        int wgid = (int)L; { const int q = nwg / NXCD, r = nwg % NXCD, xcd = wgid % NXCD, off = wgid / NXCD; wgid = (xcd < r ? xcd * (q + 1) : r * (q + 1) + (xcd - r) * q) + off; }
        const int nig = WGM * nN, gid = wgid / nig, fm = gid * WGM, gsz = (nM - fm) < WGM ? (nM - fm) : WGM;
        u.pm = fm + ((wgid % nig) % gsz); u.pn = (wgid % nig) / gsz; return true;
    }
    __device__ __forceinline__ void a_ready(const Unit&) const {}
    __device__ __forceinline__ void done(const Unit&) const {}
};

__device__ __forceinline__ unsigned cvt_pk_bf16(float lo, float hi) { unsigned r; asm volatile("v_cvt_pk_bf16_f32 %0, %1, %2" : "=v"(r) : "v"(lo), "v"(hi)); return r; }
__device__ __forceinline__ float bf_lo(unsigned w) { return __uint_as_float(w << 16); }
__device__ __forceinline__ float bf_hi(unsigned w) { return __uint_as_float(w & 0xffff0000u); }

struct EpiScaleBf16 {
    static constexpr bool PERM = true, AFTER_DRAIN = false;
    bf16_t* O; int ldc; const float* rstd;
    __device__ __forceinline__ void operator()(const f32x4 (&acc)[2][2][4][2], const Unit& u, int wr, int wc, int fr, int fq) const {
        const int row0 = u.pm * BM + wr * 64 + fr, col0 = u.pn * BM + wc * 32 + 8 * fq;
#pragma unroll
        for (int ai = 0; ai < 2; ++ai)
#pragma unroll
            for (int m = 0; m < 4; ++m) { const int row = row0 + ai * HALF + m * 16; const float s = rstd ? rstd[row] : 1.f; bf16_t* rowp = O + (size_t)row * ldc + col0;
#pragma unroll
                for (int bj = 0; bj < 2; ++bj) { const f32x4 v0 = acc[ai][bj][m][0] * s, v1 = acc[ai][bj][m][1] * s;
                    u32x4 w; w.x = cvt_pk_bf16(v0[0], v0[1]); w.y = cvt_pk_bf16(v0[2], v0[3]); w.z = cvt_pk_bf16(v1[0], v1[1]); w.w = cvt_pk_bf16(v1[2], v1[3]);
                    *(u32x4*)(rowp + bj * HALF) = w; } }
    }
};
struct EpiHeadNorm {
    static constexpr bool PERM = true, AFTER_DRAIN = false;
    bf16_t* O; int ldc; const float* rstd; const float* qn; const float* kn; float qscale; int ntq, ntk; PG8_LAS float* ex;
    const float* rcos; const float* rsin; int seq;
    template <int AI, int MM, int BJ> __device__ __forceinline__ void put(unsigned wb, float s) const { asm volatile("ds_write_b32 %0, %1 offset:%2" :: "v"(wb), "v"(s), "i"((AI * 1024 + MM * 128 + BJ * 4) * 4) : "memory"); }
    template <int AI, int MM, int BJ> __device__ __forceinline__ f32x4 get(unsigned rb) const { f32x4 p; asm volatile("ds_read_b128 %0, %1 offset:%2" : "=&v"(p) : "v"(rb), "i"((AI * 1024 + MM * 128 + BJ * 4) * 4) : "memory"); return p; }
    template <int AI, int MM> __device__ __forceinline__ void part(const f32x4 (&acc)[2][2][4][2], unsigned wb, int fq) const {
#pragma unroll
        for (int bj = 0; bj < 2; ++bj) { const f32x4 v0 = acc[AI][bj][MM][0], v1 = acc[AI][bj][MM][1];
            float s = (v0[0] * v0[0] + v0[1] * v0[1]) + (v0[2] * v0[2] + v0[3] * v0[3]) + (v1[0] * v1[0] + v1[1] * v1[1]) + (v1[2] * v1[2] + v1[3] * v1[3]);
            s += __shfl_xor(s, 16); s += __shfl_xor(s, 32);
            if (fq == 0) { if (bj == 0) put<AI, MM, 0>(wb, s); else put<AI, MM, 1>(wb, s); } }
    }
    template <int AI, int MM> __device__ __forceinline__ void fin(const f32x4 (&acc)[2][2][4][2], unsigned rb, int row, int col0, const float* gp, float gs, int wc, int fq) const {
        bf16_t* rowp = O + (size_t)row * ldc + col0; const float rsv = rstd[row], r2 = rsv * rsv;
        const f32x4 g0 = *(const f32x4*)gp * gs, g1 = *(const f32x4*)(gp + 4) * gs;
        const f32x4 pa = get<AI, MM, 0>(rb), pb = get<AI, MM, 1>(rb);
        asm volatile("s_waitcnt lgkmcnt(0)" ::: "memory"); __builtin_amdgcn_sched_barrier(0);
#pragma unroll
        for (int bj = 0; bj < 2; ++bj) { const f32x4 p = bj ? pb : pa;
            const float tot = ((p[0] + p[1]) + (p[2] + p[3])) * r2;
            const float hn = rsv / sqrtf(tot * (1.0f / 128.0f) + 1e-6f);
            f32x4 v0 = acc[AI][bj][MM][0] * hn * g0, v1 = acc[AI][bj][MM][1] * hn * g1;
            if (rcos != nullptr && wc == 0) {
                const int pos = row & (seq - 1); const float* cp = rcos + pos * 16 + 8 * (fq & 1); const float* sp = rsin + pos * 16 + 8 * (fq & 1);
                const f32x4 c0 = *(const f32x4*)cp, c1 = *(const f32x4*)(cp + 4); f32x4 s0 = *(const f32x4*)sp, s1 = *(const f32x4*)(sp + 4);
                if (fq < 2) { s0 = -s0; s1 = -s1; }
                f32x4 p0, p1;
#pragma unroll
                for (int e = 0; e < 4; ++e) { p0[e] = __shfl_xor(v0[e], 32); p1[e] = __shfl_xor(v1[e], 32); }
                v0 = v0 * c0 + p0 * s0; v1 = v1 * c1 + p1 * s1; }
            u32x4 w; w.x = cvt_pk_bf16(v0[0], v0[1]); w.y = cvt_pk_bf16(v0[2], v0[3]); w.z = cvt_pk_bf16(v1[0], v1[1]); w.w = cvt_pk_bf16(v1[2], v1[3]);
            *(u32x4*)(rowp + bj * HALF) = w; }
    }
    __device__ __forceinline__ void operator()(const f32x4 (&acc)[2][2][4][2], const Unit& u, int wr, int wc, int fr, int fq) const {
        const int row0 = u.pm * BM + wr * 64 + fr, col0 = u.pn * BM + wc * 32 + 8 * fq; const int type = u.pn < ntq ? 0 : (u.pn < ntq + ntk ? 1 : 2);
        if (type < 2) {
            const unsigned rb = (unsigned)(uintptr_t)ex + (unsigned)((wr * 64 + fr) * 8 * 4), wb = rb + (unsigned)(wc * 4);
            part<0, 0>(acc, wb, fq); part<0, 1>(acc, wb, fq); part<0, 2>(acc, wb, fq); part<0, 3>(acc, wb, fq); part<1, 0>(acc, wb, fq); part<1, 1>(acc, wb, fq); part<1, 2>(acc, wb, fq); part<1, 3>(acc, wb, fq);
            asm volatile("s_waitcnt lgkmcnt(0)" ::: "memory"); __builtin_amdgcn_s_barrier(); asm volatile("" ::: "memory");
            const float* gp = (type == 0 ? qn : kn) + wc * 32 + 8 * fq; const float gs = type == 0 ? qscale : 1.0f;
            fin<0, 0>(acc, rb, row0, col0, gp, gs, wc, fq); fin<0, 1>(acc, rb, row0 + 16, col0, gp, gs, wc, fq); fin<0, 2>(acc, rb, row0 + 32, col0, gp, gs, wc, fq); fin<0, 3>(acc, rb, row0 + 48, col0, gp, gs, wc, fq);
            fin<1, 0>(acc, rb, row0 + HALF, col0, gp, gs, wc, fq); fin<1, 1>(acc, rb, row0 + HALF + 16, col0, gp, gs, wc, fq); fin<1, 2>(acc, rb, row0 + HALF + 32, col0, gp, gs, wc, fq); fin<1, 3>(acc, rb, row0 + HALF + 48, col0, gp, gs, wc, fq);
        } else {
#pragma unroll
            for (int ai = 0; ai < 2; ++ai)
#pragma unroll
                for (int m = 0; m < 4; ++m) { bf16_t* rowp = O + (size_t)(row0 + ai * HALF + m * 16) * ldc + col0; const float sc = rstd[row0 + ai * HALF + m * 16];
#pragma unroll
                    for (int bj = 0; bj < 2; ++bj) { const f32x4 v0 = acc[ai][bj][m][0] * sc, v1 = acc[ai][bj][m][1] * sc;
                        u32x4 w; w.x = cvt_pk_bf16(v0[0], v0[1]); w.y = cvt_pk_bf16(v0[2], v0[3]); w.z = cvt_pk_bf16(v1[0], v1[1]); w.w = cvt_pk_bf16(v1[2], v1[3]);
                        *(u32x4*)(rowp + bj * HALF) = w; } }
        }
    }
};
#ifndef RESID_LOW
#define RESID_LOW 0
#endif
template <int MODE> struct EpiResidT {
    static constexpr bool PERM = true, AFTER_DRAIN = false;
    const float* basef; float* outf; bf16_t* xb; bf16_t* xl0; bf16_t* xl1; float* ss; int ldc;
    __device__ __forceinline__ void operator()(const f32x4 (&acc)[2][2][4][2], const Unit& u, int wr, int wc, int fr, int fq) const {
        const int row0 = u.pm * BM + wr * 64 + fr, col0 = u.pn * BM + wc * 32 + 8 * fq; bf16_t* xl = u.pm < 32 ? xl0 : xl1;
#pragma unroll
        for (int ai = 0; ai < 2; ++ai)
#pragma unroll
            for (int m = 0; m < 4; ++m) { const int row = row0 + ai * HALF + m * 16; const size_t off = (size_t)row * ldc + col0; float s = 0.f;
#pragma unroll
                for (int bj = 0; bj < 2; ++bj) { f32x4 b0, b1;
                    if constexpr (MODE == 0) { b0 = *(const f32x4*)(basef + off + bj * HALF); b1 = *(const f32x4*)(basef + off + bj * HALF + 4); }
                    else { const u32x4 hb = *(const u32x4*)(xb + off + bj * HALF); u32x4 lb = {0u, 0u, 0u, 0u}; if constexpr (RESID_LOW) lb = *(const u32x4*)(xl + off + bj * HALF);
                        b0[0] = bf_lo(hb.x) + bf_lo(lb.x); b0[1] = bf_hi(hb.x) + bf_hi(lb.x); b0[2] = bf_lo(hb.y) + bf_lo(lb.y); b0[3] = bf_hi(hb.y) + bf_hi(lb.y);
                        b1[0] = bf_lo(hb.z) + bf_lo(lb.z); b1[1] = bf_hi(hb.z) + bf_hi(lb.z); b1[2] = bf_lo(hb.w) + bf_lo(lb.w); b1[3] = bf_hi(hb.w) + bf_hi(lb.w); }
                    const f32x4 v0 = b0 + acc[ai][bj][m][0], v1 = b1 + acc[ai][bj][m][1];
                    if constexpr (MODE == 2 || MK_CHECK) { *(f32x4*)(outf + off + bj * HALF) = v0; *(f32x4*)(outf + off + bj * HALF + 4) = v1; }
                    if constexpr (MODE != 2) {
                        u32x4 w; w.x = cvt_pk_bf16(v0[0], v0[1]); w.y = cvt_pk_bf16(v0[2], v0[3]); w.z = cvt_pk_bf16(v1[0], v1[1]); w.w = cvt_pk_bf16(v1[2], v1[3]);
                        u32x4 l; l.x = cvt_pk_bf16(v0[0] - bf_lo(w.x), v0[1] - bf_hi(w.x)); l.y = cvt_pk_bf16(v0[2] - bf_lo(w.y), v0[3] - bf_hi(w.y));
                                 l.z = cvt_pk_bf16(v1[0] - bf_lo(w.z), v1[1] - bf_hi(w.z)); l.w = cvt_pk_bf16(v1[2] - bf_lo(w.w), v1[3] - bf_hi(w.w));
                        *(u32x4*)(xb + off + bj * HALF) = w; if constexpr (RESID_LOW) *(u32x4*)(xl + off + bj * HALF) = l;
                        s += (v0[0] * v0[0] + v0[1] * v0[1]) + (v0[2] * v0[2] + v0[3] * v0[3]) + (v1[0] * v1[0] + v1[1] * v1[1]) + (v1[2] * v1[2] + v1[3] * v1[3]); } }
                if constexpr (MODE != 2) { s += __shfl_xor(s, 16); s += __shfl_xor(s, 32);
                    if (fq == 0) ss[(size_t)row * 64 + u.pn * 4 + wc] = s; } }
    }
};
struct EpiUpConv {
    static constexpr bool PERM = true, AFTER_DRAIN = false;
    const bf16_t* a; bf16_t* h2; const float* rstd; const float* cw; const float* cb; int ldc; int seq;
    __device__ __forceinline__ void operator()(const f32x4 (&acc)[2][2][4][2], const Unit& u, int wr, int wc, int fr, int fq) const {
        const int row0 = u.pm * BM + wr * 64 + fr, col0 = u.pn * BM + wc * 32 + 8 * fq;
#pragma unroll
        for (int bj = 0; bj < 2; ++bj) { const int c = col0 + bj * HALF;
            float w0[8], w1[8], w2[8], b[8];
#pragma unroll
            for (int h = 0; h < 2; ++h) { const f32x4 t0 = *(const f32x4*)(cw + c + 4 * h), t1 = *(const f32x4*)(cw + ldc + c + 4 * h), t2 = *(const f32x4*)(cw + 2 * ldc + c + 4 * h), t3 = *(const f32x4*)(cb + c + 4 * h);
#pragma unroll
                for (int j = 0; j < 4; ++j) { w0[4 * h + j] = t0[j]; w1[4 * h + j] = t1[j]; w2[4 * h + j] = t2[j]; b[4 * h + j] = t3[j]; } }
#pragma unroll
            for (int ai = 0; ai < 2; ++ai)
#pragma unroll
                for (int m = 0; m < 4; ++m) { const int row = row0 + ai * HALF + m * 16; const int t = row & (seq - 1); const float s = rstd[row];
                    const bf16_t* ap = a + (size_t)row * ldc + c;
                    const u32x4 z4 = {0u, 0u, 0u, 0u};
                    const u32x4 a0 = *(const u32x4*)ap; const u32x4 am = t > 0 ? *(const u32x4*)(ap - ldc) : z4; const u32x4 an = t < seq - 1 ? *(const u32x4*)(ap + ldc) : z4;
                    float hv[8];
#pragma unroll
                    for (int j = 0; j < 8; ++j) { const unsigned wm = am[j >> 1], wz = a0[j >> 1], wn = an[j >> 1];
                        const float fm = (j & 1) ? bf_hi(wm) : bf_lo(wm), fz = (j & 1) ? bf_hi(wz) : bf_lo(wz), fn = (j & 1) ? bf_hi(wn) : bf_lo(wn);
                        const float g = w0[j] * fm + w1[j] * fz + w2[j] * fn + b[j];
                        const float e = __builtin_amdgcn_exp2f(-1.4426950408889634f * g);
                        const float sg = g * __builtin_amdgcn_rcpf(1.0f + e);
                        const float up = (j < 4 ? acc[ai][bj][m][0][j & 3] : acc[ai][bj][m][1][j & 3]) * s;
                        hv[j] = sg * up; }
                    u32x4 w; w.x = cvt_pk_bf16(hv[0], hv[1]); w.y = cvt_pk_bf16(hv[2], hv[3]); w.z = cvt_pk_bf16(hv[4], hv[5]); w.w = cvt_pk_bf16(hv[6], hv[7]);
                    *(u32x4*)(h2 + (size_t)row * ldc + c) = w; } }
    }
};
template <int CTRL> __device__ __forceinline__ float dpp_rot(float v) { return __builtin_bit_cast(float, __builtin_amdgcn_update_dpp(0, __builtin_bit_cast(int, v), CTRL, 0xF, 0xF, false)); }
struct EpiGateUp {
    static constexpr bool PERM = true, AFTER_DRAIN = false;
    bf16_t* h2; const float* rstd; const float* cw; const float* cb; int ldc; bf16_t* aedge; bf16_t* uedge; PG8_LAS float* ex;
    __device__ __forceinline__ void operator()(const f32x4 (&acc)[2][2][4][2], const Unit& u, int wr, int wc, int fr, int fq) const {
        const int row0 = u.pm * BM + wr * 64 + fr, ch = u.pn * HALF + wc * 32 + 8 * fq;
        f32x4 av[2][4][2], uv[2][4][2];
#pragma unroll
        for (int ai = 0; ai < 2; ++ai)
#pragma unroll
            for (int m = 0; m < 4; ++m) { const float r = rstd[row0 + ai * HALF + m * 16];
                av[ai][m][0] = acc[ai][0][m][0] * r; av[ai][m][1] = acc[ai][0][m][1] * r; uv[ai][m][0] = acc[ai][1][m][0] * r; uv[ai][m][1] = acc[ai][1][m][1] * r; }
        const unsigned eb = (unsigned)(uintptr_t)ex + (unsigned)((wc * 4 + fq) * 32);
#pragma unroll
        for (int ai = 0; ai < 2; ++ai) { const int gidx = 2 * ai + wr;
            if (fr == 0) { const unsigned a0 = eb + (unsigned)((gidx * 2 + 0) * 512);
                asm volatile("ds_write_b128 %0, %1\n\tds_write_b128 %0, %2 offset:16" :: "v"(a0), "v"(av[ai][0][0]), "v"(av[ai][0][1]) : "memory"); }
            if (fr == 15) { const unsigned a1 = eb + (unsigned)((gidx * 2 + 1) * 512);
                asm volatile("ds_write_b128 %0, %1\n\tds_write_b128 %0, %2 offset:16" :: "v"(a1), "v"(av[ai][3][0]), "v"(av[ai][3][1]) : "memory"); } }
        asm volatile("s_waitcnt lgkmcnt(0)" ::: "memory"); __builtin_amdgcn_s_barrier(); asm volatile("" ::: "memory");
        unsigned pk[2][4][2][2];
#pragma unroll
        for (int h = 0; h < 2; ++h) {
            const f32x4 w0 = *(const f32x4*)(cw + ch + 4 * h), w1 = *(const f32x4*)(cw + ldc + ch + 4 * h), w2 = *(const f32x4*)(cw + 2 * ldc + ch + 4 * h), bb = *(const f32x4*)(cb + ch + 4 * h);
#pragma unroll
            for (int ai = 0; ai < 2; ++ai) { const int gidx = 2 * ai + wr;
                f32x4 rrp, nx;
                { const unsigned ap = eb + (unsigned)(((gidx > 0 ? gidx - 1 : 0) * 2 + 1) * 512 + 16 * h), an = eb + (unsigned)(((gidx < 3 ? gidx + 1 : 3) * 2 + 0) * 512 + 16 * h);
                  asm volatile("ds_read_b128 %0, %2\n\tds_read_b128 %1, %3\n\ts_waitcnt lgkmcnt(0)" : "=&v"(rrp), "=&v"(nx) : "v"(ap), "v"(an) : "memory"); }
                f32x4 rlc;
#pragma unroll
                for (int j = 0; j < 4; ++j) rlc[j] = dpp_rot<0x12F>(av[ai][0][h][j]);
#pragma unroll
                for (int m = 0; m < 4; ++m) { const int row = row0 + ai * HALF + m * 16;
                    float hv[4];
#pragma unroll
                    for (int j = 0; j < 4; ++j) { const float cur = av[ai][m][h][j];
                        const float rr = dpp_rot<0x121>(cur);
                        float rln;
                        if (m < 3) rln = dpp_rot<0x12F>(av[ai][m + 1][h][j]); else rln = nx[j];
                        const float prev = fr != 0 ? rr : rrp[j], next = fr != 15 ? rlc[j] : rln;
                        rrp[j] = rr; rlc[j] = rln;
                        const float g = w0[j] * prev + w1[j] * cur + w2[j] * next + bb[j];
                        const float e = __builtin_amdgcn_exp2f(-1.4426950408889634f * g);
                        hv[j] = g * __builtin_amdgcn_rcpf(1.0f + e) * uv[ai][m][h][j]; }
                    pk[ai][m][h][0] = cvt_pk_bf16(hv[0], hv[1]); pk[ai][m][h][1] = cvt_pk_bf16(hv[2], hv[3]);
                    if ((m == 0 && gidx == 0 && fr < 2) || (m == 3 && gidx == 3 && fr >= 14)) {
                        const int e4 = (m == 0) ? fr : fr - 12;
                        u32x2 w; w.x = cvt_pk_bf16(av[ai][m][h][0], av[ai][m][h][1]); w.y = cvt_pk_bf16(av[ai][m][h][2], av[ai][m][h][3]);
                        *(u32x2*)(aedge + ((size_t)u.pm * 4 + e4) * ldc + ch + 4 * h) = w;
                        if (e4 == 0 || e4 == 3) { u32x2 wu; wu.x = cvt_pk_bf16(uv[ai][m][h][0], uv[ai][m][h][1]); wu.y = cvt_pk_bf16(uv[ai][m][h][2], uv[ai][m][h][3]);
                            *(u32x2*)(uedge + ((size_t)u.pm * 2 + (e4 == 3 ? 1 : 0)) * ldc + ch + 4 * h) = wu; } }
                    if (h == 1) { const bool first = (m == 0 && gidx == 0 && fr == 0), last = (m == 3 && gidx == 3 && fr == 15);
                        if (!first && !last) { u32x4 w; w.x = pk[ai][m][0][0]; w.y = pk[ai][m][0][1]; w.z = pk[ai][m][1][0]; w.w = pk[ai][m][1][1];
                            *(u32x4*)(h2 + (size_t)row * ldc + ch) = w; } }
                } }
        }
    }
};
template <class Epi, class Sched, bool ALIGN_EPI = false, bool SP2 = false, bool SPLITK = false>
__device__ __forceinline__ void gemm_phase(PG8_LAS unsigned char* lds, const Gemm g, const Sched& S, const Epi& E) {
    const int tid = threadIdx.x, wid = __builtin_amdgcn_readfirstlane(tid >> 6), lane = tid & 63, wr = wid >> 2, wc = wid & 3, fr = lane & 15, fq = lane >> 4;
    const int K = g.K, nt = K / BK;
    unsigned voffA[2], voffB[2];
#pragma unroll
    for (int i = 0; i < 2; ++i) { int R, C; stage_rc(tid * 16 + i * 8192, R, C); const int Rb = Epi::PERM ? ((R & ~31) + perm32(R & 31)) : R;
        voffA[i] = (unsigned)(R * g.lda + C) * 2u; voffB[i] = (unsigned)(Rb * K + C) * 2u; }
    const size_t kstep = (size_t)(BK * 2);
    const size_t hstepB = (size_t)HALF * K * 2, hstepA = (size_t)HALF * g.lda * 2;
    const size_t tstepB = 2 * hstepB, tstepA = 2 * hstepA;
    const unsigned ldsw = (unsigned)wid * 1024u;
    const int aoff = lds_byte(wr * 64 + fr, fq * 8), boff = lds_byte(wc * 32 + fr, fq * 8);
#define PG8_SA(b, h) (((b) * 2 + (h)) * HTB)
#define PG8_SB(b, h) ((4 + (b) * 2 + (h)) * HTB)
#define PG8_STAGE(bufoff, gbase, voff) do { _Pragma("unroll") for (int _i = 0; _i < 2; ++_i) \
        __builtin_amdgcn_global_load_lds((const unsigned*)((const char*)(gbase) + (voff)[_i]), (PG8_LAS unsigned*)(lds + (bufoff) + ldsw + _i * 8192), 16, 0, 0); } while (0)
#define PG8_LDA(dst, b, h) do { _Pragma("unroll") for (int m = 0; m < 4; ++m) _Pragma("unroll") for (int k = 0; k < 2; ++k) dst[m][k] = *(const PG8_LAS bf16x8*)(lds + PG8_SA(b, h) + aoff + m * 2048 + k * 1024); } while (0)
#define PG8_LDB(dst, b, h) do { _Pragma("unroll") for (int n = 0; n < 2; ++n) _Pragma("unroll") for (int k = 0; k < 2; ++k) dst[n][k] = *(const PG8_LAS bf16x8*)(lds + PG8_SB(b, h) + boff + n * 2048 + k * 1024); } while (0)
#define PG8_MMA(ai, bj, At, Bt) do { __builtin_amdgcn_s_setprio(1); _Pragma("unroll") for (int m = 0; m < 4; ++m) _Pragma("unroll") for (int n = 0; n < 2; ++n) _Pragma("unroll") for (int k = 0; k < 2; ++k) \
        acc[ai][bj][m][n] = __builtin_amdgcn_mfma_f32_16x16x32_bf16(Bt[n][k], At[m][k], acc[ai][bj][m][n], 0, 0, 0); __builtin_amdgcn_s_setprio(0); } while (0)
#define PG8_WAIT_V(n) asm volatile("s_waitcnt vmcnt(" #n ")" ::: "memory")
#define PG8_WAIT_L(n) asm volatile("s_waitcnt lgkmcnt(" #n ")" ::: "memory")
#define PG8_BAR __builtin_amdgcn_s_barrier()
#define PG8_SCHED __builtin_amdgcn_sched_barrier(0)
    Unit cur, nxt; int ui = 0;
    if (!S.next(0, cur)) return;
    f32x4 acc[2][2][4][2];
#pragma unroll
    for (int a = 0; a < 2; ++a)
#pragma unroll
        for (int b = 0; b < 2; ++b)
#pragma unroll
            for (int m = 0; m < 4; ++m)
#pragma unroll
                for (int n = 0; n < 2; ++n) acc[a][b][m][n] = (f32x4){0.f, 0.f, 0.f, 0.f};
    bf16x8 At[4][2], B0[2][2], B1[2][2];
    const char* cA = (const char*)g.A + (size_t)cur.pm * tstepA; const char* cB = (const char*)g.Bt + (size_t)cur.pn * tstepB;
    if constexpr (SPLITK) { cA += (size_t)cur.kb * kstep; cB += (size_t)cur.kb * kstep; }
    S.a_ready(cur);
    if constexpr (SP2) {
        PG8_STAGE(PG8_SB(0, 0), cB, voffB); PG8_STAGE(PG8_SB(0, 1), cB + hstepB, voffB); PG8_STAGE(PG8_SA(0, 0), cA, voffA); PG8_STAGE(PG8_SA(0, 1), cA + hstepA, voffA);
        if (wr == 1) PG8_BAR;
        PG8_WAIT_V(2); PG8_BAR;
        PG8_STAGE(PG8_SB(1, 0), cB + kstep, voffB); PG8_STAGE(PG8_SA(1, 0), cA + kstep, voffA); PG8_STAGE(PG8_SB(1, 1), cB + hstepB + kstep, voffB);
        PG8_WAIT_V(6); PG8_BAR;
    } else {
        PG8_STAGE(PG8_SB(0, 0), cB, voffB); PG8_STAGE(PG8_SA(0, 0), cA, voffA); PG8_STAGE(PG8_SB(0, 1), cB + hstepB, voffB); PG8_STAGE(PG8_SA(0, 1), cA + hstepA, voffA);
        if (wr == 1) PG8_BAR;
        PG8_WAIT_V(4); PG8_BAR;
        PG8_STAGE(PG8_SB(1, 0), cB + kstep, voffB); PG8_STAGE(PG8_SA(1, 0), cA + kstep, voffA); PG8_STAGE(PG8_SB(1, 1), cB + hstepB + kstep, voffB);
        PG8_WAIT_V(6); PG8_BAR;
    }
    for (;;) {
        const bool has_next = S.next(ui + 1, nxt);
        const char* nA = has_next ? (const char*)g.A + (size_t)nxt.pm * tstepA : cA; const char* nB = has_next ? (const char*)g.Bt + (size_t)nxt.pn * tstepB : cB;
        if constexpr (SPLITK) { if (has_next) { nA += (size_t)nxt.kb * kstep; nB += (size_t)nxt.kb * kstep; } }
        const int ntc = SPLITK ? cur.kn : nt;
        for (int t = 0; t < ntc; t += 2) {
            const bool last = (t == ntc - 2);
            const char* a1 = cA + (size_t)(t + 1) * kstep;
            const char* a2 = last ? nA : cA + (size_t)(t + 2) * kstep; const char* b2 = last ? nB : cB + (size_t)(t + 2) * kstep;
            const char* a3 = a2 + kstep; const char* b3 = b2 + kstep;
            if (last && has_next) S.a_ready(nxt);
            if constexpr (SP2) {
            PG8_LDB(B0, 0, 0); PG8_LDB(B1, 0, 1); PG8_SCHED; PG8_LDA(At, 0, 0); PG8_STAGE(PG8_SA(1, 1), a1 + hstepA, voffA);
            PG8_WAIT_V(8); PG8_WAIT_L(0); PG8_BAR; PG8_MMA(0, 0, At, B0); PG8_MMA(0, 1, At, B1); PG8_BAR; PG8_SCHED;
            PG8_LDA(At, 0, 1); PG8_STAGE(PG8_SB(0, 0), b2, voffB); PG8_STAGE(PG8_SB(0, 1), b2 + hstepB, voffB); PG8_STAGE(PG8_SA(0, 0), a2, voffA);
            PG8_WAIT_V(8); PG8_WAIT_L(0); PG8_BAR; PG8_MMA(1, 0, At, B0); PG8_MMA(1, 1, At, B1); PG8_BAR; PG8_SCHED;
            PG8_LDB(B0, 1, 0); PG8_LDB(B1, 1, 1); PG8_SCHED; PG8_LDA(At, 1, 0); PG8_STAGE(PG8_SA(0, 1), a2 + hstepA, voffA);
            PG8_WAIT_V(8); PG8_WAIT_L(0); PG8_BAR; PG8_MMA(0, 0, At, B0); PG8_MMA(0, 1, At, B1); PG8_BAR; PG8_SCHED;
            PG8_LDA(At, 1, 1); PG8_STAGE(PG8_SB(1, 0), b3, voffB); PG8_STAGE(PG8_SB(1, 1), b3 + hstepB, voffB); PG8_STAGE(PG8_SA(1, 0), a3, voffA);
            PG8_WAIT_V(8); PG8_WAIT_L(0); PG8_BAR; PG8_MMA(1, 0, At, B0); PG8_MMA(1, 1, At, B1); PG8_BAR; PG8_SCHED;
            } else {
            PG8_LDB(B0, 0, 0); PG8_SCHED; PG8_LDA(At, 0, 0); PG8_STAGE(PG8_SA(1, 1), a1 + hstepA, voffA);
            PG8_WAIT_L(8); PG8_BAR; PG8_WAIT_L(0); PG8_MMA(0, 0, At, B0); PG8_BAR; PG8_SCHED;
            PG8_LDB(B1, 0, 1); PG8_STAGE(PG8_SB(0, 0), b2, voffB);
            PG8_BAR; PG8_WAIT_L(0); PG8_MMA(0, 1, At, B1); PG8_BAR;
            PG8_LDA(At, 0, 1); PG8_STAGE(PG8_SA(0, 0), a2, voffA);
            PG8_BAR; PG8_WAIT_L(0); PG8_MMA(1, 0, At, B0); PG8_BAR; PG8_SCHED;
            PG8_STAGE(PG8_SB(0, 1), b2 + hstepB, voffB);
            PG8_WAIT_V(6); PG8_BAR; PG8_MMA(1, 1, At, B1); PG8_BAR;
            PG8_LDB(B0, 1, 0); PG8_SCHED; PG8_LDA(At, 1, 0); PG8_STAGE(PG8_SA(0, 1), a2 + hstepA, voffA);
            PG8_WAIT_L(8); PG8_BAR; PG8_WAIT_L(0); PG8_MMA(0, 0, At, B0); PG8_BAR; PG8_SCHED;
            PG8_LDB(B1, 1, 1); PG8_STAGE(PG8_SB(1, 0), b3, voffB);
            PG8_BAR; PG8_WAIT_L(0); PG8_MMA(0, 1, At, B1); PG8_BAR;
            PG8_LDA(At, 1, 1); PG8_STAGE(PG8_SA(1, 0), a3, voffA);
            PG8_BAR; PG8_WAIT_L(0); PG8_MMA(1, 0, At, B0); PG8_BAR; PG8_SCHED;
            PG8_STAGE(PG8_SB(1, 1), b3 + hstepB, voffB);
            PG8_WAIT_V(6); PG8_BAR; PG8_MMA(1, 1, At, B1); PG8_BAR;
            }
        }
        if constexpr (ALIGN_EPI) { if (wr == 0) PG8_BAR; }
        if constexpr (SPLITK) {
            if (cur.role == 2) {
                const __amdgpu_buffer_rsrc_t rs = __builtin_amdgcn_make_buffer_rsrc((void*)(S.scr + (size_t)cur.slot * 65536), 0, 65536 * 4, 0x00020000);
#pragma unroll
                for (int a = 0; a < 2; ++a)
#pragma unroll
                    for (int b = 0; b < 2; ++b)
#pragma unroll
                        for (int m = 0; m < 4; ++m)
#pragma unroll
                            for (int n = 0; n < 2; ++n)
                                __builtin_amdgcn_raw_buffer_store_b128(__builtin_bit_cast(u32x4, acc[a][b][m][n]), rs, (unsigned)(((wid * 32 + ((a * 2 + b) * 4 + m) * 2 + n) * 64 + lane) * 16), 0, 16);
                PG8_WAIT_V(0); PG8_BAR;
                if (tid == 0) __hip_atomic_store(S.flg + cur.slot * 16, 1u, __ATOMIC_RELAXED, __HIP_MEMORY_SCOPE_AGENT);
            } else {
                if (cur.role == 1) {
                    if (tid == 0) { unsigned spn = 0; while (__hip_atomic_load(S.flg + cur.slot * 16, __ATOMIC_RELAXED, __HIP_MEMORY_SCOPE_AGENT) == 0u) { __builtin_amdgcn_s_sleep(1); if (++spn > (1u << 22)) break; }
                        __builtin_amdgcn_fence(__ATOMIC_ACQUIRE, "agent"); }
                    PG8_WAIT_V(0); PG8_BAR;
                    const float* sp = S.scr + (size_t)cur.slot * 65536 + (size_t)(wid * 32 * 64 + lane) * 4;
#pragma unroll
                    for (int a = 0; a < 2; ++a)
#pragma unroll
                        for (int b = 0; b < 2; ++b) { f32x4 tq[4][2];
#pragma unroll
                            for (int m = 0; m < 4; ++m)
#pragma unroll
                                for (int n = 0; n < 2; ++n) tq[m][n] = *(const f32x4*)(sp + (size_t)((((a * 2 + b) * 4 + m) * 2 + n) * 64) * 4);
#pragma unroll
                            for (int m = 0; m < 4; ++m)
#pragma unroll
                                for (int n = 0; n < 2; ++n) acc[a][b][m][n] += tq[m][n]; }
                }
                E(acc, cur, wr, wc, fr, fq); S.done(cur);
            }
        } else
        if constexpr (!Epi::AFTER_DRAIN) { E(acc, cur, wr, wc, fr, fq); S.done(cur); }
        if (!has_next) break;
#pragma unroll
        for (int a = 0; a < 2; ++a)
#pragma unroll
            for (int b = 0; b < 2; ++b)
#pragma unroll
                for (int m = 0; m < 4; ++m)
#pragma unroll
                    for (int n = 0; n < 2; ++n) acc[a][b][m][n] = (f32x4){0.f, 0.f, 0.f, 0.f};
        cur = nxt; cA = nA; cB = nB; ++ui;
        if constexpr (ALIGN_EPI) { if (wr == 1) PG8_BAR; }
    }
    PG8_WAIT_V(0);
    if constexpr (!ALIGN_EPI) { if (wr == 0) PG8_BAR; }
    PG8_BAR;
    if constexpr (Epi::AFTER_DRAIN) { E.fused(acc, cur, wr, wc, fr, fq, lds, wid, lane); S.done(cur); }
#undef PG8_SA
#undef PG8_SB
#undef PG8_STAGE
#undef PG8_LDA
#undef PG8_LDB
#undef PG8_MMA
#undef PG8_WAIT_V
#undef PG8_WAIT_L
#undef PG8_BAR
#undef PG8_SCHED
}
}

namespace mla {
typedef unsigned short bf16;
using bf16x8 = __attribute__((ext_vector_type(8))) short;
using s16x4  = __attribute__((ext_vector_type(4))) short;
using f32x16 = __attribute__((ext_vector_type(16))) float;
using u32x4  = __attribute__((ext_vector_type(4))) unsigned;
constexpr int DQK = 192, DV = 128, NW = 8, QBLK = 32, KVBLK = 64;
constexpr int LDQ = 3072, LDK = 3072, LDV = 4096, LDO = 3072;
constexpr float THR = 11.5f;
constexpr int SHM_V = KVBLK * DV * 2, SHM_K = KVBLK * DQK * 2, SHM_ATTN = 2 * SHM_V + 2 * SHM_K + NW * 64 * 4;
#define MLA_SBAR() __builtin_amdgcn_sched_barrier(0)
#ifndef MLA_QG
#define MLA_QG 4
#endif
__device__ __forceinline__ int crow(int r, int hi) { return (r & 3) + 8 * (r >> 2) + 4 * hi; }
__device__ __forceinline__ unsigned cvtpk(float lo, float hi) { unsigned r; asm volatile("v_cvt_pk_bf16_f32 %0, %1, %2" : "=v"(r) : "v"(lo), "v"(hi)); return r; }
__device__ __forceinline__ void partialSM(f32x16& p0, f32x16& p1, float& m_reg, float& mn, float& alpha) {
  float pmax = p0[0];
#pragma unroll
  for (int r = 1; r < 16; ++r) pmax = fmaxf(pmax, p0[r]);
#pragma unroll
  for (int r = 0; r < 16; ++r) pmax = fmaxf(pmax, p1[r]);
  { auto rr = __builtin_amdgcn_permlane32_swap(__float_as_uint(pmax), __float_as_uint(pmax), false, false);
    pmax = fmaxf(__uint_as_float(rr[0]), __uint_as_float(rr[1])); }
  if (__builtin_expect(__all(pmax - m_reg <= THR), 1)) { mn = m_reg; alpha = 1.f; }
  else { mn = fmaxf(m_reg, pmax); alpha = __builtin_amdgcn_exp2f(m_reg - mn); m_reg = mn; }
#pragma unroll
  for (int r = 0; r < 16; ++r) p0[r] = p0[r] - mn;
#pragma unroll
  for (int r = 0; r < 16; ++r) p1[r] = p1[r] - mn;
#pragma unroll
  for (int r = 0; r < 16; ++r) p0[r] = __builtin_amdgcn_exp2f(p0[r]);
}
__device__ __forceinline__ void finishSM(f32x16& p0, f32x16& p1, float alpha, float& l_reg, bf16x8& pa0, bf16x8& pa1, bf16x8& pa2, bf16x8& pa3) {
#pragma unroll
  for (int r = 0; r < 16; ++r) p1[r] = __builtin_amdgcn_exp2f(p1[r]);
  float ps = 0;
#pragma unroll
  for (int r = 0; r < 16; ++r) ps += p0[r];
#pragma unroll
  for (int r = 0; r < 16; ++r) ps += p1[r];
  { auto rr = __builtin_amdgcn_permlane32_swap(__float_as_uint(ps), __float_as_uint(ps), false, false);
    ps = __uint_as_float(rr[0]) + __uint_as_float(rr[1]); }
  l_reg = l_reg * alpha + ps;
#define MLA_PK4(P, BASE, OUT) do { unsigned a0 = cvtpk(P[BASE + 0], P[BASE + 1]), a1 = cvtpk(P[BASE + 2], P[BASE + 3]);   \
    unsigned b0 = cvtpk(P[BASE + 4], P[BASE + 5]), b1 = cvtpk(P[BASE + 6], P[BASE + 7]);                              \
    auto r0 = __builtin_amdgcn_permlane32_swap(a0, b0, false, false); auto r1 = __builtin_amdgcn_permlane32_swap(a1, b1, false, false); \
    u32x4 w = {r0[0], r1[0], r0[1], r1[1]}; OUT = *reinterpret_cast<bf16x8*>(&w); } while (0)
  MLA_PK4(p0, 0, pa0); MLA_PK4(p0, 8, pa1); MLA_PK4(p1, 0, pa2); MLA_PK4(p1, 8, pa3);
#undef MLA_PK4
}
__device__ __forceinline__ int v_st(int k, int c) { const int kk = (k & ~0xC) | ((k & 4) << 1) | ((k & 8) >> 1); return ((kk >> 3) * 4 + (c >> 5)) * 512 + ((kk & 7) * 32 + (c & 31)) * 2; }
__device__ __forceinline__ int v_rd_base(int lane) { return ((lane & 3) << 3) | (((lane >> 2) & 3) << 6) | (((lane >> 4) & 1) << 5) | (((lane >> 5) & 1) << 8); }
constexpr int v_rd_off(int d0, int ks, int half) { return d0 * 512 + ks * 4096 + half * 2048; }
template <int OFF> __device__ __forceinline__ s16x4 tr_read(int vb) {
  s16x4 r; asm volatile("ds_read_b64_tr_b16 %0, %1 offset:%2" : "=&v"(r) : "v"(vb), "i"(OFF) : "memory"); return r;
}
template <int D0> __device__ __forceinline__ void pv_one(f32x16& od, int vb, bf16x8 pa0, bf16x8 pa1, bf16x8 pa2, bf16x8 pa3) {
  const s16x4 l0 = tr_read<v_rd_off(D0, 0, 0)>(vb), h0 = tr_read<v_rd_off(D0, 0, 1)>(vb), l1 = tr_read<v_rd_off(D0, 1, 0)>(vb), h1 = tr_read<v_rd_off(D0, 1, 1)>(vb);
  const s16x4 l2 = tr_read<v_rd_off(D0, 2, 0)>(vb), h2 = tr_read<v_rd_off(D0, 2, 1)>(vb), l3 = tr_read<v_rd_off(D0, 3, 0)>(vb), h3 = tr_read<v_rd_off(D0, 3, 1)>(vb);
  asm volatile("s_waitcnt lgkmcnt(0)" ::: "memory"); MLA_SBAR();
#define MLA_PK(L, H) (bf16x8){L[0], L[1], L[2], L[3], H[0], H[1], H[2], H[3]}
  od = __builtin_amdgcn_mfma_f32_32x32x16_bf16(pa0, MLA_PK(l0, h0), od, 0, 0, 0);
  od = __builtin_amdgcn_mfma_f32_32x32x16_bf16(pa1, MLA_PK(l1, h1), od, 0, 0, 0);
  od = __builtin_amdgcn_mfma_f32_32x32x16_bf16(pa2, MLA_PK(l2, h2), od, 0, 0, 0);
  od = __builtin_amdgcn_mfma_f32_32x32x16_bf16(pa3, MLA_PK(l3, h3), od, 0, 0, 0);
#undef MLA_PK
}
__device__ __forceinline__ void pv_d0(f32x16* o, int vb, bf16x8 pa0, bf16x8 pa1, bf16x8 pa2, bf16x8 pa3) {
  pv_one<0>(o[0], vb, pa0, pa1, pa2, pa3); pv_one<1>(o[1], vb, pa0, pa1, pa2, pa3); pv_one<2>(o[2], vb, pa0, pa1, pa2, pa3); pv_one<3>(o[3], vb, pa0, pa1, pa2, pa3);
}
constexpr int SHM_ATTN3 = 3 * SHM_V + 2 * SHM_K + NW * 64 * 4;
__device__ __forceinline__ void attn_unit_d(const bf16* __restrict__ Qb, const bf16* __restrict__ Kh, const bf16* __restrict__ Vh, bf16* __restrict__ Ob, int seq, char* lds) {
  typedef __attribute__((address_space(3))) unsigned las_u32;
  const int tid = threadIdx.x, wid = tid >> 6, wu = __builtin_amdgcn_readfirstlane(tid >> 6), lane = tid & 63, r32 = lane & 31, hi = lane >> 5, grp = wid >> 2;
  char* V_lds = lds; char* K_lds = lds + 3 * SHM_V;
  float* ws = (float*)(lds + 3 * SHM_V + 2 * SHM_K) + wid * 64; float* li_l = ws; float* al_l = ws + 32;
  char* Q_lds = lds + SHM_ATTN3 + wid * 4096;
  float m_reg = -1e30f, l_reg = 0; f32x16 o[4] = {}; bf16x8 qr[8];
  const bf16* Qw = Qb + (long)(wid * QBLK + r32) * LDQ + hi * 8;
#pragma unroll
  for (int d0 = 0; d0 < 8; ++d0) qr[d0] = *reinterpret_cast<const bf16x8*>(Qw + d0 * 16);
  const int qsw = (r32 >> 1) & 7; char* qrow = Q_lds + r32 * 128;
#pragma unroll
  for (int d0 = 0; d0 < 4; ++d0) { const bf16x8 t = *reinterpret_cast<const bf16x8*>(Qw + 128 + d0 * 16); *reinterpret_cast<bf16x8*>(qrow + (((2 * d0 + hi) ^ qsw) << 4)) = t; }
  int ksrc[3], vsrc[2];
#pragma unroll
  for (int k = 0; k < 3; ++k) { const int o_ = (wid + 8 * k) * 1024 + lane * 16, r_ = o_ / 384, sc_ = (o_ - r_ * 384) >> 4, c_ = (sc_ & ~7) | ((sc_ & 7) ^ ((r_ >> 1) & 7)); ksrc[k] = (r_ * LDK + c_ * 8) * 2; }
#pragma unroll
  for (int k = 0; k < 2; ++k) { const int o_ = (wid + 8 * k) * 1024 + lane * 16, sub_ = o_ >> 9, w_ = (o_ & 511) >> 1, kk_ = (sub_ >> 2) * 8 + (w_ >> 5), key_ = (kk_ & ~0xC) | ((kk_ & 4) << 1) | ((kk_ & 8) >> 1);
    vsrc[k] = (key_ * LDV + (sub_ & 3) * 32 + (w_ & 31)) * 2; }
  const int vb0 = (int)(uintptr_t)V_lds + v_rd_base(lane);
  const __amdgpu_buffer_rsrc_t krs = __builtin_amdgcn_make_buffer_rsrc((void*)Kh, 0, seq * LDK * 2, 0x00020000);
  const __amdgpu_buffer_rsrc_t vrs = __builtin_amdgcn_make_buffer_rsrc((void*)Vh, 0, seq * LDV * 2, 0x00020000);
#define MLD_ISSUE(k0, bk, bv) do { \
    _Pragma("unroll") for (int k = 0; k < 3; ++k) __builtin_amdgcn_raw_ptr_buffer_load_lds(krs, (las_u32*)(K_lds + (bk) * SHM_K + (wu + 8 * k) * 1024), 16, ksrc[k], (k0) * LDK * 2, 0, 0); \
    _Pragma("unroll") for (int k = 0; k < 2; ++k) __builtin_amdgcn_raw_ptr_buffer_load_lds(vrs, (las_u32*)(V_lds + (bv) * SHM_V + (wu + 8 * k) * 1024), 16, vsrc[k], (k0) * LDV * 2, 0, 0); } while (0)
#define MLD_RD(d0_, A0_, A1_, QF_) do { const int c_ = 2 * (d0_) + hi; const int off_ = (c_ ^ sw) << 4; A0_ = *reinterpret_cast<const bf16x8*>(kb_ + off_); A1_ = *reinterpret_cast<const bf16x8*>(kb_ + 32 * 384 + off_); \
      if ((d0_) >= 8) QF_ = *reinterpret_cast<const bf16x8*>(qrow + (((2 * ((d0_) - 8) + hi) ^ qsw) << 4)); else QF_ = qr[(d0_) < 8 ? (d0_) : 0]; } while (0)
#define MLD_MM(A0_, A1_, QF_) do { p0 = __builtin_amdgcn_mfma_f32_32x32x16_bf16(A0_, QF_, p0, 0, 0, 0); p1 = __builtin_amdgcn_mfma_f32_32x32x16_bf16(A1_, QF_, p1, 0, 0, 0); } while (0)
#define MLD_S(t_) do { const int b_ = (t_) & 1; f32x16 p0 = f32x16{}, p1 = f32x16{}; \
      { const int sw = (r32 >> 1) & 7; const char* kb_ = K_lds + b_ * SHM_K + r32 * 384; \
        bf16x8 xa0, xa1, xq, ya0, ya1, yq; \
        MLD_RD(0, xa0, xa1, xq); \
        MLD_RD(1, ya0, ya1, yq); MLA_SBAR(); MLD_MM(xa0, xa1, xq); MLA_SBAR(); \
        MLD_RD(2, xa0, xa1, xq); MLA_SBAR(); MLD_MM(ya0, ya1, yq); MLA_SBAR(); \
        MLD_RD(3, ya0, ya1, yq); MLA_SBAR(); MLD_MM(xa0, xa1, xq); MLA_SBAR(); \
        MLD_RD(4, xa0, xa1, xq); MLA_SBAR(); MLD_MM(ya0, ya1, yq); MLA_SBAR(); \
        MLD_RD(5, ya0, ya1, yq); MLA_SBAR(); MLD_MM(xa0, xa1, xq); MLA_SBAR(); \
        MLD_RD(6, xa0, xa1, xq); MLA_SBAR(); MLD_MM(ya0, ya1, yq); MLA_SBAR(); \
        MLD_RD(7, ya0, ya1, yq); MLA_SBAR(); MLD_MM(xa0, xa1, xq); MLA_SBAR(); \
        MLD_RD(8, xa0, xa1, xq); MLA_SBAR(); MLD_MM(ya0, ya1, yq); MLA_SBAR(); \
        MLD_RD(9, ya0, ya1, yq); MLA_SBAR(); MLD_MM(xa0, xa1, xq); MLA_SBAR(); \
        MLD_RD(10, xa0, xa1, xq); MLA_SBAR(); MLD_MM(ya0, ya1, yq); MLA_SBAR(); \
        MLD_RD(11, ya0, ya1, yq); MLA_SBAR(); MLD_MM(xa0, xa1, xq); MLA_SBAR(); \
        MLD_MM(ya0, ya1, yq); } \
      float mn; partialSM(p0, p1, m_reg, mn, al); finishSM(p0, p1, al, l_reg, pa0, pa1, pa2, pa3); } while (0)
#define MLD_O(vslot_) do { if (__any(al < 1.f)) { if (hi == 0) al_l[r32] = al; asm volatile("s_waitcnt lgkmcnt(0)" ::: "memory"); \
        _Pragma("unroll") for (int d = 0; d < 4; ++d) _Pragma("unroll") for (int r = 0; r < 16; ++r) o[d][r] *= al_l[crow(r, hi)]; } \
      MLA_SBAR(); pv_d0(o, vb0 + (vslot_) * SHM_V, pa0, pa1, pa2, pa3); } while (0)
  const int NT = seq / KVBLK;
  MLD_ISSUE(0, 0, 0); asm volatile("s_waitcnt vmcnt(0)" ::: "memory"); __syncthreads();
  bf16x8 pa0 = {}, pa1 = {}, pa2 = {}, pa3 = {}; float al = 1.f;
  int vs_cur = 0;
  for (int j = 0; j <= NT; ++j) {
    const int vs_prev = vs_cur == 0 ? 2 : vs_cur - 1, vs_next = vs_cur == 2 ? 0 : vs_cur + 1;
    if (j + 1 < NT) MLD_ISSUE((j + 1) * KVBLK, (j + 1) & 1, vs_next);
    if (grp == 0) { if (j < NT) { MLD_S(j); MLD_O(vs_cur); } }
    else { if (j > 0) MLD_O(vs_prev); if (j < NT) MLD_S(j); }
    asm volatile("s_waitcnt vmcnt(0)" ::: "memory");
    __syncthreads();
    vs_cur = vs_next;
  }
  if (hi == 0) li_l[r32] = l_reg; asm volatile("s_waitcnt lgkmcnt(0)" ::: "memory");
  float rli[16];
#pragma unroll
  for (int r = 0; r < 16; ++r) rli[r] = __builtin_amdgcn_rcpf(li_l[crow(r, hi)]);
  bf16* Ow = Ob + (long)(wid * QBLK) * LDO;
#pragma unroll
  for (int r = 0; r < 16; ++r) { const int orow = crow(r, hi);
#pragma unroll
    for (int d0 = 0; d0 < 4; ++d0) Ow[(long)orow * LDO + d0 * 32 + r32] = (bf16)(cvtpk(o[d0][r] * rli[r], 0.f) & 0xffffu); }
  asm volatile("s_waitcnt vmcnt(0)" ::: "memory");
  __syncthreads();
#undef MLD_ISSUE
#undef MLD_S
#undef MLD_RD
#undef MLD_MM
#undef MLD_O
}
}
namespace wat {
typedef unsigned short bf16;
using bf16x8 = __attribute__((ext_vector_type(8))) short;
using s16x4  = __attribute__((ext_vector_type(4))) short;
using f32x4  = __attribute__((ext_vector_type(4))) float;
using u32x4  = __attribute__((ext_vector_type(4))) unsigned;
#define WAT_LAS __attribute__((address_space(3)))
__device__ __forceinline__ unsigned cvtpk(float lo, float hi) { unsigned r; asm volatile("v_cvt_pk_bf16_f32 %0, %1, %2" : "=v"(r) : "v"(lo), "v"(hi)); return r; }
__device__ __forceinline__ int kst_off(int row, int ch) { return row * 256 + ((ch ^ ((row & 3) | (((row >> 3) & 3) << 2))) << 4); }
__device__ __forceinline__ int vst_off(int row, int ch) { return (row >> 4) * 4096 + ((row >> 2) & 1) * 2048 + (ch >> 1) * 256 + ((row >> 3) & 1) * 128 + (row & 3) * 32 + (ch & 1) * 16; }
__device__ __forceinline__ int vrd_base(int R0, int lane) { const int g4 = lane >> 4, qa = (lane & 15) >> 2, p = lane & 3, gg = g4 + ((R0 >> 3) & 1); return ((R0 >> 4) + (gg >> 1)) * 4096 + (gg & 1) * 128 + qa * 32 + p * 8; }
__device__ __forceinline__ void qk_group(f32x4& sc0, f32x4& sc1, const WAT_LAS char* Kb, int Rg, const bf16x8* qf, int lane) {
    const int a = lane & 15, g4 = lane >> 4; const int row = Rg + 8 * (a >> 2) + (a & 3); const int xk = (row & 3) | (((row >> 3) & 3) << 2);
    const WAT_LAS char* p = Kb + row * 256;
    sc0 = f32x4{0.f, 0.f, 0.f, 0.f}; sc1 = f32x4{0.f, 0.f, 0.f, 0.f};
#pragma unroll
    for (int s = 0; s < 4; ++s) { const int off = ((4 * s + g4) ^ xk) << 4;
        const bf16x8 k0 = *(const WAT_LAS bf16x8*)(p + off), k1 = *(const WAT_LAS bf16x8*)(p + 4 * 256 + off);
        sc0 = __builtin_amdgcn_mfma_f32_16x16x32_bf16(k0, qf[s], sc0, 0, 0, 0);
        sc1 = __builtin_amdgcn_mfma_f32_16x16x32_bf16(k1, qf[s], sc1, 0, 0, 0); }
}
__device__ __forceinline__ bf16x8 p_frag(const f32x4 p0, const f32x4 p1) { u32x4 w = {cvtpk(p0[0], p0[1]), cvtpk(p0[2], p0[3]), cvtpk(p1[0], p1[1]), cvtpk(p1[2], p1[3])}; return *reinterpret_cast<bf16x8*>(&w); }
template <int OFF> __device__ __forceinline__ s16x4 tr_read(unsigned addr) { s16x4 r; asm volatile("ds_read_b64_tr_b16 %0, %1 offset:%2" : "=&v"(r) : "v"(addr), "i"(OFF) : "memory"); return r; }
template <int GOFF> __device__ __forceinline__ void pv_group(f32x4* o, unsigned vb, const bf16x8 pf) {
    s16x4 lo[8], hi[8];
#define WAT_TR(c) lo[c] = tr_read<GOFF + (c) * 256>(vb); hi[c] = tr_read<GOFF + 2048 + (c) * 256>(vb);
    WAT_TR(0) WAT_TR(1) WAT_TR(2) WAT_TR(3) WAT_TR(4) WAT_TR(5) WAT_TR(6) WAT_TR(7)
#undef WAT_TR
    asm volatile("s_waitcnt lgkmcnt(0)" ::: "memory"); __builtin_amdgcn_sched_barrier(0);
#pragma unroll
    for (int c = 0; c < 8; ++c) { const bf16x8 vfr = (bf16x8){lo[c][0], lo[c][1], lo[c][2], lo[c][3], hi[c][0], hi[c][1], hi[c][2], hi[c][3]};
        o[c] = __builtin_amdgcn_mfma_f32_16x16x32_bf16(pf, vfr, o[c], 0, 0, 0); }
}
}
constexpr int NWAVES = 8;
constexpr int BATCH = 2, SEQ = 8192, DM = 4096, M = BATCH * SEQ;
constexpr int EVEN_IN = 10688, ZLD = 10752;
constexpr int Z_CQ = 9216, Z_CKV = 10112, Z_KPE = 10624;
constexpr int QRANK = 896, KVRANK = 512, MLA_H = 16, MLA_QK = 192, MLA_NOPE = 128, MLA_ROPE = 64;
constexpr int DIL_H = 24, DIL_HPG = 8, HD = 128;
constexpr int NA_H = 32, GRID_W = 64, NA_ROWS = 8, NA_COLS = 16, GRID_ROWS = SEQ / GRID_W;
constexpr int DFF = 11008, EVEN_MIX = 3072;
constexpr float NORM_EPS = 1e-6f, LOG2E = 1.4426950408889634f;
constexpr float QS_MLA = 0.07216878364870322f * LOG2E;
constexpr float QS_HD = 0.08838834764831845f * LOG2E;
constexpr size_t MiB = 1u << 20;
constexpr size_t WS_CTL = 0, CTL_ZERO_BYTES = 64 * 1024;
constexpr size_t WS_ROPE = 1 * MiB;
constexpr size_t WS_RSTD = 4 * MiB;
constexpr size_t WS_SS = 5 * MiB;
constexpr size_t WS_WIN = 16 * MiB, WS_WUQ = 100 * MiB, WS_WUKV = 106 * MiB, WS_WEOUT = 110 * MiB, WS_WQKV = 134 * MiB, WS_WOOUT = 230 * MiB;
constexpr size_t WS_WFFN = 262 * MiB, FFN_W_BYTES = 86 * MiB;
constexpr size_t WS_XB = 778 * MiB;
constexpr size_t WS_R = 906 * MiB;
constexpr size_t R_Z = 0, R_Q = 336 * MiB, R_KV = 432 * MiB, R_K = 560 * MiB, R_OMIX = 656 * MiB, R_CQN = 656 * MiB, R_CKVN = 688 * MiB;
constexpr size_t R_A = 0, R_H2 = 344 * MiB;
constexpr size_t R_QKV = 0, R_O = 384 * MiB;
constexpr size_t R_DPO = 752 * MiB, R_DPM = 848 * MiB;
constexpr size_t WS_END = WS_R + 852 * MiB;
static_assert((size_t)ZLD * DM * 2 <= 84 * MiB && (size_t)DFF * DM * 2 == 86 * MiB && (size_t)M * ZLD * 2 == 336 * MiB && (size_t)M * DFF * 2 == 344 * MiB, "ws map");
constexpr int CW_BAR = 4096;
constexpr int RING_BYTES = 131072, LDS_BYTES = 163840, LDSCTL_OFF = LDS_BYTES - 1024, MISC_OFF = LDSCTL_OFF + 320;
constexpr int NA_TB_OFF = RING_BYTES + 1024, NA_OST_OFF = NA_TB_OFF + 2048;

#define GAS __attribute__((address_space(1)))
#define LAS __attribute__((address_space(3)))
typedef unsigned short bf16;
typedef unsigned v4u __attribute__((ext_vector_type(4)));
typedef unsigned v2u __attribute__((ext_vector_type(2)));
typedef float f32x4 __attribute__((ext_vector_type(4)));
#define LDS_WAIT() asm volatile("s_waitcnt lgkmcnt(0)" ::: "memory")
#define VM_WAIT() asm volatile("s_waitcnt vmcnt(0)" ::: "memory")
__device__ __forceinline__ unsigned f2bf(float f) { unsigned u = __builtin_bit_cast(unsigned, f); return (u + 0x7fffu + ((u >> 16) & 1u)) >> 16; }
__device__ __forceinline__ unsigned pk2(float lo, float hi) { return f2bf(lo) | (f2bf(hi) << 16); }
__device__ __forceinline__ float bflo(unsigned w) { return __uint_as_float(w << 16); }
__device__ __forceinline__ float bfhi(unsigned w) { return __uint_as_float(w & 0xffff0000u); }
__device__ __forceinline__ void unpack8(const v4u w, float* f) { f[0] = bflo(w.x); f[1] = bfhi(w.x); f[2] = bflo(w.y); f[3] = bfhi(w.y); f[4] = bflo(w.z); f[5] = bfhi(w.z); f[6] = bflo(w.w); f[7] = bfhi(w.w); }
__device__ __forceinline__ v4u pack8(const float* f) { v4u w; w.x = pk2(f[0], f[1]); w.y = pk2(f[2], f[3]); w.z = pk2(f[4], f[5]); w.w = pk2(f[6], f[7]); return w; }
__device__ __forceinline__ float wave_sum(float v) {
#pragma unroll
    for (int o = 1; o < 64; o <<= 1) v += __shfl_xor(v, o);
    return v;
}
__device__ __forceinline__ float sum16(float v) {
#pragma unroll
    for (int o = 1; o < 16; o <<= 1) v += __shfl_xor(v, o);
    return v;
}

#define XB_TMO      128
#define XB_XCNT(j)  (256  + 64 * (j))
#define XB_XSUB(j)  (1280 + 64 * (j))
#define XB_XGEN(j)  (2304 + 64 * (j))
#define XB_TOP      3328
#define XB_TOPGEN   3392
#define XCD_BAR_WORDS 3456
#define XB_SPIN_CAP (1u << 20)
__device__ __forceinline__ unsigned xb_ld(unsigned* p)              { return __hip_atomic_load(p, __ATOMIC_RELAXED, __HIP_MEMORY_SCOPE_AGENT); }
__device__ __forceinline__ unsigned xb_add(unsigned* p, unsigned v) { return __hip_atomic_fetch_add(p, v, __ATOMIC_RELAXED, __HIP_MEMORY_SCOPE_AGENT); }
__device__ __forceinline__ unsigned xb_xcc_id() { return (unsigned)__builtin_amdgcn_s_getreg((3 << 11) | 20) & 0xFu; }
#define XB_SPIN(cond, bar) do { unsigned _sp = 0; while (cond) { __builtin_amdgcn_s_sleep(1); \
    if ((++_sp & 255u) == 0u) { if (xb_ld(&(bar)[XB_TMO])) break; if (_sp > XB_SPIN_CAP) { atomicAdd(&(bar)[XB_TMO], 1u); break; } } } } while (0)
struct XcdBarrier { unsigned* bar; unsigned x; volatile LAS unsigned* st; };
__device__ __forceinline__ XcdBarrier xcd_barrier_post(unsigned* bar, volatile LAS unsigned* st) {
    XcdBarrier b; b.bar = bar; b.x = xb_xcc_id(); b.st = st;
    if (threadIdx.x == 0) (void)xb_add(&bar[XB_XCNT(b.x)], 1u);
    return b;
}
__device__ __forceinline__ void xcd_barrier_complete(unsigned* bar, unsigned x, unsigned& nloc, unsigned& nx) {
    const unsigned G = gridDim.x * gridDim.y * gridDim.z;
    unsigned sum, cnt, mine, sp = 0u;
    for (;;) {
        sum = 0u; cnt = 0u; mine = 0u;
#pragma unroll
        for (unsigned j = 0; j < 16; ++j) { const unsigned c = xb_ld(&bar[XB_XCNT(j)]); sum += c; cnt += (c > 0u) ? 1u : 0u; mine = (j == x) ? c : mine; }
        if (sum == G) break;
        __builtin_amdgcn_s_sleep(1);
        if ((++sp & 255u) == 0u) { if (xb_ld(&bar[XB_TMO])) break; if (sp > XB_SPIN_CAP) { atomicAdd(&bar[XB_TMO], 1u); break; } }
    }
    nloc = mine > 0u ? mine : 1u; nx = cnt > 0u ? cnt : 1u;
}
__device__ __forceinline__ void xcd_barrier(const XcdBarrier& b) {
    asm volatile("s_waitcnt vmcnt(0)" ::: "memory");
    __syncthreads();
    if (threadIdx.x == 0) {
        unsigned* bar = b.bar;
        __builtin_amdgcn_s_waitcnt(0);
        unsigned nloc = b.st[0], nx = b.st[1];
        if (nloc == 0u) { xcd_barrier_complete(bar, b.x, nloc, nx); b.st[0] = nloc; b.st[1] = nx; }
        const unsigned old = xb_add(&bar[XB_XSUB(b.x)], 1u);
        const unsigned gen = old / nloc;
        if (old + 1u == (gen + 1u) * nloc) {
            __builtin_amdgcn_fence(__ATOMIC_RELEASE, "agent");
            asm volatile("s_waitcnt vmcnt(0)" ::: "memory");
            const unsigned og = xb_add(&bar[XB_TOP], 1u);
            const unsigned tg = og / nx;
            if (og + 1u == (tg + 1u) * nx) xb_add(&bar[XB_TOPGEN], 1u);
            else XB_SPIN(xb_ld(&bar[XB_TOPGEN]) == tg, bar);
            __builtin_amdgcn_fence(__ATOMIC_ACQUIRE, "agent");
            xb_add(&bar[XB_XGEN(b.x)], 1u);
            asm volatile("s_waitcnt vmcnt(0)" ::: "memory");
        } else {
            XB_SPIN(xb_ld(&bar[XB_XGEN(b.x)]) == gen, bar);
            __builtin_amdgcn_fence(__ATOMIC_ACQUIRE, "agent");
            asm volatile("s_waitcnt vmcnt(0)" ::: "memory");
        }
    }
    __syncthreads();
}

struct Args { const float* in[24]; float* out; unsigned char* ws; int ph_lo, ph_hi; };
struct Frame { LAS unsigned char* lds; int tid, lane, wave, gw, ngw, G; };

struct P0Item { const float* W; int K, N; bf16* dst; const float* gain; int mode, r; };
__device__ __forceinline__ void p0_item_load(const P0Item& t, float (&v)[32], int lane) {
    const int nblk = t.N / 32, kb = t.r / nblk, nb = t.r % nblk, k0 = 64 * kb, n0 = 32 * nb;
    const float* p = t.W + (size_t)(k0 + (lane >> 5)) * t.N + n0 + (lane & 31);
#pragma unroll
    for (int i = 0; i < 32; ++i) v[i] = p[(size_t)(2 * i) * t.N];
}
__device__ __forceinline__ void p0_item_store(const P0Item& t, const float (&v)[32], LAS float* scr, int lane) {
    const int nblk = t.N / 32, kb = t.r / nblk, nb = t.r % nblk, k0 = 64 * kb, n0 = 32 * nb;
    const int drow0 = (t.mode == 1) ? (n0 >= 1472 ? n0 - 1472 : n0 + 9216)
                    : (t.mode >= 2) ? ((n0 >> 7) * 256 + (n0 & 127) + (t.mode == 3 ? 128 : 0)) : n0;
#pragma unroll
    for (int i = 0; i < 32; ++i) { const int kk = 2 * i + (lane >> 5); scr[kk * 33 + (lane & 31)] = v[i]; }
    LDS_WAIT(); asm volatile("" ::: "memory");
    const int c = lane & 7;
    f32x4 ga = {1.f, 1.f, 1.f, 1.f}, gb = {1.f, 1.f, 1.f, 1.f};
    if (t.gain) { ga = *(const f32x4*)(t.gain + k0 + 8 * c); gb = *(const f32x4*)(t.gain + k0 + 8 * c + 4); }
#pragma unroll
    for (int j = 0; j < 4; ++j) { const int n = (lane >> 3) + 8 * j; const LAS float* sp = scr + (8 * c) * 33 + n;
        v4u o; o.x = pk2(sp[0 * 33] * ga[0], sp[1 * 33] * ga[1]); o.y = pk2(sp[2 * 33] * ga[2], sp[3 * 33] * ga[3]); o.z = pk2(sp[4 * 33] * gb[0], sp[5 * 33] * gb[1]); o.w = pk2(sp[6 * 33] * gb[2], sp[7 * 33] * gb[3]);
        *(v4u*)(t.dst + (size_t)(drow0 + n) * t.K + k0 + 8 * c) = o; }
    LDS_WAIT(); asm volatile("" ::: "memory");
}
#ifndef MLA_UNIT
#define MLA_UNIT mla::attn_unit_d
#endif
constexpr int N_PHASES = 20;
#ifndef LB2
#define LB2 2
#endif
__global__ void __launch_bounds__(NWAVES * 64, LB2) mk_fwd(Args args) {
    extern __shared__ __attribute__((aligned(16))) unsigned char lds[];
    Frame F;
    F.lds = (LAS unsigned char*)lds;
    F.tid = threadIdx.x; F.lane = F.tid & 63; F.wave = __builtin_amdgcn_readfirstlane(F.tid >> 6);
    F.G = gridDim.x; F.gw = blockIdx.x * NWAVES + F.wave; F.ngw = F.G * NWAVES;
    const int lane = F.lane, l15 = lane & 15, grp = lane >> 4;
    unsigned char* ws = args.ws;
    unsigned* ctl = (unsigned*)(ws + WS_CTL);
    const float* x_in = args.in[0]; float* out = args.out;
    float* cosA = (float*)(ws + WS_ROPE); float* sinA = cosA + SEQ * 16; float* cosB = sinA + SEQ * 16; float* sinB = cosB + SEQ * 32;
    float* rstd = (float*)(ws + WS_RSTD); float* ss = (float*)(ws + WS_SS);
    bf16* Win_t = (bf16*)(ws + WS_WIN); bf16* Wuq_t = (bf16*)(ws + WS_WUQ); bf16* Wukv_t = (bf16*)(ws + WS_WUKV); bf16* Weout_t = (bf16*)(ws + WS_WEOUT);
    bf16* Wqkv_t = (bf16*)(ws + WS_WQKV); bf16* Woout_t = (bf16*)(ws + WS_WOOUT);
    bf16* xb = (bf16*)(ws + WS_XB);
    unsigned char* R = ws + WS_R;
    bf16* zb = (bf16*)(R + R_Z); bf16* qb = (bf16*)(R + R_Q); bf16* kvb = (bf16*)(R + R_KV); bf16* kb = (bf16*)(R + R_K); bf16* omix = (bf16*)(R + R_OMIX);
    bf16* cqn = (bf16*)(R + R_CQN); bf16* ckvn = (bf16*)(R + R_CKVN);
    bf16* aedge = (bf16*)(R + R_A); bf16* uedge = aedge + (size_t)(M / 256) * 4 * DFF; bf16* h2b = (bf16*)(R + R_H2);
    bf16* qkvb = (bf16*)(R + R_QKV); bf16* ob = (bf16*)(R + R_O);
    bf16* dpo = (bf16*)(R + R_DPO); float* dpm = (float*)(R + R_DPM);
    bf16* xl0 = (bf16*)(ws + WS_WIN); bf16* xl1 = (bf16*)(R + R_DPO) - (size_t)8192 * DM;

    for (int u = F.tid; u < (LDS_BYTES - LDSCTL_OFF) / 4; u += NWAVES * 64) ((LAS unsigned*)(F.lds + LDSCTL_OFF))[u] = 0u;
    __syncthreads();
    const int lo = args.ph_lo, hi = args.ph_hi;
    XcdBarrier bar; bar.bar = ctl + CW_BAR; bar.x = 0; bar.st = nullptr;
    if (hi - lo > 1) bar = xcd_barrier_post(ctl + CW_BAR, (volatile LAS unsigned*)(F.lds + MISC_OFF) + 8);
#ifndef PH_MASK
#define PH_MASK 0xFFFFFu
#endif
#define IN(k) ((((PH_MASK) >> (k)) & 1u) && lo <= (k) && (k) < hi)
#define SEAM(k) do { if (IN(k) && IN((k) + 1)) xcd_barrier(bar); } while (0)

    if (IN(0)) {
        LAS float* scr = (LAS float*)(F.lds + F.wave * 16384);
        constexpr int I_WIN = (DM / 64) * (EVEN_IN / 32), I_UQ = (QRANK / 64) * (3072 / 32), I_UKV = (KVRANK / 64) * (4096 / 32), I_EOUT = (EVEN_MIX / 64) * (DM / 32);
        constexpr int I_QKV = (DM / 64) * (12288 / 32), I_OOUT = (DM / 64) * (DM / 32), I_GU = (DM / 64) * (DFF / 32), I_DN = (DFF / 64) * (DM / 32);
        constexpr int NITEMS = I_WIN + I_UQ + I_UKV + I_EOUT + I_QKV + I_OOUT + 2 * (2 * I_GU + I_DN);
#define P0_DECODE(it_, T_) do { int r = (it_); T_.gain = nullptr; T_.mode = 0; \
            if (r < I_WIN) { T_.W = args.in[2]; T_.K = DM; T_.N = EVEN_IN; T_.dst = Win_t; T_.gain = args.in[1]; T_.mode = 1; } \
            else if ((r -= I_WIN) < I_UQ) { T_.W = args.in[5]; T_.K = QRANK; T_.N = 3072; T_.dst = Wuq_t; T_.gain = args.in[3]; } \
            else if ((r -= I_UQ) < I_UKV) { T_.W = args.in[6]; T_.K = KVRANK; T_.N = 4096; T_.dst = Wukv_t; T_.gain = args.in[4]; } \
            else if ((r -= I_UKV) < I_EOUT) { T_.W = args.in[11]; T_.K = EVEN_MIX; T_.N = DM; T_.dst = Weout_t; } \
            else if ((r -= I_EOUT) < I_QKV) { T_.W = args.in[13]; T_.K = DM; T_.N = 12288; T_.dst = Wqkv_t; T_.gain = args.in[12]; } \
            else if ((r -= I_QKV) < I_OOUT) { T_.W = args.in[17]; T_.K = DM; T_.N = DM; T_.dst = Woout_t; } \
            else { r -= I_OOUT; const int layer = r / (2 * I_GU + I_DN); r -= layer * (2 * I_GU + I_DN); \
                bf16* wl = (bf16*)(ws + WS_WFFN + (size_t)layer * 3 * FFN_W_BYTES); \
                if (r < I_GU) { T_.W = args.in[19] + (size_t)layer * DM * DFF; T_.K = DM; T_.N = DFF; T_.dst = wl; T_.gain = args.in[18] + layer * DM; T_.mode = 2; } \
                else if ((r -= I_GU) < I_GU) { T_.W = args.in[20] + (size_t)layer * DM * DFF; T_.K = DM; T_.N = DFF; T_.dst = wl; T_.gain = args.in[18] + layer * DM; T_.mode = 3; } \
                else { r -= I_GU; T_.W = args.in[23] + (size_t)layer * DFF * DM; T_.K = DFF; T_.N = DM; T_.dst = (bf16*)((unsigned char*)wl + 2 * FFN_W_BYTES); } } \
            T_.r = r; } while (0)
        {
            float va[32], vb[32]; P0Item ta, tb_;
            int it = F.gw;
            if (it < NITEMS) { P0_DECODE(it, ta); p0_item_load(ta, va, lane); }
            while (it < NITEMS) {
                const int it1 = it + F.ngw, it2 = it1 + F.ngw;
                if (it1 < NITEMS) { P0_DECODE(it1, tb_); p0_item_load(tb_, vb, lane); }
                p0_item_store(ta, va, scr, lane);
                if (it1 >= NITEMS) break;
                if (it2 < NITEMS) { P0_DECODE(it2, ta); p0_item_load(ta, va, lane); }
                p0_item_store(tb_, vb, scr, lane);
                it = it2;
            }
        }
#undef P0_DECODE
        const int gtid = blockIdx.x * (NWAVES * 64) + F.tid, nthr = F.G * NWAVES * 64;
        for (int i = gtid; i < (ZLD - 10688) * DM / 8; i += nthr) ((v4u*)(Win_t + (size_t)10688 * DM))[i] = (v4u){0u, 0u, 0u, 0u};
        for (int i = gtid; i < SEQ * 48; i += nthr) {
            const bool isB = i >= SEQ * 16; const int ii = isB ? i - SEQ * 16 : i; const int pos = isB ? (ii >> 5) : (ii >> 4), k = isB ? (ii & 31) : (ii & 15);
            const double c1 = isB ? 0.6636012376960885 : 0.44036660267178046;
            double p = 1.0; for (int j = 0; j < k; ++j) p *= c1;
            const float inv = (float)p; const float ang = (float)pos * inv;
            const double rev = (double)ang * 0.15915494309189535; const float fr = (float)(rev - __builtin_rint(rev));
            const float sv = __builtin_amdgcn_sinf(fr), cv = __builtin_amdgcn_cosf(fr);
            if (isB) { cosB[ii] = cv; sinB[ii] = sv; } else { cosA[ii] = cv; sinA[ii] = sv; }
        }
#pragma unroll 2
        for (int row = F.gw; row < M; row += F.ngw) {
            const f32x4* xr = (const f32x4*)(x_in + (size_t)row * DM) + lane; v2u* xo = (v2u*)(xb + (size_t)row * DM) + lane; float s = 0.f;
#pragma unroll 4
            for (int j = 0; j < 16; ++j) { const f32x4 v = xr[64 * j]; s += (v.x * v.x + v.y * v.y) + (v.z * v.z + v.w * v.w); v2u w; w.x = pk2(v.x, v.y); w.y = pk2(v.z, v.w); xo[64 * j] = w; }
            s = wave_sum(s);
            if (lane == 0) rstd[row] = 1.0f / sqrtf(s * (1.0f / DM) + NORM_EPS);
        }
    }
    SEAM(0);
    if (IN(1)) {
        pg8::Gemm g{xb, Win_t, M, ZLD, DM, DM}; pg8::StaticOrder S; S.init(M, ZLD, F.G, (int)blockIdx.x);
        pg8::EpiHeadNorm E{zb, ZLD, rstd, args.in[9], args.in[10], QS_HD, 12, 12, (PG8_LAS float*)(F.lds + NA_TB_OFF), cosA, sinA, SEQ};
        pg8::gemm_phase<pg8::EpiHeadNorm, pg8::StaticOrder, true, true>(F.lds, g, S, E);
    }
    SEAM(1);
    if (IN(2)) {
        const float* dqn = args.in[9]; const float* dkn = args.in[10];
        float gq8[8], gk8[8];
#pragma unroll
        for (int j = 0; j < 8; ++j) { gq8[j] = dqn[l15 * 8 + j] * QS_HD; gk8[j] = dkn[l15 * 8 + j]; }
#pragma unroll 2
        for (int row = F.gw; row < M; row += F.ngw) {
            const int pos = row & (SEQ - 1); bf16* zr = zb + (size_t)row * ZLD;
            float cr8[8], sr8[8];
#pragma unroll
            for (int j = 0; j < 8; ++j) { cr8[j] = 1.f; sr8[j] = 0.f; }
            if (l15 < 4) {
#pragma unroll
                for (int j = 0; j < 8; ++j) { cr8[j] = cosA[pos * 16 + (l15 & 1) * 8 + j]; sr8[j] = sinA[pos * 16 + (l15 & 1) * 8 + j]; if (l15 < 2) sr8[j] = -sr8[j]; } }
            {
                float v0[8], v1[8]; const bool act = lane < 56; const bf16* p = zr + Z_CQ + lane * 8;
                v4u w0 = {0u, 0u, 0u, 0u}, w1 = {0u, 0u, 0u, 0u}; if (act) { w0 = *(const v4u*)p; w1 = *(const v4u*)(p + 448); }
                unpack8(w0, v0); unpack8(w1, v1); float s = 0.f;
#pragma unroll
                for (int j = 0; j < 8; ++j) s += v0[j] * v0[j] + v1[j] * v1[j];
                s = wave_sum(s); const float rs = 1.0f / sqrtf(s * (1.0f / QRANK) + NORM_EPS);
#pragma unroll
                for (int j = 0; j < 8; ++j) { v0[j] *= rs; v1[j] *= rs; }
                if (act) { bf16* o = cqn + (size_t)row * QRANK + lane * 8; *(v4u*)o = pack8(v0); *(v4u*)(o + 448) = pack8(v1); }
            }
            {
                float v0[8]; unpack8(*(const v4u*)(zr + Z_CKV + lane * 8), v0); float s = 0.f;
#pragma unroll
                for (int j = 0; j < 8; ++j) s += v0[j] * v0[j];
                s = wave_sum(s); const float rs = 1.0f / sqrtf(s * (1.0f / KVRANK) + NORM_EPS);
#pragma unroll
                for (int j = 0; j < 8; ++j) v0[j] *= rs;
                *(v4u*)(ckvn + (size_t)row * KVRANK + lane * 8) = pack8(v0);
            }
        }
    }
    SEAM(2);
    if (IN(3)) {
        { pg8::Gemm g{cqn, Wuq_t, M, 3072, QRANK, QRANK}; pg8::StaticOrder S; S.init(M, 3072, F.G, (int)blockIdx.x); pg8::EpiScaleBf16 E{qb, 3072, nullptr};
          pg8::gemm_phase<pg8::EpiScaleBf16, pg8::StaticOrder, true, true>(F.lds, g, S, E); }
        { pg8::Gemm g{ckvn, Wukv_t, M, 4096, KVRANK, KVRANK}; pg8::StaticOrder S; S.init(M, 4096, F.G, (int)blockIdx.x); pg8::EpiScaleBf16 E{kvb, 4096, nullptr};
          pg8::gemm_phase<pg8::EpiScaleBf16, pg8::StaticOrder, true, true>(F.lds, g, S, E); }
        {
            WAT_LAS char* L = (WAT_LAS char*)F.lds;
            const int NU = BATCH * 3 * DIL_HPG * 64;
            const int u0 = (int)(((long)NU * blockIdx.x) / F.G), u1 = (int)(((long)NU * (blockIdx.x + 1)) / F.G);
            const int row16 = F.tid >> 4, ch16 = F.tid & 15, kso = wat::kst_off(row16, ch16), vso = wat::vst_off(row16, ch16);
            const int w = F.wave, q = lane & 15, g4 = lane >> 4, Rw = 32 * (w >> 1);
            v4u st[8];
#define DL_GEOM(u_) const int blk_ = (u_) & 63, j_ = ((u_) >> 6) & 7, bg_ = (u_) >> 9, g_ = bg_ % 3, b_ = bg_ / 3, sh_ = 2 * g_, d_ = 1 << sh_, Ld_ = SEQ >> sh_, \
            r_ = blk_ >> (6 - sh_), p0_ = (blk_ & ((64 >> sh_) - 1)) * 128, head_ = 8 * g_ + j_;
#define DL_LOAD(u_, s_) do { DL_GEOM(u_) const bf16* base_ = zb + (size_t)(b_ * SEQ + r_) * ZLD + ((s_) ? 6144 : 3072) + head_ * HD + ch16 * 8; \
            _Pragma("unroll") for (int k = 0; k < 8; ++k) { const int kp_ = min(max(p0_ - 64 + row16 + 32 * k, 0), Ld_ - 1); st[k] = *(const v4u*)(base_ + (size_t)(kp_ << sh_) * ZLD); } } while (0)
#define DL_WRITE(s_) do { WAT_LAS char* dd_ = L + (s_) * 65536 + ((s_) ? vso : kso); _Pragma("unroll") for (int k = 0; k < 8; ++k) *(WAT_LAS v4u*)(dd_ + k * 32 * 256) = st[k]; } while (0)
#define DL_END(un_, sn_, un2_, sn2_) do { if ((un_) < u1) { VM_WAIT(); DL_WRITE(sn_); } __syncthreads(); if ((un2_) < u1) DL_LOAD(un2_, sn2_); } while (0)
            if (u0 < u1) { DL_LOAD(u0, 0); VM_WAIT(); DL_WRITE(0); __syncthreads(); DL_LOAD(u0, 1); }
            for (int u = u0; u < u1; ++u) {
                DL_GEOM(u)
                wat::bf16x8 qf[4]; wat::f32x4 sc[5][2]; wat::bf16x8 pf[5]; wat::f32x4 o[8]; float linv = 0.f, mrow = 0.f, lrow = 0.f;
                const int qp = p0_ + 16 * w + q; const size_t qtok = (size_t)(b_ * SEQ + r_) + ((size_t)qp << sh_);
                {
                    const bf16* qptr = zb + qtok * ZLD + head_ * HD + 8 * g4;
#pragma unroll
                    for (int s = 0; s < 4; ++s) qf[s] = *(const wat::bf16x8*)(qptr + 32 * s);
#pragma unroll
                    for (int gi = 0; gi < 5; ++gi) wat::qk_group(sc[gi][0], sc[gi][1], L, Rw + 32 * gi, qf, lane);
                    float m = -1e30f;
#pragma unroll
                    for (int gi = 0; gi < 5; ++gi)
#pragma unroll
                        for (int j = 0; j < 8; ++j) { const int lr = Rw + 32 * gi + 8 * g4 + j, kp = p0_ - 64 + lr, dq = kp - qp; const bool ok = dq >= -64 && dq <= 64 && kp >= 0 && kp < Ld_;
                            const float v = ok ? sc[gi][j >> 2][j & 3] : -1e30f; sc[gi][j >> 2][j & 3] = v; m = fmaxf(m, v); }
                    m = fmaxf(m, __shfl_xor(m, 16)); m = fmaxf(m, __shfl_xor(m, 32));
                    float l = 0.f;
#pragma unroll
                    for (int gi = 0; gi < 5; ++gi) {
#pragma unroll
                        for (int j = 0; j < 8; ++j) { const float sv = sc[gi][j >> 2][j & 3]; const float v = sv > -1e29f ? __builtin_amdgcn_exp2f(sv - m) : 0.f; sc[gi][j >> 2][j & 3] = v; l += v; }
                        pf[gi] = wat::p_frag(sc[gi][0], sc[gi][1]); }
                    l += __shfl_xor(l, 16); l += __shfl_xor(l, 32); linv = 1.0f / l; mrow = m; lrow = l;
#pragma unroll
                    for (int c = 0; c < 8; ++c) o[c] = wat::f32x4{0.f, 0.f, 0.f, 0.f};
                }
                DL_END(u, 1, u + 1, 0);
                {
                    const unsigned vb = (unsigned)(uintptr_t)(L + 65536) + (unsigned)wat::vrd_base(Rw, lane);
                    wat::pv_group<0>(o, vb, pf[0]); wat::pv_group<8192>(o, vb, pf[1]); wat::pv_group<16384>(o, vb, pf[2]); wat::pv_group<24576>(o, vb, pf[3]); wat::pv_group<32768>(o, vb, pf[4]);
                    WAT_LAS char* ost = L + NA_OST_OFF + w * 2304;
                    float li[4];
#pragma unroll
                    for (int r = 0; r < 4; ++r) li[r] = __shfl(linv, 4 * g4 + r);
                    const size_t tok_r = (size_t)(b_ * SEQ + r_) + ((size_t)(p0_ + 16 * w + g4) << sh_);
#pragma unroll
                    for (int hf = 0; hf < 2; ++hf) {
#pragma unroll
                        for (int r = 0; r < 4; ++r)
#pragma unroll
                            for (int c = 0; c < 4; ++c) *(WAT_LAS unsigned short*)(ost + (4 * g4 + r) * 144 + (16 * c + q) * 2) = (unsigned short)(wat::cvtpk(o[4 * hf + c][r] * li[r], 0.f) & 0xffffu);
                        asm volatile("s_waitcnt lgkmcnt(0)" ::: "memory");
#pragma unroll
                        for (int k = 0; k < 2; ++k) { const int rq = g4 + 4 * (2 * k + (q >> 3)); const v4u v = *(const WAT_LAS v4u*)(ost + rq * 144 + (q & 7) * 16);
                            const size_t tk = tok_r + ((size_t)(4 * (2 * k + (q >> 3))) << sh_);
                            *(v4u*)(dpo + ((tk * DIL_HPG + j_) * 3 + g_) * HD + 64 * hf + (q & 7) * 8) = v; }
                        asm volatile("s_waitcnt lgkmcnt(0)" ::: "memory");
                    }
                    if (g4 == 0) { float* pmp = dpm + ((qtok * DIL_HPG + j_) * 3 + g_) * 2; pmp[0] = mrow; pmp[1] = lrow; }
                }
                DL_END(u + 1, 0, u + 1, 1);
            }
#undef DL_GEOM
#undef DL_LOAD
#undef DL_WRITE
#undef DL_END
        }
    }
    SEAM(3);
    if (IN(4)) {
        const float* qn = args.in[7]; const float* kn = args.in[8];
        float gq[12], gk[12];
#pragma unroll
        for (int k = 0; k < 3; ++k)
#pragma unroll
            for (int j = 0; j < 4; ++j) { gq[4 * k + j] = qn[64 * k + 4 * l15 + j] * QS_MLA; gk[4 * k + j] = kn[64 * k + 4 * l15 + j]; }
#pragma unroll 2
        for (int row = F.gw; row < M; row += F.ngw) {
            const int pos = row & (SEQ - 1);
            float cr[4], sr[4];
#pragma unroll
            for (int j = 0; j < 4; ++j) { cr[j] = cosB[pos * 32 + 4 * (l15 & 7) + j]; sr[j] = sinB[pos * 32 + 4 * (l15 & 7) + j]; if (l15 < 8) sr[j] = -sr[j]; }
            const v2u kpe = *(const v2u*)(zb + (size_t)row * ZLD + Z_KPE + 4 * l15);
#pragma unroll
            for (int it = 0; it < 4; ++it) {
                const int h = 4 * it + grp;
                {
                    bf16* p = qb + (size_t)row * 3072 + h * MLA_QK + 4 * l15; v2u w[3];
#pragma unroll
                    for (int k = 0; k < 3; ++k) w[k] = *(const v2u*)(p + 64 * k);
                    float v[12];
#pragma unroll
                    for (int k = 0; k < 3; ++k) { v[4 * k] = bflo(w[k].x); v[4 * k + 1] = bfhi(w[k].x); v[4 * k + 2] = bflo(w[k].y); v[4 * k + 3] = bfhi(w[k].y); }
                    float s = 0.f;
#pragma unroll
                    for (int e = 0; e < 12; ++e) s += v[e] * v[e];
                    s = sum16(s); const float rs = 1.0f / sqrtf(s * (1.0f / MLA_QK) + NORM_EPS);
#pragma unroll
                    for (int e = 0; e < 12; ++e) v[e] = v[e] * rs * gq[e];
#pragma unroll
                    for (int j = 0; j < 4; ++j) { const float yp = __shfl_xor(v[8 + j], 8); v[8 + j] = v[8 + j] * cr[j] + yp * sr[j]; }
#pragma unroll
                    for (int k = 0; k < 3; ++k) { v2u o; o.x = pk2(v[4 * k], v[4 * k + 1]); o.y = pk2(v[4 * k + 2], v[4 * k + 3]); *(v2u*)(p + 64 * k) = o; }
                }
                {
                    const bf16* p = kvb + (size_t)row * 4096 + h * 256 + 4 * l15; v2u w[3];
                    w[0] = *(const v2u*)p; w[1] = *(const v2u*)(p + 64); w[2] = kpe;
                    float v[12];
#pragma unroll
                    for (int k = 0; k < 3; ++k) { v[4 * k] = bflo(w[k].x); v[4 * k + 1] = bfhi(w[k].x); v[4 * k + 2] = bflo(w[k].y); v[4 * k + 3] = bfhi(w[k].y); }
                    float s = 0.f;
#pragma unroll
                    for (int e = 0; e < 12; ++e) s += v[e] * v[e];
                    s = sum16(s); const float rs = 1.0f / sqrtf(s * (1.0f / MLA_QK) + NORM_EPS);
#pragma unroll
                    for (int e = 0; e < 12; ++e) v[e] = v[e] * rs * gk[e];
#pragma unroll
                    for (int j = 0; j < 4; ++j) { const float yp = __shfl_xor(v[8 + j], 8); v[8 + j] = v[8 + j] * cr[j] + yp * sr[j]; }
                    bf16* o_ = kb + (size_t)row * 3072 + h * MLA_QK + 4 * l15;
#pragma unroll
                    for (int k = 0; k < 3; ++k) { v2u o; o.x = pk2(v[4 * k], v[4 * k + 1]); o.y = pk2(v[4 * k + 2], v[4 * k + 3]); *(v2u*)(o_ + 64 * k) = o; }
                }
            }
#pragma unroll
            for (int it = 0; it < 2; ++it) {
                const int jh = 4 * it + grp; const size_t pb = ((size_t)row * DIL_HPG + jh) * 3;
                const float m0 = dpm[pb * 2 + 0], l0 = dpm[pb * 2 + 1], m1 = dpm[pb * 2 + 2], l1 = dpm[pb * 2 + 3], m2 = dpm[pb * 2 + 4], l2 = dpm[pb * 2 + 5];
                const float mm = fmaxf(m0, fmaxf(m1, m2)); const float w0 = __builtin_amdgcn_exp2f(m0 - mm) * l0, w1 = __builtin_amdgcn_exp2f(m1 - mm) * l1, w2 = __builtin_amdgcn_exp2f(m2 - mm) * l2;
                const float rw = 1.0f / (w0 + w1 + w2);
                float a0[8], a1[8], a2[8], x[8];
                unpack8(*(const v4u*)(dpo + (pb + 0) * HD + 8 * l15), a0); unpack8(*(const v4u*)(dpo + (pb + 1) * HD + 8 * l15), a1); unpack8(*(const v4u*)(dpo + (pb + 2) * HD + 8 * l15), a2);
#pragma unroll
                for (int j = 0; j < 8; ++j) x[j] = (w0 * a0[j] + w1 * a1[j] + w2 * a2[j]) * rw;
                *(v4u*)(omix + (size_t)row * 3072 + 2048 + jh * HD + 8 * l15) = pack8(x);
            }
        }
    }
    SEAM(4);
    if (IN(5)) {
        for (int i = 0; i * F.G + (int)blockIdx.x < BATCH * MLA_H * (SEQ / 256); ++i) {
            const int c = (int)blockIdx.x; int bh = i * 8 + (c & 7), qblk = c >> 3;
            if (F.G != 256) { const int u = i * F.G + c; bh = u >> 5; qblk = u & 31; }
            const int b = bh >> 4, h = bh & 15; const size_t r0 = (size_t)b * SEQ;
            MLA_UNIT(qb + (r0 + (size_t)qblk * 256) * 3072 + h * MLA_QK, kb + r0 * 3072 + h * MLA_QK, kvb + r0 * 4096 + h * 256 + 128,
                              omix + (r0 + (size_t)qblk * 256) * 3072 + h * HD, SEQ, (char*)lds);
        }
    }
    SEAM(5);
    if (IN(6)) {
        pg8::Gemm g{omix, Weout_t, M, DM, EVEN_MIX, EVEN_MIX}; pg8::StaticOrder S; S.init(M, DM, F.G, (int)blockIdx.x); pg8::EpiResidT<0> E{x_in, out, xb, xl0, xl1, ss, DM};
        pg8::gemm_phase<pg8::EpiResidT<0>, pg8::StaticOrder, true, true>(F.lds, g, S, E);
    }
    SEAM(6);
#define RSTD_PHASE() do { for (int row = F.gw; row < M; row += F.ngw) { const float s = wave_sum(ss[(size_t)row * 64 + lane]); if (lane == 0) rstd[row] = 1.0f / sqrtf(s * (1.0f / DM) + NORM_EPS); } } while (0)
#define FFN_GATEUP(layer) do { const bf16* wl = (const bf16*)(ws + WS_WFFN + (size_t)(layer) * 3 * FFN_W_BYTES); \
        pg8::Gemm g{xb, wl, M, 2 * DFF, DM, DM}; pg8::StaticOrder S; S.init(M, 2 * DFF, F.G, (int)blockIdx.x, DM / 64, (float*)(R + (size_t)(16 + 48 * (layer)) * MiB), ctl + 8192 + 2048 * (1 + (layer))); \
        pg8::EpiGateUp E{h2b, rstd, args.in[21] + (size_t)(layer) * 3 * DFF, args.in[22] + (size_t)(layer) * DFF, DFF, aedge, uedge, (PG8_LAS float*)(F.lds + NA_TB_OFF)}; \
        pg8::gemm_phase<pg8::EpiGateUp, pg8::StaticOrder, true, true, true>(F.lds, g, S, E); } while (0)
#define FFN_FIX(layer) do { const float* cwp = args.in[21] + (size_t)(layer) * 3 * DFF; const float* cbp = args.in[22] + (size_t)(layer) * DFF; \
        const int gtid = blockIdx.x * (NWAVES * 64) + F.tid, nthr = F.G * NWAVES * 64; \
        for (int i = gtid; i < (M / 256) * 2 * (DFF / 8); i += nthr) { const int c8 = i % (DFF / 8), e = (i / (DFF / 8)) & 1, pm = i / (2 * (DFF / 8)); const int ch = c8 * 8; \
            const int row = pm * 256 + (e ? 255 : 0), t = row & (SEQ - 1); const v4u z4 = {0u, 0u, 0u, 0u}; \
            const v4u cur = *(const v4u*)(aedge + ((size_t)pm * 4 + (e ? 3 : 0)) * DFF + ch); \
            const v4u prv = e ? *(const v4u*)(aedge + ((size_t)pm * 4 + 2) * DFF + ch) : (t > 0 ? *(const v4u*)(aedge + ((size_t)(pm - 1) * 4 + 3) * DFF + ch) : z4); \
            const v4u nxt = e ? (t < SEQ - 1 ? *(const v4u*)(aedge + ((size_t)(pm + 1) * 4 + 0) * DFF + ch) : z4) : *(const v4u*)(aedge + ((size_t)pm * 4 + 1) * DFF + ch); \
            const v4u upv = *(const v4u*)(uedge + ((size_t)pm * 2 + e) * DFF + ch); \
            const unsigned cu_[4] = {cur.x, cur.y, cur.z, cur.w}, pr_[4] = {prv.x, prv.y, prv.z, prv.w}, nx_[4] = {nxt.x, nxt.y, nxt.z, nxt.w}, up_[4] = {upv.x, upv.y, upv.z, upv.w}; \
            float hv[8]; \
            _Pragma("unroll") for (int j = 0; j < 8; ++j) { \
                const float fm = (j & 1) ? bfhi(pr_[j >> 1]) : bflo(pr_[j >> 1]), fz = (j & 1) ? bfhi(cu_[j >> 1]) : bflo(cu_[j >> 1]), fn = (j & 1) ? bfhi(nx_[j >> 1]) : bflo(nx_[j >> 1]), fu = (j & 1) ? bfhi(up_[j >> 1]) : bflo(up_[j >> 1]); \
                const float gg = cwp[ch + j] * fm + cwp[DFF + ch + j] * fz + cwp[2 * DFF + ch + j] * fn + cbp[ch + j]; \
                const float ee = __builtin_amdgcn_exp2f(-1.4426950408889634f * gg); hv[j] = gg * __builtin_amdgcn_rcpf(1.0f + ee) * fu; } \
            v4u o; o.x = pk2(hv[0], hv[1]); o.y = pk2(hv[2], hv[3]); o.z = pk2(hv[4], hv[5]); o.w = pk2(hv[6], hv[7]); \
            *(v4u*)(h2b + (size_t)row * DFF + ch) = o; } } while (0)
#define FFN_DOWN(layer) do { const bf16* wl = (const bf16*)(ws + WS_WFFN + (size_t)(layer) * 3 * FFN_W_BYTES + 2 * FFN_W_BYTES); \
        pg8::Gemm g{h2b, wl, M, DM, DFF, DFF}; pg8::StaticOrder S; S.init(M, DM, F.G, (int)blockIdx.x); pg8::EpiResidT<(layer) == 0 ? 1 : 2> E{nullptr, out, xb, xl0, xl1, ss, DM}; \
        pg8::gemm_phase<pg8::EpiResidT<(layer) == 0 ? 1 : 2>, pg8::StaticOrder, true, true>(F.lds, g, S, E); } while (0)
    if (IN(7)) RSTD_PHASE();
    SEAM(7);
    if (IN(8)) FFN_GATEUP(0);
    SEAM(8);
    if (IN(9)) FFN_FIX(0);
    SEAM(9);
    if (IN(10)) FFN_DOWN(0);
    SEAM(10);
    if (IN(11)) RSTD_PHASE();
    SEAM(11);
    if (IN(12)) {
        pg8::Gemm g{xb, Wqkv_t, M, 12288, DM, DM}; pg8::StaticOrder S; S.init(M, 12288, F.G, (int)blockIdx.x); pg8::EpiHeadNorm E{qkvb, 12288, rstd, args.in[14], args.in[15], QS_HD, 16, 16, (PG8_LAS float*)(F.lds + NA_TB_OFF), nullptr, nullptr, SEQ};
        pg8::gemm_phase<pg8::EpiHeadNorm, pg8::StaticOrder, true, true>(F.lds, g, S, E);
    }
    SEAM(12);
    if (IN(14)) {
        const float* rpb = args.in[16];
        WAT_LAS char* L = (WAT_LAS char*)F.lds;
        WAT_LAS float* tb = (WAT_LAS float*)(L + NA_TB_OFF);
        const int NU = BATCH * NA_H * GRID_ROWS;
        const int u0 = (int)(((long)NU * blockIdx.x) / F.G), u1 = (int)(((long)NU * (blockIdx.x + 1)) / F.G);
        const int row16 = F.tid >> 4, ch16 = F.tid & 15, kso = wat::kst_off(row16, ch16), vso = wat::vst_off(row16, ch16);
        const int w = F.wave, q = lane & 15, g4 = lane >> 4;
        const int cg = w & 3, kc0 = min(max(16 * cg - 8, 0), 32), gc = 16 * cg + q, cs = min(max(gc - 8, 0), 48);
        unsigned vmask = 0;
#pragma unroll
        for (int j = 0; j < 8; ++j) { const int kc = kc0 + 8 * g4 + j; if (kc >= cs && kc < cs + 16) vmask |= 1u << j; }
        const int bcol = kc0 + 8 * g4 - gc + 15;
        v4u st[8]; int cur_h = -1;
#define NA_GEOM(u_, s_) const int bh_ = (u_) >> 7, i_ = (u_) & 127, b_ = bh_ >> 5, h_ = bh_ & 31, rs_ = min(max(i_ - 4, 0), GRID_ROWS - 8); \
        const bf16* src_ = qkvb + (size_t)(b_ * SEQ + (rs_ + 4 * ((s_) & 1)) * GRID_W + row16) * 12288 + ((s_) < 2 ? 4096 : 8192) + h_ * HD + ch16 * 8;
#define NA_LOAD(u_, s_) do { NA_GEOM(u_, s_) _Pragma("unroll") for (int k = 0; k < 8; ++k) st[k] = *(const v4u*)(src_ + (size_t)k * 32 * 12288); } while (0)
#define NA_WRITE(s_) do { WAT_LAS char* d_ = L + ((s_) & 1) * 65536 + ((s_) < 2 ? kso : vso); _Pragma("unroll") for (int k = 0; k < 8; ++k) *(WAT_LAS v4u*)(d_ + k * 32 * 256) = st[k]; } while (0)
#define NA_END(un_, sn_, un2_, sn2_) do { if ((un_) < u1) { VM_WAIT(); NA_WRITE(sn_); } __syncthreads(); if ((un2_) < u1) NA_LOAD(un2_, sn2_); } while (0)
        if (u0 < u1) { NA_LOAD(u0, 0); VM_WAIT(); NA_WRITE(0); __syncthreads(); NA_LOAD(u0, 1); }
        for (int u = u0; u < u1; ++u) {
            const int bh = u >> 7, gi = u & 127, b = bh >> 5, h = bh & 31, rs0 = min(max(gi - 4, 0), GRID_ROWS - 8);
            wat::bf16x8 qf[4]; wat::f32x4 sc[8][2]; wat::bf16x8 pf[8]; wat::f32x4 o[8]; float linv = 0.f;
            if (h != cur_h) { for (int t = F.tid; t < 465; t += NWAVES * 64) tb[t] = rpb[(size_t)h * 465 + t] * LOG2E; cur_h = h; }
            if (w < 4) {
                const bf16* qp = qkvb + (size_t)(b * SEQ + gi * GRID_W + gc) * 12288 + h * HD + 8 * g4;
#pragma unroll
                for (int s = 0; s < 4; ++s) qf[s] = *(const wat::bf16x8*)(qp + 32 * s);
#pragma unroll
                for (int g = 0; g < 4; ++g) wat::qk_group(sc[g][0], sc[g][1], L, g * 64 + kc0, qf, lane);
            }
            NA_END(u, 1, u, 2);
            if (w < 4) {
#pragma unroll
                for (int g = 0; g < 4; ++g) wat::qk_group(sc[4 + g][0], sc[4 + g][1], L + 65536, g * 64 + kc0, qf, lane);
                float m = -1e30f;
#pragma unroll
                for (int kr = 0; kr < 8; ++kr) { const WAT_LAS float* tr_ = tb + (rs0 + kr - gi + NA_ROWS - 1) * 31 + bcol;
#pragma unroll
                    for (int j = 0; j < 8; ++j) { const bool ok = (vmask >> j) & 1u; const float bias = ok ? tr_[j] : 0.f; const float v = ok ? sc[kr][j >> 2][j & 3] + bias : -1e30f; sc[kr][j >> 2][j & 3] = v; m = fmaxf(m, v); } }
                m = fmaxf(m, __shfl_xor(m, 16)); m = fmaxf(m, __shfl_xor(m, 32));
                float l = 0.f;
#pragma unroll
                for (int kr = 0; kr < 8; ++kr) {
#pragma unroll
                    for (int j = 0; j < 8; ++j) { const float v = ((vmask >> j) & 1u) ? __builtin_amdgcn_exp2f(sc[kr][j >> 2][j & 3] - m) : 0.f; sc[kr][j >> 2][j & 3] = v; l += v; }
                    pf[kr] = wat::p_frag(sc[kr][0], sc[kr][1]); }
                l += __shfl_xor(l, 16); l += __shfl_xor(l, 32); linv = 1.0f / l;
#pragma unroll
                for (int c = 0; c < 8; ++c) o[c] = wat::f32x4{0.f, 0.f, 0.f, 0.f};
            }
            NA_END(u, 2, u, 3);
            if (w < 4) {
                { const unsigned vb = (unsigned)(uintptr_t)L + (unsigned)wat::vrd_base(kc0, lane); wat::pv_group<0>(o, vb, pf[0]); wat::pv_group<16384>(o, vb, pf[1]); wat::pv_group<32768>(o, vb, pf[2]); wat::pv_group<49152>(o, vb, pf[3]); }
            }
            NA_END(u, 3, u + 1, 0);
            if (w < 4) {
                { const unsigned vb = (unsigned)(uintptr_t)(L + 65536) + (unsigned)wat::vrd_base(kc0, lane); wat::pv_group<0>(o, vb, pf[4]); wat::pv_group<16384>(o, vb, pf[5]); wat::pv_group<32768>(o, vb, pf[6]); wat::pv_group<49152>(o, vb, pf[7]); }
                WAT_LAS char* ost = L + NA_OST_OFF + w * 4352;
#pragma unroll
                for (int r = 0; r < 4; ++r) { const float li = __shfl(linv, 4 * g4 + r);
#pragma unroll
                    for (int c = 0; c < 8; ++c) *(WAT_LAS unsigned short*)(ost + (4 * g4 + r) * 272 + (16 * c + q) * 2) = (unsigned short)(wat::cvtpk(o[c][r] * li, 0.f) & 0xffffu); }
                asm volatile("s_waitcnt lgkmcnt(0)" ::: "memory");
#pragma unroll
                for (int k = 0; k < 4; ++k) { const int rq = g4 + 4 * k; const v4u v = *(const WAT_LAS v4u*)(ost + rq * 272 + q * 16);
                    *(v4u*)(ob + (size_t)(b * SEQ + gi * GRID_W + 16 * cg + rq) * DM + h * HD + q * 8) = v; }
            }
            NA_END(u + 1, 0, u + 1, 1);
        }
#undef NA_GEOM
#undef NA_LOAD
#undef NA_WRITE
#undef NA_END
    }
    SEAM(14);
    if (IN(15)) {
        pg8::Gemm g{ob, Woout_t, M, DM, DM, DM}; pg8::StaticOrder S; S.init(M, DM, F.G, (int)blockIdx.x); pg8::EpiResidT<1> E{nullptr, out, xb, xl0, xl1, ss, DM};
        pg8::gemm_phase<pg8::EpiResidT<1>, pg8::StaticOrder, true, true>(F.lds, g, S, E);
    }
    SEAM(15);
    if (IN(16)) RSTD_PHASE();
    SEAM(16);
    if (IN(17)) FFN_GATEUP(1);
    SEAM(17);
    if (IN(18)) FFN_FIX(1);
    SEAM(18);
    if (IN(19)) FFN_DOWN(1);
#undef IN
#undef SEAM
}

#if MK_CHECK
constexpr size_t WS_CHK = 9 * MiB;
constexpr int NS = 32;
__device__ const int g_rows[16] = {0, 1, 63, 64, 65, 127, 128, 4095, 4096, 8190, 8191, 8192, 8193, 8255, 16382, 16383};
__device__ __forceinline__ int srow(int i) { return i < 16 ? g_rows[i] : (int)(((unsigned)i * 2654435761u >> 9) % (unsigned)M); }
__device__ __forceinline__ int scol(int j, int N) { return j == 0 ? 0 : (j == 1 ? N - 1 : (int)(((unsigned)j * 2246822519u + 12345u) % (unsigned)N)); }
__device__ __forceinline__ float bf2f(bf16 b) { return __uint_as_float((unsigned)b << 16); }
__device__ __forceinline__ void chk_rec(unsigned* w, int c, float got, float ref, float scale) {
    float e = fabsf(got - ref) / (0.03f * (fabsf(ref) + scale)); if (!(e == e) || !(e < 1e30f)) e = 1e30f;
    atomicMax(&w[c], __float_as_uint(e));
}
__device__ __forceinline__ float dot_bf(const bf16* a, const bf16* b, int K) { float s = 0.f; for (int k = 0; k < K; ++k) s += bf2f(a[k]) * bf2f(b[k]); return s; }
__global__ void k_chk_gemm(const bf16* A, int lda, const bf16* Bt, int K, int N, const float* rs, const float* base, int base_ld, int base_by_sample,
                           const bf16* got_b, const float* got_f, int ldo, unsigned* w, int c, float scale) {
    const int i = blockIdx.x, j = threadIdx.x, row = srow(i), col = scol(j, N);
    float ref = dot_bf(A + (size_t)row * lda, Bt + (size_t)col * K, K); if (rs) ref *= rs[row];
    if (base) ref += base_by_sample == 2 ? bf2f(((const bf16*)base)[(size_t)i * base_ld + col]) : base[(size_t)(base_by_sample ? i : row) * base_ld + col];
    const float got = got_b ? bf2f(got_b[(size_t)row * ldo + col]) : got_f[(size_t)row * ldo + col];
    chk_rec(w, c, got, ref, scale);
}
__global__ void k_chk_copy(const unsigned char* src, size_t row_bytes, unsigned char* dst) {
    const int i = blockIdx.x, row = srow(i); for (size_t b = threadIdx.x * 4; b < row_bytes; b += blockDim.x * 4) *(unsigned*)(dst + (size_t)i * row_bytes + b) = *(const unsigned*)(src + (size_t)row * row_bytes + b);
}
__global__ void k_chk_rstd(const float* src, const float* rstd, const bf16* xb, unsigned* w, int c) {
    const int i = blockIdx.x * blockDim.x + threadIdx.x; if (i >= NS) return; const int row = srow(i); float s = 0.f;
    for (int k = 0; k < DM; ++k) { const float v = src[(size_t)row * DM + k]; s += v * v; }
    chk_rec(w, c, rstd[row], 1.0f / sqrtf(s / DM + NORM_EPS), 0.f);
    if (xb) for (int k = 0; k < DM; k += 97) chk_rec(w, c, bf2f(xb[(size_t)row * DM + k]), src[(size_t)row * DM + k], 0.01f);
}
__global__ void k_chk_w(const float* W, int K, int N, const bf16* dst, const float* gain, int mode, unsigned* w, int c) {
    const unsigned t = blockIdx.x * blockDim.x + threadIdx.x; const int k = (int)((t * 2654435761u >> 7) % (unsigned)K), n = scol((int)t, N);
    const int dr = (mode == 1) ? (n >= 1472 ? n - 1472 : n + 9216) : (mode >= 2 ? (n >> 7) * 256 + (n & 127) + (mode == 3 ? 128 : 0) : n); float ref = W[(size_t)k * N + n]; if (gain) ref *= gain[k];
    chk_rec(w, c, bf2f(dst[(size_t)dr * K + k]), ref, 1e-4f);
}
__global__ void k_chk_rope(const float* cosT, const float* sinT, int half, double c1, unsigned* w, int c) {
    const int t = blockIdx.x * blockDim.x + threadIdx.x; const int k = t % half; int pos = 1 + (int)(((unsigned)t * 2654435761u >> 8) % (unsigned)(SEQ - 1));
    double p = 1.0; for (int j = 0; j < k; ++j) p *= c1; const double th = (double)(float)p;
    double sn = 0, cs = 0, term = 1.0; for (int n = 0; n < 24; ++n) { if (n & 1) sn += ((n >> 1) & 1 ? -term : term); else cs += ((n >> 1) & 1 ? -term : term); term *= th / (n + 1); }
    chk_rec(w, c, cosT[1 * half + k], (float)cs, 0.02f); chk_rec(w, c, sinT[1 * half + k], (float)sn, 0.02f);
    chk_rec(w, c, cosT[k], 1.f, 0.02f); chk_rec(w, c, sinT[k], 0.f, 0.02f);
    const float ca = cosT[(pos - 1) * half + k], sa = sinT[(pos - 1) * half + k], c1f = cosT[half + k], s1f = sinT[half + k];
    chk_rec(w, c, cosT[pos * half + k], ca * c1f - sa * s1f, 0.03f); chk_rec(w, c, sinT[pos * half + k], sa * c1f + ca * s1f, 0.03f);
}
__global__ void k_chk_p2(const bf16* zc, const bf16* z, const bf16* cqn, const bf16* ckvn, const float* dqn, const float* dkn, const float* cosA, const float* sinA, unsigned* w, int c) {
    const int i = blockIdx.x, t = threadIdx.x, row = srow(i), pos = row & (SEQ - 1); const bf16* src = zc + (size_t)i * ZLD;
    if (false) { const bf16* p = src + t * HD; float s = 0.f; for (int d = 0; d < HD; ++d) s += bf2f(p[d]) * bf2f(p[d]);
        const float rs = 1.0f / sqrtf(s / HD + NORM_EPS); const float* g = t < 24 ? dqn : dkn; const float qs = t < 24 ? QS_HD : 1.f;
        for (int d = 0; d < HD; ++d) { float y = bf2f(p[d]) * rs * g[d];
            if (d < 16) y = y * cosA[pos * 16 + d] - bf2f(p[d + 16]) * rs * g[d + 16] * sinA[pos * 16 + d];
            else if (d < 32) y = y * cosA[pos * 16 + d - 16] + bf2f(p[d - 16]) * rs * g[d - 16] * sinA[pos * 16 + d - 16];
            chk_rec(w, c, bf2f(z[(size_t)row * ZLD + t * HD + d]), y * qs, 0.05f * qs); } }
    else if (t == 48) { float s = 0.f; for (int d = 0; d < QRANK; ++d) s += bf2f(src[Z_CQ + d]) * bf2f(src[Z_CQ + d]); const float rs = 1.0f / sqrtf(s / QRANK + NORM_EPS);
        for (int d = 0; d < QRANK; ++d) chk_rec(w, c, bf2f(cqn[(size_t)row * QRANK + d]), bf2f(src[Z_CQ + d]) * rs, 0.05f); }
    else if (t == 49) { float s = 0.f; for (int d = 0; d < KVRANK; ++d) s += bf2f(src[Z_CKV + d]) * bf2f(src[Z_CKV + d]); const float rs = 1.0f / sqrtf(s / KVRANK + NORM_EPS);
        for (int d = 0; d < KVRANK; ++d) chk_rec(w, c, bf2f(ckvn[(size_t)row * KVRANK + d]), bf2f(src[Z_CKV + d]) * rs, 0.05f); }
}
__global__ void k_chk_p4(const bf16* qc, const bf16* q, const bf16* kv, const bf16* z, const bf16* kout, const float* qn, const float* kn, const float* cosB, const float* sinB, unsigned* w, int c) {
    const int i = blockIdx.x, t = threadIdx.x, row = srow(i), pos = row & (SEQ - 1), h = t & 15; const bool isk = t >= 16;
    float s = 0.f;
    for (int d = 0; d < MLA_QK; ++d) { const float v = isk ? (d < 128 ? bf2f(kv[(size_t)row * 4096 + h * 256 + d]) : bf2f(z[(size_t)row * ZLD + Z_KPE + d - 128])) : bf2f(qc[(size_t)i * 3072 + h * MLA_QK + d]); s += v * v; }
    const float rs = 1.0f / sqrtf(s / MLA_QK + NORM_EPS); const float* g = isk ? kn : qn; const float qs = isk ? 1.f : QS_MLA;
    for (int d = 0; d < MLA_QK; ++d) {
        auto val = [&](int dd) { return (isk ? (dd < 128 ? bf2f(kv[(size_t)row * 4096 + h * 256 + dd]) : bf2f(z[(size_t)row * ZLD + Z_KPE + dd - 128])) : bf2f(qc[(size_t)i * 3072 + h * MLA_QK + dd])) * rs * g[dd]; };
        float y = val(d);
        if (d >= 128 && d < 160) y = y * cosB[pos * 32 + d - 128] - val(d + 32) * sinB[pos * 32 + d - 128];
        else if (d >= 160) y = y * cosB[pos * 32 + d - 160] + val(d - 32) * sinB[pos * 32 + d - 160];
        const float got = isk ? bf2f(kout[(size_t)row * 3072 + h * MLA_QK + d]) : bf2f(q[(size_t)row * 3072 + h * MLA_QK + d]);
        chk_rec(w, c, got, y * qs, 0.05f * qs); }
}
__global__ void k_chk_mla(const bf16* q, const bf16* k, const bf16* kv, const bf16* omix, unsigned* w, int c) {
    const int i = blockIdx.x, t = threadIdx.x, row = srow(i), b0 = row & ~(SEQ - 1), h = (i * 7 + 3) & 15, d = (t * 37 + i) & 127;
    const bf16* qp = q + (size_t)row * 3072 + h * MLA_QK; float m = -1e30f;
    for (int key = 0; key < SEQ; ++key) m = fmaxf(m, dot_bf(qp, k + (size_t)(b0 + key) * 3072 + h * MLA_QK, MLA_QK));
    float l = 0.f, o = 0.f, o2 = 0.f;
    for (int key = 0; key < SEQ; ++key) { const float p = exp2f(dot_bf(qp, k + (size_t)(b0 + key) * 3072 + h * MLA_QK, MLA_QK) - m); const float v = bf2f(kv[(size_t)(b0 + key) * 4096 + h * 256 + 128 + d]); l += p; o += p * v; o2 += p * v * v; }
    chk_rec(w, c, bf2f(omix[(size_t)row * 3072 + h * HD + d]), o / l, 0.5f * sqrtf(o2 / l) * 0.1f + 1e-3f);
}
__global__ void k_chk_dil(const bf16* z, const bf16* omix, unsigned* w, int c) {
    const int i = blockIdx.x, t = threadIdx.x, row = srow(i), b0 = row & ~(SEQ - 1), pos = row & (SEQ - 1), j = (i * 5 + 1) & 7, d = (t * 37 + i) & 127;
    float m = -1e30f;
    for (int g = 0; g < 3; ++g) { const int dl = 1 << (2 * g), head = 8 * g + j; for (int tt = -64; tt <= 64; ++tt) { const int kp = pos + dl * tt; if (kp < 0 || kp >= SEQ) continue;
        m = fmaxf(m, dot_bf(z + (size_t)row * ZLD + head * HD, z + (size_t)(b0 + kp) * ZLD + 3072 + head * HD, HD)); } }
    float l = 0.f, o = 0.f;
    for (int g = 0; g < 3; ++g) { const int dl = 1 << (2 * g), head = 8 * g + j; for (int tt = -64; tt <= 64; ++tt) { const int kp = pos + dl * tt; if (kp < 0 || kp >= SEQ) continue;
        const float p = exp2f(dot_bf(z + (size_t)row * ZLD + head * HD, z + (size_t)(b0 + kp) * ZLD + 3072 + head * HD, HD) - m); l += p; o += p * bf2f(z[(size_t)(b0 + kp) * ZLD + 6144 + head * HD + d]); } }
    chk_rec(w, c, bf2f(omix[(size_t)row * 3072 + 2048 + j * HD + d]), o / l, 0.02f);
}
__global__ void k_chk_na(const bf16* qkv, const float* rpb, const bf16* ob, unsigned* w, int c) {
    const int i = blockIdx.x, t = threadIdx.x, row = srow(i), b0 = row & ~(SEQ - 1), pos = row & (SEQ - 1), gi = pos >> 6, gc = pos & 63, h = (i * 11 + 5) & 31, d = (t * 37 + i) & 127;
    const int rs0 = min(max(gi - 4, 0), GRID_ROWS - 8), cs0 = min(max(gc - 8, 0), 48); float m = -1e30f;
    for (int kr = 0; kr < 8; ++kr) for (int kc = 0; kc < 16; ++kc) { const int key = b0 + (rs0 + kr) * 64 + cs0 + kc;
        m = fmaxf(m, dot_bf(qkv + (size_t)row * 12288 + h * HD, qkv + (size_t)key * 12288 + 4096 + h * HD, HD) + rpb[(size_t)h * 465 + (rs0 + kr - gi + 7) * 31 + (cs0 + kc - gc + 15)] * LOG2E); }
    float l = 0.f, o = 0.f;
    for (int kr = 0; kr < 8; ++kr) for (int kc = 0; kc < 16; ++kc) { const int key = b0 + (rs0 + kr) * 64 + cs0 + kc;
        const float p = exp2f(dot_bf(qkv + (size_t)row * 12288 + h * HD, qkv + (size_t)key * 12288 + 4096 + h * HD, HD) + rpb[(size_t)h * 465 + (rs0 + kr - gi + 7) * 31 + (cs0 + kc - gc + 15)] * LOG2E - m);
        l += p; o += p * bf2f(qkv[(size_t)key * 12288 + 8192 + h * HD + d]); }
    chk_rec(w, c, bf2f(ob[(size_t)row * DM + h * HD + d]), o / l, 0.03f);
}
__global__ void k_chk_p13(const bf16* qc, const bf16* qkv, const float* qn, const float* kn, unsigned* w, int c) {
    const int i = blockIdx.x, t = threadIdx.x, row = srow(i); const bf16* p = qc + (size_t)i * 12288 + t * HD; float s = 0.f;
    for (int d = 0; d < HD; ++d) s += bf2f(p[d]) * bf2f(p[d]);
    const float rs = 1.0f / sqrtf(s / HD + NORM_EPS); const float* g = t < 32 ? qn : kn; const float qs = t < 32 ? QS_HD : 1.f;
    for (int d = 0; d < HD; ++d) chk_rec(w, c, bf2f(qkv[(size_t)row * 12288 + t * HD + d]), bf2f(p[d]) * rs * g[d] * qs, 0.05f * qs);
}
__global__ void k_chk_qkvn(const bf16* xb, const bf16* Wt, const float* rstd, const bf16* qkv, const float* qn, const float* kn, unsigned* w, int c) {
    const int i = blockIdx.x, t = threadIdx.x, row = srow(i), head = (t * 7 + i) % 96, d = (t * 37 + i * 5) & 127; float s = 0.f, mine = 0.f;
    for (int dd = 0; dd < HD; ++dd) { const float v = dot_bf(xb + (size_t)row * DM, Wt + (size_t)(head * HD + dd) * DM, DM) * rstd[row]; s += v * v; if (dd == d) mine = v; }
    float ref = mine; if (head < 64) { const float rs = 1.0f / sqrtf(s / HD + NORM_EPS); ref = mine * rs * (head < 32 ? qn[d] * QS_HD : kn[d]); }
    chk_rec(w, c, bf2f(qkv[(size_t)row * 12288 + head * HD + d]), ref, head < 32 ? 0.05f * QS_HD : 0.05f);
}
__global__ void k_chk_zn(const bf16* xb, const bf16* Wt, const float* rstd, const bf16* z, const float* dqn, const float* dkn, const float* cosA, const float* sinA, unsigned* w, int c) {
    const int i = blockIdx.x, t = threadIdx.x, row = srow(i), pos = row & (SEQ - 1);
    if (t < 48) { const int d = (t * 37 + i * 5) & 127; const int dp = d < 16 ? d + 16 : (d < 32 ? d - 16 : d); float s = 0.f, mine = 0.f, other = 0.f;
        for (int dd = 0; dd < HD; ++dd) { const float v = dot_bf(xb + (size_t)row * DM, Wt + (size_t)(t * HD + dd) * DM, DM) * rstd[row]; s += v * v; if (dd == d) mine = v; if (dd == dp) other = v; }
        const float rs = 1.0f / sqrtf(s / HD + NORM_EPS); const float* g = t < 24 ? dqn : dkn; const float qs = t < 24 ? QS_HD : 1.f;
        float y = mine * rs * g[d]; const float yo = other * rs * g[dp];
        if (d < 16) y = y * cosA[pos * 16 + d] - yo * sinA[pos * 16 + d]; else if (d < 32) y = y * cosA[pos * 16 + d - 16] + yo * sinA[pos * 16 + d - 16];
        chk_rec(w, c, bf2f(z[(size_t)row * ZLD + t * HD + d]), y * qs, 0.05f * qs); }
    else { const int col = 6144 + scol(t, 10688 - 6144); const float ref = dot_bf(xb + (size_t)row * DM, Wt + (size_t)col * DM, DM) * rstd[row]; chk_rec(w, c, bf2f(z[(size_t)row * ZLD + col]), ref, 0.05f); }
}
__global__ void k_chk_up(const bf16* xb, const bf16* Wgu, const float* rstd, const float* cw, const float* cb, const bf16* h2, unsigned* w, int c) {
    const int i = blockIdx.x, j = threadIdx.x, col = scol(j, DFF); int row = srow(i); if (i & 1) row = (row & ~255) + ((i & 2) ? 255 : 0) + ((i & 4) ? ((i & 2) ? -1 : 1) : 0);
    const int cls = i < 16 ? 42 + i : 58 + (i & 1);
    const int t = row & (SEQ - 1); const bf16* wg = Wgu + (size_t)((col >> 7) * 256 + (col & 127)) * DM; const bf16* wu = wg + (size_t)128 * DM;
    const bool edge = (row & 255) == 0 || (row & 255) == 255;
    auto rd = [&](float v) { return edge ? __uint_as_float(f2bf(v) << 16) : v; };
    const float up = rd(dot_bf(xb + (size_t)row * DM, wu, DM) * rstd[row]);
    float g = cb[col] + cw[DFF + col] * rd(dot_bf(xb + (size_t)row * DM, wg, DM) * rstd[row]);
    if (t > 0) g += cw[col] * rd(dot_bf(xb + (size_t)(row - 1) * DM, wg, DM) * rstd[row - 1]); if (t < SEQ - 1) g += cw[2 * DFF + col] * rd(dot_bf(xb + (size_t)(row + 1) * DM, wg, DM) * rstd[row + 1]);
    const float ref = g / (1.0f + expf(-g)) * up;
    chk_rec(w, cls, bf2f(h2[(size_t)row * DFF + col]), ref, 0.05f);
}
__global__ void k_chk_final(unsigned* w, float* out) {
    if (threadIdx.x != 0 || blockIdx.x != 0) return;
    for (int c = 0; c < 64; ++c) { const float e = __uint_as_float(w[c]); if (e > 1.0f) { int b = 0; float x = e; while (x >= 10.f && b < 20) { x *= 0.1f; ++b; } float V = (float)(10 + c) * 100.f; for (int q = 0; q < b; ++q) V *= 10.f; out[0] = V; return; } }
}
#endif
#ifndef MK_ONE_LAUNCH
#define MK_ONE_LAUNCH 1
#endif
extern "C" void kernel_launch(void* const* d_in, const int* in_sizes, int n_in, void* d_out, int out_size, void* d_ws, size_t ws_size, hipStream_t stream) {
    static int grid = 0;
    if (grid == 0) {
        const long long want[24] = {(long long)M * DM, DM, (long long)DM * EVEN_IN, QRANK, KVRANK, (long long)QRANK * 3072, (long long)KVRANK * 4096, MLA_QK, MLA_QK, HD, HD, (long long)EVEN_MIX * DM,
                                    DM, (long long)DM * 12288, HD, HD, (long long)NA_H * 15 * 31, (long long)DM * DM, 2 * DM, 2LL * DM * DFF, 2LL * DM * DFF, 2 * 3 * DFF, 2 * DFF, 2LL * DFF * DM};
        bool sizes_ok = n_in == 24; for (int i = 0; sizes_ok && i < 24; ++i) if ((long long)in_sizes[i] != want[i]) { fprintf(stderr, "kernel_launch: input %d has %d elements, expected %lld\n", i, in_sizes[i], want[i]); sizes_ok = false; }
        if (!sizes_ok || out_size != M * DM || ws_size < WS_END) { fprintf(stderr, "kernel_launch: unexpected shapes: n_in %d in0 %d out %d ws %zu (need %zu)\n", n_in, n_in > 0 ? in_sizes[0] : -1, out_size, ws_size, (size_t)WS_END); grid = -1; return; }
        int dev = 0, cus = 0, per_cu = 0;
        if (hipGetDevice(&dev) != hipSuccess || hipDeviceGetAttribute(&cus, hipDeviceAttributeMultiprocessorCount, dev) != hipSuccess) { grid = -1; return; }
        if (hipFuncSetAttribute((const void*)mk_fwd, hipFuncAttributeMaxDynamicSharedMemorySize, LDS_BYTES) != hipSuccess) { fprintf(stderr, "kernel_launch: hipFuncSetAttribute failed\n"); grid = -1; return; }
        if (hipOccupancyMaxActiveBlocksPerMultiprocessor(&per_cu, (const void*)mk_fwd, NWAVES * 64, LDS_BYTES) != hipSuccess || per_cu < 1) fprintf(stderr, "kernel_launch: occupancy query reports %d\n", per_cu);
        (void)hipGetLastError();
        grid = cus;
    }
    if (grid < 0) return;
    if (hipMemsetAsync((char*)d_ws + WS_CTL, 0, CTL_ZERO_BYTES, stream) != hipSuccess) return;
    Args a{};
    for (int i = 0; i < 24; ++i) a.in[i] = (const float*)d_in[i];
    a.out = (float*)d_out; a.ws = (unsigned char*)d_ws;
#if MK_ONE_LAUNCH
    a.ph_lo = 0; a.ph_hi = N_PHASES;
    hipLaunchKernelGGL(mk_fwd, dim3(grid), dim3(NWAVES * 64), LDS_BYTES, stream, a);
#else
#if MK_CHECK
    unsigned char* ws = (unsigned char*)d_ws; unsigned* cw = (unsigned*)(ws + WS_CHK); (void)hipMemsetAsync(cw, 0, 256, stream);
    bf16* cp_z = (bf16*)(ws + WS_CHK + 1 * MiB); bf16* cp_q = (bf16*)(ws + WS_CHK + 2 * MiB); float* cp_out = (float*)(ws + WS_CHK + 3 * MiB); bf16* cp_qkv = (bf16*)(ws + WS_CHK + 4 * MiB);
    float* cosA = (float*)(ws + WS_ROPE); float* sinA = cosA + SEQ * 16; float* cosB = sinA + SEQ * 16; float* sinB = cosB + SEQ * 32;
    float* rstd = (float*)(ws + WS_RSTD); bf16* xb = (bf16*)(ws + WS_XB); unsigned char* R = ws + WS_R;
    bf16* zb = (bf16*)(R + R_Z); bf16* qb = (bf16*)(R + R_Q); bf16* kvb = (bf16*)(R + R_KV); bf16* kb = (bf16*)(R + R_K); bf16* omix = (bf16*)(R + R_OMIX);
    bf16* cqn = (bf16*)(R + R_CQN); bf16* ckvn = (bf16*)(R + R_CKVN); bf16* h2b = (bf16*)(R + R_H2); bf16* qkvb = (bf16*)(R + R_QKV); bf16* ob = (bf16*)(R + R_O);
    bf16* Win_t = (bf16*)(ws + WS_WIN); bf16* Wuq_t = (bf16*)(ws + WS_WUQ); bf16* Wukv_t = (bf16*)(ws + WS_WUKV); bf16* Weout_t = (bf16*)(ws + WS_WEOUT); bf16* Wqkv_t = (bf16*)(ws + WS_WQKV); bf16* Woout_t = (bf16*)(ws + WS_WOOUT);
    float* out = (float*)d_out; const float* const* in = a.in;
    auto WL = [&](int layer, int which) { return (bf16*)(ws + WS_WFFN + (size_t)layer * 3 * FFN_W_BYTES + (size_t)which * FFN_W_BYTES); };
#endif
    for (int p = 0; p < N_PHASES; ++p) {
#if MK_CHECK
        if (p == 2) k_chk_copy<<<NS, 256, 0, stream>>>((const unsigned char*)zb, (size_t)ZLD * 2, (unsigned char*)cp_z);
        if (p == 4) k_chk_copy<<<NS, 256, 0, stream>>>((const unsigned char*)qb, (size_t)3072 * 2, (unsigned char*)cp_q);
        if (p == 10 || p == 15 || p == 19) k_chk_copy<<<NS, 256, 0, stream>>>((const unsigned char*)xb, (size_t)DM * 2, (unsigned char*)cp_out);
#endif
        a.ph_lo = p; a.ph_hi = p + 1; hipLaunchKernelGGL(mk_fwd, dim3(grid), dim3(NWAVES * 64), LDS_BYTES, stream, a);
#if MK_CHECK
        const int c = 2 * p;
        if (p == 0) {
            k_chk_w<<<4, 64, 0, stream>>>(in[2], DM, EVEN_IN, Win_t, in[1], 1, cw, c); k_chk_w<<<4, 64, 0, stream>>>(in[5], QRANK, 3072, Wuq_t, in[3], 0, cw, c); k_chk_w<<<4, 64, 0, stream>>>(in[6], KVRANK, 4096, Wukv_t, in[4], 0, cw, c);
            k_chk_w<<<4, 64, 0, stream>>>(in[11], EVEN_MIX, DM, Weout_t, nullptr, 0, cw, c); k_chk_w<<<4, 64, 0, stream>>>(in[13], DM, 12288, Wqkv_t, in[12], 0, cw, c); k_chk_w<<<4, 64, 0, stream>>>(in[17], DM, DM, Woout_t, nullptr, 0, cw, c);
            for (int l = 0; l < 2; ++l) { k_chk_w<<<4, 64, 0, stream>>>(in[19] + (size_t)l * DM * DFF, DM, DFF, WL(l, 0), in[18] + l * DM, 2, cw, c); k_chk_w<<<4, 64, 0, stream>>>(in[20] + (size_t)l * DM * DFF, DM, DFF, WL(l, 0), in[18] + l * DM, 3, cw, c);
                k_chk_w<<<4, 64, 0, stream>>>(in[23] + (size_t)l * DFF * DM, DFF, DM, WL(l, 2), nullptr, 0, cw, c); }
            k_chk_rstd<<<1, 64, 0, stream>>>(in[0], rstd, xb, cw, c + 1);
            k_chk_rope<<<8, 64, 0, stream>>>(cosA, sinA, 16, 0.44036660267178046, cw, 40); k_chk_rope<<<8, 64, 0, stream>>>(cosB, sinB, 32, 0.6636012376960885, cw, 41);
        }
        if (p == 1) k_chk_zn<<<NS, 64, 0, stream>>>(xb, Win_t, rstd, zb, in[9], in[10], cosA, sinA, cw, c);
        if (p == 2) k_chk_p2<<<NS, 64, 0, stream>>>(cp_z, zb, cqn, ckvn, in[9], in[10], cosA, sinA, cw, c);
        if (p == 3) { k_chk_gemm<<<NS, 64, 0, stream>>>(cqn, QRANK, Wuq_t, QRANK, 3072, nullptr, nullptr, 0, 0, qb, nullptr, 3072, cw, c, 0.05f);
                      k_chk_gemm<<<NS, 64, 0, stream>>>(ckvn, KVRANK, Wukv_t, KVRANK, 4096, nullptr, nullptr, 0, 0, kvb, nullptr, 4096, cw, c + 1, 0.05f); }
        if (p == 4) k_chk_p4<<<NS, 32, 0, stream>>>(cp_q, qb, kvb, zb, kb, in[7], in[8], cosB, sinB, cw, c);
        if (p == 5) { k_chk_mla<<<NS, 8, 0, stream>>>(qb, kb, kvb, omix, cw, c); k_chk_dil<<<NS, 8, 0, stream>>>(zb, omix, cw, c + 1); }
        if (p == 6) k_chk_gemm<<<NS, 64, 0, stream>>>(omix, EVEN_MIX, Weout_t, EVEN_MIX, DM, nullptr, in[0], DM, 0, nullptr, out, DM, cw, c, 0.05f);
        if (p == 7 || p == 11 || p == 16) k_chk_rstd<<<1, 64, 0, stream>>>(out, rstd, xb, cw, c);
        if (p == 9 || p == 18) { const int l = p == 9 ? 0 : 1; k_chk_up<<<NS, 64, 0, stream>>>(xb, WL(l, 0), rstd, in[21] + (size_t)l * 3 * DFF, in[22] + (size_t)l * DFF, h2b, cw, c); }
        if (p == 10 || p == 19) k_chk_gemm<<<NS, 64, 0, stream>>>(h2b, DFF, WL(p == 10 ? 0 : 1, 2), DFF, DM, nullptr, cp_out, DM, 2, nullptr, out, DM, cw, c, 0.05f);
        if (p == 12) k_chk_qkvn<<<NS, 64, 0, stream>>>(xb, Wqkv_t, rstd, qkvb, in[14], in[15], cw, c);
        if (p == 14) k_chk_na<<<NS, 8, 0, stream>>>(qkvb, in[16], ob, cw, c);
        if (p == 15) k_chk_gemm<<<NS, 64, 0, stream>>>(ob, DM, Woout_t, DM, DM, nullptr, cp_out, DM, 2, nullptr, out, DM, cw, c, 0.05f);
#endif
    }
#if MK_CHECK
    k_chk_final<<<1, 64, 0, stream>>>(cw, out);
#endif
#endif
    const hipError_t le = hipPeekAtLastError();
    if (le != hipSuccess) fprintf(stderr, "kernel_launch: launch failed: %s\n", hipGetErrorName(le));
}
```

```cpp
#include <hip/hip_runtime.h>
#include <cstdio>
#include <cstdint>
#ifndef MK_CHECK
#define MK_CHECK 0
#endif
namespace pg8 {
#define PG8_LAS __attribute__((address_space(3)))
typedef unsigned short bf16_t;
typedef short bf16x8 __attribute__((ext_vector_type(8)));
typedef float f32x4 __attribute__((ext_vector_type(4)));
typedef unsigned u32x4 __attribute__((ext_vector_type(4)));
typedef unsigned u32x2 __attribute__((ext_vector_type(2)));
constexpr int BM = 256, BK = 64, HALF = 128, HTB = HALF * BK * 2  , STAGE_BYTES = 8 * HTB, NXCD = 8, WGM = 8;

__host__ __device__ __forceinline__ int lds_byte(int r, int c) { const int st = (r >> 4) * 2 + (c >> 5), rr = r & 15, cc = c & 31, ob = rr * 64 + cc * 2; return st * 1024 + (ob ^ (((ob >> 9) & 1) << 5)); }
__host__ __device__ __forceinline__ void stage_rc(int b, int& R, int& C) { const int st = b / 1024, sb = b % 1024, swz = sb ^ (((sb >> 9) & 1) << 5); R = (st >> 1) * 16 + swz / 64; C = (st & 1) * 32 + (swz % 64) / 2; }
__host__ __device__ __forceinline__ int perm32(int rho) { const int n = rho >> 4, i = rho & 15; return 8 * (i >> 2) + 4 * n + (i & 3); }

struct Unit { int pm, pn, kb, kn, role, slot; };
struct Gemm { const bf16_t* A; const bf16_t* Bt; int M, N, K, lda; };

struct StaticOrder {
    int nM, nN, nwg, G, c, ntk; float* scr; unsigned* flg;
    __host__ __device__ void init(int M, int N, int G_, int c_, int ntk_ = 0, float* scr_ = nullptr, unsigned* flg_ = nullptr) { nM = M / BM; nN = N / BM; nwg = nM * nN; G = G_; c = c_; ntk = ntk_; scr = scr_; flg = flg_; }
    __host__ __device__ bool next(int i, Unit& u) const {
        long L = (long)i * G + c; u.kb = 0; u.kn = ntk; u.role = 0; u.slot = 0;
        if (scr != nullptr) { const int full = nwg / G, rem = nwg - full * G;
            if (rem > 0 && 2 * rem <= G && i == full) {
                if (c < rem) { u.role = 1; u.kn = ntk / 2; u.slot = c; }
                else if (c < 2 * rem) { L -= rem; u.role = 2; u.kb = ntk / 2; u.kn = ntk - ntk / 2; u.slot = c - rem; }
                else return false; } }
        if (L >= nwg) return false;
        int wgid = (int)L; { const int q = nwg / NXCD, r = nwg % NXCD, xcd = wgid % NXCD, off = wgid / NXCD; wgid = (xcd < r ? xcd * (q + 1) : r * (q + 1) + (xcd - r) * q) + off; }
        const int nig = WGM * nN, gid = wgid / nig, fm = gid * WGM, gsz = (nM - fm) < WGM ? (nM - fm) : WGM;
        u.pm = fm + ((wgid % nig) % gsz); u.pn = (wgid % nig) / gsz; return true;
    }
    __device__ __forceinline__ void a_ready(const Unit&) const {}
    __device__ __forceinline__ void done(const Unit&) const {}
};

__device__ __forceinline__ unsigned cvt_pk_bf16(float lo, float hi) { unsigned r; asm volatile("v_cvt_pk_bf16_f32 %0, %1, %2" : "=v"(r) : "v"(lo), "v"(hi)); return r; }
__device__ __forceinline__ float bf_lo(unsigned w) { return __uint_as_float(w << 16); }
__device__ __forceinline__ float bf_hi(unsigned w) { return __uint_as_float(w & 0xffff0000u); }

struct EpiScaleBf16 {
    static constexpr bool PERM = true, AFTER_DRAIN = false;
    bf16_t* O; int ldc; const float* rstd;
    __device__ __forceinline__ void operator()(const f32x4 (&acc)[2][2][4][2], const Unit& u, int wr, int wc, int fr, int fq) const {
        const int row0 = u.pm * BM + wr * 64 + fr, col0 = u.pn * BM + wc * 32 + 8 * fq;
#pragma unroll
        for (int ai = 0; ai < 2; ++ai)
#pragma unroll
            for (int m = 0; m < 4; ++m) { const int row = row0 + ai * HALF + m * 16; const float s = rstd ? rstd[row] : 1.f; bf16_t* rowp = O + (size_t)row * ldc + col0;
#pragma unroll
                for (int bj = 0; bj < 2; ++bj) { const f32x4 v0 = acc[ai][bj][m][0] * s, v1 = acc[ai][bj][m][1] * s;
                    u32x4 w; w.x = cvt_pk_bf16(v0[0], v0[1]); w.y = cvt_pk_bf16(v0[2], v0[3]); w.z = cvt_pk_bf16(v1[0], v1[1]); w.w = cvt_pk_bf16(v1[2], v1[3]);
                    *(u32x4*)(rowp + bj * HALF) = w; } }
    }
};
struct EpiHeadNorm {
    static constexpr bool PERM = true, AFTER_DRAIN = false;
    bf16_t* O; int ldc; const float* rstd; const float* qn; const float* kn; float qscale; int ntq, ntk; PG8_LAS float* ex;
    const float* rcos; const float* rsin; int seq;
    float* ssq = nullptr;
    template <int AI, int MM, int BJ> __device__ __forceinline__ void put(unsigned wb, float s) const { asm volatile("ds_write_b32 %0, %1 offset:%2" :: "v"(wb), "v"(s), "i"((AI * 1024 + MM * 128 + BJ * 4) * 4) : "memory"); }
    template <int AI, int MM, int BJ> __device__ __forceinline__ f32x4 get(unsigned rb) const { f32x4 p; asm volatile("ds_read_b128 %0, %1 offset:%2" : "=&v"(p) : "v"(rb), "i"((AI * 1024 + MM * 128 + BJ * 4) * 4) : "memory"); return p; }
    template <int AI, int MM> __device__ __forceinline__ void part(const f32x4 (&acc)[2][2][4][2], unsigned wb, int fq) const {
#pragma unroll
        for (int bj = 0; bj < 2; ++bj) { const f32x4 v0 = acc[AI][bj][MM][0], v1 = acc[AI][bj][MM][1];
            float s = (v0[0] * v0[0] + v0[1] * v0[1]) + (v0[2] * v0[2] + v0[3] * v0[3]) + (v1[0] * v1[0] + v1[1] * v1[1]) + (v1[2] * v1[2] + v1[3] * v1[3]);
            s += __shfl_xor(s, 16); s += __shfl_xor(s, 32);
            if (fq == 0) { if (bj == 0) put<AI, MM, 0>(wb, s); else put<AI, MM, 1>(wb, s); } }
    }
    template <int AI, int MM> __device__ __forceinline__ void fin(const f32x4 (&acc)[2][2][4][2], unsigned rb, int row, int col0, const float* gp, float gs, int wc, int fq) const {
        bf16_t* rowp = O + (size_t)row * ldc + col0; const float rsv = rstd[row], r2 = rsv * rsv;
        const f32x4 g0 = *(const f32x4*)gp * gs, g1 = *(const f32x4*)(gp + 4) * gs;
        const f32x4 pa = get<AI, MM, 0>(rb), pb = get<AI, MM, 1>(rb);
        asm volatile("s_waitcnt lgkmcnt(0)" ::: "memory"); __builtin_amdgcn_sched_barrier(0);
#pragma unroll
        for (int bj = 0; bj < 2; ++bj) { const f32x4 p = bj ? pb : pa;
            const float tot = ((p[0] + p[1]) + (p[2] + p[3])) * r2;
            const float hn = rsv / sqrtf(tot * (1.0f / 128.0f) + 1e-6f);
            f32x4 v0 = acc[AI][bj][MM][0] * hn * g0, v1 = acc[AI][bj][MM][1] * hn * g1;
            if (rcos != nullptr && wc == 0) {
                const int pos = row & (seq - 1); const float* cp = rcos + pos * 16 + 8 * (fq & 1); const float* sp = rsin + pos * 16 + 8 * (fq & 1);
                const f32x4 c0 = *(const f32x4*)cp, c1 = *(const f32x4*)(cp + 4); f32x4 s0 = *(const f32x4*)sp, s1 = *(const f32x4*)(sp + 4);
                if (fq < 2) { s0 = -s0; s1 = -s1; }
                f32x4 p0, p1;
#pragma unroll
                for (int e = 0; e < 4; ++e) { p0[e] = __shfl_xor(v0[e], 32); p1[e] = __shfl_xor(v1[e], 32); }
                v0 = v0 * c0 + p0 * s0; v1 = v1 * c1 + p1 * s1; }
            u32x4 w; w.x = cvt_pk_bf16(v0[0], v0[1]); w.y = cvt_pk_bf16(v0[2], v0[3]); w.z = cvt_pk_bf16(v1[0], v1[1]); w.w = cvt_pk_bf16(v1[2], v1[3]);
            *(u32x4*)(rowp + bj * HALF) = w; }
    }
    __device__ __forceinline__ void operator()(const f32x4 (&acc)[2][2][4][2], const Unit& u, int wr, int wc, int fr, int fq) const {
        const int row0 = u.pm * BM + wr * 64 + fr, col0 = u.pn * BM + wc * 32 + 8 * fq; const int type = u.pn < ntq ? 0 : (u.pn < ntq + ntk ? 1 : 2);
        if (type < 2) {
            const unsigned rb = (unsigned)(uintptr_t)ex + (unsigned)((wr * 64 + fr) * 8 * 4), wb = rb + (unsigned)(wc * 4);
            part<0, 0>(acc, wb, fq); part<0, 1>(acc, wb, fq); part<0, 2>(acc, wb, fq); part<0, 3>(acc, wb, fq); part<1, 0>(acc, wb, fq); part<1, 1>(acc, wb, fq); part<1, 2>(acc, wb, fq); part<1, 3>(acc, wb, fq);
            asm volatile("s_waitcnt lgkmcnt(0)" ::: "memory"); __builtin_amdgcn_s_barrier(); asm volatile("" ::: "memory");
            const float* gp = (type == 0 ? qn : kn) + wc * 32 + 8 * fq; const float gs = type == 0 ? qscale : 1.0f;
            fin<0, 0>(acc, rb, row0, col0, gp, gs, wc, fq); fin<0, 1>(acc, rb, row0 + 16, col0, gp, gs, wc, fq); fin<0, 2>(acc, rb, row0 + 32, col0, gp, gs, wc, fq); fin<0, 3>(acc, rb, row0 + 48, col0, gp, gs, wc, fq);
            fin<1, 0>(acc, rb, row0 + HALF, col0, gp, gs, wc, fq); fin<1, 1>(acc, rb, row0 + HALF + 16, col0, gp, gs, wc, fq); fin<1, 2>(acc, rb, row0 + HALF + 32, col0, gp, gs, wc, fq); fin<1, 3>(acc, rb, row0 + HALF + 48, col0, gp, gs, wc, fq);
        } else {
#pragma unroll
            for (int ai = 0; ai < 2; ++ai)
#pragma unroll
                for (int m = 0; m < 4; ++m) { const int row = row0 + ai * HALF + m * 16; bf16_t* rowp = O + (size_t)row * ldc + col0; const float sc = rstd[row];
#pragma unroll
                    for (int bj = 0; bj < 2; ++bj) { const f32x4 v0 = acc[ai][bj][m][0] * sc, v1 = acc[ai][bj][m][1] * sc;
                        u32x4 w; w.x = cvt_pk_bf16(v0[0], v0[1]); w.y = cvt_pk_bf16(v0[2], v0[3]); w.z = cvt_pk_bf16(v1[0], v1[1]); w.w = cvt_pk_bf16(v1[2], v1[3]);
                        *(u32x4*)(rowp + bj * HALF) = w;
                        if (ssq != nullptr && u.pn >= 36) { float sq = (v0[0] * v0[0] + v0[1] * v0[1]) + (v0[2] * v0[2] + v0[3] * v0[3]) + (v1[0] * v1[0] + v1[1] * v1[1]) + (v1[2] * v1[2] + v1[3] * v1[3]);
                            sq += __shfl_xor(sq, 16); sq += __shfl_xor(sq, 32);
                            if (fq == 0) ssq[(size_t)row * 64 + (u.pn - 36) * 8 + bj * 4 + wc] = sq; } } }
        }
    }
};
#ifndef RESID_LOW
#define RESID_LOW 0
#endif
template <int MODE> struct EpiResidT {
    static constexpr bool PERM = true, AFTER_DRAIN = false;
    const float* basef; float* outf; bf16_t* xb; bf16_t* xl0; bf16_t* xl1; float* ss; int ldc;
    __device__ __forceinline__ void operator()(const f32x4 (&acc)[2][2][4][2], const Unit& u, int wr, int wc, int fr, int fq) const {
        const int row0 = u.pm * BM + wr * 64 + fr, col0 = u.pn * BM + wc * 32 + 8 * fq; bf16_t* xl = u.pm < 32 ? xl0 : xl1;
#pragma unroll
        for (int ai = 0; ai < 2; ++ai)
#pragma unroll
            for (int m = 0; m < 4; ++m) { const int row = row0 + ai * HALF + m * 16; const size_t off = (size_t)row * ldc + col0; float s = 0.f;
#pragma unroll
                for (int bj = 0; bj < 2; ++bj) { f32x4 b0, b1;
                    if constexpr (MODE == 0) { b0 = *(const f32x4*)(basef + off + bj * HALF); b1 = *(const f32x4*)(basef + off + bj * HALF + 4); }
                    else { const u32x4 hb = *(const u32x4*)(xb + off + bj * HALF); u32x4 lb = {0u, 0u, 0u, 0u}; if constexpr (RESID_LOW) lb = *(const u32x4*)(xl + off + bj * HALF);
                        b0[0] = bf_lo(hb.x) + bf_lo(lb.x); b0[1] = bf_hi(hb.x) + bf_hi(lb.x); b0[2] = bf_lo(hb.y) + bf_lo(lb.y); b0[3] = bf_hi(hb.y) + bf_hi(lb.y);
                        b1[0] = bf_lo(hb.z) + bf_lo(lb.z); b1[1] = bf_hi(hb.z) + bf_hi(lb.z); b1[2] = bf_lo(hb.w) + bf_lo(lb.w); b1[3] = bf_hi(hb.w) + bf_hi(lb.w); }
                    const f32x4 v0 = b0 + acc[ai][bj][m][0], v1 = b1 + acc[ai][bj][m][1];
                    if constexpr (MODE == 2 || MK_CHECK) { *(f32x4*)(outf + off + bj * HALF) = v0; *(f32x4*)(outf + off + bj * HALF + 4) = v1; }
                    if constexpr (MODE != 2) {
                        u32x4 w; w.x = cvt_pk_bf16(v0[0], v0[1]); w.y = cvt_pk_bf16(v0[2], v0[3]); w.z = cvt_pk_bf16(v1[0], v1[1]); w.w = cvt_pk_bf16(v1[2], v1[3]);
                        u32x4 l; l.x = cvt_pk_bf16(v0[0] - bf_lo(w.x), v0[1] - bf_hi(w.x)); l.y = cvt_pk_bf16(v0[2] - bf_lo(w.y), v0[3] - bf_hi(w.y));
                                 l.z = cvt_pk_bf16(v1[0] - bf_lo(w.z), v1[1] - bf_hi(w.z)); l.w = cvt_pk_bf16(v1[2] - bf_lo(w.w), v1[3] - bf_hi(w.w));
                        *(u32x4*)(xb + off + bj * HALF) = w; if constexpr (RESID_LOW) *(u32x4*)(xl + off + bj * HALF) = l;
                        s += (v0[0] * v0[0] + v0[1] * v0[1]) + (v0[2] * v0[2] + v0[3] * v0[3]) + (v1[0] * v1[0] + v1[1] * v1[1]) + (v1[2] * v1[2] + v1[3] * v1[3]); } }
                if constexpr (MODE != 2) { s += __shfl_xor(s, 16); s += __shfl_xor(s, 32);
                    if (fq == 0) ss[(size_t)row * 64 + u.pn * 4 + wc] = s; } }
    }
};
struct EpiUpConv {
    static constexpr bool PERM = true, AFTER_DRAIN = false;
    const bf16_t* a; bf16_t* h2; const float* rstd; const float* cw; const float* cb; int ldc; int seq;
    __device__ __forceinline__ void operator()(const f32x4 (&acc)[2][2][4][2], const Unit& u, int wr, int wc, int fr, int fq) const {
        const int row0 = u.pm * BM + wr * 64 + fr, col0 = u.pn * BM + wc * 32 + 8 * fq;
#pragma unroll
        for (int bj = 0; bj < 2; ++bj) { const int c = col0 + bj * HALF;
            float w0[8], w1[8], w2[8], b[8];
#pragma unroll
            for (int h = 0; h < 2; ++h) { const f32x4 t0 = *(const f32x4*)(cw + c + 4 * h), t1 = *(const f32x4*)(cw + ldc + c + 4 * h), t2 = *(const f32x4*)(cw + 2 * ldc + c + 4 * h), t3 = *(const f32x4*)(cb + c + 4 * h);
#pragma unroll
                for (int j = 0; j < 4; ++j) { w0[4 * h + j] = t0[j]; w1[4 * h + j] = t1[j]; w2[4 * h + j] = t2[j]; b[4 * h + j] = t3[j]; } }
#pragma unroll
            for (int ai = 0; ai < 2; ++ai)
#pragma unroll
                for (int m = 0; m < 4; ++m) { const int row = row0 + ai * HALF + m * 16; const int t = row & (seq - 1); const float s = rstd[row];
                    const bf16_t* ap = a + (size_t)row * ldc + c;
                    const u32x4 z4 = {0u, 0u, 0u, 0u};
                    const u32x4 a0 = *(const u32x4*)ap; const u32x4 am = t > 0 ? *(const u32x4*)(ap - ldc) : z4; const u32x4 an = t < seq - 1 ? *(const u32x4*)(ap + ldc) : z4;
                    float hv[8];
#pragma unroll
                    for (int j = 0; j < 8; ++j) { const unsigned wm = am[j >> 1], wz = a0[j >> 1], wn = an[j >> 1];
                        const float fm = (j & 1) ? bf_hi(wm) : bf_lo(wm), fz = (j & 1) ? bf_hi(wz) : bf_lo(wz), fn = (j & 1) ? bf_hi(wn) : bf_lo(wn);
                        const float g = w0[j] * fm + w1[j] * fz + w2[j] * fn + b[j];
                        const float e = __builtin_amdgcn_exp2f(-1.4426950408889634f * g);
                        const float sg = g * __builtin_amdgcn_rcpf(1.0f + e);
                        const float up = (j < 4 ? acc[ai][bj][m][0][j & 3] : acc[ai][bj][m][1][j & 3]) * s;
                        hv[j] = sg * up; }
                    u32x4 w; w.x = cvt_pk_bf16(hv[0], hv[1]); w.y = cvt_pk_bf16(hv[2], hv[3]); w.z = cvt_pk_bf16(hv[4], hv[5]); w.w = cvt_pk_bf16(hv[6], hv[7]);
                    *(u32x4*)(h2 + (size_t)row * ldc + c) = w; } }
    }
};
template <int CTRL> __device__ __forceinline__ float dpp_rot(float v) { return __builtin_bit_cast(float, __builtin_amdgcn_update_dpp(0, __builtin_bit_cast(int, v), CTRL, 0xF, 0xF, false)); }
struct EpiGateUp {
    static constexpr bool PERM = true, AFTER_DRAIN = false;
    bf16_t* h2; const float* rstd; const float* cw; const float* cb; int ldc; bf16_t* aedge; bf16_t* uedge; PG8_LAS float* ex;
    __device__ __forceinline__ void operator()(const f32x4 (&acc)[2][2][4][2], const Unit& u, int wr, int wc, int fr, int fq) const {
        const int row0 = u.pm * BM + wr * 64 + fr, ch = u.pn * HALF + wc * 32 + 8 * fq;
        f32x4 av[2][4][2], uv[2][4][2];
#pragma unroll
        for (int ai = 0; ai < 2; ++ai)
#pragma unroll
            for (int m = 0; m < 4; ++m) { const float r = rstd[row0 + ai * HALF + m * 16];
                av[ai][m][0] = acc[ai][0][m][0] * r; av[ai][m][1] = acc[ai][0][m][1] * r; uv[ai][m][0] = acc[ai][1][m][0] * r; uv[ai][m][1] = acc[ai][1][m][1] * r; }
        const unsigned eb = (unsigned)(uintptr_t)ex + (unsigned)((wc * 4 + fq) * 32);
#pragma unroll
        for (int ai = 0; ai < 2; ++ai) { const int gidx = 2 * ai + wr;
            if (fr == 0) { const unsigned a0 = eb + (unsigned)((gidx * 2 + 0) * 512);
                asm volatile("ds_write_b128 %0, %1\n\tds_write_b128 %0, %2 offset:16" :: "v"(a0), "v"(av[ai][0][0]), "v"(av[ai][0][1]) : "memory"); }
            if (fr == 15) { const unsigned a1 = eb + (unsigned)((gidx * 2 + 1) * 512);
                asm volatile("ds_write_b128 %0, %1\n\tds_write_b128 %0, %2 offset:16" :: "v"(a1), "v"(av[ai][3][0]), "v"(av[ai][3][1]) : "memory"); } }
        asm volatile("s_waitcnt lgkmcnt(0)" ::: "memory"); __builtin_amdgcn_s_barrier(); asm volatile("" ::: "memory");
        unsigned pk[2][4][2][2];
#pragma unroll
        for (int h = 0; h < 2; ++h) {
            const f32x4 w0 = *(const f32x4*)(cw + ch + 4 * h), w1 = *(const f32x4*)(cw + ldc + ch + 4 * h), w2 = *(const f32x4*)(cw + 2 * ldc + ch + 4 * h), bb = *(const f32x4*)(cb + ch + 4 * h);
#pragma unroll
            for (int ai = 0; ai < 2; ++ai) { const int gidx = 2 * ai + wr;
                f32x4 rrp, nx;
                { const unsigned ap = eb + (unsigned)(((gidx > 0 ? gidx - 1 : 0) * 2 + 1) * 512 + 16 * h), an = eb + (unsigned)(((gidx < 3 ? gidx + 1 : 3) * 2 + 0) * 512 + 16 * h);
                  asm volatile("ds_read_b128 %0, %2\n\tds_read_b128 %1, %3\n\ts_waitcnt lgkmcnt(0)" : "=&v"(rrp), "=&v"(nx) : "v"(ap), "v"(an) : "memory"); }
                f32x4 rlc;
#pragma unroll
                for (int j = 0; j < 4; ++j) rlc[j] = dpp_rot<0x12F>(av[ai][0][h][j]);
#pragma unroll
                for (int m = 0; m < 4; ++m) { const int row = row0 + ai * HALF + m * 16;
                    float hv[4];
#pragma unroll
                    for (int j = 0; j < 4; ++j) { const float cur = av[ai][m][h][j];
                        const float rr = dpp_rot<0x121>(cur);
                        float rln;
                        if (m < 3) rln = dpp_rot<0x12F>(av[ai][m + 1][h][j]); else rln = nx[j];
                        const float prev = fr != 0 ? rr : rrp[j], next = fr != 15 ? rlc[j] : rln;
                        rrp[j] = rr; rlc[j] = rln;
                        const float g = w0[j] * prev + w1[j] * cur + w2[j] * next + bb[j];
                        const float e = __builtin_amdgcn_exp2f(-1.4426950408889634f * g);
                        hv[j] = g * __builtin_amdgcn_rcpf(1.0f + e) * uv[ai][m][h][j]; }
                    pk[ai][m][h][0] = cvt_pk_bf16(hv[0], hv[1]); pk[ai][m][h][1] = cvt_pk_bf16(hv[2], hv[3]);
                    if ((m == 0 && gidx == 0 && fr < 2) || (m == 3 && gidx == 3 && fr >= 14)) {
                        const int e4 = (m == 0) ? fr : fr - 12;
                        u32x2 w; w.x = cvt_pk_bf16(av[ai][m][h][0], av[ai][m][h][1]); w.y = cvt_pk_bf16(av[ai][m][h][2], av[ai][m][h][3]);
                        *(u32x2*)(aedge + ((size_t)u.pm * 4 + e4) * ldc + ch + 4 * h) = w;
                        if (e4 == 0 || e4 == 3) { u32x2 wu; wu.x = cvt_pk_bf16(uv[ai][m][h][0], uv[ai][m][h][1]); wu.y = cvt_pk_bf16(uv[ai][m][h][2], uv[ai][m][h][3]);
                            *(u32x2*)(uedge + ((size_t)u.pm * 2 + (e4 == 3 ? 1 : 0)) * ldc + ch + 4 * h) = wu; } }
                    if (h == 1) { const bool first = (m == 0 && gidx == 0 && fr == 0), last = (m == 3 && gidx == 3 && fr == 15);
                        if (!first && !last) { u32x4 w; w.x = pk[ai][m][0][0]; w.y = pk[ai][m][0][1]; w.z = pk[ai][m][1][0]; w.w = pk[ai][m][1][1];
                            *(u32x4*)(h2 + (size_t)row * ldc + ch) = w; } }
                } }
        }
    }
};
template <class Epi, class Sched, bool ALIGN_EPI = false, bool SP2 = false, bool SPLITK = false>
__device__ __forceinline__ void gemm_phase(PG8_LAS unsigned char* lds, const Gemm g, const Sched& S, const Epi& E) {
    const int tid = threadIdx.x, wid = __builtin_amdgcn_readfirstlane(tid >> 6), lane = tid & 63, wr = wid >> 2, wc = wid & 3, fr = lane & 15, fq = lane >> 4;
    const int K = g.K, nt = K / BK;
    unsigned voffA[2], voffB[2];
#pragma unroll
    for (int i = 0; i < 2; ++i) { int R, C; stage_rc(tid * 16 + i * 8192, R, C); const int Rb = Epi::PERM ? ((R & ~31) + perm32(R & 31)) : R;
        voffA[i] = (unsigned)(R * g.lda + C) * 2u; voffB[i] = (unsigned)(Rb * K + C) * 2u; }
    const size_t kstep = (size_t)(BK * 2);
    const size_t hstepB = (size_t)HALF * K * 2, hstepA = (size_t)HALF * g.lda * 2;
    const size_t tstepB = 2 * hstepB, tstepA = 2 * hstepA;
    const unsigned ldsw = (unsigned)wid * 1024u;
    const int aoff = lds_byte(wr * 64 + fr, fq * 8), boff = lds_byte(wc * 32 + fr, fq * 8);
#define PG8_SA(b, h) (((b) * 2 + (h)) * HTB)
#define PG8_SB(b, h) ((4 + (b) * 2 + (h)) * HTB)
#define PG8_STAGE(bufoff, gbase, voff) do { _Pragma("unroll") for (int _i = 0; _i < 2; ++_i) \
        __builtin_amdgcn_global_load_lds((const unsigned*)((const char*)(gbase) + (voff)[_i]), (PG8_LAS unsigned*)(lds + (bufoff) + ldsw + _i * 8192), 16, 0, 0); } while (0)
#define PG8_LDA(dst, b, h) do { _Pragma("unroll") for (int m = 0; m < 4; ++m) _Pragma("unroll") for (int k = 0; k < 2; ++k) dst[m][k] = *(const PG8_LAS bf16x8*)(lds + PG8_SA(b, h) + aoff + m * 2048 + k * 1024); } while (0)
#define PG8_LDB(dst, b, h) do { _Pragma("unroll") for (int n = 0; n < 2; ++n) _Pragma("unroll") for (int k = 0; k < 2; ++k) dst[n][k] = *(const PG8_LAS bf16x8*)(lds + PG8_SB(b, h) + boff + n * 2048 + k * 1024); } while (0)
#define PG8_MMA(ai, bj, At, Bt) do { __builtin_amdgcn_s_setprio(1); _Pragma("unroll") for (int m = 0; m < 4; ++m) _Pragma("unroll") for (int n = 0; n < 2; ++n) _Pragma("unroll") for (int k = 0; k < 2; ++k) \
        acc[ai][bj][m][n] = __builtin_amdgcn_mfma_f32_16x16x32_bf16(Bt[n][k], At[m][k], acc[ai][bj][m][n], 0, 0, 0); __builtin_amdgcn_s_setprio(0); } while (0)
#define PG8_WAIT_V(n) asm volatile("s_waitcnt vmcnt(" #n ")" ::: "memory")
#define PG8_WAIT_L(n) asm volatile("s_waitcnt lgkmcnt(" #n ")" ::: "memory")
#define PG8_BAR __builtin_amdgcn_s_barrier()
#define PG8_SCHED __builtin_amdgcn_sched_barrier(0)
    Unit cur, nxt; int ui = 0;
    if (!S.next(0, cur)) return;
    f32x4 acc[2][2][4][2];
#pragma unroll
    for (int a = 0; a < 2; ++a)
#pragma unroll
        for (int b = 0; b < 2; ++b)
#pragma unroll
            for (int m = 0; m < 4; ++m)
#pragma unroll
                for (int n = 0; n < 2; ++n) acc[a][b][m][n] = (f32x4){0.f, 0.f, 0.f, 0.f};
    bf16x8 At[4][2], B0[2][2], B1[2][2];
    const char* cA = (const char*)g.A + (size_t)cur.pm * tstepA; const char* cB = (const char*)g.Bt + (size_t)cur.pn * tstepB;
    if constexpr (SPLITK) { cA += (size_t)cur.kb * kstep; cB += (size_t)cur.kb * kstep; }
    S.a_ready(cur);
    if constexpr (SP2) {
        PG8_STAGE(PG8_SB(0, 0), cB, voffB); PG8_STAGE(PG8_SB(0, 1), cB + hstepB, voffB); PG8_STAGE(PG8_SA(0, 0), cA, voffA); PG8_STAGE(PG8_SA(0, 1), cA + hstepA, voffA);
        if (wr == 1) PG8_BAR;
        PG8_WAIT_V(2); PG8_BAR;
        PG8_STAGE(PG8_SB(1, 0), cB + kstep, voffB); PG8_STAGE(PG8_SA(1, 0), cA + kstep, voffA); PG8_STAGE(PG8_SB(1, 1), cB + hstepB + kstep, voffB);
        PG8_WAIT_V(6); PG8_BAR;
    } else {
        PG8_STAGE(PG8_SB(0, 0), cB, voffB); PG8_STAGE(PG8_SA(0, 0), cA, voffA); PG8_STAGE(PG8_SB(0, 1), cB + hstepB, voffB); PG8_STAGE(PG8_SA(0, 1), cA + hstepA, voffA);
        if (wr == 1) PG8_BAR;
        PG8_WAIT_V(4); PG8_BAR;
        PG8_STAGE(PG8_SB(1, 0), cB + kstep, voffB); PG8_STAGE(PG8_SA(1, 0), cA + kstep, voffA); PG8_STAGE(PG8_SB(1, 1), cB + hstepB + kstep, voffB);
        PG8_WAIT_V(6); PG8_BAR;
    }
    for (;;) {
        const bool has_next = S.next(ui + 1, nxt);
        const char* nA = has_next ? (const char*)g.A + (size_t)nxt.pm * tstepA : cA; const char* nB = has_next ? (const char*)g.Bt + (size_t)nxt.pn * tstepB : cB;
        if constexpr (SPLITK) { if (has_next) { nA += (size_t)nxt.kb * kstep; nB += (size_t)nxt.kb * kstep; } }
        const int ntc = SPLITK ? cur.kn : nt;
        for (int t = 0; t < ntc; t += 2) {
            const bool last = (t == ntc - 2);
            const char* a1 = cA + (size_t)(t + 1) * kstep;
            const char* a2 = last ? nA : cA + (size_t)(t + 2) * kstep; const char* b2 = last ? nB : cB + (size_t)(t + 2) * kstep;
            const char* a3 = a2 + kstep; const char* b3 = b2 + kstep;
            if (last && has_next) S.a_ready(nxt);
            if constexpr (SP2) {
            PG8_LDB(B0, 0, 0); PG8_LDB(B1, 0, 1); PG8_SCHED; PG8_LDA(At, 0, 0); PG8_STAGE(PG8_SA(1, 1), a1 + hstepA, voffA);
            PG8_WAIT_V(8); PG8_WAIT_L(0); PG8_BAR; PG8_MMA(0, 0, At, B0); PG8_MMA(0, 1, At, B1); PG8_BAR; PG8_SCHED;
            PG8_LDA(At, 0, 1); PG8_STAGE(PG8_SB(0, 0), b2, voffB); PG8_STAGE(PG8_SB(0, 1), b2 + hstepB, voffB); PG8_STAGE(PG8_SA(0, 0), a2, voffA);
            PG8_WAIT_V(8); PG8_WAIT_L(0); PG8_BAR; PG8_MMA(1, 0, At, B0); PG8_MMA(1, 1, At, B1); PG8_BAR; PG8_SCHED;
            PG8_LDB(B0, 1, 0); PG8_LDB(B1, 1, 1); PG8_SCHED; PG8_LDA(At, 1, 0); PG8_STAGE(PG8_SA(0, 1), a2 + hstepA, voffA);
            PG8_WAIT_V(8); PG8_WAIT_L(0); PG8_BAR; PG8_MMA(0, 0, At, B0); PG8_MMA(0, 1, At, B1); PG8_BAR; PG8_SCHED;
            PG8_LDA(At, 1, 1); PG8_STAGE(PG8_SB(1, 0), b3, voffB); PG8_STAGE(PG8_SB(1, 1), b3 + hstepB, voffB); PG8_STAGE(PG8_SA(1, 0), a3, voffA);
            PG8_WAIT_V(8); PG8_WAIT_L(0); PG8_BAR; PG8_MMA(1, 0, At, B0); PG8_MMA(1, 1, At, B1); PG8_BAR; PG8_SCHED;
            } else {
            PG8_LDB(B0, 0, 0); PG8_SCHED; PG8_LDA(At, 0, 0); PG8_STAGE(PG8_SA(1, 1), a1 + hstepA, voffA);
            PG8_WAIT_L(8); PG8_BAR; PG8_WAIT_L(0); PG8_MMA(0, 0, At, B0); PG8_BAR; PG8_SCHED;
            PG8_LDB(B1, 0, 1); PG8_STAGE(PG8_SB(0, 0), b2, voffB);
            PG8_BAR; PG8_WAIT_L(0); PG8_MMA(0, 1, At, B1); PG8_BAR;
            PG8_LDA(At, 0, 1); PG8_STAGE(PG8_SA(0, 0), a2, voffA);
            PG8_BAR; PG8_WAIT_L(0); PG8_MMA(1, 0, At, B0); PG8_BAR; PG8_SCHED;
            PG8_STAGE(PG8_SB(0, 1), b2 + hstepB, voffB);
            PG8_WAIT_V(6); PG8_BAR; PG8_MMA(1, 1, At, B1); PG8_BAR;
            PG8_LDB(B0, 1, 0); PG8_SCHED; PG8_LDA(At, 1, 0); PG8_STAGE(PG8_SA(0, 1), a2 + hstepA, voffA);
            PG8_WAIT_L(8); PG8_BAR; PG8_WAIT_L(0); PG8_MMA(0, 0, At, B0); PG8_BAR; PG8_SCHED;
            PG8_LDB(B1, 1, 1); PG8_STAGE(PG8_SB(1, 0), b3, voffB);
            PG8_BAR; PG8_WAIT_L(0); PG8_MMA(0, 1, At, B1); PG8_BAR;
            PG8_LDA(At, 1, 1); PG8_STAGE(PG8_SA(1, 0), a3, voffA);
            PG8_BAR; PG8_WAIT_L(0); PG8_MMA(1, 0, At, B0); PG8_BAR; PG8_SCHED;
            PG8_STAGE(PG8_SB(1, 1), b3 + hstepB, voffB);
            PG8_WAIT_V(6); PG8_BAR; PG8_MMA(1, 1, At, B1); PG8_BAR;
            }
        }
        if constexpr (ALIGN_EPI) { if (wr == 0) PG8_BAR; }
        if constexpr (SPLITK) {
            if (cur.role == 2) {
                const __amdgpu_buffer_rsrc_t rs = __builtin_amdgcn_make_buffer_rsrc((void*)(S.scr + (size_t)cur.slot * 65536), 0, 65536 * 4, 0x00020000);
#pragma unroll
                for (int a = 0; a < 2; ++a)
#pragma unroll
                    for (int b = 0; b < 2; ++b)
#pragma unroll
                        for (int m = 0; m < 4; ++m)
#pragma unroll
                            for (int n = 0; n < 2; ++n)
                                __builtin_amdgcn_raw_buffer_store_b128(__builtin_bit_cast(u32x4, acc[a][b][m][n]), rs, (unsigned)(((wid * 32 + ((a * 2 + b) * 4 + m) * 2 + n) * 64 + lane) * 16), 0, 16);
                PG8_WAIT_V(0); PG8_BAR;
                if (tid == 0) __hip_atomic_store(S.flg + cur.slot * 16, 1u, __ATOMIC_RELAXED, __HIP_MEMORY_SCOPE_AGENT);
            } else {
                if (cur.role == 1) {
                    if (tid == 0) { unsigned spn = 0; while (__hip_atomic_load(S.flg + cur.slot * 16, __ATOMIC_RELAXED, __HIP_MEMORY_SCOPE_AGENT) == 0u) { __builtin_amdgcn_s_sleep(1); if (++spn > (1u << 22)) break; }
                        __builtin_amdgcn_fence(__ATOMIC_ACQUIRE, "agent"); }
                    PG8_WAIT_V(0); PG8_BAR;
                    const float* sp = S.scr + (size_t)cur.slot * 65536 + (size_t)(wid * 32 * 64 + lane) * 4;
#pragma unroll
                    for (int a = 0; a < 2; ++a)
#pragma unroll
                        for (int b = 0; b < 2; ++b) { f32x4 tq[4][2];
#pragma unroll
                            for (int m = 0; m < 4; ++m)
#pragma unroll
                                for (int n = 0; n < 2; ++n) tq[m][n] = *(const f32x4*)(sp + (size_t)((((a * 2 + b) * 4 + m) * 2 + n) * 64) * 4);
#pragma unroll
                            for (int m = 0; m < 4; ++m)
#pragma unroll
                                for (int n = 0; n < 2; ++n) acc[a][b][m][n] += tq[m][n]; }
                }
                E(acc, cur, wr, wc, fr, fq); S.done(cur);
            }
        } else
        if constexpr (!Epi::AFTER_DRAIN) { E(acc, cur, wr, wc, fr, fq); S.done(cur); }
        if (!has_next) break;
#pragma unroll
        for (int a = 0; a < 2; ++a)
#pragma unroll
            for (int b = 0; b < 2; ++b)
#pragma unroll
                for (int m = 0; m < 4; ++m)
#pragma unroll
                    for (int n = 0; n < 2; ++n) acc[a][b][m][n] = (f32x4){0.f, 0.f, 0.f, 0.f};
        cur = nxt; cA = nA; cB = nB; ++ui;
        if constexpr (ALIGN_EPI) { if (wr == 1) PG8_BAR; }
    }
    PG8_WAIT_V(0);
    if constexpr (!ALIGN_EPI) { if (wr == 0) PG8_BAR; }
    PG8_BAR;
    if constexpr (Epi::AFTER_DRAIN) { E.fused(acc, cur, wr, wc, fr, fq, lds, wid, lane); S.done(cur); }
#undef PG8_SA
#undef PG8_SB
#undef PG8_STAGE
#undef PG8_LDA
#undef PG8_LDB
#undef PG8_MMA
#undef PG8_WAIT_V
#undef PG8_WAIT_L
#undef PG8_BAR
#undef PG8_SCHED
}
}

namespace mla {
typedef unsigned short bf16;
using bf16x8 = __attribute__((ext_vector_type(8))) short;
using s16x4  = __attribute__((ext_vector_type(4))) short;
using f32x16 = __attribute__((ext_vector_type(16))) float;
using u32x4  = __attribute__((ext_vector_type(4))) unsigned;
constexpr int DQK = 192, DV = 128, NW = 8, QBLK = 32, KVBLK = 64;
constexpr int LDQ = 3072, LDK = 3072, LDV = 4096, LDO = 3072;
constexpr float THR = 11.5f;
constexpr int SHM_V = KVBLK * DV * 2, SHM_K = KVBLK * DQK * 2, SHM_ATTN = 2 * SHM_V + 2 * SHM_K + NW * 64 * 4;
#define MLA_SBAR() __builtin_amdgcn_sched_barrier(0)
#ifndef MLA_QG
#define MLA_QG 4
#endif
__device__ __forceinline__ int crow(int r, int hi) { return (r & 3) + 8 * (r >> 2) + 4 * hi; }
__device__ __forceinline__ unsigned cvtpk(float lo, float hi) { unsigned r; asm volatile("v_cvt_pk_bf16_f32 %0, %1, %2" : "=v"(r) : "v"(lo), "v"(hi)); return r; }
__device__ __forceinline__ void partialSM(f32x16& p0, f32x16& p1, float& m_reg, float& mn, float& alpha) {
  float pmax = p0[0];
#pragma unroll
  for (int r = 1; r < 16; ++r) pmax = fmaxf(pmax, p0[r]);
#pragma unroll
  for (int r = 0; r < 16; ++r) pmax = fmaxf(pmax, p1[r]);
  { auto rr = __builtin_amdgcn_permlane32_swap(__float_as_uint(pmax), __float_as_uint(pmax), false, false);
    pmax = fmaxf(__uint_as_float(rr[0]), __uint_as_float(rr[1])); }
  if (__builtin_expect(__all(pmax - m_reg <= THR), 1)) { mn = m_reg; alpha = 1.f; }
  else { mn = fmaxf(m_reg, pmax); alpha = __builtin_amdgcn_exp2f(m_reg - mn); m_reg = mn; }
#pragma unroll
  for (int r = 0; r < 16; ++r) p0[r] = p0[r] - mn;
#pragma unroll
  for (int r = 0; r < 16; ++r) p1[r] = p1[r] - mn;
#pragma unroll
  for (int r = 0; r < 16; ++r) p0[r] = __builtin_amdgcn_exp2f(p0[r]);
}
__device__ __forceinline__ void finishSM(f32x16& p0, f32x16& p1, float alpha, float& l_reg, bf16x8& pa0, bf16x8& pa1, bf16x8& pa2, bf16x8& pa3) {
#pragma unroll
  for (int r = 0; r < 16; ++r) p1[r] = __builtin_amdgcn_exp2f(p1[r]);
  float ps = 0;
#pragma unroll
  for (int r = 0; r < 16; ++r) ps += p0[r];
#pragma unroll
  for (int r = 0; r < 16; ++r) ps += p1[r];
  { auto rr = __builtin_amdgcn_permlane32_swap(__float_as_uint(ps), __float_as_uint(ps), false, false);
    ps = __uint_as_float(rr[0]) + __uint_as_float(rr[1]); }
  l_reg = l_reg * alpha + ps;
#define MLA_PK4(P, BASE, OUT) do { unsigned a0 = cvtpk(P[BASE + 0], P[BASE + 1]), a1 = cvtpk(P[BASE + 2], P[BASE + 3]);   \
    unsigned b0 = cvtpk(P[BASE + 4], P[BASE + 5]), b1 = cvtpk(P[BASE + 6], P[BASE + 7]);                              \
    auto r0 = __builtin_amdgcn_permlane32_swap(a0, b0, false, false); auto r1 = __builtin_amdgcn_permlane32_swap(a1, b1, false, false); \
    u32x4 w = {r0[0], r1[0], r0[1], r1[1]}; OUT = *reinterpret_cast<bf16x8*>(&w); } while (0)
  MLA_PK4(p0, 0, pa0); MLA_PK4(p0, 8, pa1); MLA_PK4(p1, 0, pa2); MLA_PK4(p1, 8, pa3);
#undef MLA_PK4
}
__device__ __forceinline__ int v_st(int k, int c) { const int kk = (k & ~0xC) | ((k & 4) << 1) | ((k & 8) >> 1); return ((kk >> 3) * 4 + (c >> 5)) * 512 + ((kk & 7) * 32 + (c & 31)) * 2; }
__device__ __forceinline__ int v_rd_base(int lane) { return ((lane & 3) << 3) | (((lane >> 2) & 3) << 6) | (((lane >> 4) & 1) << 5) | (((lane >> 5) & 1) << 8); }
constexpr int v_rd_off(int d0, int ks, int half) { return d0 * 512 + ks * 4096 + half * 2048; }
template <int OFF> __device__ __forceinline__ s16x4 tr_read(int vb) {
  s16x4 r; asm volatile("ds_read_b64_tr_b16 %0, %1 offset:%2" : "=&v"(r) : "v"(vb), "i"(OFF) : "memory"); return r;
}
template <int D0> __device__ __forceinline__ void pv_one(f32x16& od, int vb, bf16x8 pa0, bf16x8 pa1, bf16x8 pa2, bf16x8 pa3) {
  const s16x4 l0 = tr_read<v_rd_off(D0, 0, 0)>(vb), h0 = tr_read<v_rd_off(D0, 0, 1)>(vb), l1 = tr_read<v_rd_off(D0, 1, 0)>(vb), h1 = tr_read<v_rd_off(D0, 1, 1)>(vb);
  const s16x4 l2 = tr_read<v_rd_off(D0, 2, 0)>(vb), h2 = tr_read<v_rd_off(D0, 2, 1)>(vb), l3 = tr_read<v_rd_off(D0, 3, 0)>(vb), h3 = tr_read<v_rd_off(D0, 3, 1)>(vb);
  asm volatile("s_waitcnt lgkmcnt(0)" ::: "memory"); MLA_SBAR();
#define MLA_PK(L, H) (bf16x8){L[0], L[1], L[2], L[3], H[0], H[1], H[2], H[3]}
  od = __builtin_amdgcn_mfma_f32_32x32x16_bf16(pa0, MLA_PK(l0, h0), od, 0, 0, 0);
  od = __builtin_amdgcn_mfma_f32_32x32x16_bf16(pa1, MLA_PK(l1, h1), od, 0, 0, 0);
  od = __builtin_amdgcn_mfma_f32_32x32x16_bf16(pa2, MLA_PK(l2, h2), od, 0, 0, 0);
  od = __builtin_amdgcn_mfma_f32_32x32x16_bf16(pa3, MLA_PK(l3, h3), od, 0, 0, 0);
#undef MLA_PK
}
__device__ __forceinline__ void pv_d0(f32x16* o, int vb, bf16x8 pa0, bf16x8 pa1, bf16x8 pa2, bf16x8 pa3) {
  pv_one<0>(o[0], vb, pa0, pa1, pa2, pa3); pv_one<1>(o[1], vb, pa0, pa1, pa2, pa3); pv_one<2>(o[2], vb, pa0, pa1, pa2, pa3); pv_one<3>(o[3], vb, pa0, pa1, pa2, pa3);
}
constexpr int SHM_ATTN3 = 3 * SHM_V + 2 * SHM_K + NW * 64 * 4;
__device__ __forceinline__ void attn_unit_d(const bf16* __restrict__ Qb, const bf16* __restrict__ Kh, const bf16* __restrict__ Vh, bf16* __restrict__ Ob, int seq, char* lds) {
  typedef __attribute__((address_space(3))) unsigned las_u32;
  const int tid = threadIdx.x, wid = tid >> 6, wu = __builtin_amdgcn_readfirstlane(tid >> 6), lane = tid & 63, r32 = lane & 31, hi = lane >> 5, grp = wid >> 2;
  char* V_lds = lds; char* K_lds = lds + 3 * SHM_V;
  float* ws = (float*)(lds + 3 * SHM_V + 2 * SHM_K) + wid * 64; float* li_l = ws; float* al_l = ws + 32;
  char* Q_lds = lds + SHM_ATTN3 + wid * 4096;
  float m_reg = -1e30f, l_reg = 0; f32x16 o[4] = {}; bf16x8 qr[8];
  const bf16* Qw = Qb + (long)(wid * QBLK + r32) * LDQ + hi * 8;
#pragma unroll
  for (int d0 = 0; d0 < 8; ++d0) qr[d0] = *reinterpret_cast<const bf16x8*>(Qw + d0 * 16);
  const int qsw = (r32 >> 1) & 7; char* qrow = Q_lds + r32 * 128;
#pragma unroll
  for (int d0 = 0; d0 < 4; ++d0) { const bf16x8 t = *reinterpret_cast<const bf16x8*>(Qw + 128 + d0 * 16); *reinterpret_cast<bf16x8*>(qrow + (((2 * d0 + hi) ^ qsw) << 4)) = t; }
  int ksrc[3], vsrc[2];
#pragma unroll
  for (int k = 0; k < 3; ++k) { const int o_ = (wid + 8 * k) * 1024 + lane * 16, r_ = o_ / 384, sc_ = (o_ - r_ * 384) >> 4, c_ = (sc_ & ~7) | ((sc_ & 7) ^ ((r_ >> 1) & 7)); ksrc[k] = (r_ * LDK + c_ * 8) * 2; }
#pragma unroll
  for (int k = 0; k < 2; ++k) { const int o_ = (wid + 8 * k) * 1024 + lane * 16, sub_ = o_ >> 9, w_ = (o_ & 511) >> 1, kk_ = (sub_ >> 2) * 8 + (w_ >> 5), key_ = (kk_ & ~0xC) | ((kk_ & 4) << 1) | ((kk_ & 8) >> 1);
    vsrc[k] = (key_ * LDV + (sub_ & 3) * 32 + (w_ & 31)) * 2; }
  const int vb0 = (int)(uintptr_t)V_lds + v_rd_base(lane);
  const __amdgpu_buffer_rsrc_t krs = __builtin_amdgcn_make_buffer_rsrc((void*)Kh, 0, seq * LDK * 2, 0x00020000);
  const __amdgpu_buffer_rsrc_t vrs = __builtin_amdgcn_make_buffer_rsrc((void*)Vh, 0, seq * LDV * 2, 0x00020000);
#define MLD_ISSUE(k0, bk, bv) do { \
    _Pragma("unroll") for (int k = 0; k < 3; ++k) __builtin_amdgcn_raw_ptr_buffer_load_lds(krs, (las_u32*)(K_lds + (bk) * SHM_K + (wu + 8 * k) * 1024), 16, ksrc[k], (k0) * LDK * 2, 0, 0); \
    _Pragma("unroll") for (int k = 0; k < 2; ++k) __builtin_amdgcn_raw_ptr_buffer_load_lds(vrs, (las_u32*)(V_lds + (bv) * SHM_V + (wu + 8 * k) * 1024), 16, vsrc[k], (k0) * LDV * 2, 0, 0); } while (0)
#define MLD_RD(d0_, A0_, A1_, QF_) do { const int c_ = 2 * (d0_) + hi; const int off_ = (c_ ^ sw) << 4; A0_ = *reinterpret_cast<const bf16x8*>(kb_ + off_); A1_ = *reinterpret_cast<const bf16x8*>(kb_ + 32 * 384 + off_); \
      if ((d0_) >= 8) QF_ = *reinterpret_cast<const bf16x8*>(qrow + (((2 * ((d0_) - 8) + hi) ^ qsw) << 4)); else QF_ = qr[(d0_) < 8 ? (d0_) : 0]; } while (0)
#define MLD_MM(A0_, A1_, QF_) do { p0 = __builtin_amdgcn_mfma_f32_32x32x16_bf16(A0_, QF_, p0, 0, 0, 0); p1 = __builtin_amdgcn_mfma_f32_32x32x16_bf16(A1_, QF_, p1, 0, 0, 0); } while (0)
#define MLD_S(t_) do { const int b_ = (t_) & 1; f32x16 p0 = f32x16{}, p1 = f32x16{}; \
      { const int sw = (r32 >> 1) & 7; const char* kb_ = K_lds + b_ * SHM_K + r32 * 384; \
        bf16x8 xa0, xa1, xq, ya0, ya1, yq; \
        MLD_RD(0, xa0, xa1, xq); \
        MLD_RD(1, ya0, ya1, yq); MLA_SBAR(); MLD_MM(xa0, xa1, xq); MLA_SBAR(); \
        MLD_RD(2, xa0, xa1, xq); MLA_SBAR(); MLD_MM(ya0, ya1, yq); MLA_SBAR(); \
        MLD_RD(3, ya0, ya1, yq); MLA_SBAR(); MLD_MM(xa0, xa1, xq); MLA_SBAR(); \
        MLD_RD(4, xa0, xa1, xq); MLA_SBAR(); MLD_MM(ya0, ya1, yq); MLA_SBAR(); \
        MLD_RD(5, ya0, ya1, yq); MLA_SBAR(); MLD_MM(xa0, xa1, xq); MLA_SBAR(); \
        MLD_RD(6, xa0, xa1, xq); MLA_SBAR(); MLD_MM(ya0, ya1, yq); MLA_SBAR(); \
        MLD_RD(7, ya0, ya1, yq); MLA_SBAR(); MLD_MM(xa0, xa1, xq); MLA_SBAR(); \
        MLD_RD(8, xa0, xa1, xq); MLA_SBAR(); MLD_MM(ya0, ya1, yq); MLA_SBAR(); \
        MLD_RD(9, ya0, ya1, yq); MLA_SBAR(); MLD_MM(xa0, xa1, xq); MLA_SBAR(); \
        MLD_RD(10, xa0, xa1, xq); MLA_SBAR(); MLD_MM(ya0, ya1, yq); MLA_SBAR(); \
        MLD_RD(11, ya0, ya1, yq); MLA_SBAR(); MLD_MM(xa0, xa1, xq); MLA_SBAR(); \
        MLD_MM(ya0, ya1, yq); } \
      float mn; partialSM(p0, p1, m_reg, mn, al); finishSM(p0, p1, al, l_reg, pa0, pa1, pa2, pa3); } while (0)
#define MLD_O(vslot_) do { if (__any(al < 1.f)) { if (hi == 0) al_l[r32] = al; asm volatile("s_waitcnt lgkmcnt(0)" ::: "memory"); \
        _Pragma("unroll") for (int d = 0; d < 4; ++d) _Pragma("unroll") for (int r = 0; r < 16; ++r) o[d][r] *= al_l[crow(r, hi)]; } \
      MLA_SBAR(); pv_d0(o, vb0 + (vslot_) * SHM_V, pa0, pa1, pa2, pa3); } while (0)
  const int NT = seq / KVBLK;
  MLD_ISSUE(0, 0, 0); asm volatile("s_waitcnt vmcnt(0)" ::: "memory"); __syncthreads();
  bf16x8 pa0 = {}, pa1 = {}, pa2 = {}, pa3 = {}; float al = 1.f;
  int vs_cur = 0;
  for (int j = 0; j <= NT; ++j) {
    const int vs_prev = vs_cur == 0 ? 2 : vs_cur - 1, vs_next = vs_cur == 2 ? 0 : vs_cur + 1;
    if (j + 1 < NT) MLD_ISSUE((j + 1) * KVBLK, (j + 1) & 1, vs_next);
    if (grp == 0) { if (j < NT) { MLD_S(j); MLD_O(vs_cur); } }
    else { if (j > 0) MLD_O(vs_prev); if (j < NT) MLD_S(j); }
    asm volatile("s_waitcnt vmcnt(0)" ::: "memory");
    __syncthreads();
    vs_cur = vs_next;
  }
  if (hi == 0) li_l[r32] = l_reg; asm volatile("s_waitcnt lgkmcnt(0)" ::: "memory");
  float rli[16];
#pragma unroll
  for (int r = 0; r < 16; ++r) rli[r] = __builtin_amdgcn_rcpf(li_l[crow(r, hi)]);
  bf16* Ow = Ob + (long)(wid * QBLK) * LDO;
#pragma unroll
  for (int r = 0; r < 16; ++r) { const int orow = crow(r, hi);
#pragma unroll
    for (int d0 = 0; d0 < 4; ++d0) Ow[(long)orow * LDO + d0 * 32 + r32] = (bf16)(cvtpk(o[d0][r] * rli[r], 0.f) & 0xffffu); }
  asm volatile("s_waitcnt vmcnt(0)" ::: "memory");
  __syncthreads();
#undef MLD_ISSUE
#undef MLD_S
#undef MLD_RD
#undef MLD_MM
#undef MLD_O
}
}
namespace wat {
typedef unsigned short bf16;
using bf16x8 = __attribute__((ext_vector_type(8))) short;
using s16x4  = __attribute__((ext_vector_type(4))) short;
using f32x4  = __attribute__((ext_vector_type(4))) float;
using u32x4  = __attribute__((ext_vector_type(4))) unsigned;
#define WAT_LAS __attribute__((address_space(3)))
__device__ __forceinline__ unsigned cvtpk(float lo, float hi) { unsigned r; asm volatile("v_cvt_pk_bf16_f32 %0, %1, %2" : "=v"(r) : "v"(lo), "v"(hi)); return r; }
__device__ __forceinline__ int kst_off(int row, int ch) { return row * 256 + ((ch ^ ((row & 3) | (((row >> 3) & 3) << 2))) << 4); }
__device__ __forceinline__ int vst_off(int row, int ch) { return (row >> 4) * 4096 + ((row >> 2) & 1) * 2048 + (ch >> 1) * 256 + ((row >> 3) & 1) * 128 + (row & 3) * 32 + (ch & 1) * 16; }
__device__ __forceinline__ int vrd_base(int R0, int lane) { const int g4 = lane >> 4, qa = (lane & 15) >> 2, p = lane & 3, gg = g4 + ((R0 >> 3) & 1); return ((R0 >> 4) + (gg >> 1)) * 4096 + (gg & 1) * 128 + qa * 32 + p * 8; }
__device__ __forceinline__ void qk_group(f32x4& sc0, f32x4& sc1, const WAT_LAS char* Kb, int Rg, const bf16x8* qf, int lane) {
    const int a = lane & 15, g4 = lane >> 4; const int row = Rg + 8 * (a >> 2) + (a & 3); const int xk = (row & 3) | (((row >> 3) & 3) << 2);
    const WAT_LAS char* p = Kb + row * 256;
    sc0 = f32x4{0.f, 0.f, 0.f, 0.f}; sc1 = f32x4{0.f, 0.f, 0.f, 0.f};
#pragma unroll
    for (int s = 0; s < 4; ++s) { const int off = ((4 * s + g4) ^ xk) << 4;
        const bf16x8 k0 = *(const WAT_LAS bf16x8*)(p + off), k1 = *(const WAT_LAS bf16x8*)(p + 4 * 256 + off);
        sc0 = __builtin_amdgcn_mfma_f32_16x16x32_bf16(k0, qf[s], sc0, 0, 0, 0);
        sc1 = __builtin_amdgcn_mfma_f32_16x16x32_bf16(k1, qf[s], sc1, 0, 0, 0); }
}
__device__ __forceinline__ bf16x8 p_frag(const f32x4 p0, const f32x4 p1) { u32x4 w = {cvtpk(p0[0], p0[1]), cvtpk(p0[2], p0[3]), cvtpk(p1[0], p1[1]), cvtpk(p1[2], p1[3])}; return *reinterpret_cast<bf16x8*>(&w); }
template <int OFF> __device__ __forceinline__ s16x4 tr_read(unsigned addr) { s16x4 r; asm volatile("ds_read_b64_tr_b16 %0, %1 offset:%2" : "=&v"(r) : "v"(addr), "i"(OFF) : "memory"); return r; }
template <int GOFF> __device__ __forceinline__ void pv_group(f32x4* o, unsigned vb, const bf16x8 pf) {
    s16x4 lo[8], hi[8];
#define WAT_TR(c) lo[c] = tr_read<GOFF + (c) * 256>(vb); hi[c] = tr_read<GOFF + 2048 + (c) * 256>(vb);
    WAT_TR(0) WAT_TR(1) WAT_TR(2) WAT_TR(3) WAT_TR(4) WAT_TR(5) WAT_TR(6) WAT_TR(7)
#undef WAT_TR
    asm volatile("s_waitcnt lgkmcnt(0)" ::: "memory"); __builtin_amdgcn_sched_barrier(0);
#pragma unroll
    for (int c = 0; c < 8; ++c) { const bf16x8 vfr = (bf16x8){lo[c][0], lo[c][1], lo[c][2], lo[c][3], hi[c][0], hi[c][1], hi[c][2], hi[c][3]};
        o[c] = __builtin_amdgcn_mfma_f32_16x16x32_bf16(pf, vfr, o[c], 0, 0, 0); }
}
}
constexpr int NWAVES = 8;
constexpr int BATCH = 2, SEQ = 8192, DM = 4096, M = BATCH * SEQ;
constexpr int EVEN_IN = 10688, ZLD = 10752;
constexpr int Z_CQ = 9216, Z_CKV = 10112, Z_KPE = 10624;
constexpr int QRANK = 896, KVRANK = 512, MLA_H = 16, MLA_QK = 192, MLA_NOPE = 128, MLA_ROPE = 64;
constexpr int DIL_H = 24, DIL_HPG = 8, HD = 128;
constexpr int NA_H = 32, GRID_W = 64, NA_ROWS = 8, NA_COLS = 16, GRID_ROWS = SEQ / GRID_W;
constexpr int DFF = 11008, EVEN_MIX = 3072;
constexpr float NORM_EPS = 1e-6f, LOG2E = 1.4426950408889634f;
constexpr float QS_MLA = 0.07216878364870322f * LOG2E;
constexpr float QS_HD = 0.08838834764831845f * LOG2E;
constexpr size_t MiB = 1u << 20;
constexpr size_t WS_CTL = 0, CTL_ZERO_BYTES = 64 * 1024;
constexpr size_t WS_ROPE = 1 * MiB;
constexpr size_t WS_RSTD = 4 * MiB;
constexpr size_t WS_SS = 5 * MiB;
constexpr size_t WS_WIN = 16 * MiB, WS_WUQ = 100 * MiB, WS_WUKV = 106 * MiB, WS_WEOUT = 110 * MiB, WS_WQKV = 134 * MiB, WS_WOOUT = 230 * MiB;
constexpr size_t WS_WFFN = 262 * MiB, FFN_W_BYTES = 86 * MiB;
constexpr size_t WS_XB = 778 * MiB;
constexpr size_t WS_R = 906 * MiB;
constexpr size_t R_Z = 0, R_Q = 336 * MiB, R_KV = 432 * MiB, R_K = 560 * MiB, R_OMIX = 656 * MiB, R_CQN = 656 * MiB, R_CKVN = 688 * MiB;
constexpr size_t R_A = 0, R_H2 = 344 * MiB;
constexpr size_t R_QKV = 0, R_O = 384 * MiB;
constexpr size_t R_DPO = 752 * MiB, R_DPM = 848 * MiB;
constexpr size_t WS_END = WS_R + 852 * MiB;
static_assert((size_t)ZLD * DM * 2 <= 84 * MiB && (size_t)DFF * DM * 2 == 86 * MiB && (size_t)M * ZLD * 2 == 336 * MiB && (size_t)M * DFF * 2 == 344 * MiB, "ws map");
constexpr int CW_BAR = 4096;
constexpr int RING_BYTES = 131072, LDS_BYTES = 163840, LDSCTL_OFF = LDS_BYTES - 1024, MISC_OFF = LDSCTL_OFF + 320;
constexpr int NA_TB_OFF = RING_BYTES + 1024, NA_OST_OFF = NA_TB_OFF + 2048;

#define GAS __attribute__((address_space(1)))
#define LAS __attribute__((address_space(3)))
typedef unsigned short bf16;
typedef unsigned v4u __attribute__((ext_vector_type(4)));
typedef unsigned v2u __attribute__((ext_vector_type(2)));
typedef float f32x4 __attribute__((ext_vector_type(4)));
#define LDS_WAIT() asm volatile("s_waitcnt lgkmcnt(0)" ::: "memory")
#define VM_WAIT() asm volatile("s_waitcnt vmcnt(0)" ::: "memory")
__device__ __forceinline__ unsigned f2bf(float f) { unsigned u = __builtin_bit_cast(unsigned, f); return (u + 0x7fffu + ((u >> 16) & 1u)) >> 16; }
__device__ __forceinline__ unsigned pk2(float lo, float hi) { return f2bf(lo) | (f2bf(hi) << 16); }
__device__ __forceinline__ float bflo(unsigned w) { return __uint_as_float(w << 16); }
__device__ __forceinline__ float bfhi(unsigned w) { return __uint_as_float(w & 0xffff0000u); }
__device__ __forceinline__ void unpack8(const v4u w, float* f) { f[0] = bflo(w.x); f[1] = bfhi(w.x); f[2] = bflo(w.y); f[3] = bfhi(w.y); f[4] = bflo(w.z); f[5] = bfhi(w.z); f[6] = bflo(w.w); f[7] = bfhi(w.w); }
__device__ __forceinline__ v4u pack8(const float* f) { v4u w; w.x = pk2(f[0], f[1]); w.y = pk2(f[2], f[3]); w.z = pk2(f[4], f[5]); w.w = pk2(f[6], f[7]); return w; }
__device__ __forceinline__ float wave_sum(float v) {
#pragma unroll
    for (int o = 1; o < 64; o <<= 1) v += __shfl_xor(v, o);
    return v;
}
__device__ __forceinline__ float sum16(float v) {
#pragma unroll
    for (int o = 1; o < 16; o <<= 1) v += __shfl_xor(v, o);
    return v;
}

#define XB_TMO      128
#define XB_XCNT(j)  (256  + 64 * (j))
#define XB_XSUB(j)  (1280 + 64 * (j))
#define XB_XGEN(j)  (2304 + 64 * (j))
#define XB_TOP      3328
#define XB_TOPGEN   3392
#define XCD_BAR_WORDS 3456
#define XB_SPIN_CAP (1u << 20)
__device__ __forceinline__ unsigned xb_ld(unsigned* p)              { return __hip_atomic_load(p, __ATOMIC_RELAXED, __HIP_MEMORY_SCOPE_AGENT); }
__device__ __forceinline__ unsigned xb_add(unsigned* p, unsigned v) { return __hip_atomic_fetch_add(p, v, __ATOMIC_RELAXED, __HIP_MEMORY_SCOPE_AGENT); }
__device__ __forceinline__ unsigned xb_xcc_id() { return (unsigned)__builtin_amdgcn_s_getreg((3 << 11) | 20) & 0xFu; }
#define XB_SPIN(cond, bar) do { unsigned _sp = 0; while (cond) { __builtin_amdgcn_s_sleep(1); \
    if ((++_sp & 255u) == 0u) { if (xb_ld(&(bar)[XB_TMO])) break; if (_sp > XB_SPIN_CAP) { atomicAdd(&(bar)[XB_TMO], 1u); break; } } } } while (0)
struct XcdBarrier { unsigned* bar; unsigned x; volatile LAS unsigned* st; };
__device__ __forceinline__ XcdBarrier xcd_barrier_post(unsigned* bar, volatile LAS unsigned* st) {
    XcdBarrier b; b.bar = bar; b.x = xb_xcc_id(); b.st = st;
    if (threadIdx.x == 0) (void)xb_add(&bar[XB_XCNT(b.x)], 1u);
    return b;
}
__device__ __forceinline__ void xcd_barrier_complete(unsigned* bar, unsigned x, unsigned& nloc, unsigned& nx) {
    const unsigned G = gridDim.x * gridDim.y * gridDim.z;
    unsigned sum, cnt, mine, sp = 0u;
    for (;;) {
        sum = 0u; cnt = 0u; mine = 0u;
#pragma unroll
        for (unsigned j = 0; j < 16; ++j) { const unsigned c = xb_ld(&bar[XB_XCNT(j)]); sum += c; cnt += (c > 0u) ? 1u : 0u; mine = (j == x) ? c : mine; }
        if (sum == G) break;
        __builtin_amdgcn_s_sleep(1);
        if ((++sp & 255u) == 0u) { if (xb_ld(&bar[XB_TMO])) break; if (sp > XB_SPIN_CAP) { atomicAdd(&bar[XB_TMO], 1u); break; } }
    }
    nloc = mine > 0u ? mine : 1u; nx = cnt > 0u ? cnt : 1u;
}
__device__ __forceinline__ void xcd_barrier(const XcdBarrier& b) {
    asm volatile("s_waitcnt vmcnt(0)" ::: "memory");
    __syncthreads();
    if (threadIdx.x == 0) {
        unsigned* bar = b.bar;
        __builtin_amdgcn_s_waitcnt(0);
        unsigned nloc = b.st[0], nx = b.st[1];
        if (nloc == 0u) { xcd_barrier_complete(bar, b.x, nloc, nx); b.st[0] = nloc; b.st[1] = nx; }
        const unsigned old = xb_add(&bar[XB_XSUB(b.x)], 1u);
        const unsigned gen = old / nloc;
        if (old + 1u == (gen + 1u) * nloc) {
            __builtin_amdgcn_fence(__ATOMIC_RELEASE, "agent");
            asm volatile("s_waitcnt vmcnt(0)" ::: "memory");
            const unsigned og = xb_add(&bar[XB_TOP], 1u);
            const unsigned tg = og / nx;
            if (og + 1u == (tg + 1u) * nx) xb_add(&bar[XB_TOPGEN], 1u);
            else XB_SPIN(xb_ld(&bar[XB_TOPGEN]) == tg, bar);
            __builtin_amdgcn_fence(__ATOMIC_ACQUIRE, "agent");
            xb_add(&bar[XB_XGEN(b.x)], 1u);
            asm volatile("s_waitcnt vmcnt(0)" ::: "memory");
        } else {
            XB_SPIN(xb_ld(&bar[XB_XGEN(b.x)]) == gen, bar);
            __builtin_amdgcn_fence(__ATOMIC_ACQUIRE, "agent");
            asm volatile("s_waitcnt vmcnt(0)" ::: "memory");
        }
    }
    __syncthreads();
}

struct Args { const float* in[24]; float* out; unsigned char* ws; int ph_lo, ph_hi; };
struct Frame { LAS unsigned char* lds; int tid, lane, wave, gw, ngw, G; };

struct P0Item { const float* W; int K, N; bf16* dst; const float* gain; int mode, r; };
__device__ __forceinline__ void p0_item_load(const P0Item& t, float (&v)[32], int lane) {
    const int nblk = t.N / 32, kb = t.r / nblk, nb = t.r % nblk, k0 = 64 * kb, n0 = 32 * nb;
    const float* p = t.W + (size_t)(k0 + (lane >> 5)) * t.N + n0 + (lane & 31);
#pragma unroll
    for (int i = 0; i < 32; ++i) v[i] = p[(size_t)(2 * i) * t.N];
}
__device__ __forceinline__ void p0_item_store(const P0Item& t, const float (&v)[32], LAS float* scr, int lane) {
    const int nblk = t.N / 32, kb = t.r / nblk, nb = t.r % nblk, k0 = 64 * kb, n0 = 32 * nb;
    const int drow0 = (t.mode == 1) ? (n0 >= 1472 ? n0 - 1472 : n0 + 9216)
                    : (t.mode >= 2) ? ((n0 >> 7) * 256 + (n0 & 127) + (t.mode == 3 ? 128 : 0)) : n0;
#pragma unroll
    for (int i = 0; i < 32; ++i) { const int kk = 2 * i + (lane >> 5); scr[kk * 33 + (lane & 31)] = v[i]; }
    LDS_WAIT(); asm volatile("" ::: "memory");
    const int c = lane & 7;
    f32x4 ga = {1.f, 1.f, 1.f, 1.f}, gb = {1.f, 1.f, 1.f, 1.f};
    if (t.gain) { ga = *(const f32x4*)(t.gain + k0 + 8 * c); gb = *(const f32x4*)(t.gain + k0 + 8 * c + 4); }
#pragma unroll
    for (int j = 0; j < 4; ++j) { const int n = (lane >> 3) + 8 * j; const LAS float* sp = scr + (8 * c) * 33 + n;
        v4u o; o.x = pk2(sp[0 * 33] * ga[0], sp[1 * 33] * ga[1]); o.y = pk2(sp[2 * 33] * ga[2], sp[3 * 33] * ga[3]); o.z = pk2(sp[4 * 33] * gb[0], sp[5 * 33] * gb[1]); o.w = pk2(sp[6 * 33] * gb[2], sp[7 * 33] * gb[3]);
        *(v4u*)(t.dst + (size_t)(drow0 + n) * t.K + k0 + 8 * c) = o; }
    LDS_WAIT(); asm volatile("" ::: "memory");
}
#ifndef MLA_UNIT
#define MLA_UNIT mla::attn_unit_d
#endif
constexpr int N_PHASES = 20;
#ifndef LB2
#define LB2 2
#endif
__global__ void __launch_bounds__(NWAVES * 64, LB2) mk_fwd(Args args) {
    extern __shared__ __attribute__((aligned(16))) unsigned char lds[];
    Frame F;
    F.lds = (LAS unsigned char*)lds;
    F.tid = threadIdx.x; F.lane = F.tid & 63; F.wave = __builtin_amdgcn_readfirstlane(F.tid >> 6);
    F.G = gridDim.x; F.gw = blockIdx.x * NWAVES + F.wave; F.ngw = F.G * NWAVES;
    const int lane = F.lane, l15 = lane & 15, grp = lane >> 4;
    unsigned char* ws = args.ws;
    unsigned* ctl = (unsigned*)(ws + WS_CTL);
    const float* x_in = args.in[0]; float* out = args.out;
    float* cosA = (float*)(ws + WS_ROPE); float* sinA = cosA + SEQ * 16; float* cosB = sinA + SEQ * 16; float* sinB = cosB + SEQ * 32;
    float* rstd = (float*)(ws + WS_RSTD); float* ss = (float*)(ws + WS_SS);
    bf16* Win_t = (bf16*)(ws + WS_WIN); bf16* Wuq_t = (bf16*)(ws + WS_WUQ); bf16* Wukv_t = (bf16*)(ws + WS_WUKV); bf16* Weout_t = (bf16*)(ws + WS_WEOUT);
    bf16* Wqkv_t = (bf16*)(ws + WS_WQKV); bf16* Woout_t = (bf16*)(ws + WS_WOOUT);
    bf16* xb = (bf16*)(ws + WS_XB);
    unsigned char* R = ws + WS_R;
    bf16* zb = (bf16*)(R + R_Z); bf16* qb = (bf16*)(R + R_Q); bf16* kvb = (bf16*)(R + R_KV); bf16* kb = (bf16*)(R + R_K); bf16* omix = (bf16*)(R + R_OMIX);
    bf16* cqn = (bf16*)(R + R_CQN); bf16* ckvn = (bf16*)(R + R_CKVN);
    bf16* aedge = (bf16*)(R + R_A); bf16* uedge = aedge + (size_t)(M / 256) * 4 * DFF; bf16* h2b = (bf16*)(R + R_H2);
    bf16* qkvb = (bf16*)(R + R_QKV); bf16* ob = (bf16*)(R + R_O);
    bf16* dpo = (bf16*)(R + R_DPO); float* dpm = (float*)(R + R_DPM);
    bf16* xl0 = (bf16*)(ws + WS_WIN); bf16* xl1 = (bf16*)(R + R_DPO) - (size_t)8192 * DM;

    for (int u = F.tid; u < (LDS_BYTES - LDSCTL_OFF) / 4; u += NWAVES * 64) ((LAS unsigned*)(F.lds + LDSCTL_OFF))[u] = 0u;
    __syncthreads();
    const int lo = args.ph_lo, hi = args.ph_hi;
    XcdBarrier bar; bar.bar = ctl + CW_BAR; bar.x = 0; bar.st = nullptr;
    if (hi - lo > 1) bar = xcd_barrier_post(ctl + CW_BAR, (volatile LAS unsigned*)(F.lds + MISC_OFF) + 8);
#ifndef PH_MASK
#define PH_MASK 0xFFFFFu
#endif
#define IN(k) ((((PH_MASK) >> (k)) & 1u) && lo <= (k) && (k) < hi)
#define SEAM(k) do { if (IN(k) && IN((k) + 1)) xcd_barrier(bar); } while (0)

    if (IN(0)) {
        LAS float* scr = (LAS float*)(F.lds + F.wave * 16384);
        constexpr int I_WIN = (DM / 64) * (EVEN_IN / 32), I_UQ = (QRANK / 64) * (3072 / 32), I_UKV = (KVRANK / 64) * (4096 / 32), I_EOUT = (EVEN_MIX / 64) * (DM / 32);
        constexpr int I_QKV = (DM / 64) * (12288 / 32), I_OOUT = (DM / 64) * (DM / 32), I_GU = (DM / 64) * (DFF / 32), I_DN = (DFF / 64) * (DM / 32);
        constexpr int NITEMS = I_WIN + I_UQ + I_UKV + I_EOUT + I_QKV + I_OOUT + 2 * (2 * I_GU + I_DN);
#define P0_DECODE(it_, T_) do { int r = (it_); T_.gain = nullptr; T_.mode = 0; \
            if (r < I_WIN) { T_.W = args.in[2]; T_.K = DM; T_.N = EVEN_IN; T_.dst = Win_t; T_.gain = args.in[1]; T_.mode = 1; } \
            else if ((r -= I_WIN) < I_UQ) { T_.W = args.in[5]; T_.K = QRANK; T_.N = 3072; T_.dst = Wuq_t; T_.gain = args.in[3]; } \
            else if ((r -= I_UQ) < I_UKV) { T_.W = args.in[6]; T_.K = KVRANK; T_.N = 4096; T_.dst = Wukv_t; T_.gain = args.in[4]; } \
            else if ((r -= I_UKV) < I_EOUT) { T_.W = args.in[11]; T_.K = EVEN_MIX; T_.N = DM; T_.dst = Weout_t; } \
            else if ((r -= I_EOUT) < I_QKV) { T_.W = args.in[13]; T_.K = DM; T_.N = 12288; T_.dst = Wqkv_t; T_.gain = args.in[12]; } \
            else if ((r -= I_QKV) < I_OOUT) { T_.W = args.in[17]; T_.K = DM; T_.N = DM; T_.dst = Woout_t; } \
            else { r -= I_OOUT; const int layer = r / (2 * I_GU + I_DN); r -= layer * (2 * I_GU + I_DN); \
                bf16* wl = (bf16*)(ws + WS_WFFN + (size_t)layer * 3 * FFN_W_BYTES); \
                if (r < I_GU) { T_.W = args.in[19] + (size_t)layer * DM * DFF; T_.K = DM; T_.N = DFF; T_.dst = wl; T_.gain = args.in[18] + layer * DM; T_.mode = 2; } \
                else if ((r -= I_GU) < I_GU) { T_.W = args.in[20] + (size_t)layer * DM * DFF; T_.K = DM; T_.N = DFF; T_.dst = wl; T_.gain = args.in[18] + layer * DM; T_.mode = 3; } \
                else { r -= I_GU; T_.W = args.in[23] + (size_t)layer * DFF * DM; T_.K = DFF; T_.N = DM; T_.dst = (bf16*)((unsigned char*)wl + 2 * FFN_W_BYTES); } } \
            T_.r = r; } while (0)
        {
            float va[32], vb[32]; P0Item ta, tb_;
            int it = F.gw;
            if (it < NITEMS) { P0_DECODE(it, ta); p0_item_load(ta, va, lane); }
            while (it < NITEMS) {
                const int it1 = it + F.ngw, it2 = it1 + F.ngw;
                if (it1 < NITEMS) { P0_DECODE(it1, tb_); p0_item_load(tb_, vb, lane); }
                p0_item_store(ta, va, scr, lane);
                if (it1 >= NITEMS) break;
                if (it2 < NITEMS) { P0_DECODE(it2, ta); p0_item_load(ta, va, lane); }
                p0_item_store(tb_, vb, scr, lane);
                it = it2;
            }
        }
#undef P0_DECODE
        const int gtid = blockIdx.x * (NWAVES * 64) + F.tid, nthr = F.G * NWAVES * 64;
        for (int i = gtid; i < (ZLD - 10688) * DM / 8; i += nthr) ((v4u*)(Win_t + (size_t)10688 * DM))[i] = (v4u){0u, 0u, 0u, 0u};
        for (int i = gtid; i < SEQ * 48; i += nthr) {
            const bool isB = i >= SEQ * 16; const int ii = isB ? i - SEQ * 16 : i; const int pos = isB ? (ii >> 5) : (ii >> 4), k = isB ? (ii & 31) : (ii & 15);
            const double c1 = isB ? 0.6636012376960885 : 0.44036660267178046;
            double p = 1.0; for (int j = 0; j < k; ++j) p *= c1;
            const float inv = (float)p; const float ang = (float)pos * inv;
            const double rev = (double)ang * 0.15915494309189535; const float fr = (float)(rev - __builtin_rint(rev));
            const float sv = __builtin_amdgcn_sinf(fr), cv = __builtin_amdgcn_cosf(fr);
            if (isB) { cosB[ii] = cv; sinB[ii] = sv; } else { cosA[ii] = cv; sinA[ii] = sv; }
        }
#pragma unroll 2
        for (int row = F.gw; row < M; row += F.ngw) {
            const f32x4* xr = (const f32x4*)(x_in + (size_t)row * DM) + lane; v2u* xo = (v2u*)(xb + (size_t)row * DM) + lane; float s = 0.f;
#pragma unroll 4
            for (int j = 0; j < 16; ++j) { const f32x4 v = xr[64 * j]; s += (v.x * v.x + v.y * v.y) + (v.z * v.z + v.w * v.w); v2u w; w.x = pk2(v.x, v.y); w.y = pk2(v.z, v.w); xo[64 * j] = w; }
            s = wave_sum(s);
            if (lane == 0) rstd[row] = 1.0f / sqrtf(s * (1.0f / DM) + NORM_EPS);
        }
    }
    SEAM(0);
    if (IN(1)) {
        pg8::Gemm g{xb, Win_t, M, ZLD, DM, DM}; pg8::StaticOrder S; S.init(M, ZLD, F.G, (int)blockIdx.x);
        pg8::EpiHeadNorm E{zb, ZLD, rstd, args.in[9], args.in[10], QS_HD, 12, 12, (PG8_LAS float*)(F.lds + NA_TB_OFF), cosA, sinA, SEQ, ss};
        pg8::gemm_phase<pg8::EpiHeadNorm, pg8::StaticOrder, true, true>(F.lds, g, S, E);
    }
    SEAM(1);
    if (IN(3)) {
        {
            const int pm_lo = F.G == 256 ? 8 * ((int)blockIdx.x & 7) + (((int)blockIdx.x >> 3) & 7) : 0, pm_hi = F.G == 256 ? pm_lo + 1 : M / 256;
            for (int pmi = pm_lo; pmi < pm_hi; ++pmi) {
                const int row = pmi * 256 + (F.tid >> 1); const f32x4* sp = (const f32x4*)(ss + (size_t)row * 64) + ((F.tid & 1) ? 7 : 0);
                f32x4 a = sp[0] + sp[1] + sp[2] + sp[3]; if ((F.tid & 1) == 0) a += sp[4] + sp[5] + sp[6];
                const float tot = (a[0] + a[1]) + (a[2] + a[3]);
                rstd[((F.tid & 1) ? 2 * M : M) + row] = 1.0f / sqrtf(tot * ((F.tid & 1) ? 1.0f / KVRANK : 1.0f / QRANK) + NORM_EPS); }
            asm volatile("s_waitcnt vmcnt(0)" ::: "memory"); __syncthreads();
        }
        { pg8::Gemm g{zb + Z_CQ, Wuq_t, M, 3072, QRANK, ZLD}; pg8::StaticOrder S; S.init(M, 3072, F.G, (int)blockIdx.x); pg8::EpiScaleBf16 E{qb, 3072, rstd + M};
          pg8::gemm_phase<pg8::EpiScaleBf16, pg8::StaticOrder, true, true>(F.lds, g, S, E); }
        { pg8::Gemm g{zb + Z_CKV, Wukv_t, M, 4096, KVRANK, ZLD}; pg8::StaticOrder S; S.init(M, 4096, F.G, (int)blockIdx.x); pg8::EpiScaleBf16 E{kvb, 4096, rstd + 2 * M};
          pg8::gemm_phase<pg8::EpiScaleBf16, pg8::StaticOrder, true, true>(F.lds, g, S, E); }
        {
            WAT_LAS char* L = (WAT_LAS char*)F.lds;
            const int NU = BATCH * 3 * DIL_HPG * 64;
            const int u0 = (int)(((long)NU * blockIdx.x) / F.G), u1 = (int)(((long)NU * (blockIdx.x + 1)) / F.G);
            const int row16 = F.tid >> 4, ch16 = F.tid & 15, kso = wat::kst_off(row16, ch16), vso = wat::vst_off(row16, ch16);
            const int w = F.wave, q = lane & 15, g4 = lane >> 4, Rw = 32 * (w >> 1);
            v4u st[8];
#define DL_GEOM(u_) const int blk_ = (u_) & 63, j_ = ((u_) >> 6) & 7, bg_ = (u_) >> 9, g_ = bg_ % 3, b_ = bg_ / 3, sh_ = 2 * g_, d_ = 1 << sh_, Ld_ = SEQ >> sh_, \
            r_ = blk_ >> (6 - sh_), p0_ = (blk_ & ((64 >> sh_) - 1)) * 128, head_ = 8 * g_ + j_;
#define DL_LOAD(u_, s_) do { DL_GEOM(u_) const bf16* base_ = zb + (size_t)(b_ * SEQ + r_) * ZLD + ((s_) ? 6144 : 3072) + head_ * HD + ch16 * 8; \
            _Pragma("unroll") for (int k = 0; k < 8; ++k) { const int kp_ = min(max(p0_ - 64 + row16 + 32 * k, 0), Ld_ - 1); st[k] = *(const v4u*)(base_ + (size_t)(kp_ << sh_) * ZLD); } } while (0)
#define DL_WRITE(s_) do { WAT_LAS char* dd_ = L + (s_) * 65536 + ((s_) ? vso : kso); _Pragma("unroll") for (int k = 0; k < 8; ++k) *(WAT_LAS v4u*)(dd_ + k * 32 * 256) = st[k]; } while (0)
#define DL_END(un_, sn_, un2_, sn2_) do { if ((un_) < u1) { VM_WAIT(); DL_WRITE(sn_); } __syncthreads(); if ((un2_) < u1) DL_LOAD(un2_, sn2_); } while (0)
            if (u0 < u1) { DL_LOAD(u0, 0); VM_WAIT(); DL_WRITE(0); __syncthreads(); DL_LOAD(u0, 1); }
            for (int u = u0; u < u1; ++u) {
                DL_GEOM(u)
                wat::bf16x8 qf[4]; wat::f32x4 sc[5][2]; wat::bf16x8 pf[5]; wat::f32x4 o[8]; float linv = 0.f, mrow = 0.f, lrow = 0.f;
                const int qp = p0_ + 16 * w + q; const size_t qtok = (size_t)(b_ * SEQ + r_) + ((size_t)qp << sh_);
                {
                    const bf16* qptr = zb + qtok * ZLD + head_ * HD + 8 * g4;
#pragma unroll
                    for (int s = 0; s < 4; ++s) qf[s] = *(const wat::bf16x8*)(qptr + 32 * s);
#pragma unroll
                    for (int gi = 0; gi < 5; ++gi) wat::qk_group(sc[gi][0], sc[gi][1], L, Rw + 32 * gi, qf, lane);
                    float m = -1e30f;
#pragma unroll
                    for (int gi = 0; gi < 5; ++gi)
#pragma unroll
                        for (int j = 0; j < 8; ++j) { const int lr = Rw + 32 * gi + 8 * g4 + j, kp = p0_ - 64 + lr, dq = kp - qp; const bool ok = dq >= -64 && dq <= 64 && kp >= 0 && kp < Ld_;
                            const float v = ok ? sc[gi][j >> 2][j & 3] : -1e30f; sc[gi][j >> 2][j & 3] = v; m = fmaxf(m, v); }
                    m = fmaxf(m, __shfl_xor(m, 16)); m = fmaxf(m, __shfl_xor(m, 32));
                    float l = 0.f;
#pragma unroll
                    for (int gi = 0; gi < 5; ++gi) {
#pragma unroll
                        for (int j = 0; j < 8; ++j) { const float sv = sc[gi][j >> 2][j & 3]; const float v = sv > -1e29f ? __builtin_amdgcn_exp2f(sv - m) : 0.f; sc[gi][j >> 2][j & 3] = v; l += v; }
                        pf[gi] = wat::p_frag(sc[gi][0], sc[gi][1]); }
                    l += __shfl_xor(l, 16); l += __shfl_xor(l, 32); linv = 1.0f / l; mrow = m; lrow = l;
#pragma unroll
                    for (int c = 0; c < 8; ++c) o[c] = wat::f32x4{0.f, 0.f, 0.f, 0.f};
                }
                DL_END(u, 1, u + 1, 0);
                {
                    const unsigned vb = (unsigned)(uintptr_t)(L + 65536) + (unsigned)wat::vrd_base(Rw, lane);
                    wat::pv_group<0>(o, vb, pf[0]); wat::pv_group<8192>(o, vb, pf[1]); wat::pv_group<16384>(o, vb, pf[2]); wat::pv_group<24576>(o, vb, pf[3]); wat::pv_group<32768>(o, vb, pf[4]);
                    WAT_LAS char* ost = L + NA_OST_OFF + w * 2304;
                    float li[4];
#pragma unroll
                    for (int r = 0; r < 4; ++r) li[r] = __shfl(linv, 4 * g4 + r);
                    const size_t tok_r = (size_t)(b_ * SEQ + r_) + ((size_t)(p0_ + 16 * w + g4) << sh_);
#pragma unroll
                    for (int hf = 0; hf < 2; ++hf) {
#pragma unroll
                        for (int r = 0; r < 4; ++r)
#pragma unroll
                            for (int c = 0; c < 4; ++c) *(WAT_LAS unsigned short*)(ost + (4 * g4 + r) * 144 + (16 * c + q) * 2) = (unsigned short)(wat::cvtpk(o[4 * hf + c][r] * li[r], 0.f) & 0xffffu);
                        asm volatile("s_waitcnt lgkmcnt(0)" ::: "memory");
#pragma unroll
                        for (int k = 0; k < 2; ++k) { const int rq = g4 + 4 * (2 * k + (q >> 3)); const v4u v = *(const WAT_LAS v4u*)(ost + rq * 144 + (q & 7) * 16);
                            const size_t tk = tok_r + ((size_t)(4 * (2 * k + (q >> 3))) << sh_);
                            *(v4u*)(dpo + ((tk * DIL_HPG + j_) * 3 + g_) * HD + 64 * hf + (q & 7) * 8) = v; }
                        asm volatile("s_waitcnt lgkmcnt(0)" ::: "memory");
                    }
                    if (g4 == 0) { float* pmp = dpm + ((qtok * DIL_HPG + j_) * 3 + g_) * 2; pmp[0] = mrow; pmp[1] = lrow; }
                }
                DL_END(u + 1, 0, u + 1, 1);
            }
#undef DL_GEOM
#undef DL_LOAD
#undef DL_WRITE
#undef DL_END
        }
    }
    SEAM(3);
    if (IN(4)) {
        const float* qn = args.in[7]; const float* kn = args.in[8];
        float gq[12], gk[12];
#pragma unroll
        for (int k = 0; k < 3; ++k)
#pragma unroll
            for (int j = 0; j < 4; ++j) { gq[4 * k + j] = qn[64 * k + 4 * l15 + j] * QS_MLA; gk[4 * k + j] = kn[64 * k + 4 * l15 + j]; }
#pragma unroll 2
        for (int row = F.gw; row < M; row += F.ngw) {
            const int pos = row & (SEQ - 1);
            float cr[4], sr[4];
#pragma unroll
            for (int j = 0; j < 4; ++j) { cr[j] = cosB[pos * 32 + 4 * (l15 & 7) + j]; sr[j] = sinB[pos * 32 + 4 * (l15 & 7) + j]; if (l15 < 8) sr[j] = -sr[j]; }
            const v2u kpe = *(const v2u*)(zb + (size_t)row * ZLD + Z_KPE + 4 * l15);
#pragma unroll
            for (int it = 0; it < 4; ++it) {
                const int h = 4 * it + grp;
                {
                    bf16* p = qb + (size_t)row * 3072 + h * MLA_QK + 4 * l15; v2u w[3];
#pragma unroll
                    for (int k = 0; k < 3; ++k) w[k] = *(const v2u*)(p + 64 * k);
                    float v[12];
#pragma unroll
                    for (int k = 0; k < 3; ++k) { v[4 * k] = bflo(w[k].x); v[4 * k + 1] = bfhi(w[k].x); v[4 * k + 2] = bflo(w[k].y); v[4 * k + 3] = bfhi(w[k].y); }
                    float s = 0.f;
#pragma unroll
                    for (int e = 0; e < 12; ++e) s += v[e] * v[e];
                    s = sum16(s); const float rs = 1.0f / sqrtf(s * (1.0f / MLA_QK) + NORM_EPS);
#pragma unroll
                    for (int e = 0; e < 12; ++e) v[e] = v[e] * rs * gq[e];
#pragma unroll
                    for (int j = 0; j < 4; ++j) { const float yp = __shfl_xor(v[8 + j], 8); v[8 + j] = v[8 + j] * cr[j] + yp * sr[j]; }
#pragma unroll
                    for (int k = 0; k < 3; ++k) { v2u o; o.x = pk2(v[4 * k], v[4 * k + 1]); o.y = pk2(v[4 * k + 2], v[4 * k + 3]); *(v2u*)(p + 64 * k) = o; }
                }
                {
                    const bf16* p = kvb + (size_t)row * 4096 + h * 256 + 4 * l15; v2u w[3];
                    w[0] = *(const v2u*)p; w[1] = *(const v2u*)(p + 64); w[2] = kpe;
                    float v[12];
#pragma unroll
                    for (int k = 0; k < 3; ++k) { v[4 * k] = bflo(w[k].x); v[4 * k + 1] = bfhi(w[k].x); v[4 * k + 2] = bflo(w[k].y); v[4 * k + 3] = bfhi(w[k].y); }
                    float s = 0.f;
#pragma unroll
                    for (int e = 0; e < 12; ++e) s += v[e] * v[e];
                    s = sum16(s); const float rs = 1.0f / sqrtf(s * (1.0f / MLA_QK) + NORM_EPS);
#pragma unroll
                    for (int e = 0; e < 12; ++e) v[e] = v[e] * rs * gk[e];
#pragma unroll
                    for (int j = 0; j < 4; ++j) { const float yp = __shfl_xor(v[8 + j], 8); v[8 + j] = v[8 + j] * cr[j] + yp * sr[j]; }
                    bf16* o_ = kb + (size_t)row * 3072 + h * MLA_QK + 4 * l15;
#pragma unroll
                    for (int k = 0; k < 3; ++k) { v2u o; o.x = pk2(v[4 * k], v[4 * k + 1]); o.y = pk2(v[4 * k + 2], v[4 * k + 3]); *(v2u*)(o_ + 64 * k) = o; }
                }
            }
#pragma unroll
            for (int it = 0; it < 2; ++it) {
                const int jh = 4 * it + grp; const size_t pb = ((size_t)row * DIL_HPG + jh) * 3;
                const float m0 = dpm[pb * 2 + 0], l0 = dpm[pb * 2 + 1], m1 = dpm[pb * 2 + 2], l1 = dpm[pb * 2 + 3], m2 = dpm[pb * 2 + 4], l2 = dpm[pb * 2 + 5];
                const float mm = fmaxf(m0, fmaxf(m1, m2)); const float w0 = __builtin_amdgcn_exp2f(m0 - mm) * l0, w1 = __builtin_amdgcn_exp2f(m1 - mm) * l1, w2 = __builtin_amdgcn_exp2f(m2 - mm) * l2;
                const float rw = 1.0f / (w0 + w1 + w2);
                float a0[8], a1[8], a2[8], x[8];
                unpack8(*(const v4u*)(dpo + (pb + 0) * HD + 8 * l15), a0); unpack8(*(const v4u*)(dpo + (pb + 1) * HD + 8 * l15), a1); unpack8(*(const v4u*)(dpo + (pb + 2) * HD + 8 * l15), a2);
#pragma unroll
                for (int j = 0; j < 8; ++j) x[j] = (w0 * a0[j] + w1 * a1[j] + w2 * a2[j]) * rw;
                *(v4u*)(omix + (size_t)row * 3072 + 2048 + jh * HD + 8 * l15) = pack8(x);
            }
        }
    }
    SEAM(4);
    if (IN(5)) {
        for (int i = 0; i * F.G + (int)blockIdx.x < BATCH * MLA_H * (SEQ / 256); ++i) {
            const int c = (int)blockIdx.x; int bh = i * 8 + (c & 7), qblk = c >> 3;
            if (F.G != 256) { const int u = i * F.G + c; bh = u >> 5; qblk = u & 31; }
            const int b = bh >> 4, h = bh & 15; const size_t r0 = (size_t)b * SEQ;
            MLA_UNIT(qb + (r0 + (size_t)qblk * 256) * 3072 + h * MLA_QK, kb + r0 * 3072 + h * MLA_QK, kvb + r0 * 4096 + h * 256 + 128,
                              omix + (r0 + (size_t)qblk * 256) * 3072 + h * HD, SEQ, (char*)lds);
        }
    }
    SEAM(5);
    if (IN(6)) {
        pg8::Gemm g{omix, Weout_t, M, DM, EVEN_MIX, EVEN_MIX}; pg8::StaticOrder S; S.init(M, DM, F.G, (int)blockIdx.x); pg8::EpiResidT<0> E{x_in, out, xb, xl0, xl1, ss, DM};
        pg8::gemm_phase<pg8::EpiResidT<0>, pg8::StaticOrder, true, true>(F.lds, g, S, E);
    }
    SEAM(6);
#define RSTD_PHASE() do { for (int row = F.gw; row < M; row += F.ngw) { const float s = wave_sum(ss[(size_t)row * 64 + lane]); if (lane == 0) rstd[row] = 1.0f / sqrtf(s * (1.0f / DM) + NORM_EPS); } } while (0)
#define FFN_GATEUP(layer) do { const bf16* wl = (const bf16*)(ws + WS_WFFN + (size_t)(layer) * 3 * FFN_W_BYTES); \
        pg8::Gemm g{xb, wl, M, 2 * DFF, DM, DM}; pg8::StaticOrder S; S.init(M, 2 * DFF, F.G, (int)blockIdx.x, DM / 64, (float*)(R + (size_t)(16 + 48 * (layer)) * MiB), ctl + 8192 + 2048 * (1 + (layer))); \
        pg8::EpiGateUp E{h2b, rstd, args.in[21] + (size_t)(layer) * 3 * DFF, args.in[22] + (size_t)(layer) * DFF, DFF, aedge, uedge, (PG8_LAS float*)(F.lds + NA_TB_OFF)}; \
        pg8::gemm_phase<pg8::EpiGateUp, pg8::StaticOrder, true, true, true>(F.lds, g, S, E); } while (0)
#define FFN_FIX(layer) do { const float* cwp = args.in[21] + (size_t)(layer) * 3 * DFF; const float* cbp = args.in[22] + (size_t)(layer) * DFF; \
        const int gtid = blockIdx.x * (NWAVES * 64) + F.tid, nthr = F.G * NWAVES * 64; \
        for (int i = gtid; i < (M / 256) * 2 * (DFF / 8); i += nthr) { const int c8 = i % (DFF / 8), e = (i / (DFF / 8)) & 1, pm = i / (2 * (DFF / 8)); const int ch = c8 * 8; \
            const int row = pm * 256 + (e ? 255 : 0), t = row & (SEQ - 1); const v4u z4 = {0u, 0u, 0u, 0u}; \
            const v4u cur = *(const v4u*)(aedge + ((size_t)pm * 4 + (e ? 3 : 0)) * DFF + ch); \
            const v4u prv = e ? *(const v4u*)(aedge + ((size_t)pm * 4 + 2) * DFF + ch) : (t > 0 ? *(const v4u*)(aedge + ((size_t)(pm - 1) * 4 + 3) * DFF + ch) : z4); \
            const v4u nxt = e ? (t < SEQ - 1 ? *(const v4u*)(aedge + ((size_t)(pm + 1) * 4 + 0) * DFF + ch) : z4) : *(const v4u*)(aedge + ((size_t)pm * 4 + 1) * DFF + ch); \
            const v4u upv = *(const v4u*)(uedge + ((size_t)pm * 2 + e) * DFF + ch); \
            const unsigned cu_[4] = {cur.x, cur.y, cur.z, cur.w}, pr_[4] = {prv.x, prv.y, prv.z, prv.w}, nx_[4] = {nxt.x, nxt.y, nxt.z, nxt.w}, up_[4] = {upv.x, upv.y, upv.z, upv.w}; \
            float hv[8]; \
            _Pragma("unroll") for (int j = 0; j < 8; ++j) { \
                const float fm = (j & 1) ? bfhi(pr_[j >> 1]) : bflo(pr_[j >> 1]), fz = (j & 1) ? bfhi(cu_[j >> 1]) : bflo(cu_[j >> 1]), fn = (j & 1) ? bfhi(nx_[j >> 1]) : bflo(nx_[j >> 1]), fu = (j & 1) ? bfhi(up_[j >> 1]) : bflo(up_[j >> 1]); \
                const float gg = cwp[ch + j] * fm + cwp[DFF + ch + j] * fz + cwp[2 * DFF + ch + j] * fn + cbp[ch + j]; \
                const float ee = __builtin_amdgcn_exp2f(-1.4426950408889634f * gg); hv[j] = gg * __builtin_amdgcn_rcpf(1.0f + ee) * fu; } \
            v4u o; o.x = pk2(hv[0], hv[1]); o.y = pk2(hv[2], hv[3]); o.z = pk2(hv[4], hv[5]); o.w = pk2(hv[6], hv[7]); \
            *(v4u*)(h2b + (size_t)row * DFF + ch) = o; } } while (0)
#define FFN_DOWN(layer) do { const bf16* wl = (const bf16*)(ws + WS_WFFN + (size_t)(layer) * 3 * FFN_W_BYTES + 2 * FFN_W_BYTES); \
        pg8::Gemm g{h2b, wl, M, DM, DFF, DFF}; pg8::StaticOrder S; S.init(M, DM, F.G, (int)blockIdx.x); pg8::EpiResidT<(layer) == 0 ? 1 : 2> E{nullptr, out, xb, xl0, xl1, ss, DM}; \
        pg8::gemm_phase<pg8::EpiResidT<(layer) == 0 ? 1 : 2>, pg8::StaticOrder, true, true>(F.lds, g, S, E); } while (0)
    if (IN(7)) RSTD_PHASE();
    SEAM(7);
    if (IN(8)) FFN_GATEUP(0);
    SEAM(8);
    if (IN(9)) FFN_FIX(0);
    SEAM(9);
    if (IN(10)) FFN_DOWN(0);
    SEAM(10);
    if (IN(11)) RSTD_PHASE();
    SEAM(11);
    if (IN(12)) {
        pg8::Gemm g{xb, Wqkv_t, M, 12288, DM, DM}; pg8::StaticOrder S; S.init(M, 12288, F.G, (int)blockIdx.x); pg8::EpiHeadNorm E{qkvb, 12288, rstd, args.in[14], args.in[15], QS_HD, 16, 16, (PG8_LAS float*)(F.lds + NA_TB_OFF), nullptr, nullptr, SEQ};
        pg8::gemm_phase<pg8::EpiHeadNorm, pg8::StaticOrder, true, true>(F.lds, g, S, E);
    }
    SEAM(12);
    if (IN(14)) {
        const float* rpb = args.in[16];
        WAT_LAS char* L = (WAT_LAS char*)F.lds;
        WAT_LAS float* tb = (WAT_LAS float*)(L + NA_TB_OFF);
        const int NU = BATCH * NA_H * GRID_ROWS;
        const int u0 = (int)(((long)NU * blockIdx.x) / F.G), u1 = (int)(((long)NU * (blockIdx.x + 1)) / F.G);
        const int row16 = F.tid >> 4, ch16 = F.tid & 15, kso = wat::kst_off(row16, ch16), vso = wat::vst_off(row16, ch16);
        const int w = F.wave, q = lane & 15, g4 = lane >> 4;
        const int cg = w & 3, kc0 = min(max(16 * cg - 8, 0), 32), gc = 16 * cg + q, cs = min(max(gc - 8, 0), 48);
        unsigned vmask = 0;
#pragma unroll
        for (int j = 0; j < 8; ++j) { const int kc = kc0 + 8 * g4 + j; if (kc >= cs && kc < cs + 16) vmask |= 1u << j; }
        const int bcol = kc0 + 8 * g4 - gc + 15;
        v4u st[8]; int cur_h = -1;
#define NA_GEOM(u_, s_) const int bh_ = (u_) >> 7, i_ = (u_) & 127, b_ = bh_ >> 5, h_ = bh_ & 31, rs_ = min(max(i_ - 4, 0), GRID_ROWS - 8); \
        const bf16* src_ = qkvb + (size_t)(b_ * SEQ + (rs_ + 4 * ((s_) & 1)) * GRID_W + row16) * 12288 + ((s_) < 2 ? 4096 : 8192) + h_ * HD + ch16 * 8;
#define NA_LOAD(u_, s_) do { NA_GEOM(u_, s_) _Pragma("unroll") for (int k = 0; k < 8; ++k) st[k] = *(const v4u*)(src_ + (size_t)k * 32 * 12288); } while (0)
#define NA_WRITE(s_) do { WAT_LAS char* d_ = L + ((s_) & 1) * 65536 + ((s_) < 2 ? kso : vso); _Pragma("unroll") for (int k = 0; k < 8; ++k) *(WAT_LAS v4u*)(d_ + k * 32 * 256) = st[k]; } while (0)
#define NA_END(un_, sn_, un2_, sn2_) do { if ((un_) < u1) { VM_WAIT(); NA_WRITE(sn_); } __syncthreads(); if ((un2_) < u1) NA_LOAD(un2_, sn2_); } while (0)
        if (u0 < u1) { NA_LOAD(u0, 0); VM_WAIT(); NA_WRITE(0); __syncthreads(); NA_LOAD(u0, 1); }
        for (int u = u0; u < u1; ++u) {
            const int bh = u >> 7, gi = u & 127, b = bh >> 5, h = bh & 31, rs0 = min(max(gi - 4, 0), GRID_ROWS - 8);
            wat::bf16x8 qf[4]; wat::f32x4 sc[8][2]; wat::bf16x8 pf[8]; wat::f32x4 o[8]; float linv = 0.f;
            if (h != cur_h) { for (int t = F.tid; t < 465; t += NWAVES * 64) tb[t] = rpb[(size_t)h * 465 + t] * LOG2E; cur_h = h; }
            if (w < 4) {
                const bf16* qp = qkvb + (size_t)(b * SEQ + gi * GRID_W + gc) * 12288 + h * HD + 8 * g4;
#pragma unroll
                for (int s = 0; s < 4; ++s) qf[s] = *(const wat::bf16x8*)(qp + 32 * s);
#pragma unroll
                for (int g = 0; g < 4; ++g) wat::qk_group(sc[g][0], sc[g][1], L, g * 64 + kc0, qf, lane);
            }
            NA_END(u, 1, u, 2);
            if (w < 4) {
#pragma unroll
                for (int g = 0; g < 4; ++g) wat::qk_group(sc[4 + g][0], sc[4 + g][1], L + 65536, g * 64 + kc0, qf, lane);
                float m = -1e30f;
#pragma unroll
                for (int kr = 0; kr < 8; ++kr) { const WAT_LAS float* tr_ = tb + (rs0 + kr - gi + NA_ROWS - 1) * 31 + bcol;
#pragma unroll
                    for (int j = 0; j < 8; ++j) { const bool ok = (vmask >> j) & 1u; const float bias = ok ? tr_[j] : 0.f; const float v = ok ? sc[kr][j >> 2][j & 3] + bias : -1e30f; sc[kr][j >> 2][j & 3] = v; m = fmaxf(m, v); } }
                m = fmaxf(m, __shfl_xor(m, 16)); m = fmaxf(m, __shfl_xor(m, 32));
                float l = 0.f;
#pragma unroll
                for (int kr = 0; kr < 8; ++kr) {
#pragma unroll
                    for (int j = 0; j < 8; ++j) { const float v = ((vmask >> j) & 1u) ? __builtin_amdgcn_exp2f(sc[kr][j >> 2][j & 3] - m) : 0.f; sc[kr][j >> 2][j & 3] = v; l += v; }
                    pf[kr] = wat::p_frag(sc[kr][0], sc[kr][1]); }
                l += __shfl_xor(l, 16); l += __shfl_xor(l, 32); linv = 1.0f / l;
#pragma unroll
                for (int c = 0; c < 8; ++c) o[c] = wat::f32x4{0.f, 0.f, 0.f, 0.f};
            }
            NA_END(u, 2, u, 3);
            if (w < 4) {
                { const unsigned vb = (unsigned)(uintptr_t)L + (unsigned)wat::vrd_base(kc0, lane); wat::pv_group<0>(o, vb, pf[0]); wat::pv_group<16384>(o, vb, pf[1]); wat::pv_group<32768>(o, vb, pf[2]); wat::pv_group<49152>(o, vb, pf[3]); }
            }
            NA_END(u, 3, u + 1, 0);
            if (w < 4) {
                { const unsigned vb = (unsigned)(uintptr_t)(L + 65536) + (unsigned)wat::vrd_base(kc0, lane); wat::pv_group<0>(o, vb, pf[4]); wat::pv_group<16384>(o, vb, pf[5]); wat::pv_group<32768>(o, vb, pf[6]); wat::pv_group<49152>(o, vb, pf[7]); }
                WAT_LAS char* ost = L + NA_OST_OFF + w * 4352;
#pragma unroll
                for (int r = 0; r < 4; ++r) { const float li = __shfl(linv, 4 * g4 + r);
#pragma unroll
                    for (int c = 0; c < 8; ++c) *(WAT_LAS unsigned short*)(ost + (4 * g4 + r) * 272 + (16 * c + q) * 2) = (unsigned short)(wat::cvtpk(o[c][r] * li, 0.f) & 0xffffu); }
                asm volatile("s_waitcnt lgkmcnt(0)" ::: "memory");
#pragma unroll
                for (int k = 0; k < 4; ++k) { const int rq = g4 + 4 * k; const v4u v = *(const WAT_LAS v4u*)(ost + rq * 272 + q * 16);
                    *(v4u*)(ob + (size_t)(b * SEQ + gi * GRID_W + 16 * cg + rq) * DM + h * HD + q * 8) = v; }
            }
            NA_END(u + 1, 0, u + 1, 1);
        }
#undef NA_GEOM
#undef NA_LOAD
#undef NA_WRITE
#undef NA_END
    }
    SEAM(14);
    if (IN(15)) {
        pg8::Gemm g{ob, Woout_t, M, DM, DM, DM}; pg8::StaticOrder S; S.init(M, DM, F.G, (int)blockIdx.x); pg8::EpiResidT<1> E{nullptr, out, xb, xl0, xl1, ss, DM};
        pg8::gemm_phase<pg8::EpiResidT<1>, pg8::StaticOrder, true, true>(F.lds, g, S, E);
    }
    SEAM(15);
    if (IN(16)) RSTD_PHASE();
    SEAM(16);
    if (IN(17)) FFN_GATEUP(1);
    SEAM(17);
    if (IN(18)) FFN_FIX(1);
    SEAM(18);
    if (IN(19)) FFN_DOWN(1);
#undef IN
#undef SEAM
}

#if MK_CHECK
constexpr size_t WS_CHK = 9 * MiB;
constexpr int NS = 32;
__device__ const int g_rows[16] = {0, 1, 63, 64, 65, 127, 128, 4095, 4096, 8190, 8191, 8192, 8193, 8255, 16382, 16383};
__device__ __forceinline__ int srow(int i) { return i < 16 ? g_rows[i] : (int)(((unsigned)i * 2654435761u >> 9) % (unsigned)M); }
__device__ __forceinline__ int scol(int j, int N) { return j == 0 ? 0 : (j == 1 ? N - 1 : (int)(((unsigned)j * 2246822519u + 12345u) % (unsigned)N)); }
__device__ __forceinline__ float bf2f(bf16 b) { return __uint_as_float((unsigned)b << 16); }
__device__ __forceinline__ void chk_rec(unsigned* w, int c, float got, float ref, float scale) {
    float e = fabsf(got - ref) / (0.03f * (fabsf(ref) + scale)); if (!(e == e) || !(e < 1e30f)) e = 1e30f;
    atomicMax(&w[c], __float_as_uint(e));
}
__device__ __forceinline__ float dot_bf(const bf16* a, const bf16* b, int K) { float s = 0.f; for (int k = 0; k < K; ++k) s += bf2f(a[k]) * bf2f(b[k]); return s; }
__global__ void k_chk_gemm(const bf16* A, int lda, const bf16* Bt, int K, int N, const float* rs, const float* base, int base_ld, int base_by_sample,
                           const bf16* got_b, const float* got_f, int ldo, unsigned* w, int c, float scale) {
    const int i = blockIdx.x, j = threadIdx.x, row = srow(i), col = scol(j, N);
    float ref = dot_bf(A + (size_t)row * lda, Bt + (size_t)col * K, K); if (rs) ref *= rs[row];
    if (base) ref += base_by_sample == 2 ? bf2f(((const bf16*)base)[(size_t)i * base_ld + col]) : base[(size_t)(base_by_sample ? i : row) * base_ld + col];
    const float got = got_b ? bf2f(got_b[(size_t)row * ldo + col]) : got_f[(size_t)row * ldo + col];
    chk_rec(w, c, got, ref, scale);
}
__global__ void k_chk_copy(const unsigned char* src, size_t row_bytes, unsigned char* dst) {
    const int i = blockIdx.x, row = srow(i); for (size_t b = threadIdx.x * 4; b < row_bytes; b += blockDim.x * 4) *(unsigned*)(dst + (size_t)i * row_bytes + b) = *(const unsigned*)(src + (size_t)row * row_bytes + b);
}
__global__ void k_chk_rstd(const float* src, const float* rstd, const bf16* xb, unsigned* w, int c) {
    const int i = blockIdx.x * blockDim.x + threadIdx.x; if (i >= NS) return; const int row = srow(i); float s = 0.f;
    for (int k = 0; k < DM; ++k) { const float v = src[(size_t)row * DM + k]; s += v * v; }
    chk_rec(w, c, rstd[row], 1.0f / sqrtf(s / DM + NORM_EPS), 0.f);
    if (xb) for (int k = 0; k < DM; k += 97) chk_rec(w, c, bf2f(xb[(size_t)row * DM + k]), src[(size_t)row * DM + k], 0.01f);
}
__global__ void k_chk_w(const float* W, int K, int N, const bf16* dst, const float* gain, int mode, unsigned* w, int c) {
    const unsigned t = blockIdx.x * blockDim.x + threadIdx.x; const int k = (int)((t * 2654435761u >> 7) % (unsigned)K), n = scol((int)t, N);
    const int dr = (mode == 1) ? (n >= 1472 ? n - 1472 : n + 9216) : (mode >= 2 ? (n >> 7) * 256 + (n & 127) + (mode == 3 ? 128 : 0) : n); float ref = W[(size_t)k * N + n]; if (gain) ref *= gain[k];
    chk_rec(w, c, bf2f(dst[(size_t)dr * K + k]), ref, 1e-4f);
}
__global__ void k_chk_rope(const float* cosT, const float* sinT, int half, double c1, unsigned* w, int c) {
    const int t = blockIdx.x * blockDim.x + threadIdx.x; const int k = t % half; int pos = 1 + (int)(((unsigned)t * 2654435761u >> 8) % (unsigned)(SEQ - 1));
    double p = 1.0; for (int j = 0; j < k; ++j) p *= c1; const double th = (double)(float)p;
    double sn = 0, cs = 0, term = 1.0; for (int n = 0; n < 24; ++n) { if (n & 1) sn += ((n >> 1) & 1 ? -term : term); else cs += ((n >> 1) & 1 ? -term : term); term *= th / (n + 1); }
    chk_rec(w, c, cosT[1 * half + k], (float)cs, 0.02f); chk_rec(w, c, sinT[1 * half + k], (float)sn, 0.02f);
    chk_rec(w, c, cosT[k], 1.f, 0.02f); chk_rec(w, c, sinT[k], 0.f, 0.02f);
    const float ca = cosT[(pos - 1) * half + k], sa = sinT[(pos - 1) * half + k], c1f = cosT[half + k], s1f = sinT[half + k];
    chk_rec(w, c, cosT[pos * half + k], ca * c1f - sa * s1f, 0.03f); chk_rec(w, c, sinT[pos * half + k], sa * c1f + ca * s1f, 0.03f);
}
__global__ void k_chk_p2(const bf16* zc, const bf16* z, const bf16* cqn, const bf16* ckvn, const float* dqn, const float* dkn, const float* cosA, const float* sinA, unsigned* w, int c) {
    const int i = blockIdx.x, t = threadIdx.x, row = srow(i), pos = row & (SEQ - 1); const bf16* src = zc + (size_t)i * ZLD;
    if (false) { const bf16* p = src + t * HD; float s = 0.f; for (int d = 0; d < HD; ++d) s += bf2f(p[d]) * bf2f(p[d]);
        const float rs = 1.0f / sqrtf(s / HD + NORM_EPS); const float* g = t < 24 ? dqn : dkn; const float qs = t < 24 ? QS_HD : 1.f;
        for (int d = 0; d < HD; ++d) { float y = bf2f(p[d]) * rs * g[d];
            if (d < 16) y = y * cosA[pos * 16 + d] - bf2f(p[d + 16]) * rs * g[d + 16] * sinA[pos * 16 + d];
            else if (d < 32) y = y * cosA[pos * 16 + d - 16] + bf2f(p[d - 16]) * rs * g[d - 16] * sinA[pos * 16 + d - 16];
            chk_rec(w, c, bf2f(z[(size_t)row * ZLD + t * HD + d]), y * qs, 0.05f * qs); } }
    else if (t == 48) { float s = 0.f; for (int d = 0; d < QRANK; ++d) s += bf2f(src[Z_CQ + d]) * bf2f(src[Z_CQ + d]); const float rs = 1.0f / sqrtf(s / QRANK + NORM_EPS);
        for (int d = 0; d < QRANK; ++d) chk_rec(w, c, bf2f(cqn[(size_t)row * QRANK + d]), bf2f(src[Z_CQ + d]) * rs, 0.05f); }
    else if (t == 49) { float s = 0.f; for (int d = 0; d < KVRANK; ++d) s += bf2f(src[Z_CKV + d]) * bf2f(src[Z_CKV + d]); const float rs = 1.0f / sqrtf(s / KVRANK + NORM_EPS);
        for (int d = 0; d < KVRANK; ++d) chk_rec(w, c, bf2f(ckvn[(size_t)row * KVRANK + d]), bf2f(src[Z_CKV + d]) * rs, 0.05f); }
}
__global__ void k_chk_p4(const bf16* qc, const bf16* q, const bf16* kv, const bf16* z, const bf16* kout, const float* qn, const float* kn, const float* cosB, const float* sinB, unsigned* w, int c) {
    const int i = blockIdx.x, t = threadIdx.x, row = srow(i), pos = row & (SEQ - 1), h = t & 15; const bool isk = t >= 16;
    float s = 0.f;
    for (int d = 0; d < MLA_QK; ++d) { const float v = isk ? (d < 128 ? bf2f(kv[(size_t)row * 4096 + h * 256 + d]) : bf2f(z[(size_t)row * ZLD + Z_KPE + d - 128])) : bf2f(qc[(size_t)i * 3072 + h * MLA_QK + d]); s += v * v; }
    const float rs = 1.0f / sqrtf(s / MLA_QK + NORM_EPS); const float* g = isk ? kn : qn; const float qs = isk ? 1.f : QS_MLA;
    for (int d = 0; d < MLA_QK; ++d) {
        auto val = [&](int dd) { return (isk ? (dd < 128 ? bf2f(kv[(size_t)row * 4096 + h * 256 + dd]) : bf2f(z[(size_t)row * ZLD + Z_KPE + dd - 128])) : bf2f(qc[(size_t)i * 3072 + h * MLA_QK + dd])) * rs * g[dd]; };
        float y = val(d);
        if (d >= 128 && d < 160) y = y * cosB[pos * 32 + d - 128] - val(d + 32) * sinB[pos * 32 + d - 128];
        else if (d >= 160) y = y * cosB[pos * 32 + d - 160] + val(d - 32) * sinB[pos * 32 + d - 160];
        const float got = isk ? bf2f(kout[(size_t)row * 3072 + h * MLA_QK + d]) : bf2f(q[(size_t)row * 3072 + h * MLA_QK + d]);
        chk_rec(w, c, got, y * qs, 0.05f * qs); }
}
__global__ void k_chk_mla(const bf16* q, const bf16* k, const bf16* kv, const bf16* omix, unsigned* w, int c) {
    const int i = blockIdx.x, t = threadIdx.x, row = srow(i), b0 = row & ~(SEQ - 1), h = (i * 7 + 3) & 15, d = (t * 37 + i) & 127;
    const bf16* qp = q + (size_t)row * 3072 + h * MLA_QK; float m = -1e30f;
    for (int key = 0; key < SEQ; ++key) m = fmaxf(m, dot_bf(qp, k + (size_t)(b0 + key) * 3072 + h * MLA_QK, MLA_QK));
    float l = 0.f, o = 0.f, o2 = 0.f;
    for (int key = 0; key < SEQ; ++key) { const float p = exp2f(dot_bf(qp, k + (size_t)(b0 + key) * 3072 + h * MLA_QK, MLA_QK) - m); const float v = bf2f(kv[(size_t)(b0 + key) * 4096 + h * 256 + 128 + d]); l += p; o += p * v; o2 += p * v * v; }
    chk_rec(w, c, bf2f(omix[(size_t)row * 3072 + h * HD + d]), o / l, 0.5f * sqrtf(o2 / l) * 0.1f + 1e-3f);
}
__global__ void k_chk_dil(const bf16* z, const bf16* omix, unsigned* w, int c) {
    const int i = blockIdx.x, t = threadIdx.x, row = srow(i), b0 = row & ~(SEQ - 1), pos = row & (SEQ - 1), j = (i * 5 + 1) & 7, d = (t * 37 + i) & 127;
    float m = -1e30f;
    for (int g = 0; g < 3; ++g) { const int dl = 1 << (2 * g), head = 8 * g + j; for (int tt = -64; tt <= 64; ++tt) { const int kp = pos + dl * tt; if (kp < 0 || kp >= SEQ) continue;
        m = fmaxf(m, dot_bf(z + (size_t)row * ZLD + head * HD, z + (size_t)(b0 + kp) * ZLD + 3072 + head * HD, HD)); } }
    float l = 0.f, o = 0.f;
    for (int g = 0; g < 3; ++g) { const int dl = 1 << (2 * g), head = 8 * g + j; for (int tt = -64; tt <= 64; ++tt) { const int kp = pos + dl * tt; if (kp < 0 || kp >= SEQ) continue;
        const float p = exp2f(dot_bf(z + (size_t)row * ZLD + head * HD, z + (size_t)(b0 + kp) * ZLD + 3072 + head * HD, HD) - m); l += p; o += p * bf2f(z[(size_t)(b0 + kp) * ZLD + 6144 + head * HD + d]); } }
    chk_rec(w, c, bf2f(omix[(size_t)row * 3072 + 2048 + j * HD + d]), o / l, 0.02f);
}
__global__ void k_chk_na(const bf16* qkv, const float* rpb, const bf16* ob, unsigned* w, int c) {
    const int i = blockIdx.x, t = threadIdx.x, row = srow(i), b0 = row & ~(SEQ - 1), pos = row & (SEQ - 1), gi = pos >> 6, gc = pos & 63, h = (i * 11 + 5) & 31, d = (t * 37 + i) & 127;
    const int rs0 = min(max(gi - 4, 0), GRID_ROWS - 8), cs0 = min(max(gc - 8, 0), 48); float m = -1e30f;
    for (int kr = 0; kr < 8; ++kr) for (int kc = 0; kc < 16; ++kc) { const int key = b0 + (rs0 + kr) * 64 + cs0 + kc;
        m = fmaxf(m, dot_bf(qkv + (size_t)row * 12288 + h * HD, qkv + (size_t)key * 12288 + 4096 + h * HD, HD) + rpb[(size_t)h * 465 + (rs0 + kr - gi + 7) * 31 + (cs0 + kc - gc + 15)] * LOG2E); }
    float l = 0.f, o = 0.f;
    for (int kr = 0; kr < 8; ++kr) for (int kc = 0; kc < 16; ++kc) { const int key = b0 + (rs0 + kr) * 64 + cs0 + kc;
        const float p = exp2f(dot_bf(qkv + (size_t)row * 12288 + h * HD, qkv + (size_t)key * 12288 + 4096 + h * HD, HD) + rpb[(size_t)h * 465 + (rs0 + kr - gi + 7) * 31 + (cs0 + kc - gc + 15)] * LOG2E - m);
        l += p; o += p * bf2f(qkv[(size_t)key * 12288 + 8192 + h * HD + d]); }
    chk_rec(w, c, bf2f(ob[(size_t)row * DM + h * HD + d]), o / l, 0.03f);
}
__global__ void k_chk_p13(const bf16* qc, const bf16* qkv, const float* qn, const float* kn, unsigned* w, int c) {
    const int i = blockIdx.x, t = threadIdx.x, row = srow(i); const bf16* p = qc + (size_t)i * 12288 + t * HD; float s = 0.f;
    for (int d = 0; d < HD; ++d) s += bf2f(p[d]) * bf2f(p[d]);
    const float rs = 1.0f / sqrtf(s / HD + NORM_EPS); const float* g = t < 32 ? qn : kn; const float qs = t < 32 ? QS_HD : 1.f;
    for (int d = 0; d < HD; ++d) chk_rec(w, c, bf2f(qkv[(size_t)row * 12288 + t * HD + d]), bf2f(p[d]) * rs * g[d] * qs, 0.05f * qs);
}
__global__ void k_chk_qkvn(const bf16* xb, const bf16* Wt, const float* rstd, const bf16* qkv, const float* qn, const float* kn, unsigned* w, int c) {
    const int i = blockIdx.x, t = threadIdx.x, row = srow(i), head = (t * 7 + i) % 96, d = (t * 37 + i * 5) & 127; float s = 0.f, mine = 0.f;
    for (int dd = 0; dd < HD; ++dd) { const float v = dot_bf(xb + (size_t)row * DM, Wt + (size_t)(head * HD + dd) * DM, DM) * rstd[row]; s += v * v; if (dd == d) mine = v; }
    float ref = mine; if (head < 64) { const float rs = 1.0f / sqrtf(s / HD + NORM_EPS); ref = mine * rs * (head < 32 ? qn[d] * QS_HD : kn[d]); }
    chk_rec(w, c, bf2f(qkv[(size_t)row * 12288 + head * HD + d]), ref, head < 32 ? 0.05f * QS_HD : 0.05f);
}
__global__ void k_chk_zn(const bf16* xb, const bf16* Wt, const float* rstd, const bf16* z, const float* dqn, const float* dkn, const float* cosA, const float* sinA, unsigned* w, int c) {
    const int i = blockIdx.x, t = threadIdx.x, row = srow(i), pos = row & (SEQ - 1);
    if (t < 48) { const int d = (t * 37 + i * 5) & 127; const int dp = d < 16 ? d + 16 : (d < 32 ? d - 16 : d); float s = 0.f, mine = 0.f, other = 0.f;
        for (int dd = 0; dd < HD; ++dd) { const float v = dot_bf(xb + (size_t)row * DM, Wt + (size_t)(t * HD + dd) * DM, DM) * rstd[row]; s += v * v; if (dd == d) mine = v; if (dd == dp) other = v; }
        const float rs = 1.0f / sqrtf(s / HD + NORM_EPS); const float* g = t < 24 ? dqn : dkn; const float qs = t < 24 ? QS_HD : 1.f;
        float y = mine * rs * g[d]; const float yo = other * rs * g[dp];
        if (d < 16) y = y * cosA[pos * 16 + d] - yo * sinA[pos * 16 + d]; else if (d < 32) y = y * cosA[pos * 16 + d - 16] + yo * sinA[pos * 16 + d - 16];
        chk_rec(w, c, bf2f(z[(size_t)row * ZLD + t * HD + d]), y * qs, 0.05f * qs); }
    else { const int col = 6144 + scol(t, 10688 - 6144); const float ref = dot_bf(xb + (size_t)row * DM, Wt + (size_t)col * DM, DM) * rstd[row]; chk_rec(w, c, bf2f(z[(size_t)row * ZLD + col]), ref, 0.05f); }
}
__global__ void k_chk_up(const bf16* xb, const bf16* Wgu, const float* rstd, const float* cw, const float* cb, const bf16* h2, unsigned* w, int c) {
    const int i = blockIdx.x, j = threadIdx.x, col = scol(j, DFF); int row = srow(i); if (i & 1) row = (row & ~255) + ((i & 2) ? 255 : 0) + ((i & 4) ? ((i & 2) ? -1 : 1) : 0);
    const int cls = i < 16 ? 42 + i : 58 + (i & 1);
    const int t = row & (SEQ - 1); const bf16* wg = Wgu + (size_t)((col >> 7) * 256 + (col & 127)) * DM; const bf16* wu = wg + (size_t)128 * DM;
    const bool edge = (row & 255) == 0 || (row & 255) == 255;
    auto rd = [&](float v) { return edge ? __uint_as_float(f2bf(v) << 16) : v; };
    const float up = rd(dot_bf(xb + (size_t)row * DM, wu, DM) * rstd[row]);
    float g = cb[col] + cw[DFF + col] * rd(dot_bf(xb + (size_t)row * DM, wg, DM) * rstd[row]);
    if (t > 0) g += cw[col] * rd(dot_bf(xb + (size_t)(row - 1) * DM, wg, DM) * rstd[row - 1]); if (t < SEQ - 1) g += cw[2 * DFF + col] * rd(dot_bf(xb + (size_t)(row + 1) * DM, wg, DM) * rstd[row + 1]);
    const float ref = g / (1.0f + expf(-g)) * up;
    chk_rec(w, cls, bf2f(h2[(size_t)row * DFF + col]), ref, 0.05f);
}
__global__ void k_chk_rq(const bf16* z, const float* rq, const float* rkv, unsigned* w, int c) {
    const int i = blockIdx.x * blockDim.x + threadIdx.x; if (i >= NS) return; const int row = srow(i); const bf16* src = z + (size_t)row * ZLD; float s = 0.f, t = 0.f;
    for (int d = 0; d < QRANK; ++d) s += bf2f(src[Z_CQ + d]) * bf2f(src[Z_CQ + d]);
    for (int d = 0; d < KVRANK; ++d) t += bf2f(src[Z_CKV + d]) * bf2f(src[Z_CKV + d]);
    chk_rec(w, c, rq[row], 1.0f / sqrtf(s / QRANK + NORM_EPS), 0.f); chk_rec(w, c, rkv[row], 1.0f / sqrtf(t / KVRANK + NORM_EPS), 0.f);
}
__global__ void k_chk_final(unsigned* w, float* out) {
    if (threadIdx.x != 0 || blockIdx.x != 0) return;
    for (int c = 0; c < 64; ++c) { const float e = __uint_as_float(w[c]); if (e > 1.0f) { int b = 0; float x = e; while (x >= 10.f && b < 20) { x *= 0.1f; ++b; } float V = (float)(10 + c) * 100.f; for (int q = 0; q < b; ++q) V *= 10.f; out[0] = V; return; } }
}
#endif
#ifndef MK_ONE_LAUNCH
#define MK_ONE_LAUNCH 1
#endif
extern "C" void kernel_launch(void* const* d_in, const int* in_sizes, int n_in, void* d_out, int out_size, void* d_ws, size_t ws_size, hipStream_t stream) {
    static int grid = 0;
    if (grid == 0) {
        const long long want[24] = {(long long)M * DM, DM, (long long)DM * EVEN_IN, QRANK, KVRANK, (long long)QRANK * 3072, (long long)KVRANK * 4096, MLA_QK, MLA_QK, HD, HD, (long long)EVEN_MIX * DM,
                                    DM, (long long)DM * 12288, HD, HD, (long long)NA_H * 15 * 31, (long long)DM * DM, 2 * DM, 2LL * DM * DFF, 2LL * DM * DFF, 2 * 3 * DFF, 2 * DFF, 2LL * DFF * DM};
        bool sizes_ok = n_in == 24; for (int i = 0; sizes_ok && i < 24; ++i) if ((long long)in_sizes[i] != want[i]) { fprintf(stderr, "kernel_launch: input %d has %d elements, expected %lld\n", i, in_sizes[i], want[i]); sizes_ok = false; }
        if (!sizes_ok || out_size != M * DM || ws_size < WS_END) { fprintf(stderr, "kernel_launch: unexpected shapes: n_in %d in0 %d out %d ws %zu (need %zu)\n", n_in, n_in > 0 ? in_sizes[0] : -1, out_size, ws_size, (size_t)WS_END); grid = -1; return; }
        int dev = 0, cus = 0, per_cu = 0;
        if (hipGetDevice(&dev) != hipSuccess || hipDeviceGetAttribute(&cus, hipDeviceAttributeMultiprocessorCount, dev) != hipSuccess) { grid = -1; return; }
        if (hipFuncSetAttribute((const void*)mk_fwd, hipFuncAttributeMaxDynamicSharedMemorySize, LDS_BYTES) != hipSuccess) { fprintf(stderr, "kernel_launch: hipFuncSetAttribute failed\n"); grid = -1; return; }
        if (hipOccupancyMaxActiveBlocksPerMultiprocessor(&per_cu, (const void*)mk_fwd, NWAVES * 64, LDS_BYTES) != hipSuccess || per_cu < 1) fprintf(stderr, "kernel_launch: occupancy query reports %d\n", per_cu);
        (void)hipGetLastError();
        grid = cus;
    }
    if (grid < 0) return;
    if (hipMemsetAsync((char*)d_ws + WS_CTL, 0, CTL_ZERO_BYTES, stream) != hipSuccess) return;
    Args a{};
    for (int i = 0; i < 24; ++i) a.in[i] = (const float*)d_in[i];
    a.out = (float*)d_out; a.ws = (unsigned char*)d_ws;
#if MK_ONE_LAUNCH
    a.ph_lo = 0; a.ph_hi = N_PHASES;
    hipLaunchKernelGGL(mk_fwd, dim3(grid), dim3(NWAVES * 64), LDS_BYTES, stream, a);
#else
#if MK_CHECK
    unsigned char* ws = (unsigned char*)d_ws; unsigned* cw = (unsigned*)(ws + WS_CHK); (void)hipMemsetAsync(cw, 0, 256, stream);
    bf16* cp_z = (bf16*)(ws + WS_CHK + 1 * MiB); bf16* cp_q = (bf16*)(ws + WS_CHK + 2 * MiB); float* cp_out = (float*)(ws + WS_CHK + 3 * MiB); bf16* cp_qkv = (bf16*)(ws + WS_CHK + 4 * MiB);
    float* cosA = (float*)(ws + WS_ROPE); float* sinA = cosA + SEQ * 16; float* cosB = sinA + SEQ * 16; float* sinB = cosB + SEQ * 32;
    float* rstd = (float*)(ws + WS_RSTD); bf16* xb = (bf16*)(ws + WS_XB); unsigned char* R = ws + WS_R;
    bf16* zb = (bf16*)(R + R_Z); bf16* qb = (bf16*)(R + R_Q); bf16* kvb = (bf16*)(R + R_KV); bf16* kb = (bf16*)(R + R_K); bf16* omix = (bf16*)(R + R_OMIX);
    bf16* cqn = (bf16*)(R + R_CQN); bf16* ckvn = (bf16*)(R + R_CKVN); bf16* h2b = (bf16*)(R + R_H2); bf16* qkvb = (bf16*)(R + R_QKV); bf16* ob = (bf16*)(R + R_O);
    bf16* Win_t = (bf16*)(ws + WS_WIN); bf16* Wuq_t = (bf16*)(ws + WS_WUQ); bf16* Wukv_t = (bf16*)(ws + WS_WUKV); bf16* Weout_t = (bf16*)(ws + WS_WEOUT); bf16* Wqkv_t = (bf16*)(ws + WS_WQKV); bf16* Woout_t = (bf16*)(ws + WS_WOOUT);
    float* out = (float*)d_out; const float* const* in = a.in;
    auto WL = [&](int layer, int which) { return (bf16*)(ws + WS_WFFN + (size_t)layer * 3 * FFN_W_BYTES + (size_t)which * FFN_W_BYTES); };
#endif
    for (int p = 0; p < N_PHASES; ++p) {
#if MK_CHECK
        if (p == 2) k_chk_copy<<<NS, 256, 0, stream>>>((const unsigned char*)zb, (size_t)ZLD * 2, (unsigned char*)cp_z);
        if (p == 4) k_chk_copy<<<NS, 256, 0, stream>>>((const unsigned char*)qb, (size_t)3072 * 2, (unsigned char*)cp_q);
        if (p == 10 || p == 15 || p == 19) k_chk_copy<<<NS, 256, 0, stream>>>((const unsigned char*)xb, (size_t)DM * 2, (unsigned char*)cp_out);
#endif
        a.ph_lo = p; a.ph_hi = p + 1; hipLaunchKernelGGL(mk_fwd, dim3(grid), dim3(NWAVES * 64), LDS_BYTES, stream, a);
#if MK_CHECK
        const int c = 2 * p;
        if (p == 0) {
            k_chk_w<<<4, 64, 0, stream>>>(in[2], DM, EVEN_IN, Win_t, in[1], 1, cw, c); k_chk_w<<<4, 64, 0, stream>>>(in[5], QRANK, 3072, Wuq_t, in[3], 0, cw, c); k_chk_w<<<4, 64, 0, stream>>>(in[6], KVRANK, 4096, Wukv_t, in[4], 0, cw, c);
            k_chk_w<<<4, 64, 0, stream>>>(in[11], EVEN_MIX, DM, Weout_t, nullptr, 0, cw, c); k_chk_w<<<4, 64, 0, stream>>>(in[13], DM, 12288, Wqkv_t, in[12], 0, cw, c); k_chk_w<<<4, 64, 0, stream>>>(in[17], DM, DM, Woout_t, nullptr, 0, cw, c);
            for (int l = 0; l < 2; ++l) { k_chk_w<<<4, 64, 0, stream>>>(in[19] + (size_t)l * DM * DFF, DM, DFF, WL(l, 0), in[18] + l * DM, 2, cw, c); k_chk_w<<<4, 64, 0, stream>>>(in[20] + (size_t)l * DM * DFF, DM, DFF, WL(l, 0), in[18] + l * DM, 3, cw, c);
                k_chk_w<<<4, 64, 0, stream>>>(in[23] + (size_t)l * DFF * DM, DFF, DM, WL(l, 2), nullptr, 0, cw, c); }
            k_chk_rstd<<<1, 64, 0, stream>>>(in[0], rstd, xb, cw, c + 1);
            k_chk_rope<<<8, 64, 0, stream>>>(cosA, sinA, 16, 0.44036660267178046, cw, 40); k_chk_rope<<<8, 64, 0, stream>>>(cosB, sinB, 32, 0.6636012376960885, cw, 41);
        }
        if (p == 1) k_chk_zn<<<NS, 64, 0, stream>>>(xb, Win_t, rstd, zb, in[9], in[10], cosA, sinA, cw, c);
        if (p == 3) { k_chk_rq<<<1, 64, 0, stream>>>(zb, rstd + M, rstd + 2 * M, cw, 4);
                      k_chk_gemm<<<NS, 64, 0, stream>>>(zb + Z_CQ, ZLD, Wuq_t, QRANK, 3072, rstd + M, nullptr, 0, 0, qb, nullptr, 3072, cw, c, 0.05f);
                      k_chk_gemm<<<NS, 64, 0, stream>>>(zb + Z_CKV, ZLD, Wukv_t, KVRANK, 4096, rstd + 2 * M, nullptr, 0, 0, kvb, nullptr, 4096, cw, c + 1, 0.05f); }
        if (p == 4) k_chk_p4<<<NS, 32, 0, stream>>>(cp_q, qb, kvb, zb, kb, in[7], in[8], cosB, sinB, cw, c);
        if (p == 5) { k_chk_mla<<<NS, 8, 0, stream>>>(qb, kb, kvb, omix, cw, c); k_chk_dil<<<NS, 8, 0, stream>>>(zb, omix, cw, c + 1); }
        if (p == 6) k_chk_gemm<<<NS, 64, 0, stream>>>(omix, EVEN_MIX, Weout_t, EVEN_MIX, DM, nullptr, in[0], DM, 0, nullptr, out, DM, cw, c, 0.05f);
        if (p == 7 || p == 11 || p == 16) k_chk_rstd<<<1, 64, 0, stream>>>(out, rstd, xb, cw, c);
        if (p == 9 || p == 18) { const int l = p == 9 ? 0 : 1; k_chk_up<<<NS, 64, 0, stream>>>(xb, WL(l, 0), rstd, in[21] + (size_t)l * 3 * DFF, in[22] + (size_t)l * DFF, h2b, cw, c); }
        if (p == 10 || p == 19) k_chk_gemm<<<NS, 64, 0, stream>>>(h2b, DFF, WL(p == 10 ? 0 : 1, 2), DFF, DM, nullptr, cp_out, DM, 2, nullptr, out, DM, cw, c, 0.05f);
        if (p == 12) k_chk_qkvn<<<NS, 64, 0, stream>>>(xb, Wqkv_t, rstd, qkvb, in[14], in[15], cw, c);
        if (p == 14) k_chk_na<<<NS, 8, 0, stream>>>(qkvb, in[16], ob, cw, c);
        if (p == 15) k_chk_gemm<<<NS, 64, 0, stream>>>(ob, DM, Woout_t, DM, DM, nullptr, cp_out, DM, 2, nullptr, out, DM, cw, c, 0.05f);
#endif
    }
#if MK_CHECK
    k_chk_final<<<1, 64, 0, stream>>>(cw, out);
#endif
#endif
    const hipError_t le = hipPeekAtLastError();
    if (le != hipSuccess) fprintf(stderr, "kernel_launch: launch failed: %s\n", hipGetErrorName(le));
}
```

```cpp
#include <hip/hip_runtime.h>
#include <cstdio>
#include <cstdint>
#ifndef MK_CHECK
#define MK_CHECK 0
#endif
namespace pg8 {
#define PG8_LAS __attribute__((address_space(3)))
typedef unsigned short bf16_t;
typedef short bf16x8 __attribute__((ext_vector_type(8)));
typedef float f32x4 __attribute__((ext_vector_type(4)));
typedef unsigned u32x4 __attribute__((ext_vector_type(4)));
typedef unsigned u32x2 __attribute__((ext_vector_type(2)));
constexpr int BM = 256, BK = 64, HALF = 128, HTB = HALF * BK * 2  , STAGE_BYTES = 8 * HTB, NXCD = 8, WGM = 8;

__host__ __device__ __forceinline__ int lds_byte(int r, int c) { const int st = (r >> 4) * 2 + (c >> 5), rr = r & 15, cc = c & 31, ob = rr * 64 + cc * 2; return st * 1024 + (ob ^ (((ob >> 9) & 1) << 5)); }
__host__ __device__ __forceinline__ void stage_rc(int b, int& R, int& C) { const int st = b / 1024, sb = b % 1024, swz = sb ^ (((sb >> 9) & 1) << 5); R = (st >> 1) * 16 + swz / 64; C = (st & 1) * 32 + (swz % 64) / 2; }
__host__ __device__ __forceinline__ int perm32(int rho) { const int n = rho >> 4, i = rho & 15; return 8 * (i >> 2) + 4 * n + (i & 3); }

struct Unit { int pm, pn, kb, kn, role, slot; };
struct Gemm { const bf16_t* A; const bf16_t* Bt; int M, N, K, lda; };

struct StaticOrder {
    int nM, nN, nwg, G, c, ntk; float* scr; unsigned* flg;
    __host__ __device__ void init(int M, int N, int G_, int c_, int ntk_ = 0, float* scr_ = nullptr, unsigned* flg_ = nullptr) { nM = M / BM; nN = N / BM; nwg = nM * nN; G = G_; c = c_; ntk = ntk_; scr = scr_; flg = flg_; }
    __host__ __device__ bool next(int i, Unit& u) const {
        long L = (long)i * G + c; u.kb = 0; u.kn = ntk; u.role = 0; u.slot = 0;
        if (scr != nullptr) { const int full = nwg / G, rem = nwg - full * G;
            if (rem > 0 && 2 * rem <= G && i == full) {
                if (c < rem) { u.role = 1; u.kn = ntk / 2; u.slot = c; }
                else if (c < 2 * rem) { L -= rem; u.role = 2; u.kb = ntk / 2; u.kn = ntk - ntk / 2; u.slot = c - rem; }
                else return false; } }
        if (L >= nwg) return false;
        int wgid = (int)L; { const int q = nwg / NXCD, r = nwg % NXCD, xcd = wgid % NXCD, off = wgid / NXCD; wgid = (xcd < r ? xcd * (q + 1) : r * (q + 1) + (xcd - r) * q) + off; }
        const int nig = WGM * nN, gid = wgid / nig, fm = gid * WGM, gsz = (nM - fm) < WGM ? (nM - fm) : WGM;
        u.pm = fm + ((wgid % nig) % gsz); u.pn = (wgid % nig) / gsz; return true;
    }
    __device__ __forceinline__ void a_ready(const Unit&) const {}
    __device__ __forceinline__ void done(const Unit&) const {}
};

__device__ __forceinline__ unsigned cvt_pk_bf16(float lo, float hi) { unsigned r; asm volatile("v_cvt_pk_bf16_f32 %0, %1, %2" : "=v"(r) : "v"(lo), "v"(hi)); return r; }
__device__ __forceinline__ float bf_lo(unsigned w) { return __uint_as_float(w << 16); }
__device__ __forceinline__ float bf_hi(unsigned w) { return __uint_as_float(w & 0xffff0000u); }

struct EpiScaleBf16 {
    static constexpr bool PERM = true, AFTER_DRAIN = false;
    bf16_t* O; int ldc; const float* rstd;
    __device__ __forceinline__ void operator()(const f32x4 (&acc)[2][2][4][2], const Unit& u, int wr, int wc, int fr, int fq) const {
        const int row0 = u.pm * BM + wr * 64 + fr, col0 = u.pn * BM + wc * 32 + 8 * fq;
#pragma unroll
        for (int ai = 0; ai < 2; ++ai)
#pragma unroll
            for (int m = 0; m < 4; ++m) { const int row = row0 + ai * HALF + m * 16; const float s = rstd ? rstd[row] : 1.f; bf16_t* rowp = O + (size_t)row * ldc + col0;
#pragma unroll
                for (int bj = 0; bj < 2; ++bj) { const f32x4 v0 = acc[ai][bj][m][0] * s, v1 = acc[ai][bj][m][1] * s;
                    u32x4 w; w.x = cvt_pk_bf16(v0[0], v0[1]); w.y = cvt_pk_bf16(v0[2], v0[3]); w.z = cvt_pk_bf16(v1[0], v1[1]); w.w = cvt_pk_bf16(v1[2], v1[3]);
                    *(u32x4*)(rowp + bj * HALF) = w; } }
    }
};
struct EpiHeadNorm {
    static constexpr bool PERM = true, AFTER_DRAIN = false;
    bf16_t* O; int ldc; const float* rstd; const float* qn; const float* kn; float qscale; int ntq, ntk; PG8_LAS float* ex;
    const float* rcos; const float* rsin; int seq;
    float* ssq = nullptr;
    template <int AI, int MM, int BJ> __device__ __forceinline__ void put(unsigned wb, float s) const { asm volatile("ds_write_b32 %0, %1 offset:%2" :: "v"(wb), "v"(s), "i"((AI * 1024 + MM * 128 + BJ * 4) * 4) : "memory"); }
    template <int AI, int MM, int BJ> __device__ __forceinline__ f32x4 get(unsigned rb) const { f32x4 p; asm volatile("ds_read_b128 %0, %1 offset:%2" : "=&v"(p) : "v"(rb), "i"((AI * 1024 + MM * 128 + BJ * 4) * 4) : "memory"); return p; }
    template <int AI, int MM> __device__ __forceinline__ void part(const f32x4 (&acc)[2][2][4][2], unsigned wb, int fq) const {
#pragma unroll
        for (int bj = 0; bj < 2; ++bj) { const f32x4 v0 = acc[AI][bj][MM][0], v1 = acc[AI][bj][MM][1];
            float s = (v0[0] * v0[0] + v0[1] * v0[1]) + (v0[2] * v0[2] + v0[3] * v0[3]) + (v1[0] * v1[0] + v1[1] * v1[1]) + (v1[2] * v1[2] + v1[3] * v1[3]);
            s += __shfl_xor(s, 16); s += __shfl_xor(s, 32);
            if (fq == 0) { if (bj == 0) put<AI, MM, 0>(wb, s); else put<AI, MM, 1>(wb, s); } }
    }
    template <int AI, int MM> __device__ __forceinline__ void fin(const f32x4 (&acc)[2][2][4][2], unsigned rb, int row, int col0, const float* gp, float gs, int wc, int fq) const {
        bf16_t* rowp = O + (size_t)row * ldc + col0; const float rsv = rstd[row], r2 = rsv * rsv;
        const f32x4 g0 = *(const f32x4*)gp * gs, g1 = *(const f32x4*)(gp + 4) * gs;
        const f32x4 pa = get<AI, MM, 0>(rb), pb = get<AI, MM, 1>(rb);
        asm volatile("s_waitcnt lgkmcnt(0)" ::: "memory"); __builtin_amdgcn_sched_barrier(0);
#pragma unroll
        for (int bj = 0; bj < 2; ++bj) { const f32x4 p = bj ? pb : pa;
            const float tot = ((p[0] + p[1]) + (p[2] + p[3])) * r2;
            const float hn = rsv / sqrtf(tot * (1.0f / 128.0f) + 1e-6f);
            f32x4 v0 = acc[AI][bj][MM][0] * hn * g0, v1 = acc[AI][bj][MM][1] * hn * g1;
            if (rcos != nullptr && wc == 0) {
                const int pos = row & (seq - 1); const float* cp = rcos + pos * 16 + 8 * (fq & 1); const float* sp = rsin + pos * 16 + 8 * (fq & 1);
                const f32x4 c0 = *(const f32x4*)cp, c1 = *(const f32x4*)(cp + 4); f32x4 s0 = *(const f32x4*)sp, s1 = *(const f32x4*)(sp + 4);
                if (fq < 2) { s0 = -s0; s1 = -s1; }
                f32x4 p0, p1;
#pragma unroll
                for (int e = 0; e < 4; ++e) { p0[e] = __shfl_xor(v0[e], 32); p1[e] = __shfl_xor(v1[e], 32); }
                v0 = v0 * c0 + p0 * s0; v1 = v1 * c1 + p1 * s1; }
            u32x4 w; w.x = cvt_pk_bf16(v0[0], v0[1]); w.y = cvt_pk_bf16(v0[2], v0[3]); w.z = cvt_pk_bf16(v1[0], v1[1]); w.w = cvt_pk_bf16(v1[2], v1[3]);
            *(u32x4*)(rowp + bj * HALF) = w; }
    }
    __device__ __forceinline__ void operator()(const f32x4 (&acc)[2][2][4][2], const Unit& u, int wr, int wc, int fr, int fq) const {
        const int row0 = u.pm * BM + wr * 64 + fr, col0 = u.pn * BM + wc * 32 + 8 * fq; const int type = u.pn < ntq ? 0 : (u.pn < ntq + ntk ? 1 : 2);
        if (type < 2) {
            const unsigned rb = (unsigned)(uintptr_t)ex + (unsigned)((wr * 64 + fr) * 8 * 4), wb = rb + (unsigned)(wc * 4);
            part<0, 0>(acc, wb, fq); part<0, 1>(acc, wb, fq); part<0, 2>(acc, wb, fq); part<0, 3>(acc, wb, fq); part<1, 0>(acc, wb, fq); part<1, 1>(acc, wb, fq); part<1, 2>(acc, wb, fq); part<1, 3>(acc, wb, fq);
            asm volatile("s_waitcnt lgkmcnt(0)" ::: "memory"); __builtin_amdgcn_s_barrier(); asm volatile("" ::: "memory");
            const float* gp = (type == 0 ? qn : kn) + wc * 32 + 8 * fq; const float gs = type == 0 ? qscale : 1.0f;
            fin<0, 0>(acc, rb, row0, col0, gp, gs, wc, fq); fin<0, 1>(acc, rb, row0 + 16, col0, gp, gs, wc, fq); fin<0, 2>(acc, rb, row0 + 32, col0, gp, gs, wc, fq); fin<0, 3>(acc, rb, row0 + 48, col0, gp, gs, wc, fq);
            fin<1, 0>(acc, rb, row0 + HALF, col0, gp, gs, wc, fq); fin<1, 1>(acc, rb, row0 + HALF + 16, col0, gp, gs, wc, fq); fin<1, 2>(acc, rb, row0 + HALF + 32, col0, gp, gs, wc, fq); fin<1, 3>(acc, rb, row0 + HALF + 48, col0, gp, gs, wc, fq);
        } else {
#pragma unroll
            for (int ai = 0; ai < 2; ++ai)
#pragma unroll
                for (int m = 0; m < 4; ++m) { const int row = row0 + ai * HALF + m * 16; bf16_t* rowp = O + (size_t)row * ldc + col0; const float sc = rstd[row];
#pragma unroll
                    for (int bj = 0; bj < 2; ++bj) { const f32x4 v0 = acc[ai][bj][m][0] * sc, v1 = acc[ai][bj][m][1] * sc;
                        u32x4 w; w.x = cvt_pk_bf16(v0[0], v0[1]); w.y = cvt_pk_bf16(v0[2], v0[3]); w.z = cvt_pk_bf16(v1[0], v1[1]); w.w = cvt_pk_bf16(v1[2], v1[3]);
                        *(u32x4*)(rowp + bj * HALF) = w;
                        if (ssq != nullptr && u.pn >= 36) { float sq = (v0[0] * v0[0] + v0[1] * v0[1]) + (v0[2] * v0[2] + v0[3] * v0[3]) + (v1[0] * v1[0] + v1[1] * v1[1]) + (v1[2] * v1[2] + v1[3] * v1[3]);
                            sq += __shfl_xor(sq, 16); sq += __shfl_xor(sq, 32);
                            if (fq == 0) ssq[(size_t)row * 64 + (u.pn - 36) * 8 + bj * 4 + wc] = sq; } } }
        }
    }
};
#ifndef RESID_LOW
#define RESID_LOW 0
#endif
template <int MODE> struct EpiResidT {
    static constexpr bool PERM = true, AFTER_DRAIN = false;
    const float* basef; float* outf; bf16_t* xb; bf16_t* xl0; bf16_t* xl1; float* ss; int ldc;
    __device__ __forceinline__ void operator()(const f32x4 (&acc)[2][2][4][2], const Unit& u, int wr, int wc, int fr, int fq) const {
        const int row0 = u.pm * BM + wr * 64 + fr, col0 = u.pn * BM + wc * 32 + 8 * fq; bf16_t* xl = u.pm < 32 ? xl0 : xl1;
#pragma unroll
        for (int ai = 0; ai < 2; ++ai)
#pragma unroll
            for (int m = 0; m < 4; ++m) { const int row = row0 + ai * HALF + m * 16; const size_t off = (size_t)row * ldc + col0; float s = 0.f;
#pragma unroll
                for (int bj = 0; bj < 2; ++bj) { f32x4 b0, b1;
                    if constexpr (MODE == 0) { b0 = *(const f32x4*)(basef + off + bj * HALF); b1 = *(const f32x4*)(basef + off + bj * HALF + 4); }
                    else { const u32x4 hb = *(const u32x4*)(xb + off + bj * HALF); u32x4 lb = {0u, 0u, 0u, 0u}; if constexpr (RESID_LOW) lb = *(const u32x4*)(xl + off + bj * HALF);
                        b0[0] = bf_lo(hb.x) + bf_lo(lb.x); b0[1] = bf_hi(hb.x) + bf_hi(lb.x); b0[2] = bf_lo(hb.y) + bf_lo(lb.y); b0[3] = bf_hi(hb.y) + bf_hi(lb.y);
                        b1[0] = bf_lo(hb.z) + bf_lo(lb.z); b1[1] = bf_hi(hb.z) + bf_hi(lb.z); b1[2] = bf_lo(hb.w) + bf_lo(lb.w); b1[3] = bf_hi(hb.w) + bf_hi(lb.w); }
                    const f32x4 v0 = b0 + acc[ai][bj][m][0], v1 = b1 + acc[ai][bj][m][1];
                    if constexpr (MODE == 2 || MK_CHECK) { *(f32x4*)(outf + off + bj * HALF) = v0; *(f32x4*)(outf + off + bj * HALF + 4) = v1; }
                    if constexpr (MODE != 2) {
                        u32x4 w; w.x = cvt_pk_bf16(v0[0], v0[1]); w.y = cvt_pk_bf16(v0[2], v0[3]); w.z = cvt_pk_bf16(v1[0], v1[1]); w.w = cvt_pk_bf16(v1[2], v1[3]);
                        u32x4 l; l.x = cvt_pk_bf16(v0[0] - bf_lo(w.x), v0[1] - bf_hi(w.x)); l.y = cvt_pk_bf16(v0[2] - bf_lo(w.y), v0[3] - bf_hi(w.y));
                                 l.z = cvt_pk_bf16(v1[0] - bf_lo(w.z), v1[1] - bf_hi(w.z)); l.w = cvt_pk_bf16(v1[2] - bf_lo(w.w), v1[3] - bf_hi(w.w));
                        *(u32x4*)(xb + off + bj * HALF) = w; if constexpr (RESID_LOW) *(u32x4*)(xl + off + bj * HALF) = l;
                        s += (v0[0] * v0[0] + v0[1] * v0[1]) + (v0[2] * v0[2] + v0[3] * v0[3]) + (v1[0] * v1[0] + v1[1] * v1[1]) + (v1[2] * v1[2] + v1[3] * v1[3]); } }
                if constexpr (MODE != 2) { s += __shfl_xor(s, 16); s += __shfl_xor(s, 32);
                    if (fq == 0) ss[(size_t)row * 64 + u.pn * 4 + wc] = s; } }
    }
};
struct EpiUpConv {
    static constexpr bool PERM = true, AFTER_DRAIN = false;
    const bf16_t* a; bf16_t* h2; const float* rstd; const float* cw; const float* cb; int ldc; int seq;
    __device__ __forceinline__ void operator()(const f32x4 (&acc)[2][2][4][2], const Unit& u, int wr, int wc, int fr, int fq) const {
        const int row0 = u.pm * BM + wr * 64 + fr, col0 = u.pn * BM + wc * 32 + 8 * fq;
#pragma unroll
        for (int bj = 0; bj < 2; ++bj) { const int c = col0 + bj * HALF;
            float w0[8], w1[8], w2[8], b[8];
#pragma unroll
            for (int h = 0; h < 2; ++h) { const f32x4 t0 = *(const f32x4*)(cw + c + 4 * h), t1 = *(const f32x4*)(cw + ldc + c + 4 * h), t2 = *(const f32x4*)(cw + 2 * ldc + c + 4 * h), t3 = *(const f32x4*)(cb + c + 4 * h);
#pragma unroll
                for (int j = 0; j < 4; ++j) { w0[4 * h + j] = t0[j]; w1[4 * h + j] = t1[j]; w2[4 * h + j] = t2[j]; b[4 * h + j] = t3[j]; } }
#pragma unroll
            for (int ai = 0; ai < 2; ++ai)
#pragma unroll
                for (int m = 0; m < 4; ++m) { const int row = row0 + ai * HALF + m * 16; const int t = row & (seq - 1); const float s = rstd[row];
                    const bf16_t* ap = a + (size_t)row * ldc + c;
                    const u32x4 z4 = {0u, 0u, 0u, 0u};
                    const u32x4 a0 = *(const u32x4*)ap; const u32x4 am = t > 0 ? *(const u32x4*)(ap - ldc) : z4; const u32x4 an = t < seq - 1 ? *(const u32x4*)(ap + ldc) : z4;
                    float hv[8];
#pragma unroll
                    for (int j = 0; j < 8; ++j) { const unsigned wm = am[j >> 1], wz = a0[j >> 1], wn = an[j >> 1];
                        const float fm = (j & 1) ? bf_hi(wm) : bf_lo(wm), fz = (j & 1) ? bf_hi(wz) : bf_lo(wz), fn = (j & 1) ? bf_hi(wn) : bf_lo(wn);
                        const float g = w0[j] * fm + w1[j] * fz + w2[j] * fn + b[j];
                        const float e = __builtin_amdgcn_exp2f(-1.4426950408889634f * g);
                        const float sg = g * __builtin_amdgcn_rcpf(1.0f + e);
                        const float up = (j < 4 ? acc[ai][bj][m][0][j & 3] : acc[ai][bj][m][1][j & 3]) * s;
                        hv[j] = sg * up; }
                    u32x4 w; w.x = cvt_pk_bf16(hv[0], hv[1]); w.y = cvt_pk_bf16(hv[2], hv[3]); w.z = cvt_pk_bf16(hv[4], hv[5]); w.w = cvt_pk_bf16(hv[6], hv[7]);
                    *(u32x4*)(h2 + (size_t)row * ldc + c) = w; } }
    }
};
template <int CTRL> __device__ __forceinline__ float dpp_rot(float v) { return __builtin_bit_cast(float, __builtin_amdgcn_update_dpp(0, __builtin_bit_cast(int, v), CTRL, 0xF, 0xF, false)); }
struct EpiGateUp {
    static constexpr bool PERM = true, AFTER_DRAIN = false;
    bf16_t* h2; const float* rstd; const float* cw; const float* cb; int ldc; bf16_t* aedge; bf16_t* uedge; PG8_LAS float* ex;
    __device__ __forceinline__ void operator()(const f32x4 (&acc)[2][2][4][2], const Unit& u, int wr, int wc, int fr, int fq) const {
        const int row0 = u.pm * BM + wr * 64 + fr, ch = u.pn * HALF + wc * 32 + 8 * fq;
        f32x4 av[2][4][2], uv[2][4][2];
#pragma unroll
        for (int ai = 0; ai < 2; ++ai)
#pragma unroll
            for (int m = 0; m < 4; ++m) { const float r = rstd[row0 + ai * HALF + m * 16];
                av[ai][m][0] = acc[ai][0][m][0] * r; av[ai][m][1] = acc[ai][0][m][1] * r; uv[ai][m][0] = acc[ai][1][m][0] * r; uv[ai][m][1] = acc[ai][1][m][1] * r; }
        const unsigned eb = (unsigned)(uintptr_t)ex + (unsigned)((wc * 4 + fq) * 32);
#pragma unroll
        for (int ai = 0; ai < 2; ++ai) { const int gidx = 2 * ai + wr;
            if (fr == 0) { const unsigned a0 = eb + (unsigned)((gidx * 2 + 0) * 512);
                asm volatile("ds_write_b128 %0, %1\n\tds_write_b128 %0, %2 offset:16" :: "v"(a0), "v"(av[ai][0][0]), "v"(av[ai][0][1]) : "memory"); }
            if (fr == 15) { const unsigned a1 = eb + (unsigned)((gidx * 2 + 1) * 512);
                asm volatile("ds_write_b128 %0, %1\n\tds_write_b128 %0, %2 offset:16" :: "v"(a1), "v"(av[ai][3][0]), "v"(av[ai][3][1]) : "memory"); } }
        asm volatile("s_waitcnt lgkmcnt(0)" ::: "memory"); __builtin_amdgcn_s_barrier(); asm volatile("" ::: "memory");
        unsigned pk[2][4][2][2];
#pragma unroll
        for (int h = 0; h < 2; ++h) {
            const f32x4 w0 = *(const f32x4*)(cw + ch + 4 * h), w1 = *(const f32x4*)(cw + ldc + ch + 4 * h), w2 = *(const f32x4*)(cw + 2 * ldc + ch + 4 * h), bb = *(const f32x4*)(cb + ch + 4 * h);
#pragma unroll
            for (int ai = 0; ai < 2; ++ai) { const int gidx = 2 * ai + wr;
                f32x4 rrp, nx;
                { const unsigned ap = eb + (unsigned)(((gidx > 0 ? gidx - 1 : 0) * 2 + 1) * 512 + 16 * h), an = eb + (unsigned)(((gidx < 3 ? gidx + 1 : 3) * 2 + 0) * 512 + 16 * h);
                  asm volatile("ds_read_b128 %0, %2\n\tds_read_b128 %1, %3\n\ts_waitcnt lgkmcnt(0)" : "=&v"(rrp), "=&v"(nx) : "v"(ap), "v"(an) : "memory"); }
                f32x4 rlc;
#pragma unroll
                for (int j = 0; j < 4; ++j) rlc[j] = dpp_rot<0x12F>(av[ai][0][h][j]);
#pragma unroll
                for (int m = 0; m < 4; ++m) { const int row = row0 + ai * HALF + m * 16;
                    float hv[4];
#pragma unroll
                    for (int j = 0; j < 4; ++j) { const float cur = av[ai][m][h][j];
                        const float rr = dpp_rot<0x121>(cur);
                        float rln;
                        if (m < 3) rln = dpp_rot<0x12F>(av[ai][m + 1][h][j]); else rln = nx[j];
                        const float prev = fr != 0 ? rr : rrp[j], next = fr != 15 ? rlc[j] : rln;
                        rrp[j] = rr; rlc[j] = rln;
                        const float g = w0[j] * prev + w1[j] * cur + w2[j] * next + bb[j];
                        const float e = __builtin_amdgcn_exp2f(-1.4426950408889634f * g);
                        hv[j] = g * __builtin_amdgcn_rcpf(1.0f + e) * uv[ai][m][h][j]; }
                    pk[ai][m][h][0] = cvt_pk_bf16(hv[0], hv[1]); pk[ai][m][h][1] = cvt_pk_bf16(hv[2], hv[3]);
                    if ((m == 0 && gidx == 0 && fr < 2) || (m == 3 && gidx == 3 && fr >= 14)) {
                        const int e4 = (m == 0) ? fr : fr - 12;
                        u32x2 w; w.x = cvt_pk_bf16(av[ai][m][h][0], av[ai][m][h][1]); w.y = cvt_pk_bf16(av[ai][m][h][2], av[ai][m][h][3]);
                        *(u32x2*)(aedge + ((size_t)u.pm * 4 + e4) * ldc + ch + 4 * h) = w;
                        if (e4 == 0 || e4 == 3) { u32x2 wu; wu.x = cvt_pk_bf16(uv[ai][m][h][0], uv[ai][m][h][1]); wu.y = cvt_pk_bf16(uv[ai][m][h][2], uv[ai][m][h][3]);
                            *(u32x2*)(uedge + ((size_t)u.pm * 2 + (e4 == 3 ? 1 : 0)) * ldc + ch + 4 * h) = wu; } }
                    if (h == 1) { const bool first = (m == 0 && gidx == 0 && fr == 0), last = (m == 3 && gidx == 3 && fr == 15);
                        if (!first && !last) { u32x4 w; w.x = pk[ai][m][0][0]; w.y = pk[ai][m][0][1]; w.z = pk[ai][m][1][0]; w.w = pk[ai][m][1][1];
                            *(u32x4*)(h2 + (size_t)row * ldc + ch) = w; } }
                } }
        }
    }
};
template <class Epi, class Sched, bool ALIGN_EPI = false, bool SP2 = false, bool SPLITK = false>
__device__ __forceinline__ void gemm_phase(PG8_LAS unsigned char* lds, const Gemm g, const Sched& S, const Epi& E) {
    const int tid = threadIdx.x, wid = __builtin_amdgcn_readfirstlane(tid >> 6), lane = tid & 63, wr = wid >> 2, wc = wid & 3, fr = lane & 15, fq = lane >> 4;
    const int K = g.K, nt = K / BK;
    unsigned voffA[2], voffB[2];
#pragma unroll
    for (int i = 0; i < 2; ++i) { int R, C; stage_rc(tid * 16 + i * 8192, R, C); const int Rb = Epi::PERM ? ((R & ~31) + perm32(R & 31)) : R;
        voffA[i] = (unsigned)(R * g.lda + C) * 2u; voffB[i] = (unsigned)(Rb * K + C) * 2u; }
    const size_t kstep = (size_t)(BK * 2);
    const size_t hstepB = (size_t)HALF * K * 2, hstepA = (size_t)HALF * g.lda * 2;
    const size_t tstepB = 2 * hstepB, tstepA = 2 * hstepA;
    const unsigned ldsw = (unsigned)wid * 1024u;
    const int aoff = lds_byte(wr * 64 + fr, fq * 8), boff = lds_byte(wc * 32 + fr, fq * 8);
#define PG8_SA(b, h) (((b) * 2 + (h)) * HTB)
#define PG8_SB(b, h) ((4 + (b) * 2 + (h)) * HTB)
#define PG8_STAGE(bufoff, gbase, voff) do { _Pragma("unroll") for (int _i = 0; _i < 2; ++_i) \
        __builtin_amdgcn_global_load_lds((const unsigned*)((const char*)(gbase) + (voff)[_i]), (PG8_LAS unsigned*)(lds + (bufoff) + ldsw + _i * 8192), 16, 0, 0); } while (0)
#define PG8_LDA(dst, b, h) do { _Pragma("unroll") for (int m = 0; m < 4; ++m) _Pragma("unroll") for (int k = 0; k < 2; ++k) dst[m][k] = *(const PG8_LAS bf16x8*)(lds + PG8_SA(b, h) + aoff + m * 2048 + k * 1024); } while (0)
#define PG8_LDB(dst, b, h) do { _Pragma("unroll") for (int n = 0; n < 2; ++n) _Pragma("unroll") for (int k = 0; k < 2; ++k) dst[n][k] = *(const PG8_LAS bf16x8*)(lds + PG8_SB(b, h) + boff + n * 2048 + k * 1024); } while (0)
#define PG8_MMA(ai, bj, At, Bt) do { __builtin_amdgcn_s_setprio(1); _Pragma("unroll") for (int m = 0; m < 4; ++m) _Pragma("unroll") for (int n = 0; n < 2; ++n) _Pragma("unroll") for (int k = 0; k < 2; ++k) \
        acc[ai][bj][m][n] = __builtin_amdgcn_mfma_f32_16x16x32_bf16(Bt[n][k], At[m][k], acc[ai][bj][m][n], 0, 0, 0); __builtin_amdgcn_s_setprio(0); } while (0)
#define PG8_WAIT_V(n) asm volatile("s_waitcnt vmcnt(" #n ")" ::: "memory")
#define PG8_WAIT_L(n) asm volatile("s_waitcnt lgkmcnt(" #n ")" ::: "memory")
#define PG8_BAR __builtin_amdgcn_s_barrier()
#define PG8_SCHED __builtin_amdgcn_sched_barrier(0)
    Unit cur, nxt; int ui = 0;
    if (!S.next(0, cur)) return;
    f32x4 acc[2][2][4][2];
#pragma unroll
    for (int a = 0; a < 2; ++a)
#pragma unroll
        for (int b = 0; b < 2; ++b)
#pragma unroll
            for (int m = 0; m < 4; ++m)
#pragma unroll
                for (int n = 0; n < 2; ++n) acc[a][b][m][n] = (f32x4){0.f, 0.f, 0.f, 0.f};
    bf16x8 At[4][2], B0[2][2], B1[2][2];
    const char* cA = (const char*)g.A + (size_t)cur.pm * tstepA; const char* cB = (const char*)g.Bt + (size_t)cur.pn * tstepB;
    if constexpr (SPLITK) { cA += (size_t)cur.kb * kstep; cB += (size_t)cur.kb * kstep; }
    S.a_ready(cur);
    if constexpr (SP2) {
        PG8_STAGE(PG8_SB(0, 0), cB, voffB); PG8_STAGE(PG8_SB(0, 1), cB + hstepB, voffB); PG8_STAGE(PG8_SA(0, 0), cA, voffA); PG8_STAGE(PG8_SA(0, 1), cA + hstepA, voffA);
        if (wr == 1) PG8_BAR;
        PG8_WAIT_V(2); PG8_BAR;
        PG8_STAGE(PG8_SB(1, 0), cB + kstep, voffB); PG8_STAGE(PG8_SA(1, 0), cA + kstep, voffA); PG8_STAGE(PG8_SB(1, 1), cB + hstepB + kstep, voffB);
        PG8_WAIT_V(6); PG8_BAR;
    } else {
        PG8_STAGE(PG8_SB(0, 0), cB, voffB); PG8_STAGE(PG8_SA(0, 0), cA, voffA); PG8_STAGE(PG8_SB(0, 1), cB + hstepB, voffB); PG8_STAGE(PG8_SA(0, 1), cA + hstepA, voffA);
        if (wr == 1) PG8_BAR;
        PG8_WAIT_V(4); PG8_BAR;
        PG8_STAGE(PG8_SB(1, 0), cB + kstep, voffB); PG8_STAGE(PG8_SA(1, 0), cA + kstep, voffA); PG8_STAGE(PG8_SB(1, 1), cB + hstepB + kstep, voffB);
        PG8_WAIT_V(6); PG8_BAR;
    }
    for (;;) {
        const bool has_next = S.next(ui + 1, nxt);
        const char* nA = has_next ? (const char*)g.A + (size_t)nxt.pm * tstepA : cA; const char* nB = has_next ? (const char*)g.Bt + (size_t)nxt.pn * tstepB : cB;
        if constexpr (SPLITK) { if (has_next) { nA += (size_t)nxt.kb * kstep; nB += (size_t)nxt.kb * kstep; } }
        const int ntc = SPLITK ? cur.kn : nt;
        for (int t = 0; t < ntc; t += 2) {
            const bool last = (t == ntc - 2);
            const char* a1 = cA + (size_t)(t + 1) * kstep;
            const char* a2 = last ? nA : cA + (size_t)(t + 2) * kstep; const char* b2 = last ? nB : cB + (size_t)(t + 2) * kstep;
            const char* a3 = a2 + kstep; const char* b3 = b2 + kstep;
            if (last && has_next) S.a_ready(nxt);
            if constexpr (SP2) {
            PG8_LDB(B0, 0, 0); PG8_LDB(B1, 0, 1); PG8_SCHED; PG8_LDA(At, 0, 0); PG8_STAGE(PG8_SA(1, 1), a1 + hstepA, voffA);
            PG8_WAIT_V(8); PG8_WAIT_L(0); PG8_BAR; PG8_MMA(0, 0, At, B0); PG8_MMA(0, 1, At, B1); PG8_BAR; PG8_SCHED;
            PG8_LDA(At, 0, 1); PG8_STAGE(PG8_SB(0, 0), b2, voffB); PG8_STAGE(PG8_SB(0, 1), b2 + hstepB, voffB); PG8_STAGE(PG8_SA(0, 0), a2, voffA);
            PG8_WAIT_V(8); PG8_WAIT_L(0); PG8_BAR; PG8_MMA(1, 0, At, B0); PG8_MMA(1, 1, At, B1); PG8_BAR; PG8_SCHED;
            PG8_LDB(B0, 1, 0); PG8_LDB(B1, 1, 1); PG8_SCHED; PG8_LDA(At, 1, 0); PG8_STAGE(PG8_SA(0, 1), a2 + hstepA, voffA);
            PG8_WAIT_V(8); PG8_WAIT_L(0); PG8_BAR; PG8_MMA(0, 0, At, B0); PG8_MMA(0, 1, At, B1); PG8_BAR; PG8_SCHED;
            PG8_LDA(At, 1, 1); PG8_STAGE(PG8_SB(1, 0), b3, voffB); PG8_STAGE(PG8_SB(1, 1), b3 + hstepB, voffB); PG8_STAGE(PG8_SA(1, 0), a3, voffA);
            PG8_WAIT_V(8); PG8_WAIT_L(0); PG8_BAR; PG8_MMA(1, 0, At, B0); PG8_MMA(1, 1, At, B1); PG8_BAR; PG8_SCHED;
            } else {
            PG8_LDB(B0, 0, 0); PG8_SCHED; PG8_LDA(At, 0, 0); PG8_STAGE(PG8_SA(1, 1), a1 + hstepA, voffA);
            PG8_WAIT_L(8); PG8_BAR; PG8_WAIT_L(0); PG8_MMA(0, 0, At, B0); PG8_BAR; PG8_SCHED;
            PG8_LDB(B1, 0, 1); PG8_STAGE(PG8_SB(0, 0), b2, voffB);
            PG8_BAR; PG8_WAIT_L(0); PG8_MMA(0, 1, At, B1); PG8_BAR;
            PG8_LDA(At, 0, 1); PG8_STAGE(PG8_SA(0, 0), a2, voffA);
            PG8_BAR; PG8_WAIT_L(0); PG8_MMA(1, 0, At, B0); PG8_BAR; PG8_SCHED;
            PG8_STAGE(PG8_SB(0, 1), b2 + hstepB, voffB);
            PG8_WAIT_V(6); PG8_BAR; PG8_MMA(1, 1, At, B1); PG8_BAR;
            PG8_LDB(B0, 1, 0); PG8_SCHED; PG8_LDA(At, 1, 0); PG8_STAGE(PG8_SA(0, 1), a2 + hstepA, voffA);
            PG8_WAIT_L(8); PG8_BAR; PG8_WAIT_L(0); PG8_MMA(0, 0, At, B0); PG8_BAR; PG8_SCHED;
            PG8_LDB(B1, 1, 1); PG8_STAGE(PG8_SB(1, 0), b3, voffB);
            PG8_BAR; PG8_WAIT_L(0); PG8_MMA(0, 1, At, B1); PG8_BAR;
            PG8_LDA(At, 1, 1); PG8_STAGE(PG8_SA(1, 0), a3, voffA);
            PG8_BAR; PG8_WAIT_L(0); PG8_MMA(1, 0, At, B0); PG8_BAR; PG8_SCHED;
            PG8_STAGE(PG8_SB(1, 1), b3 + hstepB, voffB);
            PG8_WAIT_V(6); PG8_BAR; PG8_MMA(1, 1, At, B1); PG8_BAR;
            }
        }
        if constexpr (ALIGN_EPI) { if (wr == 0) PG8_BAR; }
        if constexpr (SPLITK) {
            if (cur.role == 2) {
                const __amdgpu_buffer_rsrc_t rs = __builtin_amdgcn_make_buffer_rsrc((void*)(S.scr + (size_t)cur.slot * 65536), 0, 65536 * 4, 0x00020000);
#pragma unroll
                for (int a = 0; a < 2; ++a)
#pragma unroll
                    for (int b = 0; b < 2; ++b)
#pragma unroll
                        for (int m = 0; m < 4; ++m)
#pragma unroll
                            for (int n = 0; n < 2; ++n)
                                __builtin_amdgcn_raw_buffer_store_b128(__builtin_bit_cast(u32x4, acc[a][b][m][n]), rs, (unsigned)(((wid * 32 + ((a * 2 + b) * 4 + m) * 2 + n) * 64 + lane) * 16), 0, 16);
                PG8_WAIT_V(0); PG8_BAR;
                if (tid == 0) __hip_atomic_store(S.flg + cur.slot * 16, 1u, __ATOMIC_RELAXED, __HIP_MEMORY_SCOPE_AGENT);
            } else {
                if (cur.role == 1) {
                    if (tid == 0) { unsigned spn = 0; while (__hip_atomic_load(S.flg + cur.slot * 16, __ATOMIC_RELAXED, __HIP_MEMORY_SCOPE_AGENT) == 0u) { __builtin_amdgcn_s_sleep(1); if (++spn > (1u << 22)) break; }
                        __builtin_amdgcn_fence(__ATOMIC_ACQUIRE, "agent"); }
                    PG8_WAIT_V(0); PG8_BAR;
                    const float* sp = S.scr + (size_t)cur.slot * 65536 + (size_t)(wid * 32 * 64 + lane) * 4;
#pragma unroll
                    for (int a = 0; a < 2; ++a)
#pragma unroll
                        for (int b = 0; b < 2; ++b) { f32x4 tq[4][2];
#pragma unroll
                            for (int m = 0; m < 4; ++m)
#pragma unroll
                                for (int n = 0; n < 2; ++n) tq[m][n] = *(const f32x4*)(sp + (size_t)((((a * 2 + b) * 4 + m) * 2 + n) * 64) * 4);
#pragma unroll
                            for (int m = 0; m < 4; ++m)
#pragma unroll
                                for (int n = 0; n < 2; ++n) acc[a][b][m][n] += tq[m][n]; }
                }
                E(acc, cur, wr, wc, fr, fq); S.done(cur);
            }
        } else
        if constexpr (!Epi::AFTER_DRAIN) { E(acc, cur, wr, wc, fr, fq); S.done(cur); }
        if (!has_next) break;
#pragma unroll
        for (int a = 0; a < 2; ++a)
#pragma unroll
            for (int b = 0; b < 2; ++b)
#pragma unroll
                for (int m = 0; m < 4; ++m)
#pragma unroll
                    for (int n = 0; n < 2; ++n) acc[a][b][m][n] = (f32x4){0.f, 0.f, 0.f, 0.f};
        cur = nxt; cA = nA; cB = nB; ++ui;
        if constexpr (ALIGN_EPI) { if (wr == 1) PG8_BAR; }
    }
    PG8_WAIT_V(0);
    if constexpr (!ALIGN_EPI) { if (wr == 0) PG8_BAR; }
    PG8_BAR;
    if constexpr (Epi::AFTER_DRAIN) { E.fused(acc, cur, wr, wc, fr, fq, lds, wid, lane); S.done(cur); }
#undef PG8_SA
#undef PG8_SB
#undef PG8_STAGE
#undef PG8_LDA
#undef PG8_LDB
#undef PG8_MMA
#undef PG8_WAIT_V
#undef PG8_WAIT_L
#undef PG8_BAR
#undef PG8_SCHED
}
}

namespace mla {
typedef unsigned short bf16;
using bf16x8 = __attribute__((ext_vector_type(8))) short;
using s16x4  = __attribute__((ext_vector_type(4))) short;
using f32x16 = __attribute__((ext_vector_type(16))) float;
using u32x4  = __attribute__((ext_vector_type(4))) unsigned;
constexpr int DQK = 192, DV = 128, NW = 8, QBLK = 32, KVBLK = 64;
constexpr int LDQ = 3072, LDK = 3072, LDV = 4096, LDO = 3072;
constexpr float THR = 11.5f;
constexpr int SHM_V = KVBLK * DV * 2, SHM_K = KVBLK * DQK * 2, SHM_ATTN = 2 * SHM_V + 2 * SHM_K + NW * 64 * 4;
#define MLA_SBAR() __builtin_amdgcn_sched_barrier(0)
#ifndef MLA_QG
#define MLA_QG 4
#endif
__device__ __forceinline__ int crow(int r, int hi) { return (r & 3) + 8 * (r >> 2) + 4 * hi; }
__device__ __forceinline__ unsigned cvtpk(float lo, float hi) { unsigned r; asm volatile("v_cvt_pk_bf16_f32 %0, %1, %2" : "=v"(r) : "v"(lo), "v"(hi)); return r; }
__device__ __forceinline__ void partialSM(f32x16& p0, f32x16& p1, float& m_reg, float& mn, float& alpha) {
  float pmax = p0[0];
#pragma unroll
  for (int r = 1; r < 16; ++r) pmax = fmaxf(pmax, p0[r]);
#pragma unroll
  for (int r = 0; r < 16; ++r) pmax = fmaxf(pmax, p1[r]);
  { auto rr = __builtin_amdgcn_permlane32_swap(__float_as_uint(pmax), __float_as_uint(pmax), false, false);
    pmax = fmaxf(__uint_as_float(rr[0]), __uint_as_float(rr[1])); }
  if (__builtin_expect(__all(pmax - m_reg <= THR), 1)) { mn = m_reg; alpha = 1.f; }
  else { mn = fmaxf(m_reg, pmax); alpha = __builtin_amdgcn_exp2f(m_reg - mn); m_reg = mn; }
#pragma unroll
  for (int r = 0; r < 16; ++r) p0[r] = p0[r] - mn;
#pragma unroll
  for (int r = 0; r < 16; ++r) p1[r] = p1[r] - mn;
#pragma unroll
  for (int r = 0; r < 16; ++r) p0[r] = __builtin_amdgcn_exp2f(p0[r]);
}
__device__ __forceinline__ void finishSM(f32x16& p0, f32x16& p1, float alpha, float& l_reg, bf16x8& pa0, bf16x8& pa1, bf16x8& pa2, bf16x8& pa3) {
#pragma unroll
  for (int r = 0; r < 16; ++r) p1[r] = __builtin_amdgcn_exp2f(p1[r]);
  float ps = 0;
#pragma unroll
  for (int r = 0; r < 16; ++r) ps += p0[r];
#pragma unroll
  for (int r = 0; r < 16; ++r) ps += p1[r];
  { auto rr = __builtin_amdgcn_permlane32_swap(__float_as_uint(ps), __float_as_uint(ps), false, false);
    ps = __uint_as_float(rr[0]) + __uint_as_float(rr[1]); }
  l_reg = l_reg * alpha + ps;
#define MLA_PK4(P, BASE, OUT) do { unsigned a0 = cvtpk(P[BASE + 0], P[BASE + 1]), a1 = cvtpk(P[BASE + 2], P[BASE + 3]);   \
    unsigned b0 = cvtpk(P[BASE + 4], P[BASE + 5]), b1 = cvtpk(P[BASE + 6], P[BASE + 7]);                              \
    auto r0 = __builtin_amdgcn_permlane32_swap(a0, b0, false, false); auto r1 = __builtin_amdgcn_permlane32_swap(a1, b1, false, false); \
    u32x4 w = {r0[0], r1[0], r0[1], r1[1]}; OUT = *reinterpret_cast<bf16x8*>(&w); } while (0)
  MLA_PK4(p0, 0, pa0); MLA_PK4(p0, 8, pa1); MLA_PK4(p1, 0, pa2); MLA_PK4(p1, 8, pa3);
#undef MLA_PK4
}
__device__ __forceinline__ int v_st(int k, int c) { const int kk = (k & ~0xC) | ((k & 4) << 1) | ((k & 8) >> 1); return ((kk >> 3) * 4 + (c >> 5)) * 512 + ((kk & 7) * 32 + (c & 31)) * 2; }
__device__ __forceinline__ int v_rd_base(int lane) { return ((lane & 3) << 3) | (((lane >> 2) & 3) << 6) | (((lane >> 4) & 1) << 5) | (((lane >> 5) & 1) << 8); }
constexpr int v_rd_off(int d0, int ks, int half) { return d0 * 512 + ks * 4096 + half * 2048; }
template <int OFF> __device__ __forceinline__ s16x4 tr_read(int vb) {
  s16x4 r; asm volatile("ds_read_b64_tr_b16 %0, %1 offset:%2" : "=&v"(r) : "v"(vb), "i"(OFF) : "memory"); return r;
}
template <int D0> __device__ __forceinline__ void pv_one(f32x16& od, int vb, bf16x8 pa0, bf16x8 pa1, bf16x8 pa2, bf16x8 pa3) {
  const s16x4 l0 = tr_read<v_rd_off(D0, 0, 0)>(vb), h0 = tr_read<v_rd_off(D0, 0, 1)>(vb), l1 = tr_read<v_rd_off(D0, 1, 0)>(vb), h1 = tr_read<v_rd_off(D0, 1, 1)>(vb);
  const s16x4 l2 = tr_read<v_rd_off(D0, 2, 0)>(vb), h2 = tr_read<v_rd_off(D0, 2, 1)>(vb), l3 = tr_read<v_rd_off(D0, 3, 0)>(vb), h3 = tr_read<v_rd_off(D0, 3, 1)>(vb);
  asm volatile("s_waitcnt lgkmcnt(0)" ::: "memory"); MLA_SBAR();
#define MLA_PK(L, H) (bf16x8){L[0], L[1], L[2], L[3], H[0], H[1], H[2], H[3]}
  od = __builtin_amdgcn_mfma_f32_32x32x16_bf16(pa0, MLA_PK(l0, h0), od, 0, 0, 0);
  od = __builtin_amdgcn_mfma_f32_32x32x16_bf16(pa1, MLA_PK(l1, h1), od, 0, 0, 0);
  od = __builtin_amdgcn_mfma_f32_32x32x16_bf16(pa2, MLA_PK(l2, h2), od, 0, 0, 0);
  od = __builtin_amdgcn_mfma_f32_32x32x16_bf16(pa3, MLA_PK(l3, h3), od, 0, 0, 0);
#undef MLA_PK
}
__device__ __forceinline__ void pv_d0(f32x16* o, int vb, bf16x8 pa0, bf16x8 pa1, bf16x8 pa2, bf16x8 pa3) {
  pv_one<0>(o[0], vb, pa0, pa1, pa2, pa3); pv_one<1>(o[1], vb, pa0, pa1, pa2, pa3); pv_one<2>(o[2], vb, pa0, pa1, pa2, pa3); pv_one<3>(o[3], vb, pa0, pa1, pa2, pa3);
}
constexpr int SHM_ATTN3 = 3 * SHM_V + 2 * SHM_K + NW * 64 * 4;
__device__ __forceinline__ void attn_unit_d(const bf16* __restrict__ Qb, const bf16* __restrict__ Kh, const bf16* __restrict__ Vh, bf16* __restrict__ Ob, int seq, char* lds,
                                            const float* __restrict__ qgain, float qscale, float qeps, const float* __restrict__ cosT, const float* __restrict__ sinT, int pos0) {
  typedef __attribute__((address_space(3))) unsigned las_u32;
  const int tid = threadIdx.x, wid = tid >> 6, wu = __builtin_amdgcn_readfirstlane(tid >> 6), lane = tid & 63, r32 = lane & 31, hi = lane >> 5, grp = wid >> 2;
  char* V_lds = lds; char* K_lds = lds + 3 * SHM_V;
  float* ws = (float*)(lds + 3 * SHM_V + 2 * SHM_K) + wid * 64; float* li_l = ws; float* al_l = ws + 32;
  char* Q_lds = lds + SHM_ATTN3 + wid * 4096;
  float m_reg = -1e30f, l_reg = 0; f32x16 o[4] = {}; bf16x8 qr[8];
  const bf16* Qw = Qb + (long)(wid * QBLK + r32) * LDQ + hi * 8;
  const int qsw = (r32 >> 1) & 7; char* qrow = Q_lds + r32 * 128;
  {
    bf16x8 raw[12];
#pragma unroll
    for (int d0 = 0; d0 < 12; ++d0) raw[d0] = *reinterpret_cast<const bf16x8*>(Qw + d0 * 16);
    float ssq = 0.f;
#pragma unroll
    for (int d0 = 0; d0 < 12; ++d0)
#pragma unroll
      for (int e = 0; e < 8; ++e) { const float x = __uint_as_float((unsigned)(unsigned short)raw[d0][e] << 16); ssq += x * x; }
    ssq += __shfl_xor(ssq, 32);
    const float rsq = qscale / sqrtf(ssq * (1.0f / 192.0f) + qeps);
#pragma unroll
    for (int d0 = 0; d0 < 8; ++d0) { const float* gp = qgain + 16 * d0 + 8 * hi; float y[8];
#pragma unroll
      for (int e = 0; e < 8; ++e) y[e] = __uint_as_float((unsigned)(unsigned short)raw[d0][e] << 16) * rsq * gp[e];
      u32x4 w; w.x = cvtpk(y[0], y[1]); w.y = cvtpk(y[2], y[3]); w.z = cvtpk(y[4], y[5]); w.w = cvtpk(y[6], y[7]); qr[d0] = __builtin_bit_cast(bf16x8, w); }
    const int pos = pos0 + wid * QBLK + r32;
#pragma unroll
    for (int dr = 0; dr < 2; ++dr) { const int i0 = 16 * dr + 8 * hi; const float* g1 = qgain + 128 + i0; const float* g2 = qgain + 160 + i0; const float* cp = cosT + pos * 32 + i0; const float* sp = sinT + pos * 32 + i0;
      float y1[8], y2[8];
#pragma unroll
      for (int e = 0; e < 8; ++e) { const float a = __uint_as_float((unsigned)(unsigned short)raw[8 + dr][e] << 16) * rsq * g1[e], b = __uint_as_float((unsigned)(unsigned short)raw[10 + dr][e] << 16) * rsq * g2[e];
        y1[e] = a * cp[e] - b * sp[e]; y2[e] = b * cp[e] + a * sp[e]; }
      u32x4 w1, w2; w1.x = cvtpk(y1[0], y1[1]); w1.y = cvtpk(y1[2], y1[3]); w1.z = cvtpk(y1[4], y1[5]); w1.w = cvtpk(y1[6], y1[7]); w2.x = cvtpk(y2[0], y2[1]); w2.y = cvtpk(y2[2], y2[3]); w2.z = cvtpk(y2[4], y2[5]); w2.w = cvtpk(y2[6], y2[7]);
      *reinterpret_cast<bf16x8*>(qrow + (((2 * dr + hi) ^ qsw) << 4)) = __builtin_bit_cast(bf16x8, w1);
      *reinterpret_cast<bf16x8*>(qrow + (((2 * (dr + 2) + hi) ^ qsw) << 4)) = __builtin_bit_cast(bf16x8, w2); }
  }
  int ksrc[3], vsrc[2];
#pragma unroll
  for (int k = 0; k < 3; ++k) { const int o_ = (wid + 8 * k) * 1024 + lane * 16, r_ = o_ / 384, sc_ = (o_ - r_ * 384) >> 4, c_ = (sc_ & ~7) | ((sc_ & 7) ^ ((r_ >> 1) & 7)); ksrc[k] = (r_ * LDK + c_ * 8) * 2; }
#pragma unroll
  for (int k = 0; k < 2; ++k) { const int o_ = (wid + 8 * k) * 1024 + lane * 16, sub_ = o_ >> 9, w_ = (o_ & 511) >> 1, kk_ = (sub_ >> 2) * 8 + (w_ >> 5), key_ = (kk_ & ~0xC) | ((kk_ & 4) << 1) | ((kk_ & 8) >> 1);
    vsrc[k] = (key_ * LDV + (sub_ & 3) * 32 + (w_ & 31)) * 2; }
  const int vb0 = (int)(uintptr_t)V_lds + v_rd_base(lane);
  const __amdgpu_buffer_rsrc_t krs = __builtin_amdgcn_make_buffer_rsrc((void*)Kh, 0, seq * LDK * 2, 0x00020000);
  const __amdgpu_buffer_rsrc_t vrs = __builtin_amdgcn_make_buffer_rsrc((void*)Vh, 0, seq * LDV * 2, 0x00020000);
#define MLD_ISSUE(k0, bk, bv) do { \
    _Pragma("unroll") for (int k = 0; k < 3; ++k) __builtin_amdgcn_raw_ptr_buffer_load_lds(krs, (las_u32*)(K_lds + (bk) * SHM_K + (wu + 8 * k) * 1024), 16, ksrc[k], (k0) * LDK * 2, 0, 0); \
    _Pragma("unroll") for (int k = 0; k < 2; ++k) __builtin_amdgcn_raw_ptr_buffer_load_lds(vrs, (las_u32*)(V_lds + (bv) * SHM_V + (wu + 8 * k) * 1024), 16, vsrc[k], (k0) * LDV * 2, 0, 0); } while (0)
#define MLD_RD(d0_, A0_, A1_, QF_) do { const int c_ = 2 * (d0_) + hi; const int off_ = (c_ ^ sw) << 4; A0_ = *reinterpret_cast<const bf16x8*>(kb_ + off_); A1_ = *reinterpret_cast<const bf16x8*>(kb_ + 32 * 384 + off_); \
      if ((d0_) >= 8) QF_ = *reinterpret_cast<const bf16x8*>(qrow + (((2 * ((d0_) - 8) + hi) ^ qsw) << 4)); else QF_ = qr[(d0_) < 8 ? (d0_) : 0]; } while (0)
#define MLD_MM(A0_, A1_, QF_) do { p0 = __builtin_amdgcn_mfma_f32_32x32x16_bf16(A0_, QF_, p0, 0, 0, 0); p1 = __builtin_amdgcn_mfma_f32_32x32x16_bf16(A1_, QF_, p1, 0, 0, 0); } while (0)
#define MLD_S(t_) do { const int b_ = (t_) & 1; f32x16 p0 = f32x16{}, p1 = f32x16{}; \
      { const int sw = (r32 >> 1) & 7; const char* kb_ = K_lds + b_ * SHM_K + r32 * 384; \
        bf16x8 xa0, xa1, xq, ya0, ya1, yq; \
        MLD_RD(0, xa0, xa1, xq); \
        MLD_RD(1, ya0, ya1, yq); MLA_SBAR(); MLD_MM(xa0, xa1, xq); MLA_SBAR(); \
        MLD_RD(2, xa0, xa1, xq); MLA_SBAR(); MLD_MM(ya0, ya1, yq); MLA_SBAR(); \
        MLD_RD(3, ya0, ya1, yq); MLA_SBAR(); MLD_MM(xa0, xa1, xq); MLA_SBAR(); \
        MLD_RD(4, xa0, xa1, xq); MLA_SBAR(); MLD_MM(ya0, ya1, yq); MLA_SBAR(); \
        MLD_RD(5, ya0, ya1, yq); MLA_SBAR(); MLD_MM(xa0, xa1, xq); MLA_SBAR(); \
        MLD_RD(6, xa0, xa1, xq); MLA_SBAR(); MLD_MM(ya0, ya1, yq); MLA_SBAR(); \
        MLD_RD(7, ya0, ya1, yq); MLA_SBAR(); MLD_MM(xa0, xa1, xq); MLA_SBAR(); \
        MLD_RD(8, xa0, xa1, xq); MLA_SBAR(); MLD_MM(ya0, ya1, yq); MLA_SBAR(); \
        MLD_RD(9, ya0, ya1, yq); MLA_SBAR(); MLD_MM(xa0, xa1, xq); MLA_SBAR(); \
        MLD_RD(10, xa0, xa1, xq); MLA_SBAR(); MLD_MM(ya0, ya1, yq); MLA_SBAR(); \
        MLD_RD(11, ya0, ya1, yq); MLA_SBAR(); MLD_MM(xa0, xa1, xq); MLA_SBAR(); \
        MLD_MM(ya0, ya1, yq); } \
      float mn; partialSM(p0, p1, m_reg, mn, al); finishSM(p0, p1, al, l_reg, pa0, pa1, pa2, pa3); } while (0)
#define MLD_O(vslot_) do { if (__any(al < 1.f)) { if (hi == 0) al_l[r32] = al; asm volatile("s_waitcnt lgkmcnt(0)" ::: "memory"); \
        _Pragma("unroll") for (int d = 0; d < 4; ++d) _Pragma("unroll") for (int r = 0; r < 16; ++r) o[d][r] *= al_l[crow(r, hi)]; } \
      MLA_SBAR(); pv_d0(o, vb0 + (vslot_) * SHM_V, pa0, pa1, pa2, pa3); } while (0)
  const int NT = seq / KVBLK;
  MLD_ISSUE(0, 0, 0); asm volatile("s_waitcnt vmcnt(0)" ::: "memory"); __syncthreads();
  bf16x8 pa0 = {}, pa1 = {}, pa2 = {}, pa3 = {}; float al = 1.f;
  int vs_cur = 0;
  for (int j = 0; j <= NT; ++j) {
    const int vs_prev = vs_cur == 0 ? 2 : vs_cur - 1, vs_next = vs_cur == 2 ? 0 : vs_cur + 1;
    if (j + 1 < NT) MLD_ISSUE((j + 1) * KVBLK, (j + 1) & 1, vs_next);
    if (grp == 0) { if (j < NT) { MLD_S(j); MLD_O(vs_cur); } }
    else { if (j > 0) MLD_O(vs_prev); if (j < NT) MLD_S(j); }
    asm volatile("s_waitcnt vmcnt(0)" ::: "memory");
    __syncthreads();
    vs_cur = vs_next;
  }
  if (hi == 0) li_l[r32] = l_reg; asm volatile("s_waitcnt lgkmcnt(0)" ::: "memory");
  float rli[16];
#pragma unroll
  for (int r = 0; r < 16; ++r) rli[r] = __builtin_amdgcn_rcpf(li_l[crow(r, hi)]);
  bf16* Ow = Ob + (long)(wid * QBLK) * LDO;
#pragma unroll
  for (int r = 0; r < 16; ++r) { const int orow = crow(r, hi);
#pragma unroll
    for (int d0 = 0; d0 < 4; ++d0) Ow[(long)orow * LDO + d0 * 32 + r32] = (bf16)(cvtpk(o[d0][r] * rli[r], 0.f) & 0xffffu); }
  asm volatile("s_waitcnt vmcnt(0)" ::: "memory");
  __syncthreads();
#undef MLD_ISSUE
#undef MLD_S
#undef MLD_RD
#undef MLD_MM
#undef MLD_O
}
}
namespace wat {
typedef unsigned short bf16;
using bf16x8 = __attribute__((ext_vector_type(8))) short;
using s16x4  = __attribute__((ext_vector_type(4))) short;
using f32x4  = __attribute__((ext_vector_type(4))) float;
using u32x4  = __attribute__((ext_vector_type(4))) unsigned;
#define WAT_LAS __attribute__((address_space(3)))
__device__ __forceinline__ unsigned cvtpk(float lo, float hi) { unsigned r; asm volatile("v_cvt_pk_bf16_f32 %0, %1, %2" : "=v"(r) : "v"(lo), "v"(hi)); return r; }
__device__ __forceinline__ int kst_off(int row, int ch) { return row * 256 + ((ch ^ ((row & 3) | (((row >> 3) & 3) << 2))) << 4); }
__device__ __forceinline__ int vst_off(int row, int ch) { return (row >> 4) * 4096 + ((row >> 2) & 1) * 2048 + (ch >> 1) * 256 + ((row >> 3) & 1) * 128 + (row & 3) * 32 + (ch & 1) * 16; }
__device__ __forceinline__ int vrd_base(int R0, int lane) { const int g4 = lane >> 4, qa = (lane & 15) >> 2, p = lane & 3, gg = g4 + ((R0 >> 3) & 1); return ((R0 >> 4) + (gg >> 1)) * 4096 + (gg & 1) * 128 + qa * 32 + p * 8; }
__device__ __forceinline__ void qk_group(f32x4& sc0, f32x4& sc1, const WAT_LAS char* Kb, int Rg, const bf16x8* qf, int lane) {
    const int a = lane & 15, g4 = lane >> 4; const int row = Rg + 8 * (a >> 2) + (a & 3); const int xk = (row & 3) | (((row >> 3) & 3) << 2);
    const WAT_LAS char* p = Kb + row * 256;
    sc0 = f32x4{0.f, 0.f, 0.f, 0.f}; sc1 = f32x4{0.f, 0.f, 0.f, 0.f};
#pragma unroll
    for (int s = 0; s < 4; ++s) { const int off = ((4 * s + g4) ^ xk) << 4;
        const bf16x8 k0 = *(const WAT_LAS bf16x8*)(p + off), k1 = *(const WAT_LAS bf16x8*)(p + 4 * 256 + off);
        sc0 = __builtin_amdgcn_mfma_f32_16x16x32_bf16(k0, qf[s], sc0, 0, 0, 0);
        sc1 = __builtin_amdgcn_mfma_f32_16x16x32_bf16(k1, qf[s], sc1, 0, 0, 0); }
}
__device__ __forceinline__ bf16x8 p_frag(const f32x4 p0, const f32x4 p1) { u32x4 w = {cvtpk(p0[0], p0[1]), cvtpk(p0[2], p0[3]), cvtpk(p1[0], p1[1]), cvtpk(p1[2], p1[3])}; return *reinterpret_cast<bf16x8*>(&w); }
template <int OFF> __device__ __forceinline__ s16x4 tr_read(unsigned addr) { s16x4 r; asm volatile("ds_read_b64_tr_b16 %0, %1 offset:%2" : "=&v"(r) : "v"(addr), "i"(OFF) : "memory"); return r; }
template <int GOFF> __device__ __forceinline__ void pv_group(f32x4* o, unsigned vb, const bf16x8 pf) {
    s16x4 lo[8], hi[8];
#define WAT_TR(c) lo[c] = tr_read<GOFF + (c) * 256>(vb); hi[c] = tr_read<GOFF + 2048 + (c) * 256>(vb);
    WAT_TR(0) WAT_TR(1) WAT_TR(2) WAT_TR(3) WAT_TR(4) WAT_TR(5) WAT_TR(6) WAT_TR(7)
#undef WAT_TR
    asm volatile("s_waitcnt lgkmcnt(0)" ::: "memory"); __builtin_amdgcn_sched_barrier(0);
#pragma unroll
    for (int c = 0; c < 8; ++c) { const bf16x8 vfr = (bf16x8){lo[c][0], lo[c][1], lo[c][2], lo[c][3], hi[c][0], hi[c][1], hi[c][2], hi[c][3]};
        o[c] = __builtin_amdgcn_mfma_f32_16x16x32_bf16(pf, vfr, o[c], 0, 0, 0); }
}
}
constexpr int NWAVES = 8;
constexpr int BATCH = 2, SEQ = 8192, DM = 4096, M = BATCH * SEQ;
constexpr int EVEN_IN = 10688, ZLD = 10752;
constexpr int Z_CQ = 9216, Z_CKV = 10112, Z_KPE = 10624;
constexpr int QRANK = 896, KVRANK = 512, MLA_H = 16, MLA_QK = 192, MLA_NOPE = 128, MLA_ROPE = 64;
constexpr int DIL_H = 24, DIL_HPG = 8, HD = 128;
constexpr int NA_H = 32, GRID_W = 64, NA_ROWS = 8, NA_COLS = 16, GRID_ROWS = SEQ / GRID_W;
constexpr int DFF = 11008, EVEN_MIX = 3072;
constexpr float NORM_EPS = 1e-6f, LOG2E = 1.4426950408889634f;
constexpr float QS_MLA = 0.07216878364870322f * LOG2E;
constexpr float QS_HD = 0.08838834764831845f * LOG2E;
constexpr size_t MiB = 1u << 20;
constexpr size_t WS_CTL = 0, CTL_ZERO_BYTES = 64 * 1024;
constexpr size_t WS_ROPE = 1 * MiB;
constexpr size_t WS_RSTD = 4 * MiB;
constexpr size_t WS_SS = 5 * MiB;
constexpr size_t WS_WIN = 16 * MiB, WS_WUQ = 100 * MiB, WS_WUKV = 106 * MiB, WS_WEOUT = 110 * MiB, WS_WQKV = 134 * MiB, WS_WOOUT = 230 * MiB;
constexpr size_t WS_WFFN = 262 * MiB, FFN_W_BYTES = 86 * MiB;
constexpr size_t WS_XB = 778 * MiB;
constexpr size_t WS_R = 906 * MiB;
constexpr size_t R_Z = 0, R_Q = 336 * MiB, R_KV = 432 * MiB, R_K = 560 * MiB, R_OMIX = 656 * MiB, R_CQN = 656 * MiB, R_CKVN = 688 * MiB;
constexpr size_t R_A = 0, R_H2 = 344 * MiB;
constexpr size_t R_QKV = 0, R_O = 384 * MiB;
constexpr size_t R_DPO = 752 * MiB, R_DPM = 848 * MiB;
constexpr size_t WS_END = WS_R + 852 * MiB;
static_assert((size_t)ZLD * DM * 2 <= 84 * MiB && (size_t)DFF * DM * 2 == 86 * MiB && (size_t)M * ZLD * 2 == 336 * MiB && (size_t)M * DFF * 2 == 344 * MiB, "ws map");
constexpr int CW_BAR = 4096;
constexpr int RING_BYTES = 131072, LDS_BYTES = 163840, LDSCTL_OFF = LDS_BYTES - 1024, MISC_OFF = LDSCTL_OFF + 320;
constexpr int NA_TB_OFF = RING_BYTES + 1024, NA_OST_OFF = NA_TB_OFF + 2048;

#define GAS __attribute__((address_space(1)))
#define LAS __attribute__((address_space(3)))
typedef unsigned short bf16;
typedef unsigned v4u __attribute__((ext_vector_type(4)));
typedef unsigned v2u __attribute__((ext_vector_type(2)));
typedef float f32x4 __attribute__((ext_vector_type(4)));
#define LDS_WAIT() asm volatile("s_waitcnt lgkmcnt(0)" ::: "memory")
#define VM_WAIT() asm volatile("s_waitcnt vmcnt(0)" ::: "memory")
__device__ __forceinline__ unsigned f2bf(float f) { unsigned u = __builtin_bit_cast(unsigned, f); return (u + 0x7fffu + ((u >> 16) & 1u)) >> 16; }
__device__ __forceinline__ unsigned pk2(float lo, float hi) { return f2bf(lo) | (f2bf(hi) << 16); }
__device__ __forceinline__ float bflo(unsigned w) { return __uint_as_float(w << 16); }
__device__ __forceinline__ float bfhi(unsigned w) { return __uint_as_float(w & 0xffff0000u); }
__device__ __forceinline__ void unpack8(const v4u w, float* f) { f[0] = bflo(w.x); f[1] = bfhi(w.x); f[2] = bflo(w.y); f[3] = bfhi(w.y); f[4] = bflo(w.z); f[5] = bfhi(w.z); f[6] = bflo(w.w); f[7] = bfhi(w.w); }
__device__ __forceinline__ v4u pack8(const float* f) { v4u w; w.x = pk2(f[0], f[1]); w.y = pk2(f[2], f[3]); w.z = pk2(f[4], f[5]); w.w = pk2(f[6], f[7]); return w; }
__device__ __forceinline__ float wave_sum(float v) {
#pragma unroll
    for (int o = 1; o < 64; o <<= 1) v += __shfl_xor(v, o);
    return v;
}
__device__ __forceinline__ float sum16(float v) {
#pragma unroll
    for (int o = 1; o < 16; o <<= 1) v += __shfl_xor(v, o);
    return v;
}

#define XB_TMO      128
#define XB_XCNT(j)  (256  + 64 * (j))
#define XB_XSUB(j)  (1280 + 64 * (j))
#define XB_XGEN(j)  (2304 + 64 * (j))
#define XB_TOP      3328
#define XB_TOPGEN   3392
#define XCD_BAR_WORDS 3456
#define XB_SPIN_CAP (1u << 20)
__device__ __forceinline__ unsigned xb_ld(unsigned* p)              { return __hip_atomic_load(p, __ATOMIC_RELAXED, __HIP_MEMORY_SCOPE_AGENT); }
__device__ __forceinline__ unsigned xb_add(unsigned* p, unsigned v) { return __hip_atomic_fetch_add(p, v, __ATOMIC_RELAXED, __HIP_MEMORY_SCOPE_AGENT); }
__device__ __forceinline__ unsigned xb_xcc_id() { return (unsigned)__builtin_amdgcn_s_getreg((3 << 11) | 20) & 0xFu; }
#define XB_SPIN(cond, bar) do { unsigned _sp = 0; while (cond) { __builtin_amdgcn_s_sleep(1); \
    if ((++_sp & 255u) == 0u) { if (xb_ld(&(bar)[XB_TMO])) break; if (_sp > XB_SPIN_CAP) { atomicAdd(&(bar)[XB_TMO], 1u); break; } } } } while (0)
struct XcdBarrier { unsigned* bar; unsigned x; volatile LAS unsigned* st; };
__device__ __forceinline__ XcdBarrier xcd_barrier_post(unsigned* bar, volatile LAS unsigned* st) {
    XcdBarrier b; b.bar = bar; b.x = xb_xcc_id(); b.st = st;
    if (threadIdx.x == 0) (void)xb_add(&bar[XB_XCNT(b.x)], 1u);
    return b;
}
__device__ __forceinline__ void xcd_barrier_complete(unsigned* bar, unsigned x, unsigned& nloc, unsigned& nx) {
    const unsigned G = gridDim.x * gridDim.y * gridDim.z;
    unsigned sum, cnt, mine, sp = 0u;
    for (;;) {
        sum = 0u; cnt = 0u; mine = 0u;
#pragma unroll
        for (unsigned j = 0; j < 16; ++j) { const unsigned c = xb_ld(&bar[XB_XCNT(j)]); sum += c; cnt += (c > 0u) ? 1u : 0u; mine = (j == x) ? c : mine; }
        if (sum == G) break;
        __builtin_amdgcn_s_sleep(1);
        if ((++sp & 255u) == 0u) { if (xb_ld(&bar[XB_TMO])) break; if (sp > XB_SPIN_CAP) { atomicAdd(&bar[XB_TMO], 1u); break; } }
    }
    nloc = mine > 0u ? mine : 1u; nx = cnt > 0u ? cnt : 1u;
}
__device__ __forceinline__ void xcd_barrier(const XcdBarrier& b) {
    asm volatile("s_waitcnt vmcnt(0)" ::: "memory");
    __syncthreads();
    if (threadIdx.x == 0) {
        unsigned* bar = b.bar;
        __builtin_amdgcn_s_waitcnt(0);
        unsigned nloc = b.st[0], nx = b.st[1];
        if (nloc == 0u) { xcd_barrier_complete(bar, b.x, nloc, nx); b.st[0] = nloc; b.st[1] = nx; }
        const unsigned old = xb_add(&bar[XB_XSUB(b.x)], 1u);
        const unsigned gen = old / nloc;
        if (old + 1u == (gen + 1u) * nloc) {
            __builtin_amdgcn_fence(__ATOMIC_RELEASE, "agent");
            asm volatile("s_waitcnt vmcnt(0)" ::: "memory");
            const unsigned og = xb_add(&bar[XB_TOP], 1u);
            const unsigned tg = og / nx;
            if (og + 1u == (tg + 1u) * nx) xb_add(&bar[XB_TOPGEN], 1u);
            else XB_SPIN(xb_ld(&bar[XB_TOPGEN]) == tg, bar);
            __builtin_amdgcn_fence(__ATOMIC_ACQUIRE, "agent");
            xb_add(&bar[XB_XGEN(b.x)], 1u);
            asm volatile("s_waitcnt vmcnt(0)" ::: "memory");
        } else {
            XB_SPIN(xb_ld(&bar[XB_XGEN(b.x)]) == gen, bar);
            __builtin_amdgcn_fence(__ATOMIC_ACQUIRE, "agent");
            asm volatile("s_waitcnt vmcnt(0)" ::: "memory");
        }
    }
    __syncthreads();
}

struct Args { const float* in[24]; float* out; unsigned char* ws; int ph_lo, ph_hi; };
struct Frame { LAS unsigned char* lds; int tid, lane, wave, gw, ngw, G; };

struct P0Item { const float* W; int K, N; bf16* dst; const float* gain; int mode, r; };
__device__ __forceinline__ void p0_item_load(const P0Item& t, float (&v)[32], int lane) {
    const int nblk = t.N / 32, kb = t.r / nblk, nb = t.r % nblk, k0 = 64 * kb, n0 = 32 * nb;
    const float* p = t.W + (size_t)(k0 + (lane >> 5)) * t.N + n0 + (lane & 31);
#pragma unroll
    for (int i = 0; i < 32; ++i) v[i] = p[(size_t)(2 * i) * t.N];
}
__device__ __forceinline__ void p0_item_store(const P0Item& t, const float (&v)[32], LAS float* scr, int lane) {
    const int nblk = t.N / 32, kb = t.r / nblk, nb = t.r % nblk, k0 = 64 * kb, n0 = 32 * nb;
    const int drow0 = (t.mode == 1) ? (n0 >= 1472 ? n0 - 1472 : n0 + 9216)
                    : (t.mode >= 2) ? ((n0 >> 7) * 256 + (n0 & 127) + (t.mode == 3 ? 128 : 0)) : n0;
#pragma unroll
    for (int i = 0; i < 32; ++i) { const int kk = 2 * i + (lane >> 5); scr[kk * 33 + (lane & 31)] = v[i]; }
    LDS_WAIT(); asm volatile("" ::: "memory");
    const int c = lane & 7;
    f32x4 ga = {1.f, 1.f, 1.f, 1.f}, gb = {1.f, 1.f, 1.f, 1.f};
    if (t.gain) { ga = *(const f32x4*)(t.gain + k0 + 8 * c); gb = *(const f32x4*)(t.gain + k0 + 8 * c + 4); }
#pragma unroll
    for (int j = 0; j < 4; ++j) { const int n = (lane >> 3) + 8 * j; const LAS float* sp = scr + (8 * c) * 33 + n;
        v4u o; o.x = pk2(sp[0 * 33] * ga[0], sp[1 * 33] * ga[1]); o.y = pk2(sp[2 * 33] * ga[2], sp[3 * 33] * ga[3]); o.z = pk2(sp[4 * 33] * gb[0], sp[5 * 33] * gb[1]); o.w = pk2(sp[6 * 33] * gb[2], sp[7 * 33] * gb[3]);
        *(v4u*)(t.dst + (size_t)(drow0 + n) * t.K + k0 + 8 * c) = o; }
    LDS_WAIT(); asm volatile("" ::: "memory");
}
#ifndef MLA_UNIT
#define MLA_UNIT mla::attn_unit_d
#endif
constexpr int N_PHASES = 20;
#ifndef LB2
#define LB2 2
#endif
__global__ void __launch_bounds__(NWAVES * 64, LB2) mk_fwd(Args args) {
    extern __shared__ __attribute__((aligned(16))) unsigned char lds[];
    Frame F;
    F.lds = (LAS unsigned char*)lds;
    F.tid = threadIdx.x; F.lane = F.tid & 63; F.wave = __builtin_amdgcn_readfirstlane(F.tid >> 6);
    F.G = gridDim.x; F.gw = blockIdx.x * NWAVES + F.wave; F.ngw = F.G * NWAVES;
    const int lane = F.lane, l15 = lane & 15, grp = lane >> 4;
    unsigned char* ws = args.ws;
    unsigned* ctl = (unsigned*)(ws + WS_CTL);
    const float* x_in = args.in[0]; float* out = args.out;
    float* cosA = (float*)(ws + WS_ROPE); float* sinA = cosA + SEQ * 16; float* cosB = sinA + SEQ * 16; float* sinB = cosB + SEQ * 32;
    float* rstd = (float*)(ws + WS_RSTD); float* ss = (float*)(ws + WS_SS);
    bf16* Win_t = (bf16*)(ws + WS_WIN); bf16* Wuq_t = (bf16*)(ws + WS_WUQ); bf16* Wukv_t = (bf16*)(ws + WS_WUKV); bf16* Weout_t = (bf16*)(ws + WS_WEOUT);
    bf16* Wqkv_t = (bf16*)(ws + WS_WQKV); bf16* Woout_t = (bf16*)(ws + WS_WOOUT);
    bf16* xb = (bf16*)(ws + WS_XB);
    unsigned char* R = ws + WS_R;
    bf16* zb = (bf16*)(R + R_Z); bf16* qb = (bf16*)(R + R_Q); bf16* kvb = (bf16*)(R + R_KV); bf16* kb = (bf16*)(R + R_K); bf16* omix = (bf16*)(R + R_OMIX);
    bf16* cqn = (bf16*)(R + R_CQN); bf16* ckvn = (bf16*)(R + R_CKVN);
    bf16* aedge = (bf16*)(R + R_A); bf16* uedge = aedge + (size_t)(M / 256) * 4 * DFF; bf16* h2b = (bf16*)(R + R_H2);
    bf16* qkvb = (bf16*)(R + R_QKV); bf16* ob = (bf16*)(R + R_O);
    bf16* dpo = (bf16*)(R + R_DPO); float* dpm = (float*)(R + R_DPM);
    bf16* xl0 = (bf16*)(ws + WS_WIN); bf16* xl1 = (bf16*)(R + R_DPO) - (size_t)8192 * DM;

    for (int u = F.tid; u < (LDS_BYTES - LDSCTL_OFF) / 4; u += NWAVES * 64) ((LAS unsigned*)(F.lds + LDSCTL_OFF))[u] = 0u;
    __syncthreads();
    const int lo = args.ph_lo, hi = args.ph_hi;
    XcdBarrier bar; bar.bar = ctl + CW_BAR; bar.x = 0; bar.st = nullptr;
    if (hi - lo > 1) bar = xcd_barrier_post(ctl + CW_BAR, (volatile LAS unsigned*)(F.lds + MISC_OFF) + 8);
#ifndef PH_MASK
#define PH_MASK 0xFFFFFu
#endif
#define IN(k) ((((PH_MASK) >> (k)) & 1u) && lo <= (k) && (k) < hi)
#define SEAM(k) do { if (IN(k) && IN((k) + 1)) xcd_barrier(bar); } while (0)

    if (IN(0)) {
        LAS float* scr = (LAS float*)(F.lds + F.wave * 16384);
        constexpr int I_WIN = (DM / 64) * (EVEN_IN / 32), I_UQ = (QRANK / 64) * (3072 / 32), I_UKV = (KVRANK / 64) * (4096 / 32), I_EOUT = (EVEN_MIX / 64) * (DM / 32);
        constexpr int I_QKV = (DM / 64) * (12288 / 32), I_OOUT = (DM / 64) * (DM / 32), I_GU = (DM / 64) * (DFF / 32), I_DN = (DFF / 64) * (DM / 32);
        constexpr int NITEMS = I_WIN + I_UQ + I_UKV + I_EOUT + I_QKV + I_OOUT + 2 * (2 * I_GU + I_DN);
#define P0_DECODE(it_, T_) do { int r = (it_); T_.gain = nullptr; T_.mode = 0; \
            if (r < I_WIN) { T_.W = args.in[2]; T_.K = DM; T_.N = EVEN_IN; T_.dst = Win_t; T_.gain = args.in[1]; T_.mode = 1; } \
            else if ((r -= I_WIN) < I_UQ) { T_.W = args.in[5]; T_.K = QRANK; T_.N = 3072; T_.dst = Wuq_t; T_.gain = args.in[3]; } \
            else if ((r -= I_UQ) < I_UKV) { T_.W = args.in[6]; T_.K = KVRANK; T_.N = 4096; T_.dst = Wukv_t; T_.gain = args.in[4]; } \
            else if ((r -= I_UKV) < I_EOUT) { T_.W = args.in[11]; T_.K = EVEN_MIX; T_.N = DM; T_.dst = Weout_t; } \
            else if ((r -= I_EOUT) < I_QKV) { T_.W = args.in[13]; T_.K = DM; T_.N = 12288; T_.dst = Wqkv_t; T_.gain = args.in[12]; } \
            else if ((r -= I_QKV) < I_OOUT) { T_.W = args.in[17]; T_.K = DM; T_.N = DM; T_.dst = Woout_t; } \
            else { r -= I_OOUT; const int layer = r / (2 * I_GU + I_DN); r -= layer * (2 * I_GU + I_DN); \
                bf16* wl = (bf16*)(ws + WS_WFFN + (size_t)layer * 3 * FFN_W_BYTES); \
                if (r < I_GU) { T_.W = args.in[19] + (size_t)layer * DM * DFF; T_.K = DM; T_.N = DFF; T_.dst = wl; T_.gain = args.in[18] + layer * DM; T_.mode = 2; } \
                else if ((r -= I_GU) < I_GU) { T_.W = args.in[20] + (size_t)layer * DM * DFF; T_.K = DM; T_.N = DFF; T_.dst = wl; T_.gain = args.in[18] + layer * DM; T_.mode = 3; } \
                else { r -= I_GU; T_.W = args.in[23] + (size_t)layer * DFF * DM; T_.K = DFF; T_.N = DM; T_.dst = (bf16*)((unsigned char*)wl + 2 * FFN_W_BYTES); } } \
            T_.r = r; } while (0)
        {
            float va[32], vb[32]; P0Item ta, tb_;
            int it = F.gw;
            if (it < NITEMS) { P0_DECODE(it, ta); p0_item_load(ta, va, lane); }
            while (it < NITEMS) {
                const int it1 = it + F.ngw, it2 = it1 + F.ngw;
                if (it1 < NITEMS) { P0_DECODE(it1, tb_); p0_item_load(tb_, vb, lane); }
                p0_item_store(ta, va, scr, lane);
                if (it1 >= NITEMS) break;
                if (it2 < NITEMS) { P0_DECODE(it2, ta); p0_item_load(ta, va, lane); }
                p0_item_store(tb_, vb, scr, lane);
                it = it2;
            }
        }
#undef P0_DECODE
        const int gtid = blockIdx.x * (NWAVES * 64) + F.tid, nthr = F.G * NWAVES * 64;
        for (int i = gtid; i < (ZLD - 10688) * DM / 8; i += nthr) ((v4u*)(Win_t + (size_t)10688 * DM))[i] = (v4u){0u, 0u, 0u, 0u};
        for (int i = gtid; i < SEQ * 48; i += nthr) {
            const bool isB = i >= SEQ * 16; const int ii = isB ? i - SEQ * 16 : i; const int pos = isB ? (ii >> 5) : (ii >> 4), k = isB ? (ii & 31) : (ii & 15);
            const double c1 = isB ? 0.6636012376960885 : 0.44036660267178046;
            double p = 1.0; for (int j = 0; j < k; ++j) p *= c1;
            const float inv = (float)p; const float ang = (float)pos * inv;
            const double rev = (double)ang * 0.15915494309189535; const float fr = (float)(rev - __builtin_rint(rev));
            const float sv = __builtin_amdgcn_sinf(fr), cv = __builtin_amdgcn_cosf(fr);
            if (isB) { cosB[ii] = cv; sinB[ii] = sv; } else { cosA[ii] = cv; sinA[ii] = sv; }
        }
#pragma unroll 2
        for (int row = F.gw; row < M; row += F.ngw) {
            const f32x4* xr = (const f32x4*)(x_in + (size_t)row * DM) + lane; v2u* xo = (v2u*)(xb + (size_t)row * DM) + lane; float s = 0.f;
#pragma unroll 4
            for (int j = 0; j < 16; ++j) { const f32x4 v = xr[64 * j]; s += (v.x * v.x + v.y * v.y) + (v.z * v.z + v.w * v.w); v2u w; w.x = pk2(v.x, v.y); w.y = pk2(v.z, v.w); xo[64 * j] = w; }
            s = wave_sum(s);
            if (lane == 0) rstd[row] = 1.0f / sqrtf(s * (1.0f / DM) + NORM_EPS);
        }
    }
    SEAM(0);
    if (IN(1)) {
        pg8::Gemm g{xb, Win_t, M, ZLD, DM, DM}; pg8::StaticOrder S; S.init(M, ZLD, F.G, (int)blockIdx.x);
        pg8::EpiHeadNorm E{zb, ZLD, rstd, args.in[9], args.in[10], QS_HD, 12, 12, (PG8_LAS float*)(F.lds + NA_TB_OFF), cosA, sinA, SEQ, ss};
        pg8::gemm_phase<pg8::EpiHeadNorm, pg8::StaticOrder, true, true>(F.lds, g, S, E);
    }
    SEAM(1);
    if (IN(3)) {
        {
            const int pm_lo = F.G == 256 ? 8 * ((int)blockIdx.x & 7) + (((int)blockIdx.x >> 3) & 7) : 0, pm_hi = F.G == 256 ? pm_lo + 1 : M / 256;
            for (int pmi = pm_lo; pmi < pm_hi; ++pmi) {
                const int row = pmi * 256 + (F.tid >> 1); const f32x4* sp = (const f32x4*)(ss + (size_t)row * 64) + ((F.tid & 1) ? 7 : 0);
                f32x4 a = sp[0] + sp[1] + sp[2] + sp[3]; if ((F.tid & 1) == 0) a += sp[4] + sp[5] + sp[6];
                const float tot = (a[0] + a[1]) + (a[2] + a[3]);
                rstd[((F.tid & 1) ? 2 * M : M) + row] = 1.0f / sqrtf(tot * ((F.tid & 1) ? 1.0f / KVRANK : 1.0f / QRANK) + NORM_EPS); }
            asm volatile("s_waitcnt vmcnt(0)" ::: "memory"); __syncthreads();
        }
        { pg8::Gemm g{zb + Z_CQ, Wuq_t, M, 3072, QRANK, ZLD}; pg8::StaticOrder S; S.init(M, 3072, F.G, (int)blockIdx.x); pg8::EpiScaleBf16 E{qb, 3072, rstd + M};
          pg8::gemm_phase<pg8::EpiScaleBf16, pg8::StaticOrder, true, true>(F.lds, g, S, E); }
        { pg8::Gemm g{zb + Z_CKV, Wukv_t, M, 4096, KVRANK, ZLD}; pg8::StaticOrder S; S.init(M, 4096, F.G, (int)blockIdx.x); pg8::EpiScaleBf16 E{kvb, 4096, rstd + 2 * M};
          pg8::gemm_phase<pg8::EpiScaleBf16, pg8::StaticOrder, true, true>(F.lds, g, S, E); }
        {
            WAT_LAS char* L = (WAT_LAS char*)F.lds;
            const int NU = BATCH * 3 * DIL_HPG * 64;
            const int u0 = (int)(((long)NU * blockIdx.x) / F.G), u1 = (int)(((long)NU * (blockIdx.x + 1)) / F.G);
            const int row16 = F.tid >> 4, ch16 = F.tid & 15, kso = wat::kst_off(row16, ch16), vso = wat::vst_off(row16, ch16);
            const int w = F.wave, q = lane & 15, g4 = lane >> 4, Rw = 32 * (w >> 1);
            v4u st[8];
#define DL_GEOM(u_) const int blk_ = (u_) & 63, j_ = ((u_) >> 6) & 7, bg_ = (u_) >> 9, g_ = bg_ % 3, b_ = bg_ / 3, sh_ = 2 * g_, d_ = 1 << sh_, Ld_ = SEQ >> sh_, \
            r_ = blk_ >> (6 - sh_), p0_ = (blk_ & ((64 >> sh_) - 1)) * 128, head_ = 8 * g_ + j_;
#define DL_LOAD(u_, s_) do { DL_GEOM(u_) const bf16* base_ = zb + (size_t)(b_ * SEQ + r_) * ZLD + ((s_) ? 6144 : 3072) + head_ * HD + ch16 * 8; \
            _Pragma("unroll") for (int k = 0; k < 8; ++k) { const int kp_ = min(max(p0_ - 64 + row16 + 32 * k, 0), Ld_ - 1); st[k] = *(const v4u*)(base_ + (size_t)(kp_ << sh_) * ZLD); } } while (0)
#define DL_WRITE(s_) do { WAT_LAS char* dd_ = L + (s_) * 65536 + ((s_) ? vso : kso); _Pragma("unroll") for (int k = 0; k < 8; ++k) *(WAT_LAS v4u*)(dd_ + k * 32 * 256) = st[k]; } while (0)
#define DL_END(un_, sn_, un2_, sn2_) do { if ((un_) < u1) { VM_WAIT(); DL_WRITE(sn_); } __syncthreads(); if ((un2_) < u1) DL_LOAD(un2_, sn2_); } while (0)
            if (u0 < u1) { DL_LOAD(u0, 0); VM_WAIT(); DL_WRITE(0); __syncthreads(); DL_LOAD(u0, 1); }
            for (int u = u0; u < u1; ++u) {
                DL_GEOM(u)
                wat::bf16x8 qf[4]; wat::f32x4 sc[5][2]; wat::bf16x8 pf[5]; wat::f32x4 o[8]; float linv = 0.f, mrow = 0.f, lrow = 0.f;
                const int qp = p0_ + 16 * w + q; const size_t qtok = (size_t)(b_ * SEQ + r_) + ((size_t)qp << sh_);
                {
                    const bf16* qptr = zb + qtok * ZLD + head_ * HD + 8 * g4;
#pragma unroll
                    for (int s = 0; s < 4; ++s) qf[s] = *(const wat::bf16x8*)(qptr + 32 * s);
#pragma unroll
                    for (int gi = 0; gi < 5; ++gi) wat::qk_group(sc[gi][0], sc[gi][1], L, Rw + 32 * gi, qf, lane);
                    float m = -1e30f;
#pragma unroll
                    for (int gi = 0; gi < 5; ++gi)
#pragma unroll
                        for (int j = 0; j < 8; ++j) { const int lr = Rw + 32 * gi + 8 * g4 + j, kp = p0_ - 64 + lr, dq = kp - qp; const bool ok = dq >= -64 && dq <= 64 && kp >= 0 && kp < Ld_;
                            const float v = ok ? sc[gi][j >> 2][j & 3] : -1e30f; sc[gi][j >> 2][j & 3] = v; m = fmaxf(m, v); }
                    m = fmaxf(m, __shfl_xor(m, 16)); m = fmaxf(m, __shfl_xor(m, 32));
                    float l = 0.f;
#pragma unroll
                    for (int gi = 0; gi < 5; ++gi) {
#pragma unroll
                        for (int j = 0; j < 8; ++j) { const float sv = sc[gi][j >> 2][j & 3]; const float v = sv > -1e29f ? __builtin_amdgcn_exp2f(sv - m) : 0.f; sc[gi][j >> 2][j & 3] = v; l += v; }
                        pf[gi] = wat::p_frag(sc[gi][0], sc[gi][1]); }
                    l += __shfl_xor(l, 16); l += __shfl_xor(l, 32); linv = 1.0f / l; mrow = m; lrow = l;
#pragma unroll
                    for (int c = 0; c < 8; ++c) o[c] = wat::f32x4{0.f, 0.f, 0.f, 0.f};
                }
                DL_END(u, 1, u + 1, 0);
                {
                    const unsigned vb = (unsigned)(uintptr_t)(L + 65536) + (unsigned)wat::vrd_base(Rw, lane);
                    wat::pv_group<0>(o, vb, pf[0]); wat::pv_group<8192>(o, vb, pf[1]); wat::pv_group<16384>(o, vb, pf[2]); wat::pv_group<24576>(o, vb, pf[3]); wat::pv_group<32768>(o, vb, pf[4]);
                    WAT_LAS char* ost = L + NA_OST_OFF + w * 2304;
                    float li[4];
#pragma unroll
                    for (int r = 0; r < 4; ++r) li[r] = __shfl(linv, 4 * g4 + r);
                    const size_t tok_r = (size_t)(b_ * SEQ + r_) + ((size_t)(p0_ + 16 * w + g4) << sh_);
#pragma unroll
                    for (int hf = 0; hf < 2; ++hf) {
#pragma unroll
                        for (int r = 0; r < 4; ++r)
#pragma unroll
                            for (int c = 0; c < 4; ++c) *(WAT_LAS unsigned short*)(ost + (4 * g4 + r) * 144 + (16 * c + q) * 2) = (unsigned short)(wat::cvtpk(o[4 * hf + c][r] * li[r], 0.f) & 0xffffu);
                        asm volatile("s_waitcnt lgkmcnt(0)" ::: "memory");
#pragma unroll
                        for (int k = 0; k < 2; ++k) { const int rq = g4 + 4 * (2 * k + (q >> 3)); const v4u v = *(const WAT_LAS v4u*)(ost + rq * 144 + (q & 7) * 16);
                            const size_t tk = tok_r + ((size_t)(4 * (2 * k + (q >> 3))) << sh_);
                            *(v4u*)(dpo + ((tk * DIL_HPG + j_) * 3 + g_) * HD + 64 * hf + (q & 7) * 8) = v; }
                        asm volatile("s_waitcnt lgkmcnt(0)" ::: "memory");
                    }
                    if (g4 == 0) { float* pmp = dpm + ((qtok * DIL_HPG + j_) * 3 + g_) * 2; pmp[0] = mrow; pmp[1] = lrow; }
                }
                DL_END(u + 1, 0, u + 1, 1);
            }
#undef DL_GEOM
#undef DL_LOAD
#undef DL_WRITE
#undef DL_END
        }
    }
    SEAM(3);
    if (IN(4)) {
        const float* qn = args.in[7]; const float* kn = args.in[8];
        float gq[12], gk[12];
#pragma unroll
        for (int k = 0; k < 3; ++k)
#pragma unroll
            for (int j = 0; j < 4; ++j) { gq[4 * k + j] = qn[64 * k + 4 * l15 + j] * QS_MLA; gk[4 * k + j] = kn[64 * k + 4 * l15 + j]; }
#pragma unroll 2
        for (int row = F.gw; row < M; row += F.ngw) {
            const int pos = row & (SEQ - 1);
            float cr[4], sr[4];
#pragma unroll
            for (int j = 0; j < 4; ++j) { cr[j] = cosB[pos * 32 + 4 * (l15 & 7) + j]; sr[j] = sinB[pos * 32 + 4 * (l15 & 7) + j]; if (l15 < 8) sr[j] = -sr[j]; }
            const v2u kpe = *(const v2u*)(zb + (size_t)row * ZLD + Z_KPE + 4 * l15);
#pragma unroll
            for (int it = 0; it < 4; ++it) {
                const int h = 4 * it + grp;
                {
                    const bf16* p = kvb + (size_t)row * 4096 + h * 256 + 4 * l15; v2u w[3];
                    w[0] = *(const v2u*)p; w[1] = *(const v2u*)(p + 64); w[2] = kpe;
                    float v[12];
#pragma unroll
                    for (int k = 0; k < 3; ++k) { v[4 * k] = bflo(w[k].x); v[4 * k + 1] = bfhi(w[k].x); v[4 * k + 2] = bflo(w[k].y); v[4 * k + 3] = bfhi(w[k].y); }
                    float s = 0.f;
#pragma unroll
                    for (int e = 0; e < 12; ++e) s += v[e] * v[e];
                    s = sum16(s); const float rs = 1.0f / sqrtf(s * (1.0f / MLA_QK) + NORM_EPS);
#pragma unroll
                    for (int e = 0; e < 12; ++e) v[e] = v[e] * rs * gk[e];
#pragma unroll
                    for (int j = 0; j < 4; ++j) { const float yp = __shfl_xor(v[8 + j], 8); v[8 + j] = v[8 + j] * cr[j] + yp * sr[j]; }
                    bf16* o_ = kb + (size_t)row * 3072 + h * MLA_QK + 4 * l15;
#pragma unroll
                    for (int k = 0; k < 3; ++k) { v2u o; o.x = pk2(v[4 * k], v[4 * k + 1]); o.y = pk2(v[4 * k + 2], v[4 * k + 3]); *(v2u*)(o_ + 64 * k) = o; }
                }
            }
#pragma unroll
            for (int it = 0; it < 2; ++it) {
                const int jh = 4 * it + grp; const size_t pb = ((size_t)row * DIL_HPG + jh) * 3;
                const float m0 = dpm[pb * 2 + 0], l0 = dpm[pb * 2 + 1], m1 = dpm[pb * 2 + 2], l1 = dpm[pb * 2 + 3], m2 = dpm[pb * 2 + 4], l2 = dpm[pb * 2 + 5];
                const float mm = fmaxf(m0, fmaxf(m1, m2)); const float w0 = __builtin_amdgcn_exp2f(m0 - mm) * l0, w1 = __builtin_amdgcn_exp2f(m1 - mm) * l1, w2 = __builtin_amdgcn_exp2f(m2 - mm) * l2;
                const float rw = 1.0f / (w0 + w1 + w2);
                float a0[8], a1[8], a2[8], x[8];
                unpack8(*(const v4u*)(dpo + (pb + 0) * HD + 8 * l15), a0); unpack8(*(const v4u*)(dpo + (pb + 1) * HD + 8 * l15), a1); unpack8(*(const v4u*)(dpo + (pb + 2) * HD + 8 * l15), a2);
#pragma unroll
                for (int j = 0; j < 8; ++j) x[j] = (w0 * a0[j] + w1 * a1[j] + w2 * a2[j]) * rw;
                *(v4u*)(omix + (size_t)row * 3072 + 2048 + jh * HD + 8 * l15) = pack8(x);
            }
        }
    }
    SEAM(4);
    if (IN(5)) {
        for (int i = 0; i * F.G + (int)blockIdx.x < BATCH * MLA_H * (SEQ / 256); ++i) {
            const int c = (int)blockIdx.x; int bh = i * 8 + (c & 7), qblk = c >> 3;
            if (F.G != 256) { const int u = i * F.G + c; bh = u >> 5; qblk = u & 31; }
            const int b = bh >> 4, h = bh & 15; const size_t r0 = (size_t)b * SEQ;
            MLA_UNIT(qb + (r0 + (size_t)qblk * 256) * 3072 + h * MLA_QK, kb + r0 * 3072 + h * MLA_QK, kvb + r0 * 4096 + h * 256 + 128,
                              omix + (r0 + (size_t)qblk * 256) * 3072 + h * HD, SEQ, (char*)lds, args.in[7], QS_MLA, NORM_EPS, cosB, sinB, qblk * 256);
        }
    }
    SEAM(5);
    if (IN(6)) {
        pg8::Gemm g{omix, Weout_t, M, DM, EVEN_MIX, EVEN_MIX}; pg8::StaticOrder S; S.init(M, DM, F.G, (int)blockIdx.x); pg8::EpiResidT<0> E{x_in, out, xb, xl0, xl1, ss, DM};
        pg8::gemm_phase<pg8::EpiResidT<0>, pg8::StaticOrder, true, true>(F.lds, g, S, E);
    }
    SEAM(6);
#define RSTD_PHASE() do { for (int row = F.gw; row < M; row += F.ngw) { const float s = wave_sum(ss[(size_t)row * 64 + lane]); if (lane == 0) rstd[row] = 1.0f / sqrtf(s * (1.0f / DM) + NORM_EPS); } } while (0)
#define FFN_GATEUP(layer) do { const bf16* wl = (const bf16*)(ws + WS_WFFN + (size_t)(layer) * 3 * FFN_W_BYTES); \
        pg8::Gemm g{xb, wl, M, 2 * DFF, DM, DM}; pg8::StaticOrder S; S.init(M, 2 * DFF, F.G, (int)blockIdx.x, DM / 64, (float*)(R + (size_t)(16 + 48 * (layer)) * MiB), ctl + 8192 + 2048 * (1 + (layer))); \
        pg8::EpiGateUp E{h2b, rstd, args.in[21] + (size_t)(layer) * 3 * DFF, args.in[22] + (size_t)(layer) * DFF, DFF, aedge, uedge, (PG8_LAS float*)(F.lds + NA_TB_OFF)}; \
        pg8::gemm_phase<pg8::EpiGateUp, pg8::StaticOrder, true, true, true>(F.lds, g, S, E); } while (0)
#define FFN_FIX(layer) do { const float* cwp = args.in[21] + (size_t)(layer) * 3 * DFF; const float* cbp = args.in[22] + (size_t)(layer) * DFF; \
        const int gtid = blockIdx.x * (NWAVES * 64) + F.tid, nthr = F.G * NWAVES * 64; \
        for (int i = gtid; i < (M / 256) * 2 * (DFF / 8); i += nthr) { const int c8 = i % (DFF / 8), e = (i / (DFF / 8)) & 1, pm = i / (2 * (DFF / 8)); const int ch = c8 * 8; \
            const int row = pm * 256 + (e ? 255 : 0), t = row & (SEQ - 1); const v4u z4 = {0u, 0u, 0u, 0u}; \
            const v4u cur = *(const v4u*)(aedge + ((size_t)pm * 4 + (e ? 3 : 0)) * DFF + ch); \
            const v4u prv = e ? *(const v4u*)(aedge + ((size_t)pm * 4 + 2) * DFF + ch) : (t > 0 ? *(const v4u*)(aedge + ((size_t)(pm - 1) * 4 + 3) * DFF + ch) : z4); \
            const v4u nxt = e ? (t < SEQ - 1 ? *(const v4u*)(aedge + ((size_t)(pm + 1) * 4 + 0) * DFF + ch) : z4) : *(const v4u*)(aedge + ((size_t)pm * 4 + 1) * DFF + ch); \
            const v4u upv = *(const v4u*)(uedge + ((size_t)pm * 2 + e) * DFF + ch); \
            const unsigned cu_[4] = {cur.x, cur.y, cur.z, cur.w}, pr_[4] = {prv.x, prv.y, prv.z, prv.w}, nx_[4] = {nxt.x, nxt.y, nxt.z, nxt.w}, up_[4] = {upv.x, upv.y, upv.z, upv.w}; \
            float hv[8]; \
            _Pragma("unroll") for (int j = 0; j < 8; ++j) { \
                const float fm = (j & 1) ? bfhi(pr_[j >> 1]) : bflo(pr_[j >> 1]), fz = (j & 1) ? bfhi(cu_[j >> 1]) : bflo(cu_[j >> 1]), fn = (j & 1) ? bfhi(nx_[j >> 1]) : bflo(nx_[j >> 1]), fu = (j & 1) ? bfhi(up_[j >> 1]) : bflo(up_[j >> 1]); \
                const float gg = cwp[ch + j] * fm + cwp[DFF + ch + j] * fz + cwp[2 * DFF + ch + j] * fn + cbp[ch + j]; \
                const float ee = __builtin_amdgcn_exp2f(-1.4426950408889634f * gg); hv[j] = gg * __builtin_amdgcn_rcpf(1.0f + ee) * fu; } \
            v4u o; o.x = pk2(hv[0], hv[1]); o.y = pk2(hv[2], hv[3]); o.z = pk2(hv[4], hv[5]); o.w = pk2(hv[6], hv[7]); \
            *(v4u*)(h2b + (size_t)row * DFF + ch) = o; } } while (0)
#define FFN_DOWN(layer) do { const bf16* wl = (const bf16*)(ws + WS_WFFN + (size_t)(layer) * 3 * FFN_W_BYTES + 2 * FFN_W_BYTES); \
        pg8::Gemm g{h2b, wl, M, DM, DFF, DFF}; pg8::StaticOrder S; S.init(M, DM, F.G, (int)blockIdx.x); pg8::EpiResidT<(layer) == 0 ? 1 : 2> E{nullptr, out, xb, xl0, xl1, ss, DM}; \
        pg8::gemm_phase<pg8::EpiResidT<(layer) == 0 ? 1 : 2>, pg8::StaticOrder, true, true>(F.lds, g, S, E); } while (0)
    if (IN(7)) RSTD_PHASE();
    SEAM(7);
    if (IN(8)) FFN_GATEUP(0);
    SEAM(8);
    if (IN(9)) FFN_FIX(0);
    SEAM(9);
    if (IN(10)) FFN_DOWN(0);
    SEAM(10);
    if (IN(11)) RSTD_PHASE();
    SEAM(11);
    if (IN(12)) {
        pg8::Gemm g{xb, Wqkv_t, M, 12288, DM, DM}; pg8::StaticOrder S; S.init(M, 12288, F.G, (int)blockIdx.x); pg8::EpiHeadNorm E{qkvb, 12288, rstd, args.in[14], args.in[15], QS_HD, 16, 16, (PG8_LAS float*)(F.lds + NA_TB_OFF), nullptr, nullptr, SEQ};
        pg8::gemm_phase<pg8::EpiHeadNorm, pg8::StaticOrder, true, true>(F.lds, g, S, E);
    }
    SEAM(12);
    if (IN(14)) {
        const float* rpb = args.in[16];
        WAT_LAS char* L = (WAT_LAS char*)F.lds;
        WAT_LAS float* tb = (WAT_LAS float*)(L + NA_TB_OFF);
        const int NU = BATCH * NA_H * GRID_ROWS;
        const int u0 = (int)(((long)NU * blockIdx.x) / F.G), u1 = (int)(((long)NU * (blockIdx.x + 1)) / F.G);
        const int row16 = F.tid >> 4, ch16 = F.tid & 15, kso = wat::kst_off(row16, ch16), vso = wat::vst_off(row16, ch16);
        const int w = F.wave, q = lane & 15, g4 = lane >> 4;
        const int cg = w & 3, kc0 = min(max(16 * cg - 8, 0), 32), gc = 16 * cg + q, cs = min(max(gc - 8, 0), 48);
        unsigned vmask = 0;
#pragma unroll
        for (int j = 0; j < 8; ++j) { const int kc = kc0 + 8 * g4 + j; if (kc >= cs && kc < cs + 16) vmask |= 1u << j; }
        const int bcol = kc0 + 8 * g4 - gc + 15;
        v4u st[8]; int cur_h = -1;
#define NA_GEOM(u_, s_) const int bh_ = (u_) >> 7, i_ = (u_) & 127, b_ = bh_ >> 5, h_ = bh_ & 31, rs_ = min(max(i_ - 4, 0), GRID_ROWS - 8); \
        const bf16* src_ = qkvb + (size_t)(b_ * SEQ + (rs_ + 4 * ((s_) & 1)) * GRID_W + row16) * 12288 + ((s_) < 2 ? 4096 : 8192) + h_ * HD + ch16 * 8;
#define NA_LOAD(u_, s_) do { NA_GEOM(u_, s_) _Pragma("unroll") for (int k = 0; k < 8; ++k) st[k] = *(const v4u*)(src_ + (size_t)k * 32 * 12288); } while (0)
#define NA_WRITE(s_) do { WAT_LAS char* d_ = L + ((s_) & 1) * 65536 + ((s_) < 2 ? kso : vso); _Pragma("unroll") for (int k = 0; k < 8; ++k) *(WAT_LAS v4u*)(d_ + k * 32 * 256) = st[k]; } while (0)
#define NA_END(un_, sn_, un2_, sn2_) do { if ((un_) < u1) { VM_WAIT(); NA_WRITE(sn_); } __syncthreads(); if ((un2_) < u1) NA_LOAD(un2_, sn2_); } while (0)
        if (u0 < u1) { NA_LOAD(u0, 0); VM_WAIT(); NA_WRITE(0); __syncthreads(); NA_LOAD(u0, 1); }
        for (int u = u0; u < u1; ++u) {
            const int bh = u >> 7, gi = u & 127, b = bh >> 5, h = bh & 31, rs0 = min(max(gi - 4, 0), GRID_ROWS - 8);
            wat::bf16x8 qf[4]; wat::f32x4 sc[8][2]; wat::bf16x8 pf[8]; wat::f32x4 o[8]; float linv = 0.f;
            if (h != cur_h) { for (int t = F.tid; t < 465; t += NWAVES * 64) tb[t] = rpb[(size_t)h * 465 + t] * LOG2E; cur_h = h; }
            if (w < 4) {
                const bf16* qp = qkvb + (size_t)(b * SEQ + gi * GRID_W + gc) * 12288 + h * HD + 8 * g4;
#pragma unroll
                for (int s = 0; s < 4; ++s) qf[s] = *(const wat::bf16x8*)(qp + 32 * s);
#pragma unroll
                for (int g = 0; g < 4; ++g) wat::qk_group(sc[g][0], sc[g][1], L, g * 64 + kc0, qf, lane);
            }
            NA_END(u, 1, u, 2);
            if (w < 4) {
#pragma unroll
                for (int g = 0; g < 4; ++g) wat::qk_group(sc[4 + g][0], sc[4 + g][1], L + 65536, g * 64 + kc0, qf, lane);
                float m = -1e30f;
#pragma unroll
                for (int kr = 0; kr < 8; ++kr) { const WAT_LAS float* tr_ = tb + (rs0 + kr - gi + NA_ROWS - 1) * 31 + bcol;
#pragma unroll
                    for (int j = 0; j < 8; ++j) { const bool ok = (vmask >> j) & 1u; const float bias = ok ? tr_[j] : 0.f; const float v = ok ? sc[kr][j >> 2][j & 3] + bias : -1e30f; sc[kr][j >> 2][j & 3] = v; m = fmaxf(m, v); } }
                m = fmaxf(m, __shfl_xor(m, 16)); m = fmaxf(m, __shfl_xor(m, 32));
                float l = 0.f;
#pragma unroll
                for (int kr = 0; kr < 8; ++kr) {
#pragma unroll
                    for (int j = 0; j < 8; ++j) { const float v = ((vmask >> j) & 1u) ? __builtin_amdgcn_exp2f(sc[kr][j >> 2][j & 3] - m) : 0.f; sc[kr][j >> 2][j & 3] = v; l += v; }
                    pf[kr] = wat::p_frag(sc[kr][0], sc[kr][1]); }
                l += __shfl_xor(l, 16); l += __shfl_xor(l, 32); linv = 1.0f / l;
#pragma unroll
                for (int c = 0; c < 8; ++c) o[c] = wat::f32x4{0.f, 0.f, 0.f, 0.f};
            }
            NA_END(u, 2, u, 3);
            if (w < 4) {
                { const unsigned vb = (unsigned)(uintptr_t)L + (unsigned)wat::vrd_base(kc0, lane); wat::pv_group<0>(o, vb, pf[0]); wat::pv_group<16384>(o, vb, pf[1]); wat::pv_group<32768>(o, vb, pf[2]); wat::pv_group<49152>(o, vb, pf[3]); }
            }
            NA_END(u, 3, u + 1, 0);
            if (w < 4) {
                { const unsigned vb = (unsigned)(uintptr_t)(L + 65536) + (unsigned)wat::vrd_base(kc0, lane); wat::pv_group<0>(o, vb, pf[4]); wat::pv_group<16384>(o, vb, pf[5]); wat::pv_group<32768>(o, vb, pf[6]); wat::pv_group<49152>(o, vb, pf[7]); }
                WAT_LAS char* ost = L + NA_OST_OFF + w * 4352;
#pragma unroll
                for (int r = 0; r < 4; ++r) { const float li = __shfl(linv, 4 * g4 + r);
#pragma unroll
                    for (int c = 0; c < 8; ++c) *(WAT_LAS unsigned short*)(ost + (4 * g4 + r) * 272 + (16 * c + q) * 2) = (unsigned short)(wat::cvtpk(o[c][r] * li, 0.f) & 0xffffu); }
                asm volatile("s_waitcnt lgkmcnt(0)" ::: "memory");
#pragma unroll
                for (int k = 0; k < 4; ++k) { const int rq = g4 + 4 * k; const v4u v = *(const WAT_LAS v4u*)(ost + rq * 272 + q * 16);
                    *(v4u*)(ob + (size_t)(b * SEQ + gi * GRID_W + 16 * cg + rq) * DM + h * HD + q * 8) = v; }
            }
            NA_END(u + 1, 0, u + 1, 1);
        }
#undef NA_GEOM
#undef NA_LOAD
#undef NA_WRITE
#undef NA_END
    }
    SEAM(14);
    if (IN(15)) {
        pg8::Gemm g{ob, Woout_t, M, DM, DM, DM}; pg8::StaticOrder S; S.init(M, DM, F.G, (int)blockIdx.x); pg8::EpiResidT<1> E{nullptr, out, xb, xl0, xl1, ss, DM};
        pg8::gemm_phase<pg8::EpiResidT<1>, pg8::StaticOrder, true, true>(F.lds, g, S, E);
    }
    SEAM(15);
    if (IN(16)) RSTD_PHASE();
    SEAM(16);
    if (IN(17)) FFN_GATEUP(1);
    SEAM(17);
    if (IN(18)) FFN_FIX(1);
    SEAM(18);
    if (IN(19)) FFN_DOWN(1);
#undef IN
#undef SEAM
}

#if MK_CHECK
constexpr size_t WS_CHK = 9 * MiB;
constexpr int NS = 32;
__device__ const int g_rows[16] = {0, 1, 63, 64, 65, 127, 128, 4095, 4096, 8190, 8191, 8192, 8193, 8255, 16382, 16383};
__device__ __forceinline__ int srow(int i) { return i < 16 ? g_rows[i] : (int)(((unsigned)i * 2654435761u >> 9) % (unsigned)M); }
__device__ __forceinline__ int scol(int j, int N) { return j == 0 ? 0 : (j == 1 ? N - 1 : (int)(((unsigned)j * 2246822519u + 12345u) % (unsigned)N)); }
__device__ __forceinline__ float bf2f(bf16 b) { return __uint_as_float((unsigned)b << 16); }
__device__ __forceinline__ void chk_rec(unsigned* w, int c, float got, float ref, float scale) {
    float e = fabsf(got - ref) / (0.03f * (fabsf(ref) + scale)); if (!(e == e) || !(e < 1e30f)) e = 1e30f;
    atomicMax(&w[c], __float_as_uint(e));
}
__device__ __forceinline__ float dot_bf(const bf16* a, const bf16* b, int K) { float s = 0.f; for (int k = 0; k < K; ++k) s += bf2f(a[k]) * bf2f(b[k]); return s; }
__global__ void k_chk_gemm(const bf16* A, int lda, const bf16* Bt, int K, int N, const float* rs, const float* base, int base_ld, int base_by_sample,
                           const bf16* got_b, const float* got_f, int ldo, unsigned* w, int c, float scale) {
    const int i = blockIdx.x, j = threadIdx.x, row = srow(i), col = scol(j, N);
    float ref = dot_bf(A + (size_t)row * lda, Bt + (size_t)col * K, K); if (rs) ref *= rs[row];
    if (base) ref += base_by_sample == 2 ? bf2f(((const bf16*)base)[(size_t)i * base_ld + col]) : base[(size_t)(base_by_sample ? i : row) * base_ld + col];
    const float got = got_b ? bf2f(got_b[(size_t)row * ldo + col]) : got_f[(size_t)row * ldo + col];
    chk_rec(w, c, got, ref, scale);
}
__global__ void k_chk_copy(const unsigned char* src, size_t row_bytes, unsigned char* dst) {
    const int i = blockIdx.x, row = srow(i); for (size_t b = threadIdx.x * 4; b < row_bytes; b += blockDim.x * 4) *(unsigned*)(dst + (size_t)i * row_bytes + b) = *(const unsigned*)(src + (size_t)row * row_bytes + b);
}
__global__ void k_chk_rstd(const float* src, const float* rstd, const bf16* xb, unsigned* w, int c) {
    const int i = blockIdx.x * blockDim.x + threadIdx.x; if (i >= NS) return; const int row = srow(i); float s = 0.f;
    for (int k = 0; k < DM; ++k) { const float v = src[(size_t)row * DM + k]; s += v * v; }
    chk_rec(w, c, rstd[row], 1.0f / sqrtf(s / DM + NORM_EPS), 0.f);
    if (xb) for (int k = 0; k < DM; k += 97) chk_rec(w, c, bf2f(xb[(size_t)row * DM + k]), src[(size_t)row * DM + k], 0.01f);
}
__global__ void k_chk_w(const float* W, int K, int N, const bf16* dst, const float* gain, int mode, unsigned* w, int c) {
    const unsigned t = blockIdx.x * blockDim.x + threadIdx.x; const int k = (int)((t * 2654435761u >> 7) % (unsigned)K), n = scol((int)t, N);
    const int dr = (mode == 1) ? (n >= 1472 ? n - 1472 : n + 9216) : (mode >= 2 ? (n >> 7) * 256 + (n & 127) + (mode == 3 ? 128 : 0) : n); float ref = W[(size_t)k * N + n]; if (gain) ref *= gain[k];
    chk_rec(w, c, bf2f(dst[(size_t)dr * K + k]), ref, 1e-4f);
}
__global__ void k_chk_rope(const float* cosT, const float* sinT, int half, double c1, unsigned* w, int c) {
    const int t = blockIdx.x * blockDim.x + threadIdx.x; const int k = t % half; int pos = 1 + (int)(((unsigned)t * 2654435761u >> 8) % (unsigned)(SEQ - 1));
    double p = 1.0; for (int j = 0; j < k; ++j) p *= c1; const double th = (double)(float)p;
    double sn = 0, cs = 0, term = 1.0; for (int n = 0; n < 24; ++n) { if (n & 1) sn += ((n >> 1) & 1 ? -term : term); else cs += ((n >> 1) & 1 ? -term : term); term *= th / (n + 1); }
    chk_rec(w, c, cosT[1 * half + k], (float)cs, 0.02f); chk_rec(w, c, sinT[1 * half + k], (float)sn, 0.02f);
    chk_rec(w, c, cosT[k], 1.f, 0.02f); chk_rec(w, c, sinT[k], 0.f, 0.02f);
    const float ca = cosT[(pos - 1) * half + k], sa = sinT[(pos - 1) * half + k], c1f = cosT[half + k], s1f = sinT[half + k];
    chk_rec(w, c, cosT[pos * half + k], ca * c1f - sa * s1f, 0.03f); chk_rec(w, c, sinT[pos * half + k], sa * c1f + ca * s1f, 0.03f);
}
__global__ void k_chk_p2(const bf16* zc, const bf16* z, const bf16* cqn, const bf16* ckvn, const float* dqn, const float* dkn, const float* cosA, const float* sinA, unsigned* w, int c) {
    const int i = blockIdx.x, t = threadIdx.x, row = srow(i), pos = row & (SEQ - 1); const bf16* src = zc + (size_t)i * ZLD;
    if (false) { const bf16* p = src + t * HD; float s = 0.f; for (int d = 0; d < HD; ++d) s += bf2f(p[d]) * bf2f(p[d]);
        const float rs = 1.0f / sqrtf(s / HD + NORM_EPS); const float* g = t < 24 ? dqn : dkn; const float qs = t < 24 ? QS_HD : 1.f;
        for (int d = 0; d < HD; ++d) { float y = bf2f(p[d]) * rs * g[d];
            if (d < 16) y = y * cosA[pos * 16 + d] - bf2f(p[d + 16]) * rs * g[d + 16] * sinA[pos * 16 + d];
            else if (d < 32) y = y * cosA[pos * 16 + d - 16] + bf2f(p[d - 16]) * rs * g[d - 16] * sinA[pos * 16 + d - 16];
            chk_rec(w, c, bf2f(z[(size_t)row * ZLD + t * HD + d]), y * qs, 0.05f * qs); } }
    else if (t == 48) { float s = 0.f; for (int d = 0; d < QRANK; ++d) s += bf2f(src[Z_CQ + d]) * bf2f(src[Z_CQ + d]); const float rs = 1.0f / sqrtf(s / QRANK + NORM_EPS);
        for (int d = 0; d < QRANK; ++d) chk_rec(w, c, bf2f(cqn[(size_t)row * QRANK + d]), bf2f(src[Z_CQ + d]) * rs, 0.05f); }
    else if (t == 49) { float s = 0.f; for (int d = 0; d < KVRANK; ++d) s += bf2f(src[Z_CKV + d]) * bf2f(src[Z_CKV + d]); const float rs = 1.0f / sqrtf(s / KVRANK + NORM_EPS);
        for (int d = 0; d < KVRANK; ++d) chk_rec(w, c, bf2f(ckvn[(size_t)row * KVRANK + d]), bf2f(src[Z_CKV + d]) * rs, 0.05f); }
}
__global__ void k_chk_p4(const bf16* qc, bf16* qn_out, const bf16* kv, const bf16* z, const bf16* kout, const float* qn, const float* kn, const float* cosB, const float* sinB, unsigned* w, int c) {
    const int i = blockIdx.x, t = threadIdx.x, row = srow(i), pos = row & (SEQ - 1), h = t & 15; const bool isk = t >= 16;
    float s = 0.f;
    for (int d = 0; d < MLA_QK; ++d) { const float v = isk ? (d < 128 ? bf2f(kv[(size_t)row * 4096 + h * 256 + d]) : bf2f(z[(size_t)row * ZLD + Z_KPE + d - 128])) : bf2f(qc[(size_t)i * 3072 + h * MLA_QK + d]); s += v * v; }
    const float rs = 1.0f / sqrtf(s / MLA_QK + NORM_EPS); const float* g = isk ? kn : qn; const float qs = isk ? 1.f : QS_MLA;
    for (int d = 0; d < MLA_QK; ++d) {
        auto val = [&](int dd) { return (isk ? (dd < 128 ? bf2f(kv[(size_t)row * 4096 + h * 256 + dd]) : bf2f(z[(size_t)row * ZLD + Z_KPE + dd - 128])) : bf2f(qc[(size_t)i * 3072 + h * MLA_QK + dd])) * rs * g[dd]; };
        float y = val(d);
        if (d >= 128 && d < 160) y = y * cosB[pos * 32 + d - 128] - val(d + 32) * sinB[pos * 32 + d - 128];
        else if (d >= 160) y = y * cosB[pos * 32 + d - 160] + val(d - 32) * sinB[pos * 32 + d - 160];
        if (!isk) { qn_out[(size_t)i * 3072 + h * MLA_QK + d] = (bf16)f2bf(y * qs); continue; }
        chk_rec(w, c, bf2f(kout[(size_t)row * 3072 + h * MLA_QK + d]), y * qs, 0.05f * qs); }
}
__global__ void k_chk_mla(const bf16* q, const bf16* k, const bf16* kv, const bf16* omix, unsigned* w, int c) {
    const int i = blockIdx.x, t = threadIdx.x, row = srow(i), b0 = row & ~(SEQ - 1), h = (i * 7 + 3) & 15, d = (t * 37 + i) & 127;
    const bf16* qp = q + (size_t)i * 3072 + h * MLA_QK; float m = -1e30f;
    for (int key = 0; key < SEQ; ++key) m = fmaxf(m, dot_bf(qp, k + (size_t)(b0 + key) * 3072 + h * MLA_QK, MLA_QK));
    float l = 0.f, o = 0.f, o2 = 0.f;
    for (int key = 0; key < SEQ; ++key) { const float p = exp2f(dot_bf(qp, k + (size_t)(b0 + key) * 3072 + h * MLA_QK, MLA_QK) - m); const float v = bf2f(kv[(size_t)(b0 + key) * 4096 + h * 256 + 128 + d]); l += p; o += p * v; o2 += p * v * v; }
    chk_rec(w, c, bf2f(omix[(size_t)row * 3072 + h * HD + d]), o / l, 0.5f * sqrtf(o2 / l) * 0.1f + 1e-3f);
}
__global__ void k_chk_dil(const bf16* z, const bf16* omix, unsigned* w, int c) {
    const int i = blockIdx.x, t = threadIdx.x, row = srow(i), b0 = row & ~(SEQ - 1), pos = row & (SEQ - 1), j = (i * 5 + 1) & 7, d = (t * 37 + i) & 127;
    float m = -1e30f;
    for (int g = 0; g < 3; ++g) { const int dl = 1 << (2 * g), head = 8 * g + j; for (int tt = -64; tt <= 64; ++tt) { const int kp = pos + dl * tt; if (kp < 0 || kp >= SEQ) continue;
        m = fmaxf(m, dot_bf(z + (size_t)row * ZLD + head * HD, z + (size_t)(b0 + kp) * ZLD + 3072 + head * HD, HD)); } }
    float l = 0.f, o = 0.f;
    for (int g = 0; g < 3; ++g) { const int dl = 1 << (2 * g), head = 8 * g + j; for (int tt = -64; tt <= 64; ++tt) { const int kp = pos + dl * tt; if (kp < 0 || kp >= SEQ) continue;
        const float p = exp2f(dot_bf(z + (size_t)row * ZLD + head * HD, z + (size_t)(b0 + kp) * ZLD + 3072 + head * HD, HD) - m); l += p; o += p * bf2f(z[(size_t)(b0 + kp) * ZLD + 6144 + head * HD + d]); } }
    chk_rec(w, c, bf2f(omix[(size_t)row * 3072 + 2048 + j * HD + d]), o / l, 0.02f);
}
__global__ void k_chk_na(const bf16* qkv, const float* rpb, const bf16* ob, unsigned* w, int c) {
    const int i = blockIdx.x, t = threadIdx.x, row = srow(i), b0 = row & ~(SEQ - 1), pos = row & (SEQ - 1), gi = pos >> 6, gc = pos & 63, h = (i * 11 + 5) & 31, d = (t * 37 + i) & 127;
    const int rs0 = min(max(gi - 4, 0), GRID_ROWS - 8), cs0 = min(max(gc - 8, 0), 48); float m = -1e30f;
    for (int kr = 0; kr < 8; ++kr) for (int kc = 0; kc < 16; ++kc) { const int key = b0 + (rs0 + kr) * 64 + cs0 + kc;
        m = fmaxf(m, dot_bf(qkv + (size_t)row * 12288 + h * HD, qkv + (size_t)key * 12288 + 4096 + h * HD, HD) + rpb[(size_t)h * 465 + (rs0 + kr - gi + 7) * 31 + (cs0 + kc - gc + 15)] * LOG2E); }
    float l = 0.f, o = 0.f;
    for (int kr = 0; kr < 8; ++kr) for (int kc = 0; kc < 16; ++kc) { const int key = b0 + (rs0 + kr) * 64 + cs0 + kc;
        const float p = exp2f(dot_bf(qkv + (size_t)row * 12288 + h * HD, qkv + (size_t)key * 12288 + 4096 + h * HD, HD) + rpb[(size_t)h * 465 + (rs0 + kr - gi + 7) * 31 + (cs0 + kc - gc + 15)] * LOG2E - m);
        l += p; o += p * bf2f(qkv[(size_t)key * 12288 + 8192 + h * HD + d]); }
    chk_rec(w, c, bf2f(ob[(size_t)row * DM + h * HD + d]), o / l, 0.03f);
}
__global__ void k_chk_p13(const bf16* qc, const bf16* qkv, const float* qn, const float* kn, unsigned* w, int c) {
    const int i = blockIdx.x, t = threadIdx.x, row = srow(i); const bf16* p = qc + (size_t)i * 12288 + t * HD; float s = 0.f;
    for (int d = 0; d < HD; ++d) s += bf2f(p[d]) * bf2f(p[d]);
    const float rs = 1.0f / sqrtf(s / HD + NORM_EPS); const float* g = t < 32 ? qn : kn; const float qs = t < 32 ? QS_HD : 1.f;
    for (int d = 0; d < HD; ++d) chk_rec(w, c, bf2f(qkv[(size_t)row * 12288 + t * HD + d]), bf2f(p[d]) * rs * g[d] * qs, 0.05f * qs);
}
__global__ void k_chk_qkvn(const bf16* xb, const bf16* Wt, const float* rstd, const bf16* qkv, const float* qn, const float* kn, unsigned* w, int c) {
    const int i = blockIdx.x, t = threadIdx.x, row = srow(i), head = (t * 7 + i) % 96, d = (t * 37 + i * 5) & 127; float s = 0.f, mine = 0.f;
    for (int dd = 0; dd < HD; ++dd) { const float v = dot_bf(xb + (size_t)row * DM, Wt + (size_t)(head * HD + dd) * DM, DM) * rstd[row]; s += v * v; if (dd == d) mine = v; }
    float ref = mine; if (head < 64) { const float rs = 1.0f / sqrtf(s / HD + NORM_EPS); ref = mine * rs * (head < 32 ? qn[d] * QS_HD : kn[d]); }
    chk_rec(w, c, bf2f(qkv[(size_t)row * 12288 + head * HD + d]), ref, head < 32 ? 0.05f * QS_HD : 0.05f);
}
__global__ void k_chk_zn(const bf16* xb, const bf16* Wt, const float* rstd, const bf16* z, const float* dqn, const float* dkn, const float* cosA, const float* sinA, unsigned* w, int c) {
    const int i = blockIdx.x, t = threadIdx.x, row = srow(i), pos = row & (SEQ - 1);
    if (t < 48) { const int d = (t * 37 + i * 5) & 127; const int dp = d < 16 ? d + 16 : (d < 32 ? d - 16 : d); float s = 0.f, mine = 0.f, other = 0.f;
        for (int dd = 0; dd < HD; ++dd) { const float v = dot_bf(xb + (size_t)row * DM, Wt + (size_t)(t * HD + dd) * DM, DM) * rstd[row]; s += v * v; if (dd == d) mine = v; if (dd == dp) other = v; }
        const float rs = 1.0f / sqrtf(s / HD + NORM_EPS); const float* g = t < 24 ? dqn : dkn; const float qs = t < 24 ? QS_HD : 1.f;
        float y = mine * rs * g[d]; const float yo = other * rs * g[dp];
        if (d < 16) y = y * cosA[pos * 16 + d] - yo * sinA[pos * 16 + d]; else if (d < 32) y = y * cosA[pos * 16 + d - 16] + yo * sinA[pos * 16 + d - 16];
        chk_rec(w, c, bf2f(z[(size_t)row * ZLD + t * HD + d]), y * qs, 0.05f * qs); }
    else { const int col = 6144 + scol(t, 10688 - 6144); const float ref = dot_bf(xb + (size_t)row * DM, Wt + (size_t)col * DM, DM) * rstd[row]; chk_rec(w, c, bf2f(z[(size_t)row * ZLD + col]), ref, 0.05f); }
}
__global__ void k_chk_up(const bf16* xb, const bf16* Wgu, const float* rstd, const float* cw, const float* cb, const bf16* h2, unsigned* w, int c) {
    const int i = blockIdx.x, j = threadIdx.x, col = scol(j, DFF); int row = srow(i); if (i & 1) row = (row & ~255) + ((i & 2) ? 255 : 0) + ((i & 4) ? ((i & 2) ? -1 : 1) : 0);
    const int cls = i < 16 ? 42 + i : 58 + (i & 1);
    const int t = row & (SEQ - 1); const bf16* wg = Wgu + (size_t)((col >> 7) * 256 + (col & 127)) * DM; const bf16* wu = wg + (size_t)128 * DM;
    const bool edge = (row & 255) == 0 || (row & 255) == 255;
    auto rd = [&](float v) { return edge ? __uint_as_float(f2bf(v) << 16) : v; };
    const float up = rd(dot_bf(xb + (size_t)row * DM, wu, DM) * rstd[row]);
    float g = cb[col] + cw[DFF + col] * rd(dot_bf(xb + (size_t)row * DM, wg, DM) * rstd[row]);
    if (t > 0) g += cw[col] * rd(dot_bf(xb + (size_t)(row - 1) * DM, wg, DM) * rstd[row - 1]); if (t < SEQ - 1) g += cw[2 * DFF + col] * rd(dot_bf(xb + (size_t)(row + 1) * DM, wg, DM) * rstd[row + 1]);
    const float ref = g / (1.0f + expf(-g)) * up;
    chk_rec(w, cls, bf2f(h2[(size_t)row * DFF + col]), ref, 0.05f);
}
__global__ void k_chk_rq(const bf16* z, const float* rq, const float* rkv, unsigned* w, int c) {
    const int i = blockIdx.x * blockDim.x + threadIdx.x; if (i >= NS) return; const int row = srow(i); const bf16* src = z + (size_t)row * ZLD; float s = 0.f, t = 0.f;
    for (int d = 0; d < QRANK; ++d) s += bf2f(src[Z_CQ + d]) * bf2f(src[Z_CQ + d]);
    for (int d = 0; d < KVRANK; ++d) t += bf2f(src[Z_CKV + d]) * bf2f(src[Z_CKV + d]);
    chk_rec(w, c, rq[row], 1.0f / sqrtf(s / QRANK + NORM_EPS), 0.f); chk_rec(w, c, rkv[row], 1.0f / sqrtf(t / KVRANK + NORM_EPS), 0.f);
}
__global__ void k_chk_final(unsigned* w, float* out) {
    if (threadIdx.x != 0 || blockIdx.x != 0) return;
    for (int c = 0; c < 64; ++c) { const float e = __uint_as_float(w[c]); if (e > 1.0f) { int b = 0; float x = e; while (x >= 10.f && b < 20) { x *= 0.1f; ++b; } float V = (float)(10 + c) * 100.f; for (int q = 0; q < b; ++q) V *= 10.f; out[0] = V; return; } }
}
#endif
#ifndef MK_ONE_LAUNCH
#define MK_ONE_LAUNCH 1
#endif
extern "C" void kernel_launch(void* const* d_in, const int* in_sizes, int n_in, void* d_out, int out_size, void* d_ws, size_t ws_size, hipStream_t stream) {
    static int grid = 0;
    if (grid == 0) {
        const long long want[24] = {(long long)M * DM, DM, (long long)DM * EVEN_IN, QRANK, KVRANK, (long long)QRANK * 3072, (long long)KVRANK * 4096, MLA_QK, MLA_QK, HD, HD, (long long)EVEN_MIX * DM,
                                    DM, (long long)DM * 12288, HD, HD, (long long)NA_H * 15 * 31, (long long)DM * DM, 2 * DM, 2LL * DM * DFF, 2LL * DM * DFF, 2 * 3 * DFF, 2 * DFF, 2LL * DFF * DM};
        bool sizes_ok = n_in == 24; for (int i = 0; sizes_ok && i < 24; ++i) if ((long long)in_sizes[i] != want[i]) { fprintf(stderr, "kernel_launch: input %d has %d elements, expected %lld\n", i, in_sizes[i], want[i]); sizes_ok = false; }
        if (!sizes_ok || out_size != M * DM || ws_size < WS_END) { fprintf(stderr, "kernel_launch: unexpected shapes: n_in %d in0 %d out %d ws %zu (need %zu)\n", n_in, n_in > 0 ? in_sizes[0] : -1, out_size, ws_size, (size_t)WS_END); grid = -1; return; }
        int dev = 0, cus = 0, per_cu = 0;
        if (hipGetDevice(&dev) != hipSuccess || hipDeviceGetAttribute(&cus, hipDeviceAttributeMultiprocessorCount, dev) != hipSuccess) { grid = -1; return; }
        if (hipFuncSetAttribute((const void*)mk_fwd, hipFuncAttributeMaxDynamicSharedMemorySize, LDS_BYTES) != hipSuccess) { fprintf(stderr, "kernel_launch: hipFuncSetAttribute failed\n"); grid = -1; return; }
        if (hipOccupancyMaxActiveBlocksPerMultiprocessor(&per_cu, (const void*)mk_fwd, NWAVES * 64, LDS_BYTES) != hipSuccess || per_cu < 1) fprintf(stderr, "kernel_launch: occupancy query reports %d\n", per_cu);
        (void)hipGetLastError();
        grid = cus;
    }
    if (grid < 0) return;
    if (hipMemsetAsync((char*)d_ws + WS_CTL, 0, CTL_ZERO_BYTES, stream) != hipSuccess) return;
    Args a{};
    for (int i = 0; i < 24; ++i) a.in[i] = (const float*)d_in[i];
    a.out = (float*)d_out; a.ws = (unsigned char*)d_ws;
#if MK_ONE_LAUNCH
    a.ph_lo = 0; a.ph_hi = N_PHASES;
    hipLaunchKernelGGL(mk_fwd, dim3(grid), dim3(NWAVES * 64), LDS_BYTES, stream, a);
#else
#if MK_CHECK
    unsigned char* ws = (unsigned char*)d_ws; unsigned* cw = (unsigned*)(ws + WS_CHK); (void)hipMemsetAsync(cw, 0, 256, stream);
    bf16* cp_z = (bf16*)(ws + WS_CHK + 1 * MiB); bf16* cp_q = (bf16*)(ws + WS_CHK + 2 * MiB); float* cp_out = (float*)(ws + WS_CHK + 3 * MiB); bf16* cp_qkv = (bf16*)(ws + WS_CHK + 4 * MiB); bf16* cp_qn = (bf16*)(ws + WS_CHK + 5 * MiB);
    float* cosA = (float*)(ws + WS_ROPE); float* sinA = cosA + SEQ * 16; float* cosB = sinA + SEQ * 16; float* sinB = cosB + SEQ * 32;
    float* rstd = (float*)(ws + WS_RSTD); bf16* xb = (bf16*)(ws + WS_XB); unsigned char* R = ws + WS_R;
    bf16* zb = (bf16*)(R + R_Z); bf16* qb = (bf16*)(R + R_Q); bf16* kvb = (bf16*)(R + R_KV); bf16* kb = (bf16*)(R + R_K); bf16* omix = (bf16*)(R + R_OMIX);
    bf16* cqn = (bf16*)(R + R_CQN); bf16* ckvn = (bf16*)(R + R_CKVN); bf16* h2b = (bf16*)(R + R_H2); bf16* qkvb = (bf16*)(R + R_QKV); bf16* ob = (bf16*)(R + R_O);
    bf16* Win_t = (bf16*)(ws + WS_WIN); bf16* Wuq_t = (bf16*)(ws + WS_WUQ); bf16* Wukv_t = (bf16*)(ws + WS_WUKV); bf16* Weout_t = (bf16*)(ws + WS_WEOUT); bf16* Wqkv_t = (bf16*)(ws + WS_WQKV); bf16* Woout_t = (bf16*)(ws + WS_WOOUT);
    float* out = (float*)d_out; const float* const* in = a.in;
    auto WL = [&](int layer, int which) { return (bf16*)(ws + WS_WFFN + (size_t)layer * 3 * FFN_W_BYTES + (size_t)which * FFN_W_BYTES); };
#endif
    for (int p = 0; p < N_PHASES; ++p) {
#if MK_CHECK
        if (p == 2) k_chk_copy<<<NS, 256, 0, stream>>>((const unsigned char*)zb, (size_t)ZLD * 2, (unsigned char*)cp_z);
        if (p == 4) k_chk_copy<<<NS, 256, 0, stream>>>((const unsigned char*)qb, (size_t)3072 * 2, (unsigned char*)cp_q);
        if (p == 10 || p == 15 || p == 19) k_chk_copy<<<NS, 256, 0, stream>>>((const unsigned char*)xb, (size_t)DM * 2, (unsigned char*)cp_out);
#endif
        a.ph_lo = p; a.ph_hi = p + 1; hipLaunchKernelGGL(mk_fwd, dim3(grid), dim3(NWAVES * 64), LDS_BYTES, stream, a);
#if MK_CHECK
        const int c = 2 * p;
        if (p == 0) {
            k_chk_w<<<4, 64, 0, stream>>>(in[2], DM, EVEN_IN, Win_t, in[1], 1, cw, c); k_chk_w<<<4, 64, 0, stream>>>(in[5], QRANK, 3072, Wuq_t, in[3], 0, cw, c); k_chk_w<<<4, 64, 0, stream>>>(in[6], KVRANK, 4096, Wukv_t, in[4], 0, cw, c);
            k_chk_w<<<4, 64, 0, stream>>>(in[11], EVEN_MIX, DM, Weout_t, nullptr, 0, cw, c); k_chk_w<<<4, 64, 0, stream>>>(in[13], DM, 12288, Wqkv_t, in[12], 0, cw, c); k_chk_w<<<4, 64, 0, stream>>>(in[17], DM, DM, Woout_t, nullptr, 0, cw, c);
            for (int l = 0; l < 2; ++l) { k_chk_w<<<4, 64, 0, stream>>>(in[19] + (size_t)l * DM * DFF, DM, DFF, WL(l, 0), in[18] + l * DM, 2, cw, c); k_chk_w<<<4, 64, 0, stream>>>(in[20] + (size_t)l * DM * DFF, DM, DFF, WL(l, 0), in[18] + l * DM, 3, cw, c);
                k_chk_w<<<4, 64, 0, stream>>>(in[23] + (size_t)l * DFF * DM, DFF, DM, WL(l, 2), nullptr, 0, cw, c); }
            k_chk_rstd<<<1, 64, 0, stream>>>(in[0], rstd, xb, cw, c + 1);
            k_chk_rope<<<8, 64, 0, stream>>>(cosA, sinA, 16, 0.44036660267178046, cw, 40); k_chk_rope<<<8, 64, 0, stream>>>(cosB, sinB, 32, 0.6636012376960885, cw, 41);
        }
        if (p == 1) k_chk_zn<<<NS, 64, 0, stream>>>(xb, Win_t, rstd, zb, in[9], in[10], cosA, sinA, cw, c);
        if (p == 3) { k_chk_rq<<<1, 64, 0, stream>>>(zb, rstd + M, rstd + 2 * M, cw, 4);
                      k_chk_gemm<<<NS, 64, 0, stream>>>(zb + Z_CQ, ZLD, Wuq_t, QRANK, 3072, rstd + M, nullptr, 0, 0, qb, nullptr, 3072, cw, c, 0.05f);
                      k_chk_gemm<<<NS, 64, 0, stream>>>(zb + Z_CKV, ZLD, Wukv_t, KVRANK, 4096, rstd + 2 * M, nullptr, 0, 0, kvb, nullptr, 4096, cw, c + 1, 0.05f); }
        if (p == 4) k_chk_p4<<<NS, 32, 0, stream>>>(cp_q, cp_qn, kvb, zb, kb, in[7], in[8], cosB, sinB, cw, c);
        if (p == 5) { k_chk_mla<<<NS, 8, 0, stream>>>(cp_qn, kb, kvb, omix, cw, c); k_chk_dil<<<NS, 8, 0, stream>>>(zb, omix, cw, c + 1); }
        if (p == 6) k_chk_gemm<<<NS, 64, 0, stream>>>(omix, EVEN_MIX, Weout_t, EVEN_MIX, DM, nullptr, in[0], DM, 0, nullptr, out, DM, cw, c, 0.05f);
        if (p == 7 || p == 11 || p == 16) k_chk_rstd<<<1, 64, 0, stream>>>(out, rstd, xb, cw, c);
        if (p == 9 || p == 18) { const int l = p == 9 ? 0 : 1; k_chk_up<<<NS, 64, 0, stream>>>(xb, WL(l, 0), rstd, in[21] + (size_t)l * 3 * DFF, in[22] + (size_t)l * DFF, h2b, cw, c); }
        if (p == 10 || p == 19) k_chk_gemm<<<NS, 64, 0, stream>>>(h2b, DFF, WL(p == 10 ? 0 : 1, 2), DFF, DM, nullptr, cp_out, DM, 2, nullptr, out, DM, cw, c, 0.05f);
        if (p == 12) k_chk_qkvn<<<NS, 64, 0, stream>>>(xb, Wqkv_t, rstd, qkvb, in[14], in[15], cw, c);
        if (p == 14) k_chk_na<<<NS, 8, 0, stream>>>(qkvb, in[16], ob, cw, c);
        if (p == 15) k_chk_gemm<<<NS, 64, 0, stream>>>(ob, DM, Woout_t, DM, DM, nullptr, cp_out, DM, 2, nullptr, out, DM, cw, c, 0.05f);
#endif
    }
#if MK_CHECK
    k_chk_final<<<1, 64, 0, stream>>>(cw, out);
#endif
#endif
    const hipError_t le = hipPeekAtLastError();
    if (le != hipSuccess) fprintf(stderr, "kernel_launch: launch failed: %s\n", hipGetErrorName(le));
}
```

```cpp
#include <hip/hip_runtime.h>
#include <cstdio>
#include <cstdint>
#ifndef MK_CHECK
#define MK_CHECK 0
#endif
namespace pg8 {
#define PG8_LAS __attribute__((address_space(3)))
typedef unsigned short bf16_t;
typedef short bf16x8 __attribute__((ext_vector_type(8)));
typedef float f32x4 __attribute__((ext_vector_type(4)));
typedef unsigned u32x4 __attribute__((ext_vector_type(4)));
typedef unsigned u32x2 __attribute__((ext_vector_type(2)));
constexpr int BM = 256, BK = 64, HALF = 128, HTB = HALF * BK * 2  , STAGE_BYTES = 8 * HTB, NXCD = 8, WGM = 8;

__host__ __device__ __forceinline__ int lds_byte(int r, int c) { const int st = (r >> 4) * 2 + (c >> 5), rr = r & 15, cc = c & 31, ob = rr * 64 + cc * 2; return st * 1024 + (ob ^ (((ob >> 9) & 1) << 5)); }
__host__ __device__ __forceinline__ void stage_rc(int b, int& R, int& C) { const int st = b / 1024, sb = b % 1024, swz = sb ^ (((sb >> 9) & 1) << 5); R = (st >> 1) * 16 + swz / 64; C = (st & 1) * 32 + (swz % 64) / 2; }
__host__ __device__ __forceinline__ int perm32(int rho) { const int n = rho >> 4, i = rho & 15; return 8 * (i >> 2) + 4 * n + (i & 3); }

struct Unit { int pm, pn, kb, kn, role, slot; };
struct Gemm { const bf16_t* A; const bf16_t* Bt; int M, N, K, lda; };

struct StaticOrder {
    int nM, nN, nwg, G, c, ntk; float* scr; unsigned* flg;
    __host__ __device__ void init(int M, int N, int G_, int c_, int ntk_ = 0, float* scr_ = nullptr, unsigned* flg_ = nullptr) { nM = M / BM; nN = N / BM; nwg = nM * nN; G = G_; c = c_; ntk = ntk_; scr = scr_; flg = flg_; }
    __host__ __device__ bool next(int i, Unit& u) const {
        long L = (long)i * G + c; u.kb = 0; u.kn = ntk; u.role = 0; u.slot = 0;
        if (scr != nullptr) { const int full = nwg / G, rem = nwg - full * G;
            if (rem > 0 && 2 * rem <= G && i == full) {
                if (c < rem) { u.role = 1; u.kn = ntk / 2; u.slot = c; }
                else if (c < 2 * rem) { L -= rem; u.role = 2; u.kb = ntk / 2; u.kn = ntk - ntk / 2; u.slot = c - rem; }
                else return false; } }
        if (L >= nwg) return false;
        int wgid = (int)L; { const int q = nwg / NXCD, r = nwg % NXCD, xcd = wgid % NXCD, off = wgid / NXCD; wgid = (xcd < r ? xcd * (q + 1) : r * (q + 1) + (xcd - r) * q) + off; }
        const int nig = WGM * nN, gid = wgid / nig, fm = gid * WGM, gsz = (nM - fm) < WGM ? (nM - fm) : WGM;
        u.pm = fm + ((wgid % nig) % gsz); u.pn = (wgid % nig) / gsz; return true;
    }
    __device__ __forceinline__ void a_ready(const Unit&) const {}
    __device__ __forceinline__ void done(const Unit&) const {}
};

__device__ __forceinline__ unsigned cvt_pk_bf16(float lo, float hi) { unsigned r; asm volatile("v_cvt_pk_bf16_f32 %0, %1, %2" : "=v"(r) : "v"(lo), "v"(hi)); return r; }
__device__ __forceinline__ float bf_lo(unsigned w) { return __uint_as_float(w << 16); }
__device__ __forceinline__ float bf_hi(unsigned w) { return __uint_as_float(w & 0xffff0000u); }

struct EpiScaleBf16 {
    static constexpr bool PERM = true, AFTER_DRAIN = false;
    bf16_t* O; int ldc; const float* rstd;
    __device__ __forceinline__ void operator()(const f32x4 (&acc)[2][2][4][2], const Unit& u, int wr, int wc, int fr, int fq) const {
        const int row0 = u.pm * BM + wr * 64 + fr, col0 = u.pn * BM + wc * 32 + 8 * fq;
#pragma unroll
        for (int ai = 0; ai < 2; ++ai)
#pragma unroll
            for (int m = 0; m < 4; ++m) { const int row = row0 + ai * HALF + m * 16; const float s = rstd ? rstd[row] : 1.f; bf16_t* rowp = O + (size_t)row * ldc + col0;
#pragma unroll
                for (int bj = 0; bj < 2; ++bj) { const f32x4 v0 = acc[ai][bj][m][0] * s, v1 = acc[ai][bj][m][1] * s;
                    u32x4 w; w.x = cvt_pk_bf16(v0[0], v0[1]); w.y = cvt_pk_bf16(v0[2], v0[3]); w.z = cvt_pk_bf16(v1[0], v1[1]); w.w = cvt_pk_bf16(v1[2], v1[3]);
                    *(u32x4*)(rowp + bj * HALF) = w; } }
    }
};
struct EpiHeadNorm {
    static constexpr bool PERM = true, AFTER_DRAIN = false;
    bf16_t* O; int ldc; const float* rstd; const float* qn; const float* kn; float qscale; int ntq, ntk; PG8_LAS float* ex;
    const float* rcos; const float* rsin; int seq;
    float* ssq = nullptr;
    template <int AI, int MM, int BJ> __device__ __forceinline__ void put(unsigned wb, float s) const { asm volatile("ds_write_b32 %0, %1 offset:%2" :: "v"(wb), "v"(s), "i"((AI * 1024 + MM * 128 + BJ * 4) * 4) : "memory"); }
    template <int AI, int MM, int BJ> __device__ __forceinline__ f32x4 get(unsigned rb) const { f32x4 p; asm volatile("ds_read_b128 %0, %1 offset:%2" : "=&v"(p) : "v"(rb), "i"((AI * 1024 + MM * 128 + BJ * 4) * 4) : "memory"); return p; }
    template <int AI, int MM> __device__ __forceinline__ void part(const f32x4 (&acc)[2][2][4][2], unsigned wb, int fq) const {
#pragma unroll
        for (int bj = 0; bj < 2; ++bj) { const f32x4 v0 = acc[AI][bj][MM][0], v1 = acc[AI][bj][MM][1];
            float s = (v0[0] * v0[0] + v0[1] * v0[1]) + (v0[2] * v0[2] + v0[3] * v0[3]) + (v1[0] * v1[0] + v1[1] * v1[1]) + (v1[2] * v1[2] + v1[3] * v1[3]);
            s += __shfl_xor(s, 16); s += __shfl_xor(s, 32);
            if (fq == 0) { if (bj == 0) put<AI, MM, 0>(wb, s); else put<AI, MM, 1>(wb, s); } }
    }
    template <int AI, int MM> __device__ __forceinline__ void fin(const f32x4 (&acc)[2][2][4][2], unsigned rb, int row, int col0, const float* gp, float gs, int wc, int fq) const {
        bf16_t* rowp = O + (size_t)row * ldc + col0; const float rsv = rstd[row], r2 = rsv * rsv;
        const f32x4 g0 = *(const f32x4*)gp * gs, g1 = *(const f32x4*)(gp + 4) * gs;
        const f32x4 pa = get<AI, MM, 0>(rb), pb = get<AI, MM, 1>(rb);
        asm volatile("s_waitcnt lgkmcnt(0)" ::: "memory"); __builtin_amdgcn_sched_barrier(0);
#pragma unroll
        for (int bj = 0; bj < 2; ++bj) { const f32x4 p = bj ? pb : pa;
            const float tot = ((p[0] + p[1]) + (p[2] + p[3])) * r2;
            const float hn = rsv / sqrtf(tot * (1.0f / 128.0f) + 1e-6f);
            f32x4 v0 = acc[AI][bj][MM][0] * hn * g0, v1 = acc[AI][bj][MM][1] * hn * g1;
            if (rcos != nullptr && wc == 0) {
                const int pos = row & (seq - 1); const float* cp = rcos + pos * 16 + 8 * (fq & 1); const float* sp = rsin + pos * 16 + 8 * (fq & 1);
                const f32x4 c0 = *(const f32x4*)cp, c1 = *(const f32x4*)(cp + 4); f32x4 s0 = *(const f32x4*)sp, s1 = *(const f32x4*)(sp + 4);
                if (fq < 2) { s0 = -s0; s1 = -s1; }
                f32x4 p0, p1;
#pragma unroll
                for (int e = 0; e < 4; ++e) { p0[e] = __shfl_xor(v0[e], 32); p1[e] = __shfl_xor(v1[e], 32); }
                v0 = v0 * c0 + p0 * s0; v1 = v1 * c1 + p1 * s1; }
            u32x4 w; w.x = cvt_pk_bf16(v0[0], v0[1]); w.y = cvt_pk_bf16(v0[2], v0[3]); w.z = cvt_pk_bf16(v1[0], v1[1]); w.w = cvt_pk_bf16(v1[2], v1[3]);
            *(u32x4*)(rowp + bj * HALF) = w; }
    }
    __device__ __forceinline__ void operator()(const f32x4 (&acc)[2][2][4][2], const Unit& u, int wr, int wc, int fr, int fq) const {
        const int row0 = u.pm * BM + wr * 64 + fr, col0 = u.pn * BM + wc * 32 + 8 * fq; const int type = u.pn < ntq ? 0 : (u.pn < ntq + ntk ? 1 : 2);
        if (type < 2) {
            const unsigned rb = (unsigned)(uintptr_t)ex + (unsigned)((wr * 64 + fr) * 8 * 4), wb = rb + (unsigned)(wc * 4);
            part<0, 0>(acc, wb, fq); part<0, 1>(acc, wb, fq); part<0, 2>(acc, wb, fq); part<0, 3>(acc, wb, fq); part<1, 0>(acc, wb, fq); part<1, 1>(acc, wb, fq); part<1, 2>(acc, wb, fq); part<1, 3>(acc, wb, fq);
            asm volatile("s_waitcnt lgkmcnt(0)" ::: "memory"); __builtin_amdgcn_s_barrier(); asm volatile("" ::: "memory");
            const float* gp = (type == 0 ? qn : kn) + wc * 32 + 8 * fq; const float gs = type == 0 ? qscale : 1.0f;
            fin<0, 0>(acc, rb, row0, col0, gp, gs, wc, fq); fin<0, 1>(acc, rb, row0 + 16, col0, gp, gs, wc, fq); fin<0, 2>(acc, rb, row0 + 32, col0, gp, gs, wc, fq); fin<0, 3>(acc, rb, row0 + 48, col0, gp, gs, wc, fq);
            fin<1, 0>(acc, rb, row0 + HALF, col0, gp, gs, wc, fq); fin<1, 1>(acc, rb, row0 + HALF + 16, col0, gp, gs, wc, fq); fin<1, 2>(acc, rb, row0 + HALF + 32, col0, gp, gs, wc, fq); fin<1, 3>(acc, rb, row0 + HALF + 48, col0, gp, gs, wc, fq);
        } else {
#pragma unroll
            for (int ai = 0; ai < 2; ++ai)
#pragma unroll
                for (int m = 0; m < 4; ++m) { const int row = row0 + ai * HALF + m * 16; bf16_t* rowp = O + (size_t)row * ldc + col0; const float sc = rstd[row];
#pragma unroll
                    for (int bj = 0; bj < 2; ++bj) { const f32x4 v0 = acc[ai][bj][m][0] * sc, v1 = acc[ai][bj][m][1] * sc;
                        u32x4 w; w.x = cvt_pk_bf16(v0[0], v0[1]); w.y = cvt_pk_bf16(v0[2], v0[3]); w.z = cvt_pk_bf16(v1[0], v1[1]); w.w = cvt_pk_bf16(v1[2], v1[3]);
                        *(u32x4*)(rowp + bj * HALF) = w;
                        if (ssq != nullptr && u.pn >= 36) { float sq = (v0[0] * v0[0] + v0[1] * v0[1]) + (v0[2] * v0[2] + v0[3] * v0[3]) + (v1[0] * v1[0] + v1[1] * v1[1]) + (v1[2] * v1[2] + v1[3] * v1[3]);
                            sq += __shfl_xor(sq, 16); sq += __shfl_xor(sq, 32);
                            if (fq == 0) ssq[(size_t)row * 64 + (u.pn - 36) * 8 + bj * 4 + wc] = sq; } } }
        }
    }
};
#ifndef RESID_LOW
#define RESID_LOW 0
#endif
template <int MODE> struct EpiResidT {
    static constexpr bool PERM = true, AFTER_DRAIN = false;
    const float* basef; float* outf; bf16_t* xb; bf16_t* xl0; bf16_t* xl1; float* ss; int ldc;
    __device__ __forceinline__ void operator()(const f32x4 (&acc)[2][2][4][2], const Unit& u, int wr, int wc, int fr, int fq) const {
        const int row0 = u.pm * BM + wr * 64 + fr, col0 = u.pn * BM + wc * 32 + 8 * fq; bf16_t* xl = u.pm < 32 ? xl0 : xl1;
#pragma unroll
        for (int ai = 0; ai < 2; ++ai)
#pragma unroll
            for (int m = 0; m < 4; ++m) { const int row = row0 + ai * HALF + m * 16; const size_t off = (size_t)row * ldc + col0; float s = 0.f;
#pragma unroll
                for (int bj = 0; bj < 2; ++bj) { f32x4 b0, b1;
                    if constexpr (MODE == 0) { b0 = *(const f32x4*)(basef + off + bj * HALF); b1 = *(const f32x4*)(basef + off + bj * HALF + 4); }
                    else { const u32x4 hb = *(const u32x4*)(xb + off + bj * HALF); u32x4 lb = {0u, 0u, 0u, 0u}; if constexpr (RESID_LOW) lb = *(const u32x4*)(xl + off + bj * HALF);
                        b0[0] = bf_lo(hb.x) + bf_lo(lb.x); b0[1] = bf_hi(hb.x) + bf_hi(lb.x); b0[2] = bf_lo(hb.y) + bf_lo(lb.y); b0[3] = bf_hi(hb.y) + bf_hi(lb.y);
                        b1[0] = bf_lo(hb.z) + bf_lo(lb.z); b1[1] = bf_hi(hb.z) + bf_hi(lb.z); b1[2] = bf_lo(hb.w) + bf_lo(lb.w); b1[3] = bf_hi(hb.w) + bf_hi(lb.w); }
                    const f32x4 v0 = b0 + acc[ai][bj][m][0], v1 = b1 + acc[ai][bj][m][1];
                    if constexpr (MODE == 2 || MK_CHECK) { *(f32x4*)(outf + off + bj * HALF) = v0; *(f32x4*)(outf + off + bj * HALF + 4) = v1; }
                    if constexpr (MODE != 2) {
                        u32x4 w; w.x = cvt_pk_bf16(v0[0], v0[1]); w.y = cvt_pk_bf16(v0[2], v0[3]); w.z = cvt_pk_bf16(v1[0], v1[1]); w.w = cvt_pk_bf16(v1[2], v1[3]);
                        u32x4 l; l.x = cvt_pk_bf16(v0[0] - bf_lo(w.x), v0[1] - bf_hi(w.x)); l.y = cvt_pk_bf16(v0[2] - bf_lo(w.y), v0[3] - bf_hi(w.y));
                                 l.z = cvt_pk_bf16(v1[0] - bf_lo(w.z), v1[1] - bf_hi(w.z)); l.w = cvt_pk_bf16(v1[2] - bf_lo(w.w), v1[3] - bf_hi(w.w));
                        *(u32x4*)(xb + off + bj * HALF) = w; if constexpr (RESID_LOW) *(u32x4*)(xl + off + bj * HALF) = l;
                        s += (v0[0] * v0[0] + v0[1] * v0[1]) + (v0[2] * v0[2] + v0[3] * v0[3]) + (v1[0] * v1[0] + v1[1] * v1[1]) + (v1[2] * v1[2] + v1[3] * v1[3]); } }
                if constexpr (MODE != 2) { s += __shfl_xor(s, 16); s += __shfl_xor(s, 32);
                    if (fq == 0) ss[(size_t)row * 64 + u.pn * 4 + wc] = s; } }
    }
};
struct EpiUpConv {
    static constexpr bool PERM = true, AFTER_DRAIN = false;
    const bf16_t* a; bf16_t* h2; const float* rstd; const float* cw; const float* cb; int ldc; int seq;
    __device__ __forceinline__ void operator()(const f32x4 (&acc)[2][2][4][2], const Unit& u, int wr, int wc, int fr, int fq) const {
        const int row0 = u.pm * BM + wr * 64 + fr, col0 = u.pn * BM + wc * 32 + 8 * fq;
#pragma unroll
        for (int bj = 0; bj < 2; ++bj) { const int c = col0 + bj * HALF;
            float w0[8], w1[8], w2[8], b[8];
#pragma unroll
            for (int h = 0; h < 2; ++h) { const f32x4 t0 = *(const f32x4*)(cw + c + 4 * h), t1 = *(const f32x4*)(cw + ldc + c + 4 * h), t2 = *(const f32x4*)(cw + 2 * ldc + c + 4 * h), t3 = *(const f32x4*)(cb + c + 4 * h);
#pragma unroll
                for (int j = 0; j < 4; ++j) { w0[4 * h + j] = t0[j]; w1[4 * h + j] = t1[j]; w2[4 * h + j] = t2[j]; b[4 * h + j] = t3[j]; } }
#pragma unroll
            for (int ai = 0; ai < 2; ++ai)
#pragma unroll
                for (int m = 0; m < 4; ++m) { const int row = row0 + ai * HALF + m * 16; const int t = row & (seq - 1); const float s = rstd[row];
                    const bf16_t* ap = a + (size_t)row * ldc + c;
                    const u32x4 z4 = {0u, 0u, 0u, 0u};
                    const u32x4 a0 = *(const u32x4*)ap; const u32x4 am = t > 0 ? *(const u32x4*)(ap - ldc) : z4; const u32x4 an = t < seq - 1 ? *(const u32x4*)(ap + ldc) : z4;
                    float hv[8];
#pragma unroll
                    for (int j = 0; j < 8; ++j) { const unsigned wm = am[j >> 1], wz = a0[j >> 1], wn = an[j >> 1];
                        const float fm = (j & 1) ? bf_hi(wm) : bf_lo(wm), fz = (j & 1) ? bf_hi(wz) : bf_lo(wz), fn = (j & 1) ? bf_hi(wn) : bf_lo(wn);
                        const float g = w0[j] * fm + w1[j] * fz + w2[j] * fn + b[j];
                        const float e = __builtin_amdgcn_exp2f(-1.4426950408889634f * g);
                        const float sg = g * __builtin_amdgcn_rcpf(1.0f + e);
                        const float up = (j < 4 ? acc[ai][bj][m][0][j & 3] : acc[ai][bj][m][1][j & 3]) * s;
                        hv[j] = sg * up; }
                    u32x4 w; w.x = cvt_pk_bf16(hv[0], hv[1]); w.y = cvt_pk_bf16(hv[2], hv[3]); w.z = cvt_pk_bf16(hv[4], hv[5]); w.w = cvt_pk_bf16(hv[6], hv[7]);
                    *(u32x4*)(h2 + (size_t)row * ldc + c) = w; } }
    }
};
template <int CTRL> __device__ __forceinline__ float dpp_rot(float v) { return __builtin_bit_cast(float, __builtin_amdgcn_update_dpp(0, __builtin_bit_cast(int, v), CTRL, 0xF, 0xF, false)); }
struct EpiGateUp {
    static constexpr bool PERM = true, AFTER_DRAIN = false;
    bf16_t* h2; const float* rstd; const float* cw; const float* cb; int ldc; bf16_t* aedge; bf16_t* uedge; PG8_LAS float* ex;
    __device__ __forceinline__ void operator()(const f32x4 (&acc)[2][2][4][2], const Unit& u, int wr, int wc, int fr, int fq) const {
        const int row0 = u.pm * BM + wr * 64 + fr, ch = u.pn * HALF + wc * 32 + 8 * fq;
        f32x4 av[2][4][2], uv[2][4][2];
#pragma unroll
        for (int ai = 0; ai < 2; ++ai)
#pragma unroll
            for (int m = 0; m < 4; ++m) { const float r = rstd[row0 + ai * HALF + m * 16];
                av[ai][m][0] = acc[ai][0][m][0] * r; av[ai][m][1] = acc[ai][0][m][1] * r; uv[ai][m][0] = acc[ai][1][m][0] * r; uv[ai][m][1] = acc[ai][1][m][1] * r; }
        const unsigned eb = (unsigned)(uintptr_t)ex + (unsigned)((wc * 4 + fq) * 32);
#pragma unroll
        for (int ai = 0; ai < 2; ++ai) { const int gidx = 2 * ai + wr;
            if (fr == 0) { const unsigned a0 = eb + (unsigned)((gidx * 2 + 0) * 512);
                asm volatile("ds_write_b128 %0, %1\n\tds_write_b128 %0, %2 offset:16" :: "v"(a0), "v"(av[ai][0][0]), "v"(av[ai][0][1]) : "memory"); }
            if (fr == 15) { const unsigned a1 = eb + (unsigned)((gidx * 2 + 1) * 512);
                asm volatile("ds_write_b128 %0, %1\n\tds_write_b128 %0, %2 offset:16" :: "v"(a1), "v"(av[ai][3][0]), "v"(av[ai][3][1]) : "memory"); } }
        asm volatile("s_waitcnt lgkmcnt(0)" ::: "memory"); __builtin_amdgcn_s_barrier(); asm volatile("" ::: "memory");
        unsigned pk[2][4][2][2];
#pragma unroll
        for (int h = 0; h < 2; ++h) {
            const f32x4 w0 = *(const f32x4*)(cw + ch + 4 * h), w1 = *(const f32x4*)(cw + ldc + ch + 4 * h), w2 = *(const f32x4*)(cw + 2 * ldc + ch + 4 * h), bb = *(const f32x4*)(cb + ch + 4 * h);
#pragma unroll
            for (int ai = 0; ai < 2; ++ai) { const int gidx = 2 * ai + wr;
                f32x4 rrp, nx;
                { const unsigned ap = eb + (unsigned)(((gidx > 0 ? gidx - 1 : 0) * 2 + 1) * 512 + 16 * h), an = eb + (unsigned)(((gidx < 3 ? gidx + 1 : 3) * 2 + 0) * 512 + 16 * h);
                  asm volatile("ds_read_b128 %0, %2\n\tds_read_b128 %1, %3\n\ts_waitcnt lgkmcnt(0)" : "=&v"(rrp), "=&v"(nx) : "v"(ap), "v"(an) : "memory"); }
                f32x4 rlc;
#pragma unroll
                for (int j = 0; j < 4; ++j) rlc[j] = dpp_rot<0x12F>(av[ai][0][h][j]);
#pragma unroll
                for (int m = 0; m < 4; ++m) { const int row = row0 + ai * HALF + m * 16;
                    float hv[4];
#pragma unroll
                    for (int j = 0; j < 4; ++j) { const float cur = av[ai][m][h][j];
                        const float rr = dpp_rot<0x121>(cur);
                        float rln;
                        if (m < 3) rln = dpp_rot<0x12F>(av[ai][m + 1][h][j]); else rln = nx[j];
                        const float prev = fr != 0 ? rr : rrp[j], next = fr != 15 ? rlc[j] : rln;
                        rrp[j] = rr; rlc[j] = rln;
                        const float g = w0[j] * prev + w1[j] * cur + w2[j] * next + bb[j];
                        const float e = __builtin_amdgcn_exp2f(-1.4426950408889634f * g);
                        hv[j] = g * __builtin_amdgcn_rcpf(1.0f + e) * uv[ai][m][h][j]; }
                    pk[ai][m][h][0] = cvt_pk_bf16(hv[0], hv[1]); pk[ai][m][h][1] = cvt_pk_bf16(hv[2], hv[3]);
                    if ((m == 0 && gidx == 0 && fr < 2) || (m == 3 && gidx == 3 && fr >= 14)) {
                        const int e4 = (m == 0) ? fr : fr - 12;
                        u32x2 w; w.x = cvt_pk_bf16(av[ai][m][h][0], av[ai][m][h][1]); w.y = cvt_pk_bf16(av[ai][m][h][2], av[ai][m][h][3]);
                        *(u32x2*)(aedge + ((size_t)u.pm * 4 + e4) * ldc + ch + 4 * h) = w;
                        if (e4 == 0 || e4 == 3) { u32x2 wu; wu.x = cvt_pk_bf16(uv[ai][m][h][0], uv[ai][m][h][1]); wu.y = cvt_pk_bf16(uv[ai][m][h][2], uv[ai][m][h][3]);
                            *(u32x2*)(uedge + ((size_t)u.pm * 2 + (e4 == 3 ? 1 : 0)) * ldc + ch + 4 * h) = wu; } }
                    if (h == 1) { const bool first = (m == 0 && gidx == 0 && fr == 0), last = (m == 3 && gidx == 3 && fr == 15);
                        if (!first && !last) { u32x4 w; w.x = pk[ai][m][0][0]; w.y = pk[ai][m][0][1]; w.z = pk[ai][m][1][0]; w.w = pk[ai][m][1][1];
                            *(u32x4*)(h2 + (size_t)row * ldc + ch) = w; } }
                } }
        }
    }
};
template <class Epi, class Sched, bool ALIGN_EPI = false, bool SP2 = false, bool SPLITK = false>
__device__ __forceinline__ void gemm_phase(PG8_LAS unsigned char* lds, const Gemm g, const Sched& S, const Epi& E) {
    const int tid = threadIdx.x, wid = __builtin_amdgcn_readfirstlane(tid >> 6), lane = tid & 63, wr = wid >> 2, wc = wid & 3, fr = lane & 15, fq = lane >> 4;
    const int K = g.K, nt = K / BK;
    unsigned voffA[2], voffB[2];
#pragma unroll
    for (int i = 0; i < 2; ++i) { int R, C; stage_rc(tid * 16 + i * 8192, R, C); const int Rb = Epi::PERM ? ((R & ~31) + perm32(R & 31)) : R;
        voffA[i] = (unsigned)(R * g.lda + C) * 2u; voffB[i] = (unsigned)(Rb * K + C) * 2u; }
    const size_t kstep = (size_t)(BK * 2);
    const size_t hstepB = (size_t)HALF * K * 2, hstepA = (size_t)HALF * g.lda * 2;
    const size_t tstepB = 2 * hstepB, tstepA = 2 * hstepA;
    const unsigned ldsw = (unsigned)wid * 1024u;
    const int aoff = lds_byte(wr * 64 + fr, fq * 8), boff = lds_byte(wc * 32 + fr, fq * 8);
#define PG8_SA(b, h) (((b) * 2 + (h)) * HTB)
#define PG8_SB(b, h) ((4 + (b) * 2 + (h)) * HTB)
#define PG8_STAGE(bufoff, gbase, voff) do { _Pragma("unroll") for (int _i = 0; _i < 2; ++_i) \
        __builtin_amdgcn_global_load_lds((const unsigned*)((const char*)(gbase) + (voff)[_i]), (PG8_LAS unsigned*)(lds + (bufoff) + ldsw + _i * 8192), 16, 0, 0); } while (0)
#define PG8_LDA(dst, b, h) do { _Pragma("unroll") for (int m = 0; m < 4; ++m) _Pragma("unroll") for (int k = 0; k < 2; ++k) dst[m][k] = *(const PG8_LAS bf16x8*)(lds + PG8_SA(b, h) + aoff + m * 2048 + k * 1024); } while (0)
#define PG8_LDB(dst, b, h) do { _Pragma("unroll") for (int n = 0; n < 2; ++n) _Pragma("unroll") for (int k = 0; k < 2; ++k) dst[n][k] = *(const PG8_LAS bf16x8*)(lds + PG8_SB(b, h) + boff + n * 2048 + k * 1024); } while (0)
#define PG8_MMA(ai, bj, At, Bt) do { __builtin_amdgcn_s_setprio(1); _Pragma("unroll") for (int m = 0; m < 4; ++m) _Pragma("unroll") for (int n = 0; n < 2; ++n) _Pragma("unroll") for (int k = 0; k < 2; ++k) \
        acc[ai][bj][m][n] = __builtin_amdgcn_mfma_f32_16x16x32_bf16(Bt[n][k], At[m][k], acc[ai][bj][m][n], 0, 0, 0); __builtin_amdgcn_s_setprio(0); } while (0)
#define PG8_WAIT_V(n) asm volatile("s_waitcnt vmcnt(" #n ")" ::: "memory")
#define PG8_WAIT_L(n) asm volatile("s_waitcnt lgkmcnt(" #n ")" ::: "memory")
#define PG8_BAR __builtin_amdgcn_s_barrier()
#define PG8_SCHED __builtin_amdgcn_sched_barrier(0)
    Unit cur, nxt; int ui = 0;
    if (!S.next(0, cur)) return;
    f32x4 acc[2][2][4][2];
#pragma unroll
    for (int a = 0; a < 2; ++a)
#pragma unroll
        for (int b = 0; b < 2; ++b)
#pragma unroll
            for (int m = 0; m < 4; ++m)
#pragma unroll
                for (int n = 0; n < 2; ++n) acc[a][b][m][n] = (f32x4){0.f, 0.f, 0.f, 0.f};
    bf16x8 At[4][2], B0[2][2], B1[2][2];
    const char* cA = (const char*)g.A + (size_t)cur.pm * tstepA; const char* cB = (const char*)g.Bt + (size_t)cur.pn * tstepB;
    if constexpr (SPLITK) { cA += (size_t)cur.kb * kstep; cB += (size_t)cur.kb * kstep; }
    S.a_ready(cur);
    if constexpr (SP2) {
        PG8_STAGE(PG8_SB(0, 0), cB, voffB); PG8_STAGE(PG8_SB(0, 1), cB + hstepB, voffB); PG8_STAGE(PG8_SA(0, 0), cA, voffA); PG8_STAGE(PG8_SA(0, 1), cA + hstepA, voffA);
        if (wr == 1) PG8_BAR;
        PG8_WAIT_V(2); PG8_BAR;
        PG8_STAGE(PG8_SB(1, 0), cB + kstep, voffB); PG8_STAGE(PG8_SA(1, 0), cA + kstep, voffA); PG8_STAGE(PG8_SB(1, 1), cB + hstepB + kstep, voffB);
        PG8_WAIT_V(6); PG8_BAR;
    } else {
        PG8_STAGE(PG8_SB(0, 0), cB, voffB); PG8_STAGE(PG8_SA(0, 0), cA, voffA); PG8_STAGE(PG8_SB(0, 1), cB + hstepB, voffB); PG8_STAGE(PG8_SA(0, 1), cA + hstepA, voffA);
        if (wr == 1) PG8_BAR;
        PG8_WAIT_V(4); PG8_BAR;
        PG8_STAGE(PG8_SB(1, 0), cB + kstep, voffB); PG8_STAGE(PG8_SA(1, 0), cA + kstep, voffA); PG8_STAGE(PG8_SB(1, 1), cB + hstepB + kstep, voffB);
        PG8_WAIT_V(6); PG8_BAR;
    }
    for (;;) {
        const bool has_next = S.next(ui + 1, nxt);
        const char* nA = has_next ? (const char*)g.A + (size_t)nxt.pm * tstepA : cA; const char* nB = has_next ? (const char*)g.Bt + (size_t)nxt.pn * tstepB : cB;
        if constexpr (SPLITK) { if (has_next) { nA += (size_t)nxt.kb * kstep; nB += (size_t)nxt.kb * kstep; } }
        const int ntc = SPLITK ? cur.kn : nt;
        for (int t = 0; t < ntc; t += 2) {
            const bool last = (t == ntc - 2);
            const char* a1 = cA + (size_t)(t + 1) * kstep;
            const char* a2 = last ? nA : cA + (size_t)(t + 2) * kstep; const char* b2 = last ? nB : cB + (size_t)(t + 2) * kstep;
            const char* a3 = a2 + kstep; const char* b3 = b2 + kstep;
            if (last && has_next) S.a_ready(nxt);
            if constexpr (SP2) {
            PG8_LDB(B0, 0, 0); PG8_LDB(B1, 0, 1); PG8_SCHED; PG8_LDA(At, 0, 0); PG8_STAGE(PG8_SA(1, 1), a1 + hstepA, voffA);
            PG8_WAIT_V(8); PG8_WAIT_L(0); PG8_BAR; PG8_MMA(0, 0, At, B0); PG8_MMA(0, 1, At, B1); PG8_BAR; PG8_SCHED;
            PG8_LDA(At, 0, 1); PG8_STAGE(PG8_SB(0, 0), b2, voffB); PG8_STAGE(PG8_SB(0, 1), b2 + hstepB, voffB); PG8_STAGE(PG8_SA(0, 0), a2, voffA);
            PG8_WAIT_V(8); PG8_WAIT_L(0); PG8_BAR; PG8_MMA(1, 0, At, B0); PG8_MMA(1, 1, At, B1); PG8_BAR; PG8_SCHED;
            PG8_LDB(B0, 1, 0); PG8_LDB(B1, 1, 1); PG8_SCHED; PG8_LDA(At, 1, 0); PG8_STAGE(PG8_SA(0, 1), a2 + hstepA, voffA);
            PG8_WAIT_V(8); PG8_WAIT_L(0); PG8_BAR; PG8_MMA(0, 0, At, B0); PG8_MMA(0, 1, At, B1); PG8_BAR; PG8_SCHED;
            PG8_LDA(At, 1, 1); PG8_STAGE(PG8_SB(1, 0), b3, voffB); PG8_STAGE(PG8_SB(1, 1), b3 + hstepB, voffB); PG8_STAGE(PG8_SA(1, 0), a3, voffA);
            PG8_WAIT_V(8); PG8_WAIT_L(0); PG8_BAR; PG8_MMA(1, 0, At, B0); PG8_MMA(1, 1, At, B1); PG8_BAR; PG8_SCHED;
            } else {
            PG8_LDB(B0, 0, 0); PG8_SCHED; PG8_LDA(At, 0, 0); PG8_STAGE(PG8_SA(1, 1), a1 + hstepA, voffA);
            PG8_WAIT_L(8); PG8_BAR; PG8_WAIT_L(0); PG8_MMA(0, 0, At, B0); PG8_BAR; PG8_SCHED;
            PG8_LDB(B1, 0, 1); PG8_STAGE(PG8_SB(0, 0), b2, voffB);
            PG8_BAR; PG8_WAIT_L(0); PG8_MMA(0, 1, At, B1); PG8_BAR;
            PG8_LDA(At, 0, 1); PG8_STAGE(PG8_SA(0, 0), a2, voffA);
            PG8_BAR; PG8_WAIT_L(0); PG8_MMA(1, 0, At, B0); PG8_BAR; PG8_SCHED;
            PG8_STAGE(PG8_SB(0, 1), b2 + hstepB, voffB);
            PG8_WAIT_V(6); PG8_BAR; PG8_MMA(1, 1, At, B1); PG8_BAR;
            PG8_LDB(B0, 1, 0); PG8_SCHED; PG8_LDA(At, 1, 0); PG8_STAGE(PG8_SA(0, 1), a2 + hstepA, voffA);
            PG8_WAIT_L(8); PG8_BAR; PG8_WAIT_L(0); PG8_MMA(0, 0, At, B0); PG8_BAR; PG8_SCHED;
            PG8_LDB(B1, 1, 1); PG8_STAGE(PG8_SB(1, 0), b3, voffB);
            PG8_BAR; PG8_WAIT_L(0); PG8_MMA(0, 1, At, B1); PG8_BAR;
            PG8_LDA(At, 1, 1); PG8_STAGE(PG8_SA(1, 0), a3, voffA);
            PG8_BAR; PG8_WAIT_L(0); PG8_MMA(1, 0, At, B0); PG8_BAR; PG8_SCHED;
            PG8_STAGE(PG8_SB(1, 1), b3 + hstepB, voffB);
            PG8_WAIT_V(6); PG8_BAR; PG8_MMA(1, 1, At, B1); PG8_BAR;
            }
        }
        if constexpr (ALIGN_EPI) { if (wr == 0) PG8_BAR; }
        if constexpr (SPLITK) {
            if (cur.role == 2) {
                const __amdgpu_buffer_rsrc_t rs = __builtin_amdgcn_make_buffer_rsrc((void*)(S.scr + (size_t)cur.slot * 65536), 0, 65536 * 4, 0x00020000);
#pragma unroll
                for (int a = 0; a < 2; ++a)
#pragma unroll
                    for (int b = 0; b < 2; ++b)
#pragma unroll
                        for (int m = 0; m < 4; ++m)
#pragma unroll
                            for (int n = 0; n < 2; ++n)
                                __builtin_amdgcn_raw_buffer_store_b128(__builtin_bit_cast(u32x4, acc[a][b][m][n]), rs, (unsigned)(((wid * 32 + ((a * 2 + b) * 4 + m) * 2 + n) * 64 + lane) * 16), 0, 16);
                PG8_WAIT_V(0); PG8_BAR;
                if (tid == 0) __hip_atomic_store(S.flg + cur.slot * 16, 1u, __ATOMIC_RELAXED, __HIP_MEMORY_SCOPE_AGENT);
            } else {
                if (cur.role == 1) {
                    if (tid == 0) { unsigned spn = 0; while (__hip_atomic_load(S.flg + cur.slot * 16, __ATOMIC_RELAXED, __HIP_MEMORY_SCOPE_AGENT) == 0u) { __builtin_amdgcn_s_sleep(1); if (++spn > (1u << 22)) break; }
                        __builtin_amdgcn_fence(__ATOMIC_ACQUIRE, "agent"); }
                    PG8_WAIT_V(0); PG8_BAR;
                    const float* sp = S.scr + (size_t)cur.slot * 65536 + (size_t)(wid * 32 * 64 + lane) * 4;
#pragma unroll
                    for (int a = 0; a < 2; ++a)
#pragma unroll
                        for (int b = 0; b < 2; ++b) { f32x4 tq[4][2];
#pragma unroll
                            for (int m = 0; m < 4; ++m)
#pragma unroll
                                for (int n = 0; n < 2; ++n) tq[m][n] = *(const f32x4*)(sp + (size_t)((((a * 2 + b) * 4 + m) * 2 + n) * 64) * 4);
#pragma unroll
                            for (int m = 0; m < 4; ++m)
#pragma unroll
                                for (int n = 0; n < 2; ++n) acc[a][b][m][n] += tq[m][n]; }
                }
                E(acc, cur, wr, wc, fr, fq); S.done(cur);
            }
        } else
        if constexpr (!Epi::AFTER_DRAIN) { E(acc, cur, wr, wc, fr, fq); S.done(cur); }
        if (!has_next) break;
#pragma unroll
        for (int a = 0; a < 2; ++a)
#pragma unroll
            for (int b = 0; b < 2; ++b)
#pragma unroll
                for (int m = 0; m < 4; ++m)
#pragma unroll
                    for (int n = 0; n < 2; ++n) acc[a][b][m][n] = (f32x4){0.f, 0.f, 0.f, 0.f};
        cur = nxt; cA = nA; cB = nB; ++ui;
        if constexpr (ALIGN_EPI) { if (wr == 1) PG8_BAR; }
    }
    PG8_WAIT_V(0);
    if constexpr (!ALIGN_EPI) { if (wr == 0) PG8_BAR; }
    PG8_BAR;
    if constexpr (Epi::AFTER_DRAIN) { E.fused(acc, cur, wr, wc, fr, fq, lds, wid, lane); S.done(cur); }
#undef PG8_SA
#undef PG8_SB
#undef PG8_STAGE
#undef PG8_LDA
#undef PG8_LDB
#undef PG8_MMA
#undef PG8_WAIT_V
#undef PG8_WAIT_L
#undef PG8_BAR
#undef PG8_SCHED
}
}

namespace mla {
typedef unsigned short bf16;
using bf16x8 = __attribute__((ext_vector_type(8))) short;
using s16x4  = __attribute__((ext_vector_type(4))) short;
using f32x16 = __attribute__((ext_vector_type(16))) float;
using u32x4  = __attribute__((ext_vector_type(4))) unsigned;
constexpr int DQK = 192, DV = 128, NW = 8, QBLK = 32, KVBLK = 64;
constexpr int LDQ = 3072, LDK = 3072, LDV = 4096, LDO = 3072;
constexpr float THR = 11.5f;
constexpr int SHM_V = KVBLK * DV * 2, SHM_K = KVBLK * DQK * 2, SHM_ATTN = 2 * SHM_V + 2 * SHM_K + NW * 64 * 4;
#define MLA_SBAR() __builtin_amdgcn_sched_barrier(0)
#ifndef MLA_QG
#define MLA_QG 4
#endif
__device__ __forceinline__ int crow(int r, int hi) { return (r & 3) + 8 * (r >> 2) + 4 * hi; }
__device__ __forceinline__ unsigned cvtpk(float lo, float hi) { unsigned r; asm volatile("v_cvt_pk_bf16_f32 %0, %1, %2" : "=v"(r) : "v"(lo), "v"(hi)); return r; }
__device__ __forceinline__ void partialSM(f32x16& p0, f32x16& p1, float& m_reg, float& mn, float& alpha) {
  float pmax = p0[0];
#pragma unroll
  for (int r = 1; r < 16; ++r) pmax = fmaxf(pmax, p0[r]);
#pragma unroll
  for (int r = 0; r < 16; ++r) pmax = fmaxf(pmax, p1[r]);
  { auto rr = __builtin_amdgcn_permlane32_swap(__float_as_uint(pmax), __float_as_uint(pmax), false, false);
    pmax = fmaxf(__uint_as_float(rr[0]), __uint_as_float(rr[1])); }
  if (__builtin_expect(__all(pmax - m_reg <= THR), 1)) { mn = m_reg; alpha = 1.f; }
  else { mn = fmaxf(m_reg, pmax); alpha = __builtin_amdgcn_exp2f(m_reg - mn); m_reg = mn; }
#pragma unroll
  for (int r = 0; r < 16; ++r) p0[r] = p0[r] - mn;
#pragma unroll
  for (int r = 0; r < 16; ++r) p1[r] = p1[r] - mn;
#pragma unroll
  for (int r = 0; r < 16; ++r) p0[r] = __builtin_amdgcn_exp2f(p0[r]);
}
__device__ __forceinline__ void finishSM(f32x16& p0, f32x16& p1, float alpha, float& l_reg, bf16x8& pa0, bf16x8& pa1, bf16x8& pa2, bf16x8& pa3) {
#pragma unroll
  for (int r = 0; r < 16; ++r) p1[r] = __builtin_amdgcn_exp2f(p1[r]);
  float ps = 0;
#pragma unroll
  for (int r = 0; r < 16; ++r) ps += p0[r];
#pragma unroll
  for (int r = 0; r < 16; ++r) ps += p1[r];
  { auto rr = __builtin_amdgcn_permlane32_swap(__float_as_uint(ps), __float_as_uint(ps), false, false);
    ps = __uint_as_float(rr[0]) + __uint_as_float(rr[1]); }
  l_reg = l_reg * alpha + ps;
#define MLA_PK4(P, BASE, OUT) do { unsigned a0 = cvtpk(P[BASE + 0], P[BASE + 1]), a1 = cvtpk(P[BASE + 2], P[BASE + 3]);   \
    unsigned b0 = cvtpk(P[BASE + 4], P[BASE + 5]), b1 = cvtpk(P[BASE + 6], P[BASE + 7]);                              \
    auto r0 = __builtin_amdgcn_permlane32_swap(a0, b0, false, false); auto r1 = __builtin_amdgcn_permlane32_swap(a1, b1, false, false); \
    u32x4 w = {r0[0], r1[0], r0[1], r1[1]}; OUT = *reinterpret_cast<bf16x8*>(&w); } while (0)
  MLA_PK4(p0, 0, pa0); MLA_PK4(p0, 8, pa1); MLA_PK4(p1, 0, pa2); MLA_PK4(p1, 8, pa3);
#undef MLA_PK4
}
__device__ __forceinline__ int v_st(int k, int c) { const int kk = (k & ~0xC) | ((k & 4) << 1) | ((k & 8) >> 1); return ((kk >> 3) * 4 + (c >> 5)) * 512 + ((kk & 7) * 32 + (c & 31)) * 2; }
__device__ __forceinline__ int v_rd_base(int lane) { return ((lane & 3) << 3) | (((lane >> 2) & 3) << 6) | (((lane >> 4) & 1) << 5) | (((lane >> 5) & 1) << 8); }
constexpr int v_rd_off(int d0, int ks, int half) { return d0 * 512 + ks * 4096 + half * 2048; }
template <int OFF> __device__ __forceinline__ s16x4 tr_read(int vb) {
  s16x4 r; asm volatile("ds_read_b64_tr_b16 %0, %1 offset:%2" : "=&v"(r) : "v"(vb), "i"(OFF) : "memory"); return r;
}
template <int D0> __device__ __forceinline__ void pv_one(f32x16& od, int vb, bf16x8 pa0, bf16x8 pa1, bf16x8 pa2, bf16x8 pa3) {
  const s16x4 l0 = tr_read<v_rd_off(D0, 0, 0)>(vb), h0 = tr_read<v_rd_off(D0, 0, 1)>(vb), l1 = tr_read<v_rd_off(D0, 1, 0)>(vb), h1 = tr_read<v_rd_off(D0, 1, 1)>(vb);
  const s16x4 l2 = tr_read<v_rd_off(D0, 2, 0)>(vb), h2 = tr_read<v_rd_off(D0, 2, 1)>(vb), l3 = tr_read<v_rd_off(D0, 3, 0)>(vb), h3 = tr_read<v_rd_off(D0, 3, 1)>(vb);
  asm volatile("s_waitcnt lgkmcnt(0)" ::: "memory"); MLA_SBAR();
#define MLA_PK(L, H) (bf16x8){L[0], L[1], L[2], L[3], H[0], H[1], H[2], H[3]}
  od = __builtin_amdgcn_mfma_f32_32x32x16_bf16(pa0, MLA_PK(l0, h0), od, 0, 0, 0);
  od = __builtin_amdgcn_mfma_f32_32x32x16_bf16(pa1, MLA_PK(l1, h1), od, 0, 0, 0);
  od = __builtin_amdgcn_mfma_f32_32x32x16_bf16(pa2, MLA_PK(l2, h2), od, 0, 0, 0);
  od = __builtin_amdgcn_mfma_f32_32x32x16_bf16(pa3, MLA_PK(l3, h3), od, 0, 0, 0);
#undef MLA_PK
}
__device__ __forceinline__ void pv_d0(f32x16* o, int vb, bf16x8 pa0, bf16x8 pa1, bf16x8 pa2, bf16x8 pa3) {
  pv_one<0>(o[0], vb, pa0, pa1, pa2, pa3); pv_one<1>(o[1], vb, pa0, pa1, pa2, pa3); pv_one<2>(o[2], vb, pa0, pa1, pa2, pa3); pv_one<3>(o[3], vb, pa0, pa1, pa2, pa3);
}
constexpr int SHM_ATTN3 = 3 * SHM_V + 2 * SHM_K + NW * 64 * 4;
__device__ __forceinline__ void attn_unit_d(const bf16* __restrict__ Qb, const bf16* __restrict__ Kh, const bf16* __restrict__ Vh, bf16* __restrict__ Ob, int seq, char* lds,
                                            const float* __restrict__ qgain, float qscale, float qeps, const float* __restrict__ cosT, const float* __restrict__ sinT, int pos0) {
  typedef __attribute__((address_space(3))) unsigned las_u32;
  const int tid = threadIdx.x, wid = tid >> 6, wu = __builtin_amdgcn_readfirstlane(tid >> 6), lane = tid & 63, r32 = lane & 31, hi = lane >> 5, grp = wid >> 2;
  char* V_lds = lds; char* K_lds = lds + 3 * SHM_V;
  float* ws = (float*)(lds + 3 * SHM_V + 2 * SHM_K) + wid * 64; float* li_l = ws; float* al_l = ws + 32;
  char* Q_lds = lds + SHM_ATTN3 + wid * 4096;
  float m_reg = -1e30f, l_reg = 0; f32x16 o[4] = {}; bf16x8 qr[8];
  const bf16* Qw = Qb + (long)(wid * QBLK + r32) * LDQ + hi * 8;
  const int qsw = (r32 >> 1) & 7; char* qrow = Q_lds + r32 * 128;
  {
    bf16x8 raw[12];
#pragma unroll
    for (int d0 = 0; d0 < 12; ++d0) raw[d0] = *reinterpret_cast<const bf16x8*>(Qw + d0 * 16);
    float ssq = 0.f;
#pragma unroll
    for (int d0 = 0; d0 < 12; ++d0)
#pragma unroll
      for (int e = 0; e < 8; ++e) { const float x = __uint_as_float((unsigned)(unsigned short)raw[d0][e] << 16); ssq += x * x; }
    ssq += __shfl_xor(ssq, 32);
    const float rsq = qscale / sqrtf(ssq * (1.0f / 192.0f) + qeps);
#pragma unroll
    for (int d0 = 0; d0 < 8; ++d0) { const float* gp = qgain + 16 * d0 + 8 * hi; float y[8];
#pragma unroll
      for (int e = 0; e < 8; ++e) y[e] = __uint_as_float((unsigned)(unsigned short)raw[d0][e] << 16) * rsq * gp[e];
      u32x4 w; w.x = cvtpk(y[0], y[1]); w.y = cvtpk(y[2], y[3]); w.z = cvtpk(y[4], y[5]); w.w = cvtpk(y[6], y[7]); qr[d0] = __builtin_bit_cast(bf16x8, w); }
    const int pos = pos0 + wid * QBLK + r32;
#pragma unroll
    for (int dr = 0; dr < 2; ++dr) { const int i0 = 16 * dr + 8 * hi; const float* g1 = qgain + 128 + i0; const float* g2 = qgain + 160 + i0; const float* cp = cosT + pos * 32 + i0; const float* sp = sinT + pos * 32 + i0;
      float y1[8], y2[8];
#pragma unroll
      for (int e = 0; e < 8; ++e) { const float a = __uint_as_float((unsigned)(unsigned short)raw[8 + dr][e] << 16) * rsq * g1[e], b = __uint_as_float((unsigned)(unsigned short)raw[10 + dr][e] << 16) * rsq * g2[e];
        y1[e] = a * cp[e] - b * sp[e]; y2[e] = b * cp[e] + a * sp[e]; }
      u32x4 w1, w2; w1.x = cvtpk(y1[0], y1[1]); w1.y = cvtpk(y1[2], y1[3]); w1.z = cvtpk(y1[4], y1[5]); w1.w = cvtpk(y1[6], y1[7]); w2.x = cvtpk(y2[0], y2[1]); w2.y = cvtpk(y2[2], y2[3]); w2.z = cvtpk(y2[4], y2[5]); w2.w = cvtpk(y2[6], y2[7]);
      *reinterpret_cast<bf16x8*>(qrow + (((2 * dr + hi) ^ qsw) << 4)) = __builtin_bit_cast(bf16x8, w1);
      *reinterpret_cast<bf16x8*>(qrow + (((2 * (dr + 2) + hi) ^ qsw) << 4)) = __builtin_bit_cast(bf16x8, w2); }
  }
  int ksrc[3], vsrc[2];
#pragma unroll
  for (int k = 0; k < 3; ++k) { const int o_ = (wid + 8 * k) * 1024 + lane * 16, r_ = o_ / 384, sc_ = (o_ - r_ * 384) >> 4, c_ = (sc_ & ~7) | ((sc_ & 7) ^ ((r_ >> 1) & 7)); ksrc[k] = (r_ * LDK + c_ * 8) * 2; }
#pragma unroll
  for (int k = 0; k < 2; ++k) { const int o_ = (wid + 8 * k) * 1024 + lane * 16, sub_ = o_ >> 9, w_ = (o_ & 511) >> 1, kk_ = (sub_ >> 2) * 8 + (w_ >> 5), key_ = (kk_ & ~0xC) | ((kk_ & 4) << 1) | ((kk_ & 8) >> 1);
    vsrc[k] = (key_ * LDV + (sub_ & 3) * 32 + (w_ & 31)) * 2; }
  const int vb0 = (int)(uintptr_t)V_lds + v_rd_base(lane);
  const __amdgpu_buffer_rsrc_t krs = __builtin_amdgcn_make_buffer_rsrc((void*)Kh, 0, seq * LDK * 2, 0x00020000);
  const __amdgpu_buffer_rsrc_t vrs = __builtin_amdgcn_make_buffer_rsrc((void*)Vh, 0, seq * LDV * 2, 0x00020000);
#define MLD_ISSUE(k0, bk, bv) do { \
    _Pragma("unroll") for (int k = 0; k < 3; ++k) __builtin_amdgcn_raw_ptr_buffer_load_lds(krs, (las_u32*)(K_lds + (bk) * SHM_K + (wu + 8 * k) * 1024), 16, ksrc[k], (k0) * LDK * 2, 0, 0); \
    _Pragma("unroll") for (int k = 0; k < 2; ++k) __builtin_amdgcn_raw_ptr_buffer_load_lds(vrs, (las_u32*)(V_lds + (bv) * SHM_V + (wu + 8 * k) * 1024), 16, vsrc[k], (k0) * LDV * 2, 0, 0); } while (0)
#define MLD_RD(d0_, A0_, A1_, QF_) do { const int c_ = 2 * (d0_) + hi; const int off_ = (c_ ^ sw) << 4; A0_ = *reinterpret_cast<const bf16x8*>(kb_ + off_); A1_ = *reinterpret_cast<const bf16x8*>(kb_ + 32 * 384 + off_); \
      if ((d0_) >= 8) QF_ = *reinterpret_cast<const bf16x8*>(qrow + (((2 * ((d0_) - 8) + hi) ^ qsw) << 4)); else QF_ = qr[(d0_) < 8 ? (d0_) : 0]; } while (0)
#define MLD_MM(A0_, A1_, QF_) do { p0 = __builtin_amdgcn_mfma_f32_32x32x16_bf16(A0_, QF_, p0, 0, 0, 0); p1 = __builtin_amdgcn_mfma_f32_32x32x16_bf16(A1_, QF_, p1, 0, 0, 0); } while (0)
#define MLD_S(t_) do { const int b_ = (t_) & 1; f32x16 p0 = f32x16{}, p1 = f32x16{}; \
      { const int sw = (r32 >> 1) & 7; const char* kb_ = K_lds + b_ * SHM_K + r32 * 384; \
        bf16x8 xa0, xa1, xq, ya0, ya1, yq; \
        MLD_RD(0, xa0, xa1, xq); \
        MLD_RD(1, ya0, ya1, yq); MLA_SBAR(); MLD_MM(xa0, xa1, xq); MLA_SBAR(); \
        MLD_RD(2, xa0, xa1, xq); MLA_SBAR(); MLD_MM(ya0, ya1, yq); MLA_SBAR(); \
        MLD_RD(3, ya0, ya1, yq); MLA_SBAR(); MLD_MM(xa0, xa1, xq); MLA_SBAR(); \
        MLD_RD(4, xa0, xa1, xq); MLA_SBAR(); MLD_MM(ya0, ya1, yq); MLA_SBAR(); \
        MLD_RD(5, ya0, ya1, yq); MLA_SBAR(); MLD_MM(xa0, xa1, xq); MLA_SBAR(); \
        MLD_RD(6, xa0, xa1, xq); MLA_SBAR(); MLD_MM(ya0, ya1, yq); MLA_SBAR(); \
        MLD_RD(7, ya0, ya1, yq); MLA_SBAR(); MLD_MM(xa0, xa1, xq); MLA_SBAR(); \
        MLD_RD(8, xa0, xa1, xq); MLA_SBAR(); MLD_MM(ya0, ya1, yq); MLA_SBAR(); \
        MLD_RD(9, ya0, ya1, yq); MLA_SBAR(); MLD_MM(xa0, xa1, xq); MLA_SBAR(); \
        MLD_RD(10, xa0, xa1, xq); MLA_SBAR(); MLD_MM(ya0, ya1, yq); MLA_SBAR(); \
        MLD_RD(11, ya0, ya1, yq); MLA_SBAR(); MLD_MM(xa0, xa1, xq); MLA_SBAR(); \
        MLD_MM(ya0, ya1, yq); } \
      float mn; partialSM(p0, p1, m_reg, mn, al); finishSM(p0, p1, al, l_reg, pa0, pa1, pa2, pa3); } while (0)
#define MLD_O(vslot_) do { if (__any(al < 1.f)) { if (hi == 0) al_l[r32] = al; asm volatile("s_waitcnt lgkmcnt(0)" ::: "memory"); \
        _Pragma("unroll") for (int d = 0; d < 4; ++d) _Pragma("unroll") for (int r = 0; r < 16; ++r) o[d][r] *= al_l[crow(r, hi)]; } \
      MLA_SBAR(); pv_d0(o, vb0 + (vslot_) * SHM_V, pa0, pa1, pa2, pa3); } while (0)
  const int NT = seq / KVBLK;
  MLD_ISSUE(0, 0, 0); asm volatile("s_waitcnt vmcnt(0)" ::: "memory"); __syncthreads();
  bf16x8 pa0 = {}, pa1 = {}, pa2 = {}, pa3 = {}; float al = 1.f;
  int vs_cur = 0;
  for (int j = 0; j <= NT; ++j) {
    const int vs_prev = vs_cur == 0 ? 2 : vs_cur - 1, vs_next = vs_cur == 2 ? 0 : vs_cur + 1;
    if (j + 1 < NT) MLD_ISSUE((j + 1) * KVBLK, (j + 1) & 1, vs_next);
    if (grp == 0) { if (j < NT) { MLD_S(j); MLD_O(vs_cur); } }
    else { if (j > 0) MLD_O(vs_prev); if (j < NT) MLD_S(j); }
    asm volatile("s_waitcnt vmcnt(0)" ::: "memory");
    __syncthreads();
    vs_cur = vs_next;
  }
  if (hi == 0) li_l[r32] = l_reg; asm volatile("s_waitcnt lgkmcnt(0)" ::: "memory");
  float rli[16];
#pragma unroll
  for (int r = 0; r < 16; ++r) rli[r] = __builtin_amdgcn_rcpf(li_l[crow(r, hi)]);
  bf16* Ow = Ob + (long)(wid * QBLK) * LDO;
#pragma unroll
  for (int r = 0; r < 16; ++r) { const int orow = crow(r, hi);
#pragma unroll
    for (int d0 = 0; d0 < 4; ++d0) Ow[(long)orow * LDO + d0 * 32 + r32] = (bf16)(cvtpk(o[d0][r] * rli[r], 0.f) & 0xffffu); }
  asm volatile("s_waitcnt vmcnt(0)" ::: "memory");
  __syncthreads();
#undef MLD_ISSUE
#undef MLD_S
#undef MLD_RD
#undef MLD_MM
#undef MLD_O
}
}
namespace wat {
typedef unsigned short bf16;
using bf16x8 = __attribute__((ext_vector_type(8))) short;
using s16x4  = __attribute__((ext_vector_type(4))) short;
using f32x4  = __attribute__((ext_vector_type(4))) float;
using u32x4  = __attribute__((ext_vector_type(4))) unsigned;
#define WAT_LAS __attribute__((address_space(3)))
__device__ __forceinline__ unsigned cvtpk(float lo, float hi) { unsigned r; asm volatile("v_cvt_pk_bf16_f32 %0, %1, %2" : "=v"(r) : "v"(lo), "v"(hi)); return r; }
__device__ __forceinline__ int kst_off(int row, int ch) { return row * 256 + ((ch ^ ((row & 3) | (((row >> 3) & 3) << 2))) << 4); }
__device__ __forceinline__ int vst_off(int row, int ch) { return (row >> 4) * 4096 + ((row >> 2) & 1) * 2048 + (ch >> 1) * 256 + ((row >> 3) & 1) * 128 + (row & 3) * 32 + (ch & 1) * 16; }
__device__ __forceinline__ int vrd_base(int R0, int lane) { const int g4 = lane >> 4, qa = (lane & 15) >> 2, p = lane & 3, gg = g4 + ((R0 >> 3) & 1); return ((R0 >> 4) + (gg >> 1)) * 4096 + (gg & 1) * 128 + qa * 32 + p * 8; }
__device__ __forceinline__ void qk_group(f32x4& sc0, f32x4& sc1, const WAT_LAS char* Kb, int Rg, const bf16x8* qf, int lane) {
    const int a = lane & 15, g4 = lane >> 4; const int row = Rg + 8 * (a >> 2) + (a & 3); const int xk = (row & 3) | (((row >> 3) & 3) << 2);
    const WAT_LAS char* p = Kb + row * 256;
    sc0 = f32x4{0.f, 0.f, 0.f, 0.f}; sc1 = f32x4{0.f, 0.f, 0.f, 0.f};
#pragma unroll
    for (int s = 0; s < 4; ++s) { const int off = ((4 * s + g4) ^ xk) << 4;
        const bf16x8 k0 = *(const WAT_LAS bf16x8*)(p + off), k1 = *(const WAT_LAS bf16x8*)(p + 4 * 256 + off);
        sc0 = __builtin_amdgcn_mfma_f32_16x16x32_bf16(k0, qf[s], sc0, 0, 0, 0);
        sc1 = __builtin_amdgcn_mfma_f32_16x16x32_bf16(k1, qf[s], sc1, 0, 0, 0); }
}
__device__ __forceinline__ bf16x8 p_frag(const f32x4 p0, const f32x4 p1) { u32x4 w = {cvtpk(p0[0], p0[1]), cvtpk(p0[2], p0[3]), cvtpk(p1[0], p1[1]), cvtpk(p1[2], p1[3])}; return *reinterpret_cast<bf16x8*>(&w); }
template <int OFF> __device__ __forceinline__ s16x4 tr_read(unsigned addr) { s16x4 r; asm volatile("ds_read_b64_tr_b16 %0, %1 offset:%2" : "=&v"(r) : "v"(addr), "i"(OFF) : "memory"); return r; }
template <int GOFF> __device__ __forceinline__ void pv_group(f32x4* o, unsigned vb, const bf16x8 pf) {
    s16x4 lo[8], hi[8];
#define WAT_TR(c) lo[c] = tr_read<GOFF + (c) * 256>(vb); hi[c] = tr_read<GOFF + 2048 + (c) * 256>(vb);
    WAT_TR(0) WAT_TR(1) WAT_TR(2) WAT_TR(3) WAT_TR(4) WAT_TR(5) WAT_TR(6) WAT_TR(7)
#undef WAT_TR
    asm volatile("s_waitcnt lgkmcnt(0)" ::: "memory"); __builtin_amdgcn_sched_barrier(0);
#pragma unroll
    for (int c = 0; c < 8; ++c) { const bf16x8 vfr = (bf16x8){lo[c][0], lo[c][1], lo[c][2], lo[c][3], hi[c][0], hi[c][1], hi[c][2], hi[c][3]};
        o[c] = __builtin_amdgcn_mfma_f32_16x16x32_bf16(pf, vfr, o[c], 0, 0, 0); }
}
}
constexpr int NWAVES = 8;
constexpr int BATCH = 2, SEQ = 8192, DM = 4096, M = BATCH * SEQ;
constexpr int EVEN_IN = 10688, ZLD = 10752;
constexpr int Z_CQ = 9216, Z_CKV = 10112, Z_KPE = 10624;
constexpr int QRANK = 896, KVRANK = 512, MLA_H = 16, MLA_QK = 192, MLA_NOPE = 128, MLA_ROPE = 64;
constexpr int DIL_H = 24, DIL_HPG = 8, HD = 128;
constexpr int NA_H = 32, GRID_W = 64, NA_ROWS = 8, NA_COLS = 16, GRID_ROWS = SEQ / GRID_W;
constexpr int DFF = 11008, EVEN_MIX = 3072;
constexpr float NORM_EPS = 1e-6f, LOG2E = 1.4426950408889634f;
constexpr float QS_MLA = 0.07216878364870322f * LOG2E;
constexpr float QS_HD = 0.08838834764831845f * LOG2E;
constexpr size_t MiB = 1u << 20;
constexpr size_t WS_CTL = 0, CTL_ZERO_BYTES = 64 * 1024;
constexpr size_t WS_ROPE = 1 * MiB;
constexpr size_t WS_RSTD = 4 * MiB;
constexpr size_t WS_SS = 5 * MiB;
constexpr size_t WS_WIN = 16 * MiB, WS_WUQ = 100 * MiB, WS_WUKV = 106 * MiB, WS_WEOUT = 110 * MiB, WS_WQKV = 134 * MiB, WS_WOOUT = 230 * MiB;
constexpr size_t WS_WFFN = 262 * MiB, FFN_W_BYTES = 86 * MiB;
constexpr size_t WS_XB = 778 * MiB;
constexpr size_t WS_R = 906 * MiB;
constexpr size_t R_Z = 0, R_Q = 336 * MiB, R_KV = 432 * MiB, R_K = 560 * MiB, R_OMIX = 656 * MiB, R_CQN = 656 * MiB, R_CKVN = 688 * MiB;
constexpr size_t R_A = 0, R_H2 = 344 * MiB;
constexpr size_t R_QKV = 0, R_O = 384 * MiB;
constexpr size_t R_DPO = 752 * MiB, R_DPM = 848 * MiB;
constexpr size_t WS_END = WS_R + 852 * MiB;
static_assert((size_t)ZLD * DM * 2 <= 84 * MiB && (size_t)DFF * DM * 2 == 86 * MiB && (size_t)M * ZLD * 2 == 336 * MiB && (size_t)M * DFF * 2 == 344 * MiB, "ws map");
constexpr int CW_BAR = 4096;
constexpr int RING_BYTES = 131072, LDS_BYTES = 163840, LDSCTL_OFF = LDS_BYTES - 1024, MISC_OFF = LDSCTL_OFF + 320;
constexpr int NA_TB_OFF = RING_BYTES + 1024, NA_OST_OFF = NA_TB_OFF + 2048;

#define GAS __attribute__((address_space(1)))
#define LAS __attribute__((address_space(3)))
typedef unsigned short bf16;
typedef unsigned v4u __attribute__((ext_vector_type(4)));
typedef unsigned v2u __attribute__((ext_vector_type(2)));
typedef float f32x4 __attribute__((ext_vector_type(4)));
#define LDS_WAIT() asm volatile("s_waitcnt lgkmcnt(0)" ::: "memory")
#define VM_WAIT() asm volatile("s_waitcnt vmcnt(0)" ::: "memory")
__device__ __forceinline__ unsigned f2bf(float f) { unsigned u = __builtin_bit_cast(unsigned, f); return (u + 0x7fffu + ((u >> 16) & 1u)) >> 16; }
__device__ __forceinline__ unsigned pk2(float lo, float hi) { return f2bf(lo) | (f2bf(hi) << 16); }
__device__ __forceinline__ float bflo(unsigned w) { return __uint_as_float(w << 16); }
__device__ __forceinline__ float bfhi(unsigned w) { return __uint_as_float(w & 0xffff0000u); }
__device__ __forceinline__ void unpack8(const v4u w, float* f) { f[0] = bflo(w.x); f[1] = bfhi(w.x); f[2] = bflo(w.y); f[3] = bfhi(w.y); f[4] = bflo(w.z); f[5] = bfhi(w.z); f[6] = bflo(w.w); f[7] = bfhi(w.w); }
__device__ __forceinline__ v4u pack8(const float* f) { v4u w; w.x = pk2(f[0], f[1]); w.y = pk2(f[2], f[3]); w.z = pk2(f[4], f[5]); w.w = pk2(f[6], f[7]); return w; }
__device__ __forceinline__ float wave_sum(float v) {
#pragma unroll
    for (int o = 1; o < 64; o <<= 1) v += __shfl_xor(v, o);
    return v;
}
__device__ __forceinline__ float sum16(float v) {
#pragma unroll
    for (int o = 1; o < 16; o <<= 1) v += __shfl_xor(v, o);
    return v;
}

#define XB_TMO      128
#define XB_XCNT(j)  (256  + 64 * (j))
#define XB_XSUB(j)  (1280 + 64 * (j))
#define XB_XGEN(j)  (2304 + 64 * (j))
#define XB_TOP      3328
#define XB_TOPGEN   3392
#define XCD_BAR_WORDS 3456
#define XB_SPIN_CAP (1u << 20)
__device__ __forceinline__ unsigned xb_ld(unsigned* p)              { return __hip_atomic_load(p, __ATOMIC_RELAXED, __HIP_MEMORY_SCOPE_AGENT); }
__device__ __forceinline__ unsigned xb_add(unsigned* p, unsigned v) { return __hip_atomic_fetch_add(p, v, __ATOMIC_RELAXED, __HIP_MEMORY_SCOPE_AGENT); }
__device__ __forceinline__ unsigned xb_xcc_id() { return (unsigned)__builtin_amdgcn_s_getreg((3 << 11) | 20) & 0xFu; }
#define XB_SPIN(cond, bar) do { unsigned _sp = 0; while (cond) { __builtin_amdgcn_s_sleep(1); \
    if ((++_sp & 255u) == 0u) { if (xb_ld(&(bar)[XB_TMO])) break; if (_sp > XB_SPIN_CAP) { atomicAdd(&(bar)[XB_TMO], 1u); break; } } } } while (0)
struct XcdBarrier { unsigned* bar; unsigned x; volatile LAS unsigned* st; };
__device__ __forceinline__ XcdBarrier xcd_barrier_post(unsigned* bar, volatile LAS unsigned* st) {
    XcdBarrier b; b.bar = bar; b.x = xb_xcc_id(); b.st = st;
    if (threadIdx.x == 0) (void)xb_add(&bar[XB_XCNT(b.x)], 1u);
    return b;
}
__device__ __forceinline__ void xcd_barrier_complete(unsigned* bar, unsigned x, unsigned& nloc, unsigned& nx) {
    const unsigned G = gridDim.x * gridDim.y * gridDim.z;
    unsigned sum, cnt, mine, sp = 0u;
    for (;;) {
        sum = 0u; cnt = 0u; mine = 0u;
#pragma unroll
        for (unsigned j = 0; j < 16; ++j) { const unsigned c = xb_ld(&bar[XB_XCNT(j)]); sum += c; cnt += (c > 0u) ? 1u : 0u; mine = (j == x) ? c : mine; }
        if (sum == G) break;
        __builtin_amdgcn_s_sleep(1);
        if ((++sp & 255u) == 0u) { if (xb_ld(&bar[XB_TMO])) break; if (sp > XB_SPIN_CAP) { atomicAdd(&bar[XB_TMO], 1u); break; } }
    }
    nloc = mine > 0u ? mine : 1u; nx = cnt > 0u ? cnt : 1u;
}
__device__ __forceinline__ void xcd_barrier(const XcdBarrier& b) {
    asm volatile("s_waitcnt vmcnt(0)" ::: "memory");
    __syncthreads();
    if (threadIdx.x == 0) {
        unsigned* bar = b.bar;
        __builtin_amdgcn_s_waitcnt(0);
        unsigned nloc = b.st[0], nx = b.st[1];
        if (nloc == 0u) { xcd_barrier_complete(bar, b.x, nloc, nx); b.st[0] = nloc; b.st[1] = nx; }
        const unsigned old = xb_add(&bar[XB_XSUB(b.x)], 1u);
        const unsigned gen = old / nloc;
        if (old + 1u == (gen + 1u) * nloc) {
            __builtin_amdgcn_fence(__ATOMIC_RELEASE, "agent");
            asm volatile("s_waitcnt vmcnt(0)" ::: "memory");
            const unsigned og = xb_add(&bar[XB_TOP], 1u);
            const unsigned tg = og / nx;
            if (og + 1u == (tg + 1u) * nx) xb_add(&bar[XB_TOPGEN], 1u);
            else XB_SPIN(xb_ld(&bar[XB_TOPGEN]) == tg, bar);
            __builtin_amdgcn_fence(__ATOMIC_ACQUIRE, "agent");
            xb_add(&bar[XB_XGEN(b.x)], 1u);
            asm volatile("s_waitcnt vmcnt(0)" ::: "memory");
        } else {
            XB_SPIN(xb_ld(&bar[XB_XGEN(b.x)]) == gen, bar);
            __builtin_amdgcn_fence(__ATOMIC_ACQUIRE, "agent");
            asm volatile("s_waitcnt vmcnt(0)" ::: "memory");
        }
    }
    __syncthreads();
}

struct Args { const float* in[24]; float* out; unsigned char* ws; int ph_lo, ph_hi; };
struct Frame { LAS unsigned char* lds; int tid, lane, wave, gw, ngw, G; };

struct P0Item { const float* W; int K, N; bf16* dst; const float* gain; int mode, r; };
__device__ __forceinline__ void p0_item_load(const P0Item& t, float (&v)[32], int lane) {
    const int nblk = t.N / 32, kb = t.r / nblk, nb = t.r % nblk, k0 = 64 * kb, n0 = 32 * nb;
    const float* p = t.W + (size_t)(k0 + (lane >> 5)) * t.N + n0 + (lane & 31);
#pragma unroll
    for (int i = 0; i < 32; ++i) v[i] = p[(size_t)(2 * i) * t.N];
}
__device__ __forceinline__ void p0_item_store(const P0Item& t, const float (&v)[32], LAS float* scr, int lane) {
    const int nblk = t.N / 32, kb = t.r / nblk, nb = t.r % nblk, k0 = 64 * kb, n0 = 32 * nb;
    const int drow0 = (t.mode == 1) ? (n0 >= 1472 ? n0 - 1472 : n0 + 9216)
                    : (t.mode >= 2) ? ((n0 >> 7) * 256 + (n0 & 127) + (t.mode == 3 ? 128 : 0)) : n0;
#pragma unroll
    for (int i = 0; i < 32; ++i) { const int kk = 2 * i + (lane >> 5); scr[kk * 33 + (lane & 31)] = v[i]; }
    LDS_WAIT(); asm volatile("" ::: "memory");
    const int c = lane & 7;
    f32x4 ga = {1.f, 1.f, 1.f, 1.f}, gb = {1.f, 1.f, 1.f, 1.f};
    if (t.gain) { ga = *(const f32x4*)(t.gain + k0 + 8 * c); gb = *(const f32x4*)(t.gain + k0 + 8 * c + 4); }
#pragma unroll
    for (int j = 0; j < 4; ++j) { const int n = (lane >> 3) + 8 * j; const LAS float* sp = scr + (8 * c) * 33 + n;
        v4u o; o.x = pk2(sp[0 * 33] * ga[0], sp[1 * 33] * ga[1]); o.y = pk2(sp[2 * 33] * ga[2], sp[3 * 33] * ga[3]); o.z = pk2(sp[4 * 33] * gb[0], sp[5 * 33] * gb[1]); o.w = pk2(sp[6 * 33] * gb[2], sp[7 * 33] * gb[3]);
        *(v4u*)(t.dst + (size_t)(drow0 + n) * t.K + k0 + 8 * c) = o; }
    LDS_WAIT(); asm volatile("" ::: "memory");
}
#ifndef MLA_UNIT
#define MLA_UNIT mla::attn_unit_d
#endif
constexpr int N_PHASES = 20;
#ifndef LB2
#define LB2 2
#endif
__global__ void __launch_bounds__(NWAVES * 64, LB2) mk_fwd(Args args) {
    extern __shared__ __attribute__((aligned(16))) unsigned char lds[];
    Frame F;
    F.lds = (LAS unsigned char*)lds;
    F.tid = threadIdx.x; F.lane = F.tid & 63; F.wave = __builtin_amdgcn_readfirstlane(F.tid >> 6);
    F.G = gridDim.x; F.gw = blockIdx.x * NWAVES + F.wave; F.ngw = F.G * NWAVES;
    const int lane = F.lane, l15 = lane & 15, grp = lane >> 4;
    unsigned char* ws = args.ws;
    unsigned* ctl = (unsigned*)(ws + WS_CTL);
    const float* x_in = args.in[0]; float* out = args.out;
    float* cosA = (float*)(ws + WS_ROPE); float* sinA = cosA + SEQ * 16; float* cosB = sinA + SEQ * 16; float* sinB = cosB + SEQ * 32;
    float* rstd = (float*)(ws + WS_RSTD); float* ss = (float*)(ws + WS_SS);
    bf16* Win_t = (bf16*)(ws + WS_WIN); bf16* Wuq_t = (bf16*)(ws + WS_WUQ); bf16* Wukv_t = (bf16*)(ws + WS_WUKV); bf16* Weout_t = (bf16*)(ws + WS_WEOUT);
    bf16* Wqkv_t = (bf16*)(ws + WS_WQKV); bf16* Woout_t = (bf16*)(ws + WS_WOOUT);
    bf16* xb = (bf16*)(ws + WS_XB);
    unsigned char* R = ws + WS_R;
    bf16* zb = (bf16*)(R + R_Z); bf16* qb = (bf16*)(R + R_Q); bf16* kvb = (bf16*)(R + R_KV); bf16* kb = (bf16*)(R + R_K); bf16* omix = (bf16*)(R + R_OMIX);
    bf16* cqn = (bf16*)(R + R_CQN); bf16* ckvn = (bf16*)(R + R_CKVN);
    bf16* aedge = (bf16*)(R + R_A); bf16* uedge = aedge + (size_t)(M / 256) * 4 * DFF; bf16* h2b = (bf16*)(R + R_H2);
    bf16* qkvb = (bf16*)(R + R_QKV); bf16* ob = (bf16*)(R + R_O);
    bf16* dpo = (bf16*)(R + R_DPO); float* dpm = (float*)(R + R_DPM);
    bf16* xl0 = (bf16*)(ws + WS_WIN); bf16* xl1 = (bf16*)(R + R_DPO) - (size_t)8192 * DM;

    for (int u = F.tid; u < (LDS_BYTES - LDSCTL_OFF) / 4; u += NWAVES * 64) ((LAS unsigned*)(F.lds + LDSCTL_OFF))[u] = 0u;
    __syncthreads();
    const int lo = args.ph_lo, hi = args.ph_hi;
    XcdBarrier bar; bar.bar = ctl + CW_BAR; bar.x = 0; bar.st = nullptr;
    if (hi - lo > 1) bar = xcd_barrier_post(ctl + CW_BAR, (volatile LAS unsigned*)(F.lds + MISC_OFF) + 8);
#ifndef PH_MASK
#define PH_MASK 0xFFFFFu
#endif
#define IN(k) ((((PH_MASK) >> (k)) & 1u) && lo <= (k) && (k) < hi)
#define SEAM(k) do { if (IN(k) && IN((k) + 1)) xcd_barrier(bar); } while (0)

    if (IN(0)) {
        LAS float* scr = (LAS float*)(F.lds + F.wave * 16384);
        constexpr int I_WIN = (DM / 64) * (EVEN_IN / 32), I_UQ = (QRANK / 64) * (3072 / 32), I_UKV = (KVRANK / 64) * (4096 / 32), I_EOUT = (EVEN_MIX / 64) * (DM / 32);
        constexpr int I_QKV = (DM / 64) * (12288 / 32), I_OOUT = (DM / 64) * (DM / 32), I_GU = (DM / 64) * (DFF / 32), I_DN = (DFF / 64) * (DM / 32);
        constexpr int NITEMS = I_WIN + I_UQ + I_UKV + I_EOUT + I_QKV + I_OOUT + 2 * (2 * I_GU + I_DN);
#define P0_DECODE(it_, T_) do { int r = (it_); T_.gain = nullptr; T_.mode = 0; \
            if (r < I_WIN) { T_.W = args.in[2]; T_.K = DM; T_.N = EVEN_IN; T_.dst = Win_t; T_.gain = args.in[1]; T_.mode = 1; } \
            else if ((r -= I_WIN) < I_UQ) { T_.W = args.in[5]; T_.K = QRANK; T_.N = 3072; T_.dst = Wuq_t; T_.gain = args.in[3]; } \
            else if ((r -= I_UQ) < I_UKV) { T_.W = args.in[6]; T_.K = KVRANK; T_.N = 4096; T_.dst = Wukv_t; T_.gain = args.in[4]; } \
            else if ((r -= I_UKV) < I_EOUT) { T_.W = args.in[11]; T_.K = EVEN_MIX; T_.N = DM; T_.dst = Weout_t; } \
            else if ((r -= I_EOUT) < I_QKV) { T_.W = args.in[13]; T_.K = DM; T_.N = 12288; T_.dst = Wqkv_t; T_.gain = args.in[12]; } \
            else if ((r -= I_QKV) < I_OOUT) { T_.W = args.in[17]; T_.K = DM; T_.N = DM; T_.dst = Woout_t; } \
            else { r -= I_OOUT; const int layer = r / (2 * I_GU + I_DN); r -= layer * (2 * I_GU + I_DN); \
                bf16* wl = (bf16*)(ws + WS_WFFN + (size_t)layer * 3 * FFN_W_BYTES); \
                if (r < I_GU) { T_.W = args.in[19] + (size_t)layer * DM * DFF; T_.K = DM; T_.N = DFF; T_.dst = wl; T_.gain = args.in[18] + layer * DM; T_.mode = 2; } \
                else if ((r -= I_GU) < I_GU) { T_.W = args.in[20] + (size_t)layer * DM * DFF; T_.K = DM; T_.N = DFF; T_.dst = wl; T_.gain = args.in[18] + layer * DM; T_.mode = 3; } \
                else { r -= I_GU; T_.W = args.in[23] + (size_t)layer * DFF * DM; T_.K = DFF; T_.N = DM; T_.dst = (bf16*)((unsigned char*)wl + 2 * FFN_W_BYTES); } } \
            T_.r = r; } while (0)
        {
            float va[32], vb[32]; P0Item ta, tb_;
            int it = F.gw;
            if (it < NITEMS) { P0_DECODE(it, ta); p0_item_load(ta, va, lane); }
            while (it < NITEMS) {
                const int it1 = it + F.ngw, it2 = it1 + F.ngw;
                if (it1 < NITEMS) { P0_DECODE(it1, tb_); p0_item_load(tb_, vb, lane); }
                p0_item_store(ta, va, scr, lane);
                if (it1 >= NITEMS) break;
                if (it2 < NITEMS) { P0_DECODE(it2, ta); p0_item_load(ta, va, lane); }
                p0_item_store(tb_, vb, scr, lane);
                it = it2;
            }
        }
#undef P0_DECODE
        const int gtid = blockIdx.x * (NWAVES * 64) + F.tid, nthr = F.G * NWAVES * 64;
        for (int i = gtid; i < (ZLD - 10688) * DM / 8; i += nthr) ((v4u*)(Win_t + (size_t)10688 * DM))[i] = (v4u){0u, 0u, 0u, 0u};
        for (int i = gtid; i < SEQ * 48; i += nthr) {
            const bool isB = i >= SEQ * 16; const int ii = isB ? i - SEQ * 16 : i; const int pos = isB ? (ii >> 5) : (ii >> 4), k = isB ? (ii & 31) : (ii & 15);
            const double c1 = isB ? 0.6636012376960885 : 0.44036660267178046;
            double p = 1.0; for (int j = 0; j < k; ++j) p *= c1;
            const float inv = (float)p; const float ang = (float)pos * inv;
            const double rev = (double)ang * 0.15915494309189535; const float fr = (float)(rev - __builtin_rint(rev));
            const float sv = __builtin_amdgcn_sinf(fr), cv = __builtin_amdgcn_cosf(fr);
            if (isB) { cosB[ii] = cv; sinB[ii] = sv; } else { cosA[ii] = cv; sinA[ii] = sv; }
        }
#pragma unroll 2
        for (int row = F.gw; row < M; row += F.ngw) {
            const f32x4* xr = (const f32x4*)(x_in + (size_t)row * DM) + lane; v2u* xo = (v2u*)(xb + (size_t)row * DM) + lane; float s = 0.f;
#pragma unroll 4
            for (int j = 0; j < 16; ++j) { const f32x4 v = xr[64 * j]; s += (v.x * v.x + v.y * v.y) + (v.z * v.z + v.w * v.w); v2u w; w.x = pk2(v.x, v.y); w.y = pk2(v.z, v.w); xo[64 * j] = w; }
            s = wave_sum(s);
            if (lane == 0) rstd[row] = 1.0f / sqrtf(s * (1.0f / DM) + NORM_EPS);
        }
    }
    SEAM(0);
    if (IN(1)) {
        pg8::Gemm g{xb, Win_t, M, ZLD, DM, DM}; pg8::StaticOrder S; S.init(M, ZLD, F.G, (int)blockIdx.x);
        pg8::EpiHeadNorm E{zb, ZLD, rstd, args.in[9], args.in[10], QS_HD, 12, 12, (PG8_LAS float*)(F.lds + NA_TB_OFF), cosA, sinA, SEQ, ss};
        pg8::gemm_phase<pg8::EpiHeadNorm, pg8::StaticOrder, true, true>(F.lds, g, S, E);
    }
    SEAM(1);
    if (IN(3)) {
        {
            const int pm_lo = F.G == 256 ? 8 * ((int)blockIdx.x & 7) + (((int)blockIdx.x >> 3) & 7) : 0, pm_hi = F.G == 256 ? pm_lo + 1 : M / 256;
            for (int pmi = pm_lo; pmi < pm_hi; ++pmi) {
                const int row = pmi * 256 + (F.tid >> 1); const f32x4* sp = (const f32x4*)(ss + (size_t)row * 64) + ((F.tid & 1) ? 7 : 0);
                f32x4 a = sp[0] + sp[1] + sp[2] + sp[3]; if ((F.tid & 1) == 0) a += sp[4] + sp[5] + sp[6];
                const float tot = (a[0] + a[1]) + (a[2] + a[3]);
                rstd[((F.tid & 1) ? 2 * M : M) + row] = 1.0f / sqrtf(tot * ((F.tid & 1) ? 1.0f / KVRANK : 1.0f / QRANK) + NORM_EPS); }
            asm volatile("s_waitcnt vmcnt(0)" ::: "memory"); __syncthreads();
        }
        { pg8::Gemm g{zb + Z_CQ, Wuq_t, M, 3072, QRANK, ZLD}; pg8::StaticOrder S; S.init(M, 3072, F.G, (int)blockIdx.x); pg8::EpiScaleBf16 E{qb, 3072, rstd + M};
          pg8::gemm_phase<pg8::EpiScaleBf16, pg8::StaticOrder, true, true>(F.lds, g, S, E); }
        { pg8::Gemm g{zb + Z_CKV, Wukv_t, M, 4096, KVRANK, ZLD}; pg8::StaticOrder S; S.init(M, 4096, F.G, (int)blockIdx.x); pg8::EpiScaleBf16 E{kvb, 4096, rstd + 2 * M};
          pg8::gemm_phase<pg8::EpiScaleBf16, pg8::StaticOrder, true, true>(F.lds, g, S, E); }
        {
            WAT_LAS char* L = (WAT_LAS char*)F.lds;
            const int NU = BATCH * 3 * DIL_HPG * 64;
            const int u0 = (int)(((long)NU * blockIdx.x) / F.G), u1 = (int)(((long)NU * (blockIdx.x + 1)) / F.G);
            const int row16 = F.tid >> 4, ch16 = F.tid & 15, kso = wat::kst_off(row16, ch16), vso = wat::vst_off(row16, ch16);
            const int w = F.wave, q = lane & 15, g4 = lane >> 4, Rw = 32 * (w >> 1);
            v4u st[8];
#define DL_GEOM(u_) const int blk_ = (u_) & 63, j_ = ((u_) >> 6) & 7, bg_ = (u_) >> 9, g_ = bg_ % 3, b_ = bg_ / 3, sh_ = 2 * g_, d_ = 1 << sh_, Ld_ = SEQ >> sh_, \
            r_ = blk_ >> (6 - sh_), p0_ = (blk_ & ((64 >> sh_) - 1)) * 128, head_ = 8 * g_ + j_;
#define DL_LOAD(u_, s_) do { DL_GEOM(u_) const bf16* base_ = zb + (size_t)(b_ * SEQ + r_) * ZLD + ((s_) ? 6144 : 3072) + head_ * HD + ch16 * 8; \
            _Pragma("unroll") for (int k = 0; k < 8; ++k) { const int kp_ = min(max(p0_ - 64 + row16 + 32 * k, 0), Ld_ - 1); st[k] = *(const v4u*)(base_ + (size_t)(kp_ << sh_) * ZLD); } } while (0)
#define DL_WRITE(s_) do { WAT_LAS char* dd_ = L + (s_) * 65536 + ((s_) ? vso : kso); _Pragma("unroll") for (int k = 0; k < 8; ++k) *(WAT_LAS v4u*)(dd_ + k * 32 * 256) = st[k]; } while (0)
#define DL_END(un_, sn_, un2_, sn2_) do { if ((un_) < u1) { VM_WAIT(); DL_WRITE(sn_); } __syncthreads(); if ((un2_) < u1) DL_LOAD(un2_, sn2_); } while (0)
            if (u0 < u1) { DL_LOAD(u0, 0); VM_WAIT(); DL_WRITE(0); __syncthreads(); DL_LOAD(u0, 1); }
            for (int u = u0; u < u1; ++u) {
                DL_GEOM(u)
                wat::bf16x8 qf[4]; wat::f32x4 sc[5][2]; wat::bf16x8 pf[5]; wat::f32x4 o[8]; float linv = 0.f, mrow = 0.f, lrow = 0.f;
                const int qp = p0_ + 16 * w + q; const size_t qtok = (size_t)(b_ * SEQ + r_) + ((size_t)qp << sh_);
                {
                    const bf16* qptr = zb + qtok * ZLD + head_ * HD + 8 * g4;
#pragma unroll
                    for (int s = 0; s < 4; ++s) qf[s] = *(const wat::bf16x8*)(qptr + 32 * s);
#pragma unroll
                    for (int gi = 0; gi < 5; ++gi) wat::qk_group(sc[gi][0], sc[gi][1], L, Rw + 32 * gi, qf, lane);
                    float m = -1e30f;
#pragma unroll
                    for (int gi = 0; gi < 5; ++gi)
#pragma unroll
                        for (int j = 0; j < 8; ++j) { const int lr = Rw + 32 * gi + 8 * g4 + j, kp = p0_ - 64 + lr, dq = kp - qp; const bool ok = dq >= -64 && dq <= 64 && kp >= 0 && kp < Ld_;
                            const float v = ok ? sc[gi][j >> 2][j & 3] : -1e30f; sc[gi][j >> 2][j & 3] = v; m = fmaxf(m, v); }
                    m = fmaxf(m, __shfl_xor(m, 16)); m = fmaxf(m, __shfl_xor(m, 32));
                    float l = 0.f;
#pragma unroll
                    for (int gi = 0; gi < 5; ++gi) {
#pragma unroll
                        for (int j = 0; j < 8; ++j) { const float sv = sc[gi][j >> 2][j & 3]; const float v = sv > -1e29f ? __builtin_amdgcn_exp2f(sv - m) : 0.f; sc[gi][j >> 2][j & 3] = v; l += v; }
                        pf[gi] = wat::p_frag(sc[gi][0], sc[gi][1]); }
                    l += __shfl_xor(l, 16); l += __shfl_xor(l, 32); linv = 1.0f / l; mrow = m; lrow = l;
#pragma unroll
                    for (int c = 0; c < 8; ++c) o[c] = wat::f32x4{0.f, 0.f, 0.f, 0.f};
                }
                DL_END(u, 1, u + 1, 0);
                {
                    const unsigned vb = (unsigned)(uintptr_t)(L + 65536) + (unsigned)wat::vrd_base(Rw, lane);
                    wat::pv_group<0>(o, vb, pf[0]); wat::pv_group<8192>(o, vb, pf[1]); wat::pv_group<16384>(o, vb, pf[2]); wat::pv_group<24576>(o, vb, pf[3]); wat::pv_group<32768>(o, vb, pf[4]);
                    WAT_LAS char* ost = L + NA_OST_OFF + w * 2304;
                    float li[4];
#pragma unroll
                    for (int r = 0; r < 4; ++r) li[r] = __shfl(linv, 4 * g4 + r);
                    const size_t tok_r = (size_t)(b_ * SEQ + r_) + ((size_t)(p0_ + 16 * w + g4) << sh_);
#pragma unroll
                    for (int hf = 0; hf < 2; ++hf) {
#pragma unroll
                        for (int r = 0; r < 4; ++r)
#pragma unroll
                            for (int c = 0; c < 4; ++c) *(WAT_LAS unsigned short*)(ost + (4 * g4 + r) * 144 + (16 * c + q) * 2) = (unsigned short)(wat::cvtpk(o[4 * hf + c][r] * li[r], 0.f) & 0xffffu);
                        asm volatile("s_waitcnt lgkmcnt(0)" ::: "memory");
#pragma unroll
                        for (int k = 0; k < 2; ++k) { const int rq = g4 + 4 * (2 * k + (q >> 3)); const v4u v = *(const WAT_LAS v4u*)(ost + rq * 144 + (q & 7) * 16);
                            const size_t tk = tok_r + ((size_t)(4 * (2 * k + (q >> 3))) << sh_);
                            *(v4u*)(dpo + ((tk * DIL_HPG + j_) * 3 + g_) * HD + 64 * hf + (q & 7) * 8) = v; }
                        asm volatile("s_waitcnt lgkmcnt(0)" ::: "memory");
                    }
                    if (g4 == 0) { float* pmp = dpm + ((qtok * DIL_HPG + j_) * 3 + g_) * 2; pmp[0] = mrow; pmp[1] = lrow; }
                }
                DL_END(u + 1, 0, u + 1, 1);
            }
#undef DL_GEOM
#undef DL_LOAD
#undef DL_WRITE
#undef DL_END
        }
    }
    SEAM(3);
    if (IN(4)) {
        const float* qn = args.in[7]; const float* kn = args.in[8];
        float gq[12], gk[12];
#pragma unroll
        for (int k = 0; k < 3; ++k)
#pragma unroll
            for (int j = 0; j < 4; ++j) { gq[4 * k + j] = qn[64 * k + 4 * l15 + j] * QS_MLA; gk[4 * k + j] = kn[64 * k + 4 * l15 + j]; }
#pragma unroll 2
        for (int row = F.gw; row < M; row += F.ngw) {
            const int pos = row & (SEQ - 1);
            float cr[4], sr[4];
#pragma unroll
            for (int j = 0; j < 4; ++j) { cr[j] = cosB[pos * 32 + 4 * (l15 & 7) + j]; sr[j] = sinB[pos * 32 + 4 * (l15 & 7) + j]; if (l15 < 8) sr[j] = -sr[j]; }
            const v2u kpe = *(const v2u*)(zb + (size_t)row * ZLD + Z_KPE + 4 * l15);
#pragma unroll
            for (int it = 0; it < 4; ++it) {
                const int h = 4 * it + grp;
                {
                    const bf16* p = kvb + (size_t)row * 4096 + h * 256 + 4 * l15; v2u w[3];
                    w[0] = *(const v2u*)p; w[1] = *(const v2u*)(p + 64); w[2] = kpe;
                    float v[12];
#pragma unroll
                    for (int k = 0; k < 3; ++k) { v[4 * k] = bflo(w[k].x); v[4 * k + 1] = bfhi(w[k].x); v[4 * k + 2] = bflo(w[k].y); v[4 * k + 3] = bfhi(w[k].y); }
                    float s = 0.f;
#pragma unroll
                    for (int e = 0; e < 12; ++e) s += v[e] * v[e];
                    s = sum16(s); const float rs = 1.0f / sqrtf(s * (1.0f / MLA_QK) + NORM_EPS);
#pragma unroll
                    for (int e = 0; e < 12; ++e) v[e] = v[e] * rs * gk[e];
#pragma unroll
                    for (int j = 0; j < 4; ++j) { const float yp = __shfl_xor(v[8 + j], 8); v[8 + j] = v[8 + j] * cr[j] + yp * sr[j]; }
                    bf16* o_ = kb + (size_t)row * 3072 + h * MLA_QK + 4 * l15;
#pragma unroll
                    for (int k = 0; k < 3; ++k) { v2u o; o.x = pk2(v[4 * k], v[4 * k + 1]); o.y = pk2(v[4 * k + 2], v[4 * k + 3]); *(v2u*)(o_ + 64 * k) = o; }
                }
            }
#pragma unroll
            for (int it = 0; it < 2; ++it) {
                const int jh = 4 * it + grp; const size_t pb = ((size_t)row * DIL_HPG + jh) * 3;
                const float m0 = dpm[pb * 2 + 0], l0 = dpm[pb * 2 + 1], m1 = dpm[pb * 2 + 2], l1 = dpm[pb * 2 + 3], m2 = dpm[pb * 2 + 4], l2 = dpm[pb * 2 + 5];
                const float mm = fmaxf(m0, fmaxf(m1, m2)); const float w0 = __builtin_amdgcn_exp2f(m0 - mm) * l0, w1 = __builtin_amdgcn_exp2f(m1 - mm) * l1, w2 = __builtin_amdgcn_exp2f(m2 - mm) * l2;
                const float rw = 1.0f / (w0 + w1 + w2);
                float a0[8], a1[8], a2[8], x[8];
                unpack8(*(const v4u*)(dpo + (pb + 0) * HD + 8 * l15), a0); unpack8(*(const v4u*)(dpo + (pb + 1) * HD + 8 * l15), a1); unpack8(*(const v4u*)(dpo + (pb + 2) * HD + 8 * l15), a2);
#pragma unroll
                for (int j = 0; j < 8; ++j) x[j] = (w0 * a0[j] + w1 * a1[j] + w2 * a2[j]) * rw;
                *(v4u*)(omix + (size_t)row * 3072 + 2048 + jh * HD + 8 * l15) = pack8(x);
            }
        }
    }
    SEAM(4);
    if (IN(5)) {
        for (int i = 0; i * F.G + (int)blockIdx.x < BATCH * MLA_H * (SEQ / 256); ++i) {
            const int c = (int)blockIdx.x; int bh = i * 8 + (c & 7), qblk = c >> 3;
            if (F.G != 256) { const int u = i * F.G + c; bh = u >> 5; qblk = u & 31; }
            const int b = bh >> 4, h = bh & 15; const size_t r0 = (size_t)b * SEQ;
            MLA_UNIT(qb + (r0 + (size_t)qblk * 256) * 3072 + h * MLA_QK, kb + r0 * 3072 + h * MLA_QK, kvb + r0 * 4096 + h * 256 + 128,
                              omix + (r0 + (size_t)qblk * 256) * 3072 + h * HD, SEQ, (char*)lds, args.in[7], QS_MLA, NORM_EPS, cosB, sinB, qblk * 256);
        }
    }
    SEAM(5);
    if (IN(6)) {
        pg8::Gemm g{omix, Weout_t, M, DM, EVEN_MIX, EVEN_MIX}; pg8::StaticOrder S; S.init(M, DM, F.G, (int)blockIdx.x); pg8::EpiResidT<0> E{x_in, out, xb, xl0, xl1, ss, DM};
        pg8::gemm_phase<pg8::EpiResidT<0>, pg8::StaticOrder, true, true>(F.lds, g, S, E);
    }
    SEAM(6);
#define RSTD_PHASE() do { for (int row = F.gw; row < M; row += F.ngw) { const float s = wave_sum(ss[(size_t)row * 64 + lane]); if (lane == 0) rstd[row] = 1.0f / sqrtf(s * (1.0f / DM) + NORM_EPS); } } while (0)
#define RSTD_LOCAL() do { const int pm_lo = F.G == 256 ? 8 * ((int)blockIdx.x & 7) + (((int)blockIdx.x >> 3) & 7) : 0, pm_hi = F.G == 256 ? pm_lo + 1 : M / 256; \
        for (int pmi = pm_lo; pmi < pm_hi; ++pmi) { const int row = pmi * 256 + (F.tid >> 1); const f32x4* sp = (const f32x4*)(ss + (size_t)row * 64) + (F.tid & 1) * 8; \
            const f32x4 a = ((sp[0] + sp[1]) + (sp[2] + sp[3])) + ((sp[4] + sp[5]) + (sp[6] + sp[7])); float tot = (a[0] + a[1]) + (a[2] + a[3]); tot += __shfl_xor(tot, 1); \
            if ((F.tid & 1) == 0) rstd[row] = 1.0f / sqrtf(tot * (1.0f / DM) + NORM_EPS); } \
        asm volatile("s_waitcnt vmcnt(0)" ::: "memory"); __syncthreads(); } while (0)
#define FFN_GATEUP(layer) do { const bf16* wl = (const bf16*)(ws + WS_WFFN + (size_t)(layer) * 3 * FFN_W_BYTES); \
        pg8::Gemm g{xb, wl, M, 2 * DFF, DM, DM}; pg8::StaticOrder S; S.init(M, 2 * DFF, F.G, (int)blockIdx.x, DM / 64, (float*)(R + (size_t)(16 + 48 * (layer)) * MiB), ctl + 8192 + 2048 * (1 + (layer))); \
        pg8::EpiGateUp E{h2b, rstd, args.in[21] + (size_t)(layer) * 3 * DFF, args.in[22] + (size_t)(layer) * DFF, DFF, aedge, uedge, (PG8_LAS float*)(F.lds + NA_TB_OFF)}; \
        pg8::gemm_phase<pg8::EpiGateUp, pg8::StaticOrder, true, true, true>(F.lds, g, S, E); } while (0)
#define FFN_FIX(layer) do { const float* cwp = args.in[21] + (size_t)(layer) * 3 * DFF; const float* cbp = args.in[22] + (size_t)(layer) * DFF; \
        const int gtid = blockIdx.x * (NWAVES * 64) + F.tid, nthr = F.G * NWAVES * 64; \
        for (int i = gtid; i < (M / 256) * 2 * (DFF / 8); i += nthr) { const int c8 = i % (DFF / 8), e = (i / (DFF / 8)) & 1, pm = i / (2 * (DFF / 8)); const int ch = c8 * 8; \
            const int row = pm * 256 + (e ? 255 : 0), t = row & (SEQ - 1); const v4u z4 = {0u, 0u, 0u, 0u}; \
            const v4u cur = *(const v4u*)(aedge + ((size_t)pm * 4 + (e ? 3 : 0)) * DFF + ch); \
            const v4u prv = e ? *(const v4u*)(aedge + ((size_t)pm * 4 + 2) * DFF + ch) : (t > 0 ? *(const v4u*)(aedge + ((size_t)(pm - 1) * 4 + 3) * DFF + ch) : z4); \
            const v4u nxt = e ? (t < SEQ - 1 ? *(const v4u*)(aedge + ((size_t)(pm + 1) * 4 + 0) * DFF + ch) : z4) : *(const v4u*)(aedge + ((size_t)pm * 4 + 1) * DFF + ch); \
            const v4u upv = *(const v4u*)(uedge + ((size_t)pm * 2 + e) * DFF + ch); \
            const unsigned cu_[4] = {cur.x, cur.y, cur.z, cur.w}, pr_[4] = {prv.x, prv.y, prv.z, prv.w}, nx_[4] = {nxt.x, nxt.y, nxt.z, nxt.w}, up_[4] = {upv.x, upv.y, upv.z, upv.w}; \
            float hv[8]; \
            _Pragma("unroll") for (int j = 0; j < 8; ++j) { \
                const float fm = (j & 1) ? bfhi(pr_[j >> 1]) : bflo(pr_[j >> 1]), fz = (j & 1) ? bfhi(cu_[j >> 1]) : bflo(cu_[j >> 1]), fn = (j & 1) ? bfhi(nx_[j >> 1]) : bflo(nx_[j >> 1]), fu = (j & 1) ? bfhi(up_[j >> 1]) : bflo(up_[j >> 1]); \
                const float gg = cwp[ch + j] * fm + cwp[DFF + ch + j] * fz + cwp[2 * DFF + ch + j] * fn + cbp[ch + j]; \
                const float ee = __builtin_amdgcn_exp2f(-1.4426950408889634f * gg); hv[j] = gg * __builtin_amdgcn_rcpf(1.0f + ee) * fu; } \
            v4u o; o.x = pk2(hv[0], hv[1]); o.y = pk2(hv[2], hv[3]); o.z = pk2(hv[4], hv[5]); o.w = pk2(hv[6], hv[7]); \
            *(v4u*)(h2b + (size_t)row * DFF + ch) = o; } } while (0)
#define FFN_DOWN(layer) do { const bf16* wl = (const bf16*)(ws + WS_WFFN + (size_t)(layer) * 3 * FFN_W_BYTES + 2 * FFN_W_BYTES); \
        pg8::Gemm g{h2b, wl, M, DM, DFF, DFF}; pg8::StaticOrder S; S.init(M, DM, F.G, (int)blockIdx.x); pg8::EpiResidT<(layer) == 0 ? 1 : 2> E{nullptr, out, xb, xl0, xl1, ss, DM}; \
        pg8::gemm_phase<pg8::EpiResidT<(layer) == 0 ? 1 : 2>, pg8::StaticOrder, true, true>(F.lds, g, S, E); } while (0)
    if (IN(8)) { RSTD_LOCAL(); FFN_GATEUP(0); }
    SEAM(8);
    if (IN(9)) FFN_FIX(0);
    SEAM(9);
    if (IN(10)) FFN_DOWN(0);
    SEAM(10);
    if (IN(12)) {
        RSTD_LOCAL();
        pg8::Gemm g{xb, Wqkv_t, M, 12288, DM, DM}; pg8::StaticOrder S; S.init(M, 12288, F.G, (int)blockIdx.x); pg8::EpiHeadNorm E{qkvb, 12288, rstd, args.in[14], args.in[15], QS_HD, 16, 16, (PG8_LAS float*)(F.lds + NA_TB_OFF), nullptr, nullptr, SEQ};
        pg8::gemm_phase<pg8::EpiHeadNorm, pg8::StaticOrder, true, true>(F.lds, g, S, E);
    }
    SEAM(12);
    if (IN(14)) {
        const float* rpb = args.in[16];
        WAT_LAS char* L = (WAT_LAS char*)F.lds;
        WAT_LAS float* tb = (WAT_LAS float*)(L + NA_TB_OFF);
        const int NU = BATCH * NA_H * GRID_ROWS;
        const int u0 = (int)(((long)NU * blockIdx.x) / F.G), u1 = (int)(((long)NU * (blockIdx.x + 1)) / F.G);
        const int row16 = F.tid >> 4, ch16 = F.tid & 15, kso = wat::kst_off(row16, ch16), vso = wat::vst_off(row16, ch16);
        const int w = F.wave, q = lane & 15, g4 = lane >> 4;
        const int cg = w & 3, kc0 = min(max(16 * cg - 8, 0), 32), gc = 16 * cg + q, cs = min(max(gc - 8, 0), 48);
        unsigned vmask = 0;
#pragma unroll
        for (int j = 0; j < 8; ++j) { const int kc = kc0 + 8 * g4 + j; if (kc >= cs && kc < cs + 16) vmask |= 1u << j; }
        const int bcol = kc0 + 8 * g4 - gc + 15;
        v4u st[8]; int cur_h = -1;
#define NA_GEOM(u_, s_) const int bh_ = (u_) >> 7, i_ = (u_) & 127, b_ = bh_ >> 5, h_ = bh_ & 31, rs_ = min(max(i_ - 4, 0), GRID_ROWS - 8); \
        const bf16* src_ = qkvb + (size_t)(b_ * SEQ + (rs_ + 4 * ((s_) & 1)) * GRID_W + row16) * 12288 + ((s_) < 2 ? 4096 : 8192) + h_ * HD + ch16 * 8;
#define NA_LOAD(u_, s_) do { NA_GEOM(u_, s_) _Pragma("unroll") for (int k = 0; k < 8; ++k) st[k] = *(const v4u*)(src_ + (size_t)k * 32 * 12288); } while (0)
#define NA_WRITE(s_) do { WAT_LAS char* d_ = L + ((s_) & 1) * 65536 + ((s_) < 2 ? kso : vso); _Pragma("unroll") for (int k = 0; k < 8; ++k) *(WAT_LAS v4u*)(d_ + k * 32 * 256) = st[k]; } while (0)
#define NA_END(un_, sn_, un2_, sn2_) do { if ((un_) < u1) { VM_WAIT(); NA_WRITE(sn_); } __syncthreads(); if ((un2_) < u1) NA_LOAD(un2_, sn2_); } while (0)
        if (u0 < u1) { NA_LOAD(u0, 0); VM_WAIT(); NA_WRITE(0); __syncthreads(); NA_LOAD(u0, 1); }
        for (int u = u0; u < u1; ++u) {
            const int bh = u >> 7, gi = u & 127, b = bh >> 5, h = bh & 31, rs0 = min(max(gi - 4, 0), GRID_ROWS - 8);
            wat::bf16x8 qf[4]; wat::f32x4 sc[8][2]; wat::bf16x8 pf[8]; wat::f32x4 o[8]; float linv = 0.f;
            if (h != cur_h) { for (int t = F.tid; t < 465; t += NWAVES * 64) tb[t] = rpb[(size_t)h * 465 + t] * LOG2E; cur_h = h; }
            if (w < 4) {
                const bf16* qp = qkvb + (size_t)(b * SEQ + gi * GRID_W + gc) * 12288 + h * HD + 8 * g4;
#pragma unroll
                for (int s = 0; s < 4; ++s) qf[s] = *(const wat::bf16x8*)(qp + 32 * s);
#pragma unroll
                for (int g = 0; g < 4; ++g) wat::qk_group(sc[g][0], sc[g][1], L, g * 64 + kc0, qf, lane);
            }
            NA_END(u, 1, u, 2);
            if (w < 4) {
#pragma unroll
                for (int g = 0; g < 4; ++g) wat::qk_group(sc[4 + g][0], sc[4 + g][1], L + 65536, g * 64 + kc0, qf, lane);
                float m = -1e30f;
#pragma unroll
                for (int kr = 0; kr < 8; ++kr) { const WAT_LAS float* tr_ = tb + (rs0 + kr - gi + NA_ROWS - 1) * 31 + bcol;
#pragma unroll
                    for (int j = 0; j < 8; ++j) { const bool ok = (vmask >> j) & 1u; const float bias = ok ? tr_[j] : 0.f; const float v = ok ? sc[kr][j >> 2][j & 3] + bias : -1e30f; sc[kr][j >> 2][j & 3] = v; m = fmaxf(m, v); } }
                m = fmaxf(m, __shfl_xor(m, 16)); m = fmaxf(m, __shfl_xor(m, 32));
                float l = 0.f;
#pragma unroll
                for (int kr = 0; kr < 8; ++kr) {
#pragma unroll
                    for (int j = 0; j < 8; ++j) { const float v = ((vmask >> j) & 1u) ? __builtin_amdgcn_exp2f(sc[kr][j >> 2][j & 3] - m) : 0.f; sc[kr][j >> 2][j & 3] = v; l += v; }
                    pf[kr] = wat::p_frag(sc[kr][0], sc[kr][1]); }
                l += __shfl_xor(l, 16); l += __shfl_xor(l, 32); linv = 1.0f / l;
#pragma unroll
                for (int c = 0; c < 8; ++c) o[c] = wat::f32x4{0.f, 0.f, 0.f, 0.f};
            }
            NA_END(u, 2, u, 3);
            if (w < 4) {
                { const unsigned vb = (unsigned)(uintptr_t)L + (unsigned)wat::vrd_base(kc0, lane); wat::pv_group<0>(o, vb, pf[0]); wat::pv_group<16384>(o, vb, pf[1]); wat::pv_group<32768>(o, vb, pf[2]); wat::pv_group<49152>(o, vb, pf[3]); }
            }
            NA_END(u, 3, u + 1, 0);
            if (w < 4) {
                { const unsigned vb = (unsigned)(uintptr_t)(L + 65536) + (unsigned)wat::vrd_base(kc0, lane); wat::pv_group<0>(o, vb, pf[4]); wat::pv_group<16384>(o, vb, pf[5]); wat::pv_group<32768>(o, vb, pf[6]); wat::pv_group<49152>(o, vb, pf[7]); }
                WAT_LAS char* ost = L + NA_OST_OFF + w * 4352;
#pragma unroll
                for (int r = 0; r < 4; ++r) { const float li = __shfl(linv, 4 * g4 + r);
#pragma unroll
                    for (int c = 0; c < 8; ++c) *(WAT_LAS unsigned short*)(ost + (4 * g4 + r) * 272 + (16 * c + q) * 2) = (unsigned short)(wat::cvtpk(o[c][r] * li, 0.f) & 0xffffu); }
                asm volatile("s_waitcnt lgkmcnt(0)" ::: "memory");
#pragma unroll
                for (int k = 0; k < 4; ++k) { const int rq = g4 + 4 * k; const v4u v = *(const WAT_LAS v4u*)(ost + rq * 272 + q * 16);
                    *(v4u*)(ob + (size_t)(b * SEQ + gi * GRID_W + 16 * cg + rq) * DM + h * HD + q * 8) = v; }
            }
            NA_END(u + 1, 0, u + 1, 1);
        }
#undef NA_GEOM
#undef NA_LOAD
#undef NA_WRITE
#undef NA_END
    }
    SEAM(14);
    if (IN(15)) {
        pg8::Gemm g{ob, Woout_t, M, DM, DM, DM}; pg8::StaticOrder S; S.init(M, DM, F.G, (int)blockIdx.x); pg8::EpiResidT<1> E{nullptr, out, xb, xl0, xl1, ss, DM};
        pg8::gemm_phase<pg8::EpiResidT<1>, pg8::StaticOrder, true, true>(F.lds, g, S, E);
    }
    SEAM(15);
    if (IN(17)) { RSTD_LOCAL(); FFN_GATEUP(1); }
    SEAM(17);
    if (IN(18)) FFN_FIX(1);
    SEAM(18);
    if (IN(19)) FFN_DOWN(1);
#undef IN
#undef SEAM
}

#if MK_CHECK
constexpr size_t WS_CHK = 9 * MiB;
constexpr int NS = 32;
__device__ const int g_rows[16] = {0, 1, 63, 64, 65, 127, 128, 4095, 4096, 8190, 8191, 8192, 8193, 8255, 16382, 16383};
__device__ __forceinline__ int srow(int i) { return i < 16 ? g_rows[i] : (int)(((unsigned)i * 2654435761u >> 9) % (unsigned)M); }
__device__ __forceinline__ int scol(int j, int N) { return j == 0 ? 0 : (j == 1 ? N - 1 : (int)(((unsigned)j * 2246822519u + 12345u) % (unsigned)N)); }
__device__ __forceinline__ float bf2f(bf16 b) { return __uint_as_float((unsigned)b << 16); }
__device__ __forceinline__ void chk_rec(unsigned* w, int c, float got, float ref, float scale) {
    float e = fabsf(got - ref) / (0.03f * (fabsf(ref) + scale)); if (!(e == e) || !(e < 1e30f)) e = 1e30f;
    atomicMax(&w[c], __float_as_uint(e));
}
__device__ __forceinline__ float dot_bf(const bf16* a, const bf16* b, int K) { float s = 0.f; for (int k = 0; k < K; ++k) s += bf2f(a[k]) * bf2f(b[k]); return s; }
__global__ void k_chk_gemm(const bf16* A, int lda, const bf16* Bt, int K, int N, const float* rs, const float* base, int base_ld, int base_by_sample,
                           const bf16* got_b, const float* got_f, int ldo, unsigned* w, int c, float scale) {
    const int i = blockIdx.x, j = threadIdx.x, row = srow(i), col = scol(j, N);
    float ref = dot_bf(A + (size_t)row * lda, Bt + (size_t)col * K, K); if (rs) ref *= rs[row];
    if (base) ref += base_by_sample == 2 ? bf2f(((const bf16*)base)[(size_t)i * base_ld + col]) : base[(size_t)(base_by_sample ? i : row) * base_ld + col];
    const float got = got_b ? bf2f(got_b[(size_t)row * ldo + col]) : got_f[(size_t)row * ldo + col];
    chk_rec(w, c, got, ref, scale);
}
__global__ void k_chk_copy(const unsigned char* src, size_t row_bytes, unsigned char* dst) {
    const int i = blockIdx.x, row = srow(i); for (size_t b = threadIdx.x * 4; b < row_bytes; b += blockDim.x * 4) *(unsigned*)(dst + (size_t)i * row_bytes + b) = *(const unsigned*)(src + (size_t)row * row_bytes + b);
}
__global__ void k_chk_rstd(const float* src, const float* rstd, const bf16* xb, unsigned* w, int c) {
    const int i = blockIdx.x * blockDim.x + threadIdx.x; if (i >= NS) return; const int row = srow(i); float s = 0.f;
    for (int k = 0; k < DM; ++k) { const float v = src[(size_t)row * DM + k]; s += v * v; }
    chk_rec(w, c, rstd[row], 1.0f / sqrtf(s / DM + NORM_EPS), 0.f);
    if (xb) for (int k = 0; k < DM; k += 97) chk_rec(w, c, bf2f(xb[(size_t)row * DM + k]), src[(size_t)row * DM + k], 0.01f);
}
__global__ void k_chk_w(const float* W, int K, int N, const bf16* dst, const float* gain, int mode, unsigned* w, int c) {
    const unsigned t = blockIdx.x * blockDim.x + threadIdx.x; const int k = (int)((t * 2654435761u >> 7) % (unsigned)K), n = scol((int)t, N);
    const int dr = (mode == 1) ? (n >= 1472 ? n - 1472 : n + 9216) : (mode >= 2 ? (n >> 7) * 256 + (n & 127) + (mode == 3 ? 128 : 0) : n); float ref = W[(size_t)k * N + n]; if (gain) ref *= gain[k];
    chk_rec(w, c, bf2f(dst[(size_t)dr * K + k]), ref, 1e-4f);
}
__global__ void k_chk_rope(const float* cosT, const float* sinT, int half, double c1, unsigned* w, int c) {
    const int t = blockIdx.x * blockDim.x + threadIdx.x; const int k = t % half; int pos = 1 + (int)(((unsigned)t * 2654435761u >> 8) % (unsigned)(SEQ - 1));
    double p = 1.0; for (int j = 0; j < k; ++j) p *= c1; const double th = (double)(float)p;
    double sn = 0, cs = 0, term = 1.0; for (int n = 0; n < 24; ++n) { if (n & 1) sn += ((n >> 1) & 1 ? -term : term); else cs += ((n >> 1) & 1 ? -term : term); term *= th / (n + 1); }
    chk_rec(w, c, cosT[1 * half + k], (float)cs, 0.02f); chk_rec(w, c, sinT[1 * half + k], (float)sn, 0.02f);
    chk_rec(w, c, cosT[k], 1.f, 0.02f); chk_rec(w, c, sinT[k], 0.f, 0.02f);
    const float ca = cosT[(pos - 1) * half + k], sa = sinT[(pos - 1) * half + k], c1f = cosT[half + k], s1f = sinT[half + k];
    chk_rec(w, c, cosT[pos * half + k], ca * c1f - sa * s1f, 0.03f); chk_rec(w, c, sinT[pos * half + k], sa * c1f + ca * s1f, 0.03f);
}
__global__ void k_chk_p2(const bf16* zc, const bf16* z, const bf16* cqn, const bf16* ckvn, const float* dqn, const float* dkn, const float* cosA, const float* sinA, unsigned* w, int c) {
    const int i = blockIdx.x, t = threadIdx.x, row = srow(i), pos = row & (SEQ - 1); const bf16* src = zc + (size_t)i * ZLD;
    if (false) { const bf16* p = src + t * HD; float s = 0.f; for (int d = 0; d < HD; ++d) s += bf2f(p[d]) * bf2f(p[d]);
        const float rs = 1.0f / sqrtf(s / HD + NORM_EPS); const float* g = t < 24 ? dqn : dkn; const float qs = t < 24 ? QS_HD : 1.f;
        for (int d = 0; d < HD; ++d) { float y = bf2f(p[d]) * rs * g[d];
            if (d < 16) y = y * cosA[pos * 16 + d] - bf2f(p[d + 16]) * rs * g[d + 16] * sinA[pos * 16 + d];
            else if (d < 32) y = y * cosA[pos * 16 + d - 16] + bf2f(p[d - 16]) * rs * g[d - 16] * sinA[pos * 16 + d - 16];
            chk_rec(w, c, bf2f(z[(size_t)row * ZLD + t * HD + d]), y * qs, 0.05f * qs); } }
    else if (t == 48) { float s = 0.f; for (int d = 0; d < QRANK; ++d) s += bf2f(src[Z_CQ + d]) * bf2f(src[Z_CQ + d]); const float rs = 1.0f / sqrtf(s / QRANK + NORM_EPS);
        for (int d = 0; d < QRANK; ++d) chk_rec(w, c, bf2f(cqn[(size_t)row * QRANK + d]), bf2f(src[Z_CQ + d]) * rs, 0.05f); }
    else if (t == 49) { float s = 0.f; for (int d = 0; d < KVRANK; ++d) s += bf2f(src[Z_CKV + d]) * bf2f(src[Z_CKV + d]); const float rs = 1.0f / sqrtf(s / KVRANK + NORM_EPS);
        for (int d = 0; d < KVRANK; ++d) chk_rec(w, c, bf2f(ckvn[(size_t)row * KVRANK + d]), bf2f(src[Z_CKV + d]) * rs, 0.05f); }
}
__global__ void k_chk_p4(const bf16* qc, bf16* qn_out, const bf16* kv, const bf16* z, const bf16* kout, const float* qn, const float* kn, const float* cosB, const float* sinB, unsigned* w, int c) {
    const int i = blockIdx.x, t = threadIdx.x, row = srow(i), pos = row & (SEQ - 1), h = t & 15; const bool isk = t >= 16;
    float s = 0.f;
    for (int d = 0; d < MLA_QK; ++d) { const float v = isk ? (d < 128 ? bf2f(kv[(size_t)row * 4096 + h * 256 + d]) : bf2f(z[(size_t)row * ZLD + Z_KPE + d - 128])) : bf2f(qc[(size_t)i * 3072 + h * MLA_QK + d]); s += v * v; }
    const float rs = 1.0f / sqrtf(s / MLA_QK + NORM_EPS); const float* g = isk ? kn : qn; const float qs = isk ? 1.f : QS_MLA;
    for (int d = 0; d < MLA_QK; ++d) {
        auto val = [&](int dd) { return (isk ? (dd < 128 ? bf2f(kv[(size_t)row * 4096 + h * 256 + dd]) : bf2f(z[(size_t)row * ZLD + Z_KPE + dd - 128])) : bf2f(qc[(size_t)i * 3072 + h * MLA_QK + dd])) * rs * g[dd]; };
        float y = val(d);
        if (d >= 128 && d < 160) y = y * cosB[pos * 32 + d - 128] - val(d + 32) * sinB[pos * 32 + d - 128];
        else if (d >= 160) y = y * cosB[pos * 32 + d - 160] + val(d - 32) * sinB[pos * 32 + d - 160];
        if (!isk) { qn_out[(size_t)i * 3072 + h * MLA_QK + d] = (bf16)f2bf(y * qs); continue; }
        chk_rec(w, c, bf2f(kout[(size_t)row * 3072 + h * MLA_QK + d]), y * qs, 0.05f * qs); }
}
__global__ void k_chk_mla(const bf16* q, const bf16* k, const bf16* kv, const bf16* omix, unsigned* w, int c) {
    const int i = blockIdx.x, t = threadIdx.x, row = srow(i), b0 = row & ~(SEQ - 1), h = (i * 7 + 3) & 15, d = (t * 37 + i) & 127;
    const bf16* qp = q + (size_t)i * 3072 + h * MLA_QK; float m = -1e30f;
    for (int key = 0; key < SEQ; ++key) m = fmaxf(m, dot_bf(qp, k + (size_t)(b0 + key) * 3072 + h * MLA_QK, MLA_QK));
    float l = 0.f, o = 0.f, o2 = 0.f;
    for (int key = 0; key < SEQ; ++key) { const float p = exp2f(dot_bf(qp, k + (size_t)(b0 + key) * 3072 + h * MLA_QK, MLA_QK) - m); const float v = bf2f(kv[(size_t)(b0 + key) * 4096 + h * 256 + 128 + d]); l += p; o += p * v; o2 += p * v * v; }
    chk_rec(w, c, bf2f(omix[(size_t)row * 3072 + h * HD + d]), o / l, 0.5f * sqrtf(o2 / l) * 0.1f + 1e-3f);
}
__global__ void k_chk_dil(const bf16* z, const bf16* omix, unsigned* w, int c) {
    const int i = blockIdx.x, t = threadIdx.x, row = srow(i), b0 = row & ~(SEQ - 1), pos = row & (SEQ - 1), j = (i * 5 + 1) & 7, d = (t * 37 + i) & 127;
    float m = -1e30f;
    for (int g = 0; g < 3; ++g) { const int dl = 1 << (2 * g), head = 8 * g + j; for (int tt = -64; tt <= 64; ++tt) { const int kp = pos + dl * tt; if (kp < 0 || kp >= SEQ) continue;
        m = fmaxf(m, dot_bf(z + (size_t)row * ZLD + head * HD, z + (size_t)(b0 + kp) * ZLD + 3072 + head * HD, HD)); } }
    float l = 0.f, o = 0.f;
    for (int g = 0; g < 3; ++g) { const int dl = 1 << (2 * g), head = 8 * g + j; for (int tt = -64; tt <= 64; ++tt) { const int kp = pos + dl * tt; if (kp < 0 || kp >= SEQ) continue;
        const float p = exp2f(dot_bf(z + (size_t)row * ZLD + head * HD, z + (size_t)(b0 + kp) * ZLD + 3072 + head * HD, HD) - m); l += p; o += p * bf2f(z[(size_t)(b0 + kp) * ZLD + 6144 + head * HD + d]); } }
    chk_rec(w, c, bf2f(omix[(size_t)row * 3072 + 2048 + j * HD + d]), o / l, 0.02f);
}
__global__ void k_chk_na(const bf16* qkv, const float* rpb, const bf16* ob, unsigned* w, int c) {
    const int i = blockIdx.x, t = threadIdx.x, row = srow(i), b0 = row & ~(SEQ - 1), pos = row & (SEQ - 1), gi = pos >> 6, gc = pos & 63, h = (i * 11 + 5) & 31, d = (t * 37 + i) & 127;
    const int rs0 = min(max(gi - 4, 0), GRID_ROWS - 8), cs0 = min(max(gc - 8, 0), 48); float m = -1e30f;
    for (int kr = 0; kr < 8; ++kr) for (int kc = 0; kc < 16; ++kc) { const int key = b0 + (rs0 + kr) * 64 + cs0 + kc;
        m = fmaxf(m, dot_bf(qkv + (size_t)row * 12288 + h * HD, qkv + (size_t)key * 12288 + 4096 + h * HD, HD) + rpb[(size_t)h * 465 + (rs0 + kr - gi + 7) * 31 + (cs0 + kc - gc + 15)] * LOG2E); }
    float l = 0.f, o = 0.f;
    for (int kr = 0; kr < 8; ++kr) for (int kc = 0; kc < 16; ++kc) { const int key = b0 + (rs0 + kr) * 64 + cs0 + kc;
        const float p = exp2f(dot_bf(qkv + (size_t)row * 12288 + h * HD, qkv + (size_t)key * 12288 + 4096 + h * HD, HD) + rpb[(size_t)h * 465 + (rs0 + kr - gi + 7) * 31 + (cs0 + kc - gc + 15)] * LOG2E - m);
        l += p; o += p * bf2f(qkv[(size_t)key * 12288 + 8192 + h * HD + d]); }
    chk_rec(w, c, bf2f(ob[(size_t)row * DM + h * HD + d]), o / l, 0.03f);
}
__global__ void k_chk_p13(const bf16* qc, const bf16* qkv, const float* qn, const float* kn, unsigned* w, int c) {
    const int i = blockIdx.x, t = threadIdx.x, row = srow(i); const bf16* p = qc + (size_t)i * 12288 + t * HD; float s = 0.f;
    for (int d = 0; d < HD; ++d) s += bf2f(p[d]) * bf2f(p[d]);
    const float rs = 1.0f / sqrtf(s / HD + NORM_EPS); const float* g = t < 32 ? qn : kn; const float qs = t < 32 ? QS_HD : 1.f;
    for (int d = 0; d < HD; ++d) chk_rec(w, c, bf2f(qkv[(size_t)row * 12288 + t * HD + d]), bf2f(p[d]) * rs * g[d] * qs, 0.05f * qs);
}
__global__ void k_chk_qkvn(const bf16* xb, const bf16* Wt, const float* rstd, const bf16* qkv, const float* qn, const float* kn, unsigned* w, int c) {
    const int i = blockIdx.x, t = threadIdx.x, row = srow(i), head = (t * 7 + i) % 96, d = (t * 37 + i * 5) & 127; float s = 0.f, mine = 0.f;
    for (int dd = 0; dd < HD; ++dd) { const float v = dot_bf(xb + (size_t)row * DM, Wt + (size_t)(head * HD + dd) * DM, DM) * rstd[row]; s += v * v; if (dd == d) mine = v; }
    float ref = mine; if (head < 64) { const float rs = 1.0f / sqrtf(s / HD + NORM_EPS); ref = mine * rs * (head < 32 ? qn[d] * QS_HD : kn[d]); }
    chk_rec(w, c, bf2f(qkv[(size_t)row * 12288 + head * HD + d]), ref, head < 32 ? 0.05f * QS_HD : 0.05f);
}
__global__ void k_chk_zn(const bf16* xb, const bf16* Wt, const float* rstd, const bf16* z, const float* dqn, const float* dkn, const float* cosA, const float* sinA, unsigned* w, int c) {
    const int i = blockIdx.x, t = threadIdx.x, row = srow(i), pos = row & (SEQ - 1);
    if (t < 48) { const int d = (t * 37 + i * 5) & 127; const int dp = d < 16 ? d + 16 : (d < 32 ? d - 16 : d); float s = 0.f, mine = 0.f, other = 0.f;
        for (int dd = 0; dd < HD; ++dd) { const float v = dot_bf(xb + (size_t)row * DM, Wt + (size_t)(t * HD + dd) * DM, DM) * rstd[row]; s += v * v; if (dd == d) mine = v; if (dd == dp) other = v; }
        const float rs = 1.0f / sqrtf(s / HD + NORM_EPS); const float* g = t < 24 ? dqn : dkn; const float qs = t < 24 ? QS_HD : 1.f;
        float y = mine * rs * g[d]; const float yo = other * rs * g[dp];
        if (d < 16) y = y * cosA[pos * 16 + d] - yo * sinA[pos * 16 + d]; else if (d < 32) y = y * cosA[pos * 16 + d - 16] + yo * sinA[pos * 16 + d - 16];
        chk_rec(w, c, bf2f(z[(size_t)row * ZLD + t * HD + d]), y * qs, 0.05f * qs); }
    else { const int col = 6144 + scol(t, 10688 - 6144); const float ref = dot_bf(xb + (size_t)row * DM, Wt + (size_t)col * DM, DM) * rstd[row]; chk_rec(w, c, bf2f(z[(size_t)row * ZLD + col]), ref, 0.05f); }
}
__global__ void k_chk_up(const bf16* xb, const bf16* Wgu, const float* rstd, const float* cw, const float* cb, const bf16* h2, unsigned* w, int c) {
    const int i = blockIdx.x, j = threadIdx.x, col = scol(j, DFF); int row = srow(i); if (i & 1) row = (row & ~255) + ((i & 2) ? 255 : 0) + ((i & 4) ? ((i & 2) ? -1 : 1) : 0);
    const int cls = i < 16 ? 42 + i : 58 + (i & 1);
    const int t = row & (SEQ - 1); const bf16* wg = Wgu + (size_t)((col >> 7) * 256 + (col & 127)) * DM; const bf16* wu = wg + (size_t)128 * DM;
    const bool edge = (row & 255) == 0 || (row & 255) == 255;
    auto rd = [&](float v) { return edge ? __uint_as_float(f2bf(v) << 16) : v; };
    const float up = rd(dot_bf(xb + (size_t)row * DM, wu, DM) * rstd[row]);
    float g = cb[col] + cw[DFF + col] * rd(dot_bf(xb + (size_t)row * DM, wg, DM) * rstd[row]);
    if (t > 0) g += cw[col] * rd(dot_bf(xb + (size_t)(row - 1) * DM, wg, DM) * rstd[row - 1]); if (t < SEQ - 1) g += cw[2 * DFF + col] * rd(dot_bf(xb + (size_t)(row + 1) * DM, wg, DM) * rstd[row + 1]);
    const float ref = g / (1.0f + expf(-g)) * up;
    chk_rec(w, cls, bf2f(h2[(size_t)row * DFF + col]), ref, 0.05f);
}
__global__ void k_chk_rq(const bf16* z, const float* rq, const float* rkv, unsigned* w, int c) {
    const int i = blockIdx.x * blockDim.x + threadIdx.x; if (i >= NS) return; const int row = srow(i); const bf16* src = z + (size_t)row * ZLD; float s = 0.f, t = 0.f;
    for (int d = 0; d < QRANK; ++d) s += bf2f(src[Z_CQ + d]) * bf2f(src[Z_CQ + d]);
    for (int d = 0; d < KVRANK; ++d) t += bf2f(src[Z_CKV + d]) * bf2f(src[Z_CKV + d]);
    chk_rec(w, c, rq[row], 1.0f / sqrtf(s / QRANK + NORM_EPS), 0.f); chk_rec(w, c, rkv[row], 1.0f / sqrtf(t / KVRANK + NORM_EPS), 0.f);
}
__global__ void k_chk_final(unsigned* w, float* out) {
    if (threadIdx.x != 0 || blockIdx.x != 0) return;
    for (int c = 0; c < 64; ++c) { const float e = __uint_as_float(w[c]); if (e > 1.0f) { int b = 0; float x = e; while (x >= 10.f && b < 20) { x *= 0.1f; ++b; } float V = (float)(10 + c) * 100.f; for (int q = 0; q < b; ++q) V *= 10.f; out[0] = V; return; } }
}
#endif
#ifndef MK_ONE_LAUNCH
#define MK_ONE_LAUNCH 1
#endif
extern "C" void kernel_launch(void* const* d_in, const int* in_sizes, int n_in, void* d_out, int out_size, void* d_ws, size_t ws_size, hipStream_t stream) {
    static int grid = 0;
    if (grid == 0) {
        const long long want[24] = {(long long)M * DM, DM, (long long)DM * EVEN_IN, QRANK, KVRANK, (long long)QRANK * 3072, (long long)KVRANK * 4096, MLA_QK, MLA_QK, HD, HD, (long long)EVEN_MIX * DM,
                                    DM, (long long)DM * 12288, HD, HD, (long long)NA_H * 15 * 31, (long long)DM * DM, 2 * DM, 2LL * DM * DFF, 2LL * DM * DFF, 2 * 3 * DFF, 2 * DFF, 2LL * DFF * DM};
        bool sizes_ok = n_in == 24; for (int i = 0; sizes_ok && i < 24; ++i) if ((long long)in_sizes[i] != want[i]) { fprintf(stderr, "kernel_launch: input %d has %d elements, expected %lld\n", i, in_sizes[i], want[i]); sizes_ok = false; }
        if (!sizes_ok || out_size != M * DM || ws_size < WS_END) { fprintf(stderr, "kernel_launch: unexpected shapes: n_in %d in0 %d out %d ws %zu (need %zu)\n", n_in, n_in > 0 ? in_sizes[0] : -1, out_size, ws_size, (size_t)WS_END); grid = -1; return; }
        int dev = 0, cus = 0, per_cu = 0;
        if (hipGetDevice(&dev) != hipSuccess || hipDeviceGetAttribute(&cus, hipDeviceAttributeMultiprocessorCount, dev) != hipSuccess) { grid = -1; return; }
        if (hipFuncSetAttribute((const void*)mk_fwd, hipFuncAttributeMaxDynamicSharedMemorySize, LDS_BYTES) != hipSuccess) { fprintf(stderr, "kernel_launch: hipFuncSetAttribute failed\n"); grid = -1; return; }
        if (hipOccupancyMaxActiveBlocksPerMultiprocessor(&per_cu, (const void*)mk_fwd, NWAVES * 64, LDS_BYTES) != hipSuccess || per_cu < 1) fprintf(stderr, "kernel_launch: occupancy query reports %d\n", per_cu);
        (void)hipGetLastError();
        grid = cus;
    }
    if (grid < 0) return;
    if (hipMemsetAsync((char*)d_ws + WS_CTL, 0, CTL_ZERO_BYTES, stream) != hipSuccess) return;
    Args a{};
    for (int i = 0; i < 24; ++i) a.in[i] = (const float*)d_in[i];
    a.out = (float*)d_out; a.ws = (unsigned char*)d_ws;
#if MK_ONE_LAUNCH
    a.ph_lo = 0; a.ph_hi = N_PHASES;
    hipLaunchKernelGGL(mk_fwd, dim3(grid), dim3(NWAVES * 64), LDS_BYTES, stream, a);
#else
#if MK_CHECK
    unsigned char* ws = (unsigned char*)d_ws; unsigned* cw = (unsigned*)(ws + WS_CHK); (void)hipMemsetAsync(cw, 0, 256, stream);
    bf16* cp_z = (bf16*)(ws + WS_CHK + 1 * MiB); bf16* cp_q = (bf16*)(ws + WS_CHK + 2 * MiB); float* cp_out = (float*)(ws + WS_CHK + 3 * MiB); bf16* cp_qkv = (bf16*)(ws + WS_CHK + 4 * MiB); bf16* cp_qn = (bf16*)(ws + WS_CHK + 5 * MiB);
    float* cosA = (float*)(ws + WS_ROPE); float* sinA = cosA + SEQ * 16; float* cosB = sinA + SEQ * 16; float* sinB = cosB + SEQ * 32;
    float* rstd = (float*)(ws + WS_RSTD); bf16* xb = (bf16*)(ws + WS_XB); unsigned char* R = ws + WS_R;
    bf16* zb = (bf16*)(R + R_Z); bf16* qb = (bf16*)(R + R_Q); bf16* kvb = (bf16*)(R + R_KV); bf16* kb = (bf16*)(R + R_K); bf16* omix = (bf16*)(R + R_OMIX);
    bf16* cqn = (bf16*)(R + R_CQN); bf16* ckvn = (bf16*)(R + R_CKVN); bf16* h2b = (bf16*)(R + R_H2); bf16* qkvb = (bf16*)(R + R_QKV); bf16* ob = (bf16*)(R + R_O);
    bf16* Win_t = (bf16*)(ws + WS_WIN); bf16* Wuq_t = (bf16*)(ws + WS_WUQ); bf16* Wukv_t = (bf16*)(ws + WS_WUKV); bf16* Weout_t = (bf16*)(ws + WS_WEOUT); bf16* Wqkv_t = (bf16*)(ws + WS_WQKV); bf16* Woout_t = (bf16*)(ws + WS_WOOUT);
    float* out = (float*)d_out; const float* const* in = a.in;
    auto WL = [&](int layer, int which) { return (bf16*)(ws + WS_WFFN + (size_t)layer * 3 * FFN_W_BYTES + (size_t)which * FFN_W_BYTES); };
#endif
    for (int p = 0; p < N_PHASES; ++p) {
#if MK_CHECK
        if (p == 2) k_chk_copy<<<NS, 256, 0, stream>>>((const unsigned char*)zb, (size_t)ZLD * 2, (unsigned char*)cp_z);
        if (p == 4) k_chk_copy<<<NS, 256, 0, stream>>>((const unsigned char*)qb, (size_t)3072 * 2, (unsigned char*)cp_q);
        if (p == 10 || p == 15 || p == 19) k_chk_copy<<<NS, 256, 0, stream>>>((const unsigned char*)xb, (size_t)DM * 2, (unsigned char*)cp_out);
#endif
        a.ph_lo = p; a.ph_hi = p + 1; hipLaunchKernelGGL(mk_fwd, dim3(grid), dim3(NWAVES * 64), LDS_BYTES, stream, a);
#if MK_CHECK
        const int c = 2 * p;
        if (p == 0) {
            k_chk_w<<<4, 64, 0, stream>>>(in[2], DM, EVEN_IN, Win_t, in[1], 1, cw, c); k_chk_w<<<4, 64, 0, stream>>>(in[5], QRANK, 3072, Wuq_t, in[3], 0, cw, c); k_chk_w<<<4, 64, 0, stream>>>(in[6], KVRANK, 4096, Wukv_t, in[4], 0, cw, c);
            k_chk_w<<<4, 64, 0, stream>>>(in[11], EVEN_MIX, DM, Weout_t, nullptr, 0, cw, c); k_chk_w<<<4, 64, 0, stream>>>(in[13], DM, 12288, Wqkv_t, in[12], 0, cw, c); k_chk_w<<<4, 64, 0, stream>>>(in[17], DM, DM, Woout_t, nullptr, 0, cw, c);
            for (int l = 0; l < 2; ++l) { k_chk_w<<<4, 64, 0, stream>>>(in[19] + (size_t)l * DM * DFF, DM, DFF, WL(l, 0), in[18] + l * DM, 2, cw, c); k_chk_w<<<4, 64, 0, stream>>>(in[20] + (size_t)l * DM * DFF, DM, DFF, WL(l, 0), in[18] + l * DM, 3, cw, c);
                k_chk_w<<<4, 64, 0, stream>>>(in[23] + (size_t)l * DFF * DM, DFF, DM, WL(l, 2), nullptr, 0, cw, c); }
            k_chk_rstd<<<1, 64, 0, stream>>>(in[0], rstd, xb, cw, c + 1);
            k_chk_rope<<<8, 64, 0, stream>>>(cosA, sinA, 16, 0.44036660267178046, cw, 40); k_chk_rope<<<8, 64, 0, stream>>>(cosB, sinB, 32, 0.6636012376960885, cw, 41);
        }
        if (p == 1) k_chk_zn<<<NS, 64, 0, stream>>>(xb, Win_t, rstd, zb, in[9], in[10], cosA, sinA, cw, c);
        if (p == 3) { k_chk_rq<<<1, 64, 0, stream>>>(zb, rstd + M, rstd + 2 * M, cw, 4);
                      k_chk_gemm<<<NS, 64, 0, stream>>>(zb + Z_CQ, ZLD, Wuq_t, QRANK, 3072, rstd + M, nullptr, 0, 0, qb, nullptr, 3072, cw, c, 0.05f);
                      k_chk_gemm<<<NS, 64, 0, stream>>>(zb + Z_CKV, ZLD, Wukv_t, KVRANK, 4096, rstd + 2 * M, nullptr, 0, 0, kvb, nullptr, 4096, cw, c + 1, 0.05f); }
        if (p == 4) k_chk_p4<<<NS, 32, 0, stream>>>(cp_q, cp_qn, kvb, zb, kb, in[7], in[8], cosB, sinB, cw, c);
        if (p == 5) { k_chk_mla<<<NS, 8, 0, stream>>>(cp_qn, kb, kvb, omix, cw, c); k_chk_dil<<<NS, 8, 0, stream>>>(zb, omix, cw, c + 1); }
        if (p == 6) k_chk_gemm<<<NS, 64, 0, stream>>>(omix, EVEN_MIX, Weout_t, EVEN_MIX, DM, nullptr, in[0], DM, 0, nullptr, out, DM, cw, c, 0.05f);
        if (p == 8 || p == 12 || p == 17) k_chk_rstd<<<1, 64, 0, stream>>>(out, rstd, xb, cw, c + 1);
        if (p == 9 || p == 18) { const int l = p == 9 ? 0 : 1; k_chk_up<<<NS, 64, 0, stream>>>(xb, WL(l, 0), rstd, in[21] + (size_t)l * 3 * DFF, in[22] + (size_t)l * DFF, h2b, cw, c); }
        if (p == 10 || p == 19) k_chk_gemm<<<NS, 64, 0, stream>>>(h2b, DFF, WL(p == 10 ? 0 : 1, 2), DFF, DM, nullptr, cp_out, DM, 2, nullptr, out, DM, cw, c, 0.05f);
        if (p == 12) k_chk_qkvn<<<NS, 64, 0, stream>>>(xb, Wqkv_t, rstd, qkvb, in[14], in[15], cw, c);
        if (p == 14) k_chk_na<<<NS, 8, 0, stream>>>(qkvb, in[16], ob, cw, c);
        if (p == 15) k_chk_gemm<<<NS, 64, 0, stream>>>(ob, DM, Woout_t, DM, DM, nullptr, cp_out, DM, 2, nullptr, out, DM, cw, c, 0.05f);
#endif
    }
#if MK_CHECK
    k_chk_final<<<1, 64, 0, stream>>>(cw, out);
#endif
#endif
    const hipError_t le = hipPeekAtLastError();
    if (le != hipSuccess) fprintf(stderr, "kernel_launch: launch failed: %s\n", hipGetErrorName(le));
}
```

```cpp
#include <hip/hip_runtime.h>
#include <cstdio>
#include <cstdint>
#ifndef MK_CHECK
#define MK_CHECK 0
#endif
namespace pg8 {
#define PG8_LAS __attribute__((address_space(3)))
typedef unsigned short bf16_t;
typedef short bf16x8 __attribute__((ext_vector_type(8)));
typedef float f32x4 __attribute__((ext_vector_type(4)));
typedef unsigned u32x4 __attribute__((ext_vector_type(4)));
typedef unsigned u32x2 __attribute__((ext_vector_type(2)));
constexpr int BM = 256, BK = 64, HALF = 128, HTB = HALF * BK * 2  , STAGE_BYTES = 8 * HTB, NXCD = 8, WGM = 8;

__host__ __device__ __forceinline__ int lds_byte(int r, int c) { const int st = (r >> 4) * 2 + (c >> 5), rr = r & 15, cc = c & 31, ob = rr * 64 + cc * 2; return st * 1024 + (ob ^ (((ob >> 9) & 1) << 5)); }
__host__ __device__ __forceinline__ void stage_rc(int b, int& R, int& C) { const int st = b / 1024, sb = b % 1024, swz = sb ^ (((sb >> 9) & 1) << 5); R = (st >> 1) * 16 + swz / 64; C = (st & 1) * 32 + (swz % 64) / 2; }
__host__ __device__ __forceinline__ int perm32(int rho) { const int n = rho >> 4, i = rho & 15; return 8 * (i >> 2) + 4 * n + (i & 3); }

struct Unit { int pm, pn, kb, kn, role, slot; };
struct Gemm { const bf16_t* A; const bf16_t* Bt; int M, N, K, lda; };

struct StaticOrder {
    int nM, nN, nwg, G, c, ntk; float* scr; unsigned* flg;
    __host__ __device__ void init(int M, int N, int G_, int c_, int ntk_ = 0, float* scr_ = nullptr, unsigned* flg_ = nullptr) { nM = M / BM; nN = N / BM; nwg = nM * nN; G = G_; c = c_; ntk = ntk_; scr = scr_; flg = flg_; }
    __host__ __device__ bool next(int i, Unit& u) const {
        long L = (long)i * G + c; u.kb = 0; u.kn = ntk; u.role = 0; u.slot = 0;
        if (scr != nullptr) { const int full = nwg / G, rem = nwg - full * G;
            if (rem > 0 && 2 * rem <= G && i == full) {
                if (c < rem) { u.role = 1; u.kn = ntk / 2; u.slot = c; }
                else if (c < 2 * rem) { L -= rem; u.role = 2; u.kb = ntk / 2; u.kn = ntk - ntk / 2; u.slot = c - rem; }
                else return false; } }
        if (L >= nwg) return false;
        int wgid = (int)L; { const int q = nwg / NXCD, r = nwg % NXCD, xcd = wgid % NXCD, off = wgid / NXCD; wgid = (xcd < r ? xcd * (q + 1) : r * (q + 1) + (xcd - r) * q) + off; }
        const int nig = WGM * nN, gid = wgid / nig, fm = gid * WGM, gsz = (nM - fm) < WGM ? (nM - fm) : WGM;
        u.pm = fm + ((wgid % nig) % gsz); u.pn = (wgid % nig) / gsz; return true;
    }
    __device__ __forceinline__ void a_ready(const Unit&) const {}
    __device__ __forceinline__ void done(const Unit&) const {}
};

__device__ __forceinline__ unsigned cvt_pk_bf16(float lo, float hi) { unsigned r; asm volatile("v_cvt_pk_bf16_f32 %0, %1, %2" : "=v"(r) : "v"(lo), "v"(hi)); return r; }
__device__ __forceinline__ float bf_lo(unsigned w) { return __uint_as_float(w << 16); }
__device__ __forceinline__ float bf_hi(unsigned w) { return __uint_as_float(w & 0xffff0000u); }

struct EpiScaleBf16 {
    static constexpr bool PERM = true, AFTER_DRAIN = false;
    bf16_t* O; int ldc; const float* rstd;
    __device__ __forceinline__ void operator()(const f32x4 (&acc)[2][2][4][2], const Unit& u, int wr, int wc, int fr, int fq) const {
        const int row0 = u.pm * BM + wr * 64 + fr, col0 = u.pn * BM + wc * 32 + 8 * fq;
#pragma unroll
        for (int ai = 0; ai < 2; ++ai)
#pragma unroll
            for (int m = 0; m < 4; ++m) { const int row = row0 + ai * HALF + m * 16; const float s = rstd ? rstd[row] : 1.f; bf16_t* rowp = O + (size_t)row * ldc + col0;
#pragma unroll
                for (int bj = 0; bj < 2; ++bj) { const f32x4 v0 = acc[ai][bj][m][0] * s, v1 = acc[ai][bj][m][1] * s;
                    u32x4 w; w.x = cvt_pk_bf16(v0[0], v0[1]); w.y = cvt_pk_bf16(v0[2], v0[3]); w.z = cvt_pk_bf16(v1[0], v1[1]); w.w = cvt_pk_bf16(v1[2], v1[3]);
                    *(u32x4*)(rowp + bj * HALF) = w; } }
    }
};
struct EpiHeadNorm {
    static constexpr bool PERM = true, AFTER_DRAIN = false;
    bf16_t* O; int ldc; const float* rstd; const float* qn; const float* kn; float qscale; int ntq, ntk; PG8_LAS float* ex;
    const float* rcos; const float* rsin; int seq;
    float* ssq = nullptr;
    template <int AI, int MM, int BJ> __device__ __forceinline__ void put(unsigned wb, float s) const { asm volatile("ds_write_b32 %0, %1 offset:%2" :: "v"(wb), "v"(s), "i"((AI * 1024 + MM * 128 + BJ * 4) * 4) : "memory"); }
    template <int AI, int MM, int BJ> __device__ __forceinline__ f32x4 get(unsigned rb) const { f32x4 p; asm volatile("ds_read_b128 %0, %1 offset:%2" : "=&v"(p) : "v"(rb), "i"((AI * 1024 + MM * 128 + BJ * 4) * 4) : "memory"); return p; }
    template <int AI, int MM> __device__ __forceinline__ void part(const f32x4 (&acc)[2][2][4][2], unsigned wb, int fq) const {
#pragma unroll
        for (int bj = 0; bj < 2; ++bj) { const f32x4 v0 = acc[AI][bj][MM][0], v1 = acc[AI][bj][MM][1];
            float s = (v0[0] * v0[0] + v0[1] * v0[1]) + (v0[2] * v0[2] + v0[3] * v0[3]) + (v1[0] * v1[0] + v1[1] * v1[1]) + (v1[2] * v1[2] + v1[3] * v1[3]);
            s += __shfl_xor(s, 16); s += __shfl_xor(s, 32);
            if (fq == 0) { if (bj == 0) put<AI, MM, 0>(wb, s); else put<AI, MM, 1>(wb, s); } }
    }
    template <int AI, int MM> __device__ __forceinline__ void fin(const f32x4 (&acc)[2][2][4][2], unsigned rb, int row, int col0, const float* gp, float gs, int wc, int fq) const {
        bf16_t* rowp = O + (size_t)row * ldc + col0; const float rsv = rstd[row], r2 = rsv * rsv;
        const f32x4 g0 = *(const f32x4*)gp * gs, g1 = *(const f32x4*)(gp + 4) * gs;
        const f32x4 pa = get<AI, MM, 0>(rb), pb = get<AI, MM, 1>(rb);
        asm volatile("s_waitcnt lgkmcnt(0)" ::: "memory"); __builtin_amdgcn_sched_barrier(0);
#pragma unroll
        for (int bj = 0; bj < 2; ++bj) { const f32x4 p = bj ? pb : pa;
            const float tot = ((p[0] + p[1]) + (p[2] + p[3])) * r2;
            const float hn = rsv / sqrtf(tot * (1.0f / 128.0f) + 1e-6f);
            f32x4 v0 = acc[AI][bj][MM][0] * hn * g0, v1 = acc[AI][bj][MM][1] * hn * g1;
            if (rcos != nullptr && wc == 0) {
                const int pos = row & (seq - 1); const float* cp = rcos + pos * 16 + 8 * (fq & 1); const float* sp = rsin + pos * 16 + 8 * (fq & 1);
                const f32x4 c0 = *(const f32x4*)cp, c1 = *(const f32x4*)(cp + 4); f32x4 s0 = *(const f32x4*)sp, s1 = *(const f32x4*)(sp + 4);
                if (fq < 2) { s0 = -s0; s1 = -s1; }
                f32x4 p0, p1;
#pragma unroll
                for (int e = 0; e < 4; ++e) { p0[e] = __shfl_xor(v0[e], 32); p1[e] = __shfl_xor(v1[e], 32); }
                v0 = v0 * c0 + p0 * s0; v1 = v1 * c1 + p1 * s1; }
            u32x4 w; w.x = cvt_pk_bf16(v0[0], v0[1]); w.y = cvt_pk_bf16(v0[2], v0[3]); w.z = cvt_pk_bf16(v1[0], v1[1]); w.w = cvt_pk_bf16(v1[2], v1[3]);
            *(u32x4*)(rowp + bj * HALF) = w; }
    }
    __device__ __forceinline__ void operator()(const f32x4 (&acc)[2][2][4][2], const Unit& u, int wr, int wc, int fr, int fq) const {
        const int row0 = u.pm * BM + wr * 64 + fr, col0 = u.pn * BM + wc * 32 + 8 * fq; const int type = u.pn < ntq ? 0 : (u.pn < ntq + ntk ? 1 : 2);
        if (type < 2) {
            const unsigned rb = (unsigned)(uintptr_t)ex + (unsigned)((wr * 64 + fr) * 8 * 4), wb = rb + (unsigned)(wc * 4);
            part<0, 0>(acc, wb, fq); part<0, 1>(acc, wb, fq); part<0, 2>(acc, wb, fq); part<0, 3>(acc, wb, fq); part<1, 0>(acc, wb, fq); part<1, 1>(acc, wb, fq); part<1, 2>(acc, wb, fq); part<1, 3>(acc, wb, fq);
            asm volatile("s_waitcnt lgkmcnt(0)" ::: "memory"); __builtin_amdgcn_s_barrier(); asm volatile("" ::: "memory");
            const float* gp = (type == 0 ? qn : kn) + wc * 32 + 8 * fq; const float gs = type == 0 ? qscale : 1.0f;
            fin<0, 0>(acc, rb, row0, col0, gp, gs, wc, fq); fin<0, 1>(acc, rb, row0 + 16, col0, gp, gs, wc, fq); fin<0, 2>(acc, rb, row0 + 32, col0, gp, gs, wc, fq); fin<0, 3>(acc, rb, row0 + 48, col0, gp, gs, wc, fq);
            fin<1, 0>(acc, rb, row0 + HALF, col0, gp, gs, wc, fq); fin<1, 1>(acc, rb, row0 + HALF + 16, col0, gp, gs, wc, fq); fin<1, 2>(acc, rb, row0 + HALF + 32, col0, gp, gs, wc, fq); fin<1, 3>(acc, rb, row0 + HALF + 48, col0, gp, gs, wc, fq);
        } else {
#pragma unroll
            for (int ai = 0; ai < 2; ++ai)
#pragma unroll
                for (int m = 0; m < 4; ++m) { const int row = row0 + ai * HALF + m * 16; bf16_t* rowp = O + (size_t)row * ldc + col0; const float sc = rstd[row];
#pragma unroll
                    for (int bj = 0; bj < 2; ++bj) { const f32x4 v0 = acc[ai][bj][m][0] * sc, v1 = acc[ai][bj][m][1] * sc;
                        u32x4 w; w.x = cvt_pk_bf16(v0[0], v0[1]); w.y = cvt_pk_bf16(v0[2], v0[3]); w.z = cvt_pk_bf16(v1[0], v1[1]); w.w = cvt_pk_bf16(v1[2], v1[3]);
                        *(u32x4*)(rowp + bj * HALF) = w;
                        if (ssq != nullptr && u.pn >= 36) { float sq = (v0[0] * v0[0] + v0[1] * v0[1]) + (v0[2] * v0[2] + v0[3] * v0[3]) + (v1[0] * v1[0] + v1[1] * v1[1]) + (v1[2] * v1[2] + v1[3] * v1[3]);
                            sq += __shfl_xor(sq, 16); sq += __shfl_xor(sq, 32);
                            if (fq == 0) ssq[(size_t)row * 64 + (u.pn - 36) * 8 + bj * 4 + wc] = sq; } } }
        }
    }
};
#ifndef RESID_LOW
#define RESID_LOW 0
#endif
template <int MODE> struct EpiResidT {
    static constexpr bool PERM = true, AFTER_DRAIN = false;
    const float* basef; float* outf; bf16_t* xb; bf16_t* xl0; bf16_t* xl1; float* ss; int ldc;
    __device__ __forceinline__ void operator()(const f32x4 (&acc)[2][2][4][2], const Unit& u, int wr, int wc, int fr, int fq) const {
        const int row0 = u.pm * BM + wr * 64 + fr, col0 = u.pn * BM + wc * 32 + 8 * fq; bf16_t* xl = u.pm < 32 ? xl0 : xl1;
#pragma unroll
        for (int ai = 0; ai < 2; ++ai)
#pragma unroll
            for (int m = 0; m < 4; ++m) { const int row = row0 + ai * HALF + m * 16; const size_t off = (size_t)row * ldc + col0; float s = 0.f;
#pragma unroll
                for (int bj = 0; bj < 2; ++bj) { f32x4 b0, b1;
                    if constexpr (MODE == 0) { b0 = *(const f32x4*)(basef + off + bj * HALF); b1 = *(const f32x4*)(basef + off + bj * HALF + 4); }
                    else { const u32x4 hb = *(const u32x4*)(xb + off + bj * HALF); u32x4 lb = {0u, 0u, 0u, 0u}; if constexpr (RESID_LOW) lb = *(const u32x4*)(xl + off + bj * HALF);
                        b0[0] = bf_lo(hb.x) + bf_lo(lb.x); b0[1] = bf_hi(hb.x) + bf_hi(lb.x); b0[2] = bf_lo(hb.y) + bf_lo(lb.y); b0[3] = bf_hi(hb.y) + bf_hi(lb.y);
                        b1[0] = bf_lo(hb.z) + bf_lo(lb.z); b1[1] = bf_hi(hb.z) + bf_hi(lb.z); b1[2] = bf_lo(hb.w) + bf_lo(lb.w); b1[3] = bf_hi(hb.w) + bf_hi(lb.w); }
                    const f32x4 v0 = b0 + acc[ai][bj][m][0], v1 = b1 + acc[ai][bj][m][1];
                    if constexpr (MODE == 2 || MK_CHECK) { *(f32x4*)(outf + off + bj * HALF) = v0; *(f32x4*)(outf + off + bj * HALF + 4) = v1; }
                    if constexpr (MODE != 2) {
                        u32x4 w; w.x = cvt_pk_bf16(v0[0], v0[1]); w.y = cvt_pk_bf16(v0[2], v0[3]); w.z = cvt_pk_bf16(v1[0], v1[1]); w.w = cvt_pk_bf16(v1[2], v1[3]);
                        u32x4 l; l.x = cvt_pk_bf16(v0[0] - bf_lo(w.x), v0[1] - bf_hi(w.x)); l.y = cvt_pk_bf16(v0[2] - bf_lo(w.y), v0[3] - bf_hi(w.y));
                                 l.z = cvt_pk_bf16(v1[0] - bf_lo(w.z), v1[1] - bf_hi(w.z)); l.w = cvt_pk_bf16(v1[2] - bf_lo(w.w), v1[3] - bf_hi(w.w));
                        *(u32x4*)(xb + off + bj * HALF) = w; if constexpr (RESID_LOW) *(u32x4*)(xl + off + bj * HALF) = l;
                        s += (v0[0] * v0[0] + v0[1] * v0[1]) + (v0[2] * v0[2] + v0[3] * v0[3]) + (v1[0] * v1[0] + v1[1] * v1[1]) + (v1[2] * v1[2] + v1[3] * v1[3]); } }
                if constexpr (MODE != 2) { s += __shfl_xor(s, 16); s += __shfl_xor(s, 32);
                    if (fq == 0) ss[(size_t)row * 64 + u.pn * 4 + wc] = s; } }
    }
};
struct EpiUpConv {
    static constexpr bool PERM = true, AFTER_DRAIN = false;
    const bf16_t* a; bf16_t* h2; const float* rstd; const float* cw; const float* cb; int ldc; int seq;
    __device__ __forceinline__ void operator()(const f32x4 (&acc)[2][2][4][2], const Unit& u, int wr, int wc, int fr, int fq) const {
        const int row0 = u.pm * BM + wr * 64 + fr, col0 = u.pn * BM + wc * 32 + 8 * fq;
#pragma unroll
        for (int bj = 0; bj < 2; ++bj) { const int c = col0 + bj * HALF;
            float w0[8], w1[8], w2[8], b[8];
#pragma unroll
            for (int h = 0; h < 2; ++h) { const f32x4 t0 = *(const f32x4*)(cw + c + 4 * h), t1 = *(const f32x4*)(cw + ldc + c + 4 * h), t2 = *(const f32x4*)(cw + 2 * ldc + c + 4 * h), t3 = *(const f32x4*)(cb + c + 4 * h);
#pragma unroll
                for (int j = 0; j < 4; ++j) { w0[4 * h + j] = t0[j]; w1[4 * h + j] = t1[j]; w2[4 * h + j] = t2[j]; b[4 * h + j] = t3[j]; } }
#pragma unroll
            for (int ai = 0; ai < 2; ++ai)
#pragma unroll
                for (int m = 0; m < 4; ++m) { const int row = row0 + ai * HALF + m * 16; const int t = row & (seq - 1); const float s = rstd[row];
                    const bf16_t* ap = a + (size_t)row * ldc + c;
                    const u32x4 z4 = {0u, 0u, 0u, 0u};
                    const u32x4 a0 = *(const u32x4*)ap; const u32x4 am = t > 0 ? *(const u32x4*)(ap - ldc) : z4; const u32x4 an = t < seq - 1 ? *(const u32x4*)(ap + ldc) : z4;
                    float hv[8];
#pragma unroll
                    for (int j = 0; j < 8; ++j) { const unsigned wm = am[j >> 1], wz = a0[j >> 1], wn = an[j >> 1];
                        const float fm = (j & 1) ? bf_hi(wm) : bf_lo(wm), fz = (j & 1) ? bf_hi(wz) : bf_lo(wz), fn = (j & 1) ? bf_hi(wn) : bf_lo(wn);
                        const float g = w0[j] * fm + w1[j] * fz + w2[j] * fn + b[j];
                        const float e = __builtin_amdgcn_exp2f(-1.4426950408889634f * g);
                        const float sg = g * __builtin_amdgcn_rcpf(1.0f + e);
                        const float up = (j < 4 ? acc[ai][bj][m][0][j & 3] : acc[ai][bj][m][1][j & 3]) * s;
                        hv[j] = sg * up; }
                    u32x4 w; w.x = cvt_pk_bf16(hv[0], hv[1]); w.y = cvt_pk_bf16(hv[2], hv[3]); w.z = cvt_pk_bf16(hv[4], hv[5]); w.w = cvt_pk_bf16(hv[6], hv[7]);
                    *(u32x4*)(h2 + (size_t)row * ldc + c) = w; } }
    }
};
template <int CTRL> __device__ __forceinline__ float dpp_rot(float v) { return __builtin_bit_cast(float, __builtin_amdgcn_update_dpp(0, __builtin_bit_cast(int, v), CTRL, 0xF, 0xF, false)); }
struct EpiGateUp {
    static constexpr bool PERM = true, AFTER_DRAIN = false;
    bf16_t* h2; const float* rstd; const float* cw; const float* cb; int ldc; bf16_t* aedge; bf16_t* uedge; PG8_LAS float* ex;
    __device__ __forceinline__ void operator()(const f32x4 (&acc)[2][2][4][2], const Unit& u, int wr, int wc, int fr, int fq) const {
        const int row0 = u.pm * BM + wr * 64 + fr, ch = u.pn * HALF + wc * 32 + 8 * fq;
        f32x4 av[2][4][2], uv[2][4][2];
#pragma unroll
        for (int ai = 0; ai < 2; ++ai)
#pragma unroll
            for (int m = 0; m < 4; ++m) { const float r = rstd[row0 + ai * HALF + m * 16];
                av[ai][m][0] = acc[ai][0][m][0] * r; av[ai][m][1] = acc[ai][0][m][1] * r; uv[ai][m][0] = acc[ai][1][m][0] * r; uv[ai][m][1] = acc[ai][1][m][1] * r; }
        const unsigned eb = (unsigned)(uintptr_t)ex + (unsigned)((wc * 4 + fq) * 32);
#pragma unroll
        for (int ai = 0; ai < 2; ++ai) { const int gidx = 2 * ai + wr;
            if (fr == 0) { const unsigned a0 = eb + (unsigned)((gidx * 2 + 0) * 512);
                asm volatile("ds_write_b128 %0, %1\n\tds_write_b128 %0, %2 offset:16" :: "v"(a0), "v"(av[ai][0][0]), "v"(av[ai][0][1]) : "memory"); }
            if (fr == 15) { const unsigned a1 = eb + (unsigned)((gidx * 2 + 1) * 512);
                asm volatile("ds_write_b128 %0, %1\n\tds_write_b128 %0, %2 offset:16" :: "v"(a1), "v"(av[ai][3][0]), "v"(av[ai][3][1]) : "memory"); } }
        asm volatile("s_waitcnt lgkmcnt(0)" ::: "memory"); __builtin_amdgcn_s_barrier(); asm volatile("" ::: "memory");
        unsigned pk[2][4][2][2];
#pragma unroll
        for (int h = 0; h < 2; ++h) {
            const f32x4 w0 = *(const f32x4*)(cw + ch + 4 * h), w1 = *(const f32x4*)(cw + ldc + ch + 4 * h), w2 = *(const f32x4*)(cw + 2 * ldc + ch + 4 * h), bb = *(const f32x4*)(cb + ch + 4 * h);
#pragma unroll
            for (int ai = 0; ai < 2; ++ai) { const int gidx = 2 * ai + wr;
                f32x4 rrp, nx;
                { const unsigned ap = eb + (unsigned)(((gidx > 0 ? gidx - 1 : 0) * 2 + 1) * 512 + 16 * h), an = eb + (unsigned)(((gidx < 3 ? gidx + 1 : 3) * 2 + 0) * 512 + 16 * h);
                  asm volatile("ds_read_b128 %0, %2\n\tds_read_b128 %1, %3\n\ts_waitcnt lgkmcnt(0)" : "=&v"(rrp), "=&v"(nx) : "v"(ap), "v"(an) : "memory"); }
                f32x4 rlc;
#pragma unroll
                for (int j = 0; j < 4; ++j) rlc[j] = dpp_rot<0x12F>(av[ai][0][h][j]);
#pragma unroll
                for (int m = 0; m < 4; ++m) { const int row = row0 + ai * HALF + m * 16;
                    float hv[4];
#pragma unroll
                    for (int j = 0; j < 4; ++j) { const float cur = av[ai][m][h][j];
                        const float rr = dpp_rot<0x121>(cur);
                        float rln;
                        if (m < 3) rln = dpp_rot<0x12F>(av[ai][m + 1][h][j]); else rln = nx[j];
                        const float prev = fr != 0 ? rr : rrp[j], next = fr != 15 ? rlc[j] : rln;
                        rrp[j] = rr; rlc[j] = rln;
                        const float g = w0[j] * prev + w1[j] * cur + w2[j] * next + bb[j];
                        const float e = __builtin_amdgcn_exp2f(-1.4426950408889634f * g);
                        hv[j] = g * __builtin_amdgcn_rcpf(1.0f + e) * uv[ai][m][h][j]; }
                    pk[ai][m][h][0] = cvt_pk_bf16(hv[0], hv[1]); pk[ai][m][h][1] = cvt_pk_bf16(hv[2], hv[3]);
                    if ((m == 0 && gidx == 0 && fr < 2) || (m == 3 && gidx == 3 && fr >= 14)) {
                        const int e4 = (m == 0) ? fr : fr - 12;
                        u32x2 w; w.x = cvt_pk_bf16(av[ai][m][h][0], av[ai][m][h][1]); w.y = cvt_pk_bf16(av[ai][m][h][2], av[ai][m][h][3]);
                        *(u32x2*)(aedge + ((size_t)u.pm * 4 + e4) * ldc + ch + 4 * h) = w;
                        if (e4 == 0 || e4 == 3) { u32x2 wu; wu.x = cvt_pk_bf16(uv[ai][m][h][0], uv[ai][m][h][1]); wu.y = cvt_pk_bf16(uv[ai][m][h][2], uv[ai][m][h][3]);
                            *(u32x2*)(uedge + ((size_t)u.pm * 2 + (e4 == 3 ? 1 : 0)) * ldc + ch + 4 * h) = wu; } }
                    if (h == 1) { const bool first = (m == 0 && gidx == 0 && fr == 0), last = (m == 3 && gidx == 3 && fr == 15);
                        if (!first && !last) { u32x4 w; w.x = pk[ai][m][0][0]; w.y = pk[ai][m][0][1]; w.z = pk[ai][m][1][0]; w.w = pk[ai][m][1][1];
                            *(u32x4*)(h2 + (size_t)row * ldc + ch) = w; } }
                } }
        }
    }
};
template <class Epi, class Sched, bool ALIGN_EPI = false, bool SP2 = false, bool SPLITK = false>
__device__ __forceinline__ void gemm_phase(PG8_LAS unsigned char* lds, const Gemm g, const Sched& S, const Epi& E) {
    const int tid = threadIdx.x, wid = __builtin_amdgcn_readfirstlane(tid >> 6), lane = tid & 63, wr = wid >> 2, wc = wid & 3, fr = lane & 15, fq = lane >> 4;
    const int K = g.K, nt = K / BK;
    unsigned voffA[2], voffB[2];
#pragma unroll
    for (int i = 0; i < 2; ++i) { int R, C; stage_rc(tid * 16 + i * 8192, R, C); const int Rb = Epi::PERM ? ((R & ~31) + perm32(R & 31)) : R;
        voffA[i] = (unsigned)(R * g.lda + C) * 2u; voffB[i] = (unsigned)(Rb * K + C) * 2u; }
    const size_t kstep = (size_t)(BK * 2);
    const size_t hstepB = (size_t)HALF * K * 2, hstepA = (size_t)HALF * g.lda * 2;
    const size_t tstepB = 2 * hstepB, tstepA = 2 * hstepA;
    const unsigned ldsw = (unsigned)wid * 1024u;
    const int aoff = lds_byte(wr * 64 + fr, fq * 8), boff = lds_byte(wc * 32 + fr, fq * 8);
#define PG8_SA(b, h) (((b) * 2 + (h)) * HTB)
#define PG8_SB(b, h) ((4 + (b) * 2 + (h)) * HTB)
#define PG8_STAGE(bufoff, gbase, voff) do { _Pragma("unroll") for (int _i = 0; _i < 2; ++_i) \
        __builtin_amdgcn_global_load_lds((const unsigned*)((const char*)(gbase) + (voff)[_i]), (PG8_LAS unsigned*)(lds + (bufoff) + ldsw + _i * 8192), 16, 0, 0); } while (0)
#define PG8_LDA(dst, b, h) do { _Pragma("unroll") for (int m = 0; m < 4; ++m) _Pragma("unroll") for (int k = 0; k < 2; ++k) dst[m][k] = *(const PG8_LAS bf16x8*)(lds + PG8_SA(b, h) + aoff + m * 2048 + k * 1024); } while (0)
#define PG8_LDB(dst, b, h) do { _Pragma("unroll") for (int n = 0; n < 2; ++n) _Pragma("unroll") for (int k = 0; k < 2; ++k) dst[n][k] = *(const PG8_LAS bf16x8*)(lds + PG8_SB(b, h) + boff + n * 2048 + k * 1024); } while (0)
#define PG8_MMA(ai, bj, At, Bt) do { __builtin_amdgcn_s_setprio(1); _Pragma("unroll") for (int m = 0; m < 4; ++m) _Pragma("unroll") for (int n = 0; n < 2; ++n) _Pragma("unroll") for (int k = 0; k < 2; ++k) \
        acc[ai][bj][m][n] = __builtin_amdgcn_mfma_f32_16x16x32_bf16(Bt[n][k], At[m][k], acc[ai][bj][m][n], 0, 0, 0); __builtin_amdgcn_s_setprio(0); } while (0)
#define PG8_WAIT_V(n) asm volatile("s_waitcnt vmcnt(" #n ")" ::: "memory")
#define PG8_WAIT_L(n) asm volatile("s_waitcnt lgkmcnt(" #n ")" ::: "memory")
#define PG8_BAR __builtin_amdgcn_s_barrier()
#define PG8_SCHED __builtin_amdgcn_sched_barrier(0)
    Unit cur, nxt; int ui = 0;
    if (!S.next(0, cur)) return;
    f32x4 acc[2][2][4][2];
#pragma unroll
    for (int a = 0; a < 2; ++a)
#pragma unroll
        for (int b = 0; b < 2; ++b)
#pragma unroll
            for (int m = 0; m < 4; ++m)
#pragma unroll
                for (int n = 0; n < 2; ++n) acc[a][b][m][n] = (f32x4){0.f, 0.f, 0.f, 0.f};
    bf16x8 At[4][2], B0[2][2], B1[2][2];
    const char* cA = (const char*)g.A + (size_t)cur.pm * tstepA; const char* cB = (const char*)g.Bt + (size_t)cur.pn * tstepB;
    if constexpr (SPLITK) { cA += (size_t)cur.kb * kstep; cB += (size_t)cur.kb * kstep; }
    S.a_ready(cur);
    if constexpr (SP2) {
        PG8_STAGE(PG8_SB(0, 0), cB, voffB); PG8_STAGE(PG8_SB(0, 1), cB + hstepB, voffB); PG8_STAGE(PG8_SA(0, 0), cA, voffA); PG8_STAGE(PG8_SA(0, 1), cA + hstepA, voffA);
        if (wr == 1) PG8_BAR;
        PG8_WAIT_V(2); PG8_BAR;
        PG8_STAGE(PG8_SB(1, 0), cB + kstep, voffB); PG8_STAGE(PG8_SA(1, 0), cA + kstep, voffA); PG8_STAGE(PG8_SB(1, 1), cB + hstepB + kstep, voffB);
        PG8_WAIT_V(6); PG8_BAR;
    } else {
        PG8_STAGE(PG8_SB(0, 0), cB, voffB); PG8_STAGE(PG8_SA(0, 0), cA, voffA); PG8_STAGE(PG8_SB(0, 1), cB + hstepB, voffB); PG8_STAGE(PG8_SA(0, 1), cA + hstepA, voffA);
        if (wr == 1) PG8_BAR;
        PG8_WAIT_V(4); PG8_BAR;
        PG8_STAGE(PG8_SB(1, 0), cB + kstep, voffB); PG8_STAGE(PG8_SA(1, 0), cA + kstep, voffA); PG8_STAGE(PG8_SB(1, 1), cB + hstepB + kstep, voffB);
        PG8_WAIT_V(6); PG8_BAR;
    }
    for (;;) {
        const bool has_next = S.next(ui + 1, nxt);
        const char* nA = has_next ? (const char*)g.A + (size_t)nxt.pm * tstepA : cA; const char* nB = has_next ? (const char*)g.Bt + (size_t)nxt.pn * tstepB : cB;
        if constexpr (SPLITK) { if (has_next) { nA += (size_t)nxt.kb * kstep; nB += (size_t)nxt.kb * kstep; } }
        const int ntc = SPLITK ? cur.kn : nt;
        for (int t = 0; t < ntc; t += 2) {
            const bool last = (t == ntc - 2);
            const char* a1 = cA + (size_t)(t + 1) * kstep;
            const char* a2 = last ? nA : cA + (size_t)(t + 2) * kstep; const char* b2 = last ? nB : cB + (size_t)(t + 2) * kstep;
            const char* a3 = a2 + kstep; const char* b3 = b2 + kstep;
            if (last && has_next) S.a_ready(nxt);
            if constexpr (SP2) {
            PG8_LDB(B0, 0, 0); PG8_LDB(B1, 0, 1); PG8_SCHED; PG8_LDA(At, 0, 0); PG8_STAGE(PG8_SA(1, 1), a1 + hstepA, voffA);
            PG8_WAIT_V(8); PG8_WAIT_L(0); PG8_BAR; PG8_MMA(0, 0, At, B0); PG8_MMA(0, 1, At, B1); PG8_BAR; PG8_SCHED;
            PG8_LDA(At, 0, 1); PG8_STAGE(PG8_SB(0, 0), b2, voffB); PG8_STAGE(PG8_SB(0, 1), b2 + hstepB, voffB); PG8_STAGE(PG8_SA(0, 0), a2, voffA);
            PG8_WAIT_V(8); PG8_WAIT_L(0); PG8_BAR; PG8_MMA(1, 0, At, B0); PG8_MMA(1, 1, At, B1); PG8_BAR; PG8_SCHED;
            PG8_LDB(B0, 1, 0); PG8_LDB(B1, 1, 1); PG8_SCHED; PG8_LDA(At, 1, 0); PG8_STAGE(PG8_SA(0, 1), a2 + hstepA, voffA);
            PG8_WAIT_V(8); PG8_WAIT_L(0); PG8_BAR; PG8_MMA(0, 0, At, B0); PG8_MMA(0, 1, At, B1); PG8_BAR; PG8_SCHED;
            PG8_LDA(At, 1, 1); PG8_STAGE(PG8_SB(1, 0), b3, voffB); PG8_STAGE(PG8_SB(1, 1), b3 + hstepB, voffB); PG8_STAGE(PG8_SA(1, 0), a3, voffA);
            PG8_WAIT_V(8); PG8_WAIT_L(0); PG8_BAR; PG8_MMA(1, 0, At, B0); PG8_MMA(1, 1, At, B1); PG8_BAR; PG8_SCHED;
            } else {
            PG8_LDB(B0, 0, 0); PG8_SCHED; PG8_LDA(At, 0, 0); PG8_STAGE(PG8_SA(1, 1), a1 + hstepA, voffA);
            PG8_WAIT_L(8); PG8_BAR; PG8_WAIT_L(0); PG8_MMA(0, 0, At, B0); PG8_BAR; PG8_SCHED;
            PG8_LDB(B1, 0, 1); PG8_STAGE(PG8_SB(0, 0), b2, voffB);
            PG8_BAR; PG8_WAIT_L(0); PG8_MMA(0, 1, At, B1); PG8_BAR;
            PG8_LDA(At, 0, 1); PG8_STAGE(PG8_SA(0, 0), a2, voffA);
            PG8_BAR; PG8_WAIT_L(0); PG8_MMA(1, 0, At, B0); PG8_BAR; PG8_SCHED;
            PG8_STAGE(PG8_SB(0, 1), b2 + hstepB, voffB);
            PG8_WAIT_V(6); PG8_BAR; PG8_MMA(1, 1, At, B1); PG8_BAR;
            PG8_LDB(B0, 1, 0); PG8_SCHED; PG8_LDA(At, 1, 0); PG8_STAGE(PG8_SA(0, 1), a2 + hstepA, voffA);
            PG8_WAIT_L(8); PG8_BAR; PG8_WAIT_L(0); PG8_MMA(0, 0, At, B0); PG8_BAR; PG8_SCHED;
            PG8_LDB(B1, 1, 1); PG8_STAGE(PG8_SB(1, 0), b3, voffB);
            PG8_BAR; PG8_WAIT_L(0); PG8_MMA(0, 1, At, B1); PG8_BAR;
            PG8_LDA(At, 1, 1); PG8_STAGE(PG8_SA(1, 0), a3, voffA);
            PG8_BAR; PG8_WAIT_L(0); PG8_MMA(1, 0, At, B0); PG8_BAR; PG8_SCHED;
            PG8_STAGE(PG8_SB(1, 1), b3 + hstepB, voffB);
            PG8_WAIT_V(6); PG8_BAR; PG8_MMA(1, 1, At, B1); PG8_BAR;
            }
        }
        if constexpr (ALIGN_EPI) { if (wr == 0) PG8_BAR; }
        if constexpr (SPLITK) {
            if (cur.role == 2) {
                const __amdgpu_buffer_rsrc_t rs = __builtin_amdgcn_make_buffer_rsrc((void*)(S.scr + (size_t)cur.slot * 65536), 0, 65536 * 4, 0x00020000);
#pragma unroll
                for (int a = 0; a < 2; ++a)
#pragma unroll
                    for (int b = 0; b < 2; ++b)
#pragma unroll
                        for (int m = 0; m < 4; ++m)
#pragma unroll
                            for (int n = 0; n < 2; ++n)
                                __builtin_amdgcn_raw_buffer_store_b128(__builtin_bit_cast(u32x4, acc[a][b][m][n]), rs, (unsigned)(((wid * 32 + ((a * 2 + b) * 4 + m) * 2 + n) * 64 + lane) * 16), 0, 16);
                PG8_WAIT_V(0); PG8_BAR;
                if (tid == 0) __hip_atomic_store(S.flg + cur.slot * 16, 1u, __ATOMIC_RELAXED, __HIP_MEMORY_SCOPE_AGENT);
            } else {
                if (cur.role == 1) {
                    if (tid == 0) { unsigned spn = 0; while (__hip_atomic_load(S.flg + cur.slot * 16, __ATOMIC_RELAXED, __HIP_MEMORY_SCOPE_AGENT) == 0u) { __builtin_amdgcn_s_sleep(1); if (++spn > (1u << 22)) break; }
                        __builtin_amdgcn_fence(__ATOMIC_ACQUIRE, "agent"); }
                    PG8_WAIT_V(0); PG8_BAR;
                    const float* sp = S.scr + (size_t)cur.slot * 65536 + (size_t)(wid * 32 * 64 + lane) * 4;
#pragma unroll
                    for (int a = 0; a < 2; ++a)
#pragma unroll
                        for (int b = 0; b < 2; ++b) { f32x4 tq[4][2];
#pragma unroll
                            for (int m = 0; m < 4; ++m)
#pragma unroll
                                for (int n = 0; n < 2; ++n) tq[m][n] = *(const f32x4*)(sp + (size_t)((((a * 2 + b) * 4 + m) * 2 + n) * 64) * 4);
#pragma unroll
                            for (int m = 0; m < 4; ++m)
#pragma unroll
                                for (int n = 0; n < 2; ++n) acc[a][b][m][n] += tq[m][n]; }
                }
                E(acc, cur, wr, wc, fr, fq); S.done(cur);
            }
        } else
        if constexpr (!Epi::AFTER_DRAIN) { E(acc, cur, wr, wc, fr, fq); S.done(cur); }
        if (!has_next) break;
#pragma unroll
        for (int a = 0; a < 2; ++a)
#pragma unroll
            for (int b = 0; b < 2; ++b)
#pragma unroll
                for (int m = 0; m < 4; ++m)
#pragma unroll
                    for (int n = 0; n < 2; ++n) acc[a][b][m][n] = (f32x4){0.f, 0.f, 0.f, 0.f};
        cur = nxt; cA = nA; cB = nB; ++ui;
        if constexpr (ALIGN_EPI) { if (wr == 1) PG8_BAR; }
    }
    PG8_WAIT_V(0);
    if constexpr (!ALIGN_EPI) { if (wr == 0) PG8_BAR; }
    PG8_BAR;
    if constexpr (Epi::AFTER_DRAIN) { E.fused(acc, cur, wr, wc, fr, fq, lds, wid, lane); S.done(cur); }
#undef PG8_SA
#undef PG8_SB
#undef PG8_STAGE
#undef PG8_LDA
#undef PG8_LDB
#undef PG8_MMA
#undef PG8_WAIT_V
#undef PG8_WAIT_L
#undef PG8_BAR
#undef PG8_SCHED
}
}

namespace mla {
typedef unsigned short bf16;
using bf16x8 = __attribute__((ext_vector_type(8))) short;
using s16x4  = __attribute__((ext_vector_type(4))) short;
using f32x16 = __attribute__((ext_vector_type(16))) float;
using u32x4  = __attribute__((ext_vector_type(4))) unsigned;
constexpr int DQK = 192, DV = 128, NW = 8, QBLK = 32, KVBLK = 64;
constexpr int LDQ = 3072, LDK = 3072, LDV = 4096, LDO = 3072;
constexpr float THR = 11.5f;
constexpr int SHM_V = KVBLK * DV * 2, SHM_K = KVBLK * DQK * 2, SHM_ATTN = 2 * SHM_V + 2 * SHM_K + NW * 64 * 4;
#define MLA_SBAR() __builtin_amdgcn_sched_barrier(0)
#ifndef MLA_QG
#define MLA_QG 4
#endif
__device__ __forceinline__ int crow(int r, int hi) { return (r & 3) + 8 * (r >> 2) + 4 * hi; }
__device__ __forceinline__ unsigned cvtpk(float lo, float hi) { unsigned r; asm volatile("v_cvt_pk_bf16_f32 %0, %1, %2" : "=v"(r) : "v"(lo), "v"(hi)); return r; }
__device__ __forceinline__ void partialSM(f32x16& p0, f32x16& p1, float& m_reg, float& mn, float& alpha) {
  float pmax = p0[0];
#pragma unroll
  for (int r = 1; r < 16; ++r) pmax = fmaxf(pmax, p0[r]);
#pragma unroll
  for (int r = 0; r < 16; ++r) pmax = fmaxf(pmax, p1[r]);
  { auto rr = __builtin_amdgcn_permlane32_swap(__float_as_uint(pmax), __float_as_uint(pmax), false, false);
    pmax = fmaxf(__uint_as_float(rr[0]), __uint_as_float(rr[1])); }
  if (__builtin_expect(__all(pmax - m_reg <= THR), 1)) { mn = m_reg; alpha = 1.f; }
  else { mn = fmaxf(m_reg, pmax); alpha = __builtin_amdgcn_exp2f(m_reg - mn); m_reg = mn; }
#pragma unroll
  for (int r = 0; r < 16; ++r) p0[r] = p0[r] - mn;
#pragma unroll
  for (int r = 0; r < 16; ++r) p1[r] = p1[r] - mn;
#pragma unroll
  for (int r = 0; r < 16; ++r) p0[r] = __builtin_amdgcn_exp2f(p0[r]);
}
__device__ __forceinline__ void finishSM(f32x16& p0, f32x16& p1, float alpha, float& l_reg, bf16x8& pa0, bf16x8& pa1, bf16x8& pa2, bf16x8& pa3) {
#pragma unroll
  for (int r = 0; r < 16; ++r) p1[r] = __builtin_amdgcn_exp2f(p1[r]);
  float ps = 0;
#pragma unroll
  for (int r = 0; r < 16; ++r) ps += p0[r];
#pragma unroll
  for (int r = 0; r < 16; ++r) ps += p1[r];
  { auto rr = __builtin_amdgcn_permlane32_swap(__float_as_uint(ps), __float_as_uint(ps), false, false);
    ps = __uint_as_float(rr[0]) + __uint_as_float(rr[1]); }
  l_reg = l_reg * alpha + ps;
#define MLA_PK4(P, BASE, OUT) do { unsigned a0 = cvtpk(P[BASE + 0], P[BASE + 1]), a1 = cvtpk(P[BASE + 2], P[BASE + 3]);   \
    unsigned b0 = cvtpk(P[BASE + 4], P[BASE + 5]), b1 = cvtpk(P[BASE + 6], P[BASE + 7]);                              \
    auto r0 = __builtin_amdgcn_permlane32_swap(a0, b0, false, false); auto r1 = __builtin_amdgcn_permlane32_swap(a1, b1, false, false); \
    u32x4 w = {r0[0], r1[0], r0[1], r1[1]}; OUT = *reinterpret_cast<bf16x8*>(&w); } while (0)
  MLA_PK4(p0, 0, pa0); MLA_PK4(p0, 8, pa1); MLA_PK4(p1, 0, pa2); MLA_PK4(p1, 8, pa3);
#undef MLA_PK4
}
__device__ __forceinline__ int v_st(int k, int c) { const int kk = (k & ~0xC) | ((k & 4) << 1) | ((k & 8) >> 1); return ((kk >> 3) * 4 + (c >> 5)) * 512 + ((kk & 7) * 32 + (c & 31)) * 2; }
__device__ __forceinline__ int v_rd_base(int lane) { return ((lane & 3) << 3) | (((lane >> 2) & 3) << 6) | (((lane >> 4) & 1) << 5) | (((lane >> 5) & 1) << 8); }
constexpr int v_rd_off(int d0, int ks, int half) { return d0 * 512 + ks * 4096 + half * 2048; }
template <int OFF> __device__ __forceinline__ s16x4 tr_read(int vb) {
  s16x4 r; asm volatile("ds_read_b64_tr_b16 %0, %1 offset:%2" : "=&v"(r) : "v"(vb), "i"(OFF) : "memory"); return r;
}
template <int D0> __device__ __forceinline__ void pv_one(f32x16& od, int vb, bf16x8 pa0, bf16x8 pa1, bf16x8 pa2, bf16x8 pa3) {
  const s16x4 l0 = tr_read<v_rd_off(D0, 0, 0)>(vb), h0 = tr_read<v_rd_off(D0, 0, 1)>(vb), l1 = tr_read<v_rd_off(D0, 1, 0)>(vb), h1 = tr_read<v_rd_off(D0, 1, 1)>(vb);
  const s16x4 l2 = tr_read<v_rd_off(D0, 2, 0)>(vb), h2 = tr_read<v_rd_off(D0, 2, 1)>(vb), l3 = tr_read<v_rd_off(D0, 3, 0)>(vb), h3 = tr_read<v_rd_off(D0, 3, 1)>(vb);
  asm volatile("s_waitcnt lgkmcnt(0)" ::: "memory"); MLA_SBAR();
#define MLA_PK(L, H) (bf16x8){L[0], L[1], L[2], L[3], H[0], H[1], H[2], H[3]}
  od = __builtin_amdgcn_mfma_f32_32x32x16_bf16(pa0, MLA_PK(l0, h0), od, 0, 0, 0);
  od = __builtin_amdgcn_mfma_f32_32x32x16_bf16(pa1, MLA_PK(l1, h1), od, 0, 0, 0);
  od = __builtin_amdgcn_mfma_f32_32x32x16_bf16(pa2, MLA_PK(l2, h2), od, 0, 0, 0);
  od = __builtin_amdgcn_mfma_f32_32x32x16_bf16(pa3, MLA_PK(l3, h3), od, 0, 0, 0);
#undef MLA_PK
}
__device__ __forceinline__ void pv_d0(f32x16* o, int vb, bf16x8 pa0, bf16x8 pa1, bf16x8 pa2, bf16x8 pa3) {
  pv_one<0>(o[0], vb, pa0, pa1, pa2, pa3); pv_one<1>(o[1], vb, pa0, pa1, pa2, pa3); pv_one<2>(o[2], vb, pa0, pa1, pa2, pa3); pv_one<3>(o[3], vb, pa0, pa1, pa2, pa3);
}
constexpr int SHM_ATTN3 = 3 * SHM_V + 2 * SHM_K + NW * 64 * 4;
__device__ __forceinline__ void attn_unit_d(const bf16* __restrict__ Qb, const bf16* __restrict__ Kh, const bf16* __restrict__ Vh, bf16* __restrict__ Ob, int seq, char* lds,
                                            const float* __restrict__ qgain, float qscale, float qeps, const float* __restrict__ cosT, const float* __restrict__ sinT, int pos0) {
  typedef __attribute__((address_space(3))) unsigned las_u32;
  const int tid = threadIdx.x, wid = tid >> 6, wu = __builtin_amdgcn_readfirstlane(tid >> 6), lane = tid & 63, r32 = lane & 31, hi = lane >> 5, grp = wid >> 2;
  char* V_lds = lds; char* K_lds = lds + 3 * SHM_V;
  float* ws = (float*)(lds + 3 * SHM_V + 2 * SHM_K) + wid * 64; float* li_l = ws; float* al_l = ws + 32;
  char* Q_lds = lds + SHM_ATTN3 + wid * 4096;
  float m_reg = -1e30f, l_reg = 0; f32x16 o[4] = {}; bf16x8 qr[8];
  const bf16* Qw = Qb + (long)(wid * QBLK + r32) * LDQ + hi * 8;
  const int qsw = (r32 >> 1) & 7; char* qrow = Q_lds + r32 * 128;
  {
    bf16x8 raw[12];
#pragma unroll
    for (int d0 = 0; d0 < 12; ++d0) raw[d0] = *reinterpret_cast<const bf16x8*>(Qw + d0 * 16);
    float ssq = 0.f;
#pragma unroll
    for (int d0 = 0; d0 < 12; ++d0)
#pragma unroll
      for (int e = 0; e < 8; ++e) { const float x = __uint_as_float((unsigned)(unsigned short)raw[d0][e] << 16); ssq += x * x; }
    ssq += __shfl_xor(ssq, 32);
    const float rsq = qscale / sqrtf(ssq * (1.0f / 192.0f) + qeps);
#pragma unroll
    for (int d0 = 0; d0 < 8; ++d0) { const float* gp = qgain + 16 * d0 + 8 * hi; float y[8];
#pragma unroll
      for (int e = 0; e < 8; ++e) y[e] = __uint_as_float((unsigned)(unsigned short)raw[d0][e] << 16) * rsq * gp[e];
      u32x4 w; w.x = cvtpk(y[0], y[1]); w.y = cvtpk(y[2], y[3]); w.z = cvtpk(y[4], y[5]); w.w = cvtpk(y[6], y[7]); qr[d0] = __builtin_bit_cast(bf16x8, w); }
    const int pos = pos0 + wid * QBLK + r32;
#pragma unroll
    for (int dr = 0; dr < 2; ++dr) { const int i0 = 16 * dr + 8 * hi; const float* g1 = qgain + 128 + i0; const float* g2 = qgain + 160 + i0; const float* cp = cosT + pos * 32 + i0; const float* sp = sinT + pos * 32 + i0;
      float y1[8], y2[8];
#pragma unroll
      for (int e = 0; e < 8; ++e) { const float a = __uint_as_float((unsigned)(unsigned short)raw[8 + dr][e] << 16) * rsq * g1[e], b = __uint_as_float((unsigned)(unsigned short)raw[10 + dr][e] << 16) * rsq * g2[e];
        y1[e] = a * cp[e] - b * sp[e]; y2[e] = b * cp[e] + a * sp[e]; }
      u32x4 w1, w2; w1.x = cvtpk(y1[0], y1[1]); w1.y = cvtpk(y1[2], y1[3]); w1.z = cvtpk(y1[4], y1[5]); w1.w = cvtpk(y1[6], y1[7]); w2.x = cvtpk(y2[0], y2[1]); w2.y = cvtpk(y2[2], y2[3]); w2.z = cvtpk(y2[4], y2[5]); w2.w = cvtpk(y2[6], y2[7]);
      *reinterpret_cast<bf16x8*>(qrow + (((2 * dr + hi) ^ qsw) << 4)) = __builtin_bit_cast(bf16x8, w1);
      *reinterpret_cast<bf16x8*>(qrow + (((2 * (dr + 2) + hi) ^ qsw) << 4)) = __builtin_bit_cast(bf16x8, w2); }
  }
  int ksrc[3], vsrc[2];
#pragma unroll
  for (int k = 0; k < 3; ++k) { const int o_ = (wid + 8 * k) * 1024 + lane * 16, r_ = o_ / 384, sc_ = (o_ - r_ * 384) >> 4, c_ = (sc_ & ~7) | ((sc_ & 7) ^ ((r_ >> 1) & 7)); ksrc[k] = (r_ * LDK + c_ * 8) * 2; }
#pragma unroll
  for (int k = 0; k < 2; ++k) { const int o_ = (wid + 8 * k) * 1024 + lane * 16, sub_ = o_ >> 9, w_ = (o_ & 511) >> 1, kk_ = (sub_ >> 2) * 8 + (w_ >> 5), key_ = (kk_ & ~0xC) | ((kk_ & 4) << 1) | ((kk_ & 8) >> 1);
    vsrc[k] = (key_ * LDV + (sub_ & 3) * 32 + (w_ & 31)) * 2; }
  const int vb0 = (int)(uintptr_t)V_lds + v_rd_base(lane);
  const __amdgpu_buffer_rsrc_t krs = __builtin_amdgcn_make_buffer_rsrc((void*)Kh, 0, seq * LDK * 2, 0x00020000);
  const __amdgpu_buffer_rsrc_t vrs = __builtin_amdgcn_make_buffer_rsrc((void*)Vh, 0, seq * LDV * 2, 0x00020000);
#define MLD_ISSUE(k0, bk, bv) do { \
    _Pragma("unroll") for (int k = 0; k < 3; ++k) __builtin_amdgcn_raw_ptr_buffer_load_lds(krs, (las_u32*)(K_lds + (bk) * SHM_K + (wu + 8 * k) * 1024), 16, ksrc[k], (k0) * LDK * 2, 0, 0); \
    _Pragma("unroll") for (int k = 0; k < 2; ++k) __builtin_amdgcn_raw_ptr_buffer_load_lds(vrs, (las_u32*)(V_lds + (bv) * SHM_V + (wu + 8 * k) * 1024), 16, vsrc[k], (k0) * LDV * 2, 0, 0); } while (0)
#define MLD_RD(d0_, A0_, A1_, QF_) do { const int c_ = 2 * (d0_) + hi; const int off_ = (c_ ^ sw) << 4; A0_ = *reinterpret_cast<const bf16x8*>(kb_ + off_); A1_ = *reinterpret_cast<const bf16x8*>(kb_ + 32 * 384 + off_); \
      if ((d0_) >= 8) QF_ = *reinterpret_cast<const bf16x8*>(qrow + (((2 * ((d0_) - 8) + hi) ^ qsw) << 4)); else QF_ = qr[(d0_) < 8 ? (d0_) : 0]; } while (0)
#define MLD_MM(A0_, A1_, QF_) do { p0 = __builtin_amdgcn_mfma_f32_32x32x16_bf16(A0_, QF_, p0, 0, 0, 0); p1 = __builtin_amdgcn_mfma_f32_32x32x16_bf16(A1_, QF_, p1, 0, 0, 0); } while (0)
#define MLD_S(t_) do { const int b_ = (t_) & 1; f32x16 p0 = f32x16{}, p1 = f32x16{}; \
      { const int sw = (r32 >> 1) & 7; const char* kb_ = K_lds + b_ * SHM_K + r32 * 384; \
        bf16x8 xa0, xa1, xq, ya0, ya1, yq; \
        MLD_RD(0, xa0, xa1, xq); \
        MLD_RD(1, ya0, ya1, yq); MLA_SBAR(); MLD_MM(xa0, xa1, xq); MLA_SBAR(); \
        MLD_RD(2, xa0, xa1, xq); MLA_SBAR(); MLD_MM(ya0, ya1, yq); MLA_SBAR(); \
        MLD_RD(3, ya0, ya1, yq); MLA_SBAR(); MLD_MM(xa0, xa1, xq); MLA_SBAR(); \
        MLD_RD(4, xa0, xa1, xq); MLA_SBAR(); MLD_MM(ya0, ya1, yq); MLA_SBAR(); \
        MLD_RD(5, ya0, ya1, yq); MLA_SBAR(); MLD_MM(xa0, xa1, xq); MLA_SBAR(); \
        MLD_RD(6, xa0, xa1, xq); MLA_SBAR(); MLD_MM(ya0, ya1, yq); MLA_SBAR(); \
        MLD_RD(7, ya0, ya1, yq); MLA_SBAR(); MLD_MM(xa0, xa1, xq); MLA_SBAR(); \
        MLD_RD(8, xa0, xa1, xq); MLA_SBAR(); MLD_MM(ya0, ya1, yq); MLA_SBAR(); \
        MLD_RD(9, ya0, ya1, yq); MLA_SBAR(); MLD_MM(xa0, xa1, xq); MLA_SBAR(); \
        MLD_RD(10, xa0, xa1, xq); MLA_SBAR(); MLD_MM(ya0, ya1, yq); MLA_SBAR(); \
        MLD_RD(11, ya0, ya1, yq); MLA_SBAR(); MLD_MM(xa0, xa1, xq); MLA_SBAR(); \
        MLD_MM(ya0, ya1, yq); } \
      float mn; partialSM(p0, p1, m_reg, mn, al); finishSM(p0, p1, al, l_reg, pa0, pa1, pa2, pa3); } while (0)
#define MLD_O(vslot_) do { if (__any(al < 1.f)) { if (hi == 0) al_l[r32] = al; asm volatile("s_waitcnt lgkmcnt(0)" ::: "memory"); \
        _Pragma("unroll") for (int d = 0; d < 4; ++d) _Pragma("unroll") for (int r = 0; r < 16; ++r) o[d][r] *= al_l[crow(r, hi)]; } \
      MLA_SBAR(); pv_d0(o, vb0 + (vslot_) * SHM_V, pa0, pa1, pa2, pa3); } while (0)
  const int NT = seq / KVBLK;
  MLD_ISSUE(0, 0, 0); asm volatile("s_waitcnt vmcnt(0)" ::: "memory"); __syncthreads();
  bf16x8 pa0 = {}, pa1 = {}, pa2 = {}, pa3 = {}; float al = 1.f;
  int vs_cur = 0;
  for (int j = 0; j <= NT; ++j) {
    const int vs_prev = vs_cur == 0 ? 2 : vs_cur - 1, vs_next = vs_cur == 2 ? 0 : vs_cur + 1;
    if (j + 1 < NT) MLD_ISSUE((j + 1) * KVBLK, (j + 1) & 1, vs_next);
    if (grp == 0) { if (j < NT) { MLD_S(j); MLD_O(vs_cur); } }
    else { if (j > 0) MLD_O(vs_prev); if (j < NT) MLD_S(j); }
    asm volatile("s_waitcnt vmcnt(0)" ::: "memory");
    __syncthreads();
    vs_cur = vs_next;
  }
  if (hi == 0) li_l[r32] = l_reg; asm volatile("s_waitcnt lgkmcnt(0)" ::: "memory");
  float rli[16];
#pragma unroll
  for (int r = 0; r < 16; ++r) rli[r] = __builtin_amdgcn_rcpf(li_l[crow(r, hi)]);
  bf16* Ow = Ob + (long)(wid * QBLK) * LDO;
#pragma unroll
  for (int r = 0; r < 16; ++r) { const int orow = crow(r, hi);
#pragma unroll
    for (int d0 = 0; d0 < 4; ++d0) Ow[(long)orow * LDO + d0 * 32 + r32] = (bf16)(cvtpk(o[d0][r] * rli[r], 0.f) & 0xffffu); }
  asm volatile("s_waitcnt vmcnt(0)" ::: "memory");
  __syncthreads();
#undef MLD_ISSUE
#undef MLD_S
#undef MLD_RD
#undef MLD_MM
#undef MLD_O
}
}
namespace wat {
typedef unsigned short bf16;
using bf16x8 = __attribute__((ext_vector_type(8))) short;
using s16x4  = __attribute__((ext_vector_type(4))) short;
using f32x4  = __attribute__((ext_vector_type(4))) float;
using u32x4  = __attribute__((ext_vector_type(4))) unsigned;
#define WAT_LAS __attribute__((address_space(3)))
__device__ __forceinline__ unsigned cvtpk(float lo, float hi) { unsigned r; asm volatile("v_cvt_pk_bf16_f32 %0, %1, %2" : "=v"(r) : "v"(lo), "v"(hi)); return r; }
__device__ __forceinline__ int kst_off(int row, int ch) { return row * 256 + ((ch ^ ((row & 3) | (((row >> 3) & 3) << 2))) << 4); }
__device__ __forceinline__ int vst_off(int row, int ch) { return (row >> 4) * 4096 + ((row >> 2) & 1) * 2048 + (ch >> 1) * 256 + ((row >> 3) & 1) * 128 + (row & 3) * 32 + (ch & 1) * 16; }
__device__ __forceinline__ int vrd_base(int R0, int lane) { const int g4 = lane >> 4, qa = (lane & 15) >> 2, p = lane & 3, gg = g4 + ((R0 >> 3) & 1); return ((R0 >> 4) + (gg >> 1)) * 4096 + (gg & 1) * 128 + qa * 32 + p * 8; }
__device__ __forceinline__ void qk_group(f32x4& sc0, f32x4& sc1, const WAT_LAS char* Kb, int Rg, const bf16x8* qf, int lane) {
    const int a = lane & 15, g4 = lane >> 4; const int row = Rg + 8 * (a >> 2) + (a & 3); const int xk = (row & 3) | (((row >> 3) & 3) << 2);
    const WAT_LAS char* p = Kb + row * 256;
    sc0 = f32x4{0.f, 0.f, 0.f, 0.f}; sc1 = f32x4{0.f, 0.f, 0.f, 0.f};
#pragma unroll
    for (int s = 0; s < 4; ++s) { const int off = ((4 * s + g4) ^ xk) << 4;
        const bf16x8 k0 = *(const WAT_LAS bf16x8*)(p + off), k1 = *(const WAT_LAS bf16x8*)(p + 4 * 256 + off);
        sc0 = __builtin_amdgcn_mfma_f32_16x16x32_bf16(k0, qf[s], sc0, 0, 0, 0);
        sc1 = __builtin_amdgcn_mfma_f32_16x16x32_bf16(k1, qf[s], sc1, 0, 0, 0); }
}
__device__ __forceinline__ bf16x8 p_frag(const f32x4 p0, const f32x4 p1) { u32x4 w = {cvtpk(p0[0], p0[1]), cvtpk(p0[2], p0[3]), cvtpk(p1[0], p1[1]), cvtpk(p1[2], p1[3])}; return *reinterpret_cast<bf16x8*>(&w); }
template <int OFF> __device__ __forceinline__ s16x4 tr_read(unsigned addr) { s16x4 r; asm volatile("ds_read_b64_tr_b16 %0, %1 offset:%2" : "=&v"(r) : "v"(addr), "i"(OFF) : "memory"); return r; }
template <int GOFF> __device__ __forceinline__ void pv_group(f32x4* o, unsigned vb, const bf16x8 pf) {
    s16x4 lo[8], hi[8];
#define WAT_TR(c) lo[c] = tr_read<GOFF + (c) * 256>(vb); hi[c] = tr_read<GOFF + 2048 + (c) * 256>(vb);
    WAT_TR(0) WAT_TR(1) WAT_TR(2) WAT_TR(3) WAT_TR(4) WAT_TR(5) WAT_TR(6) WAT_TR(7)
#undef WAT_TR
    asm volatile("s_waitcnt lgkmcnt(0)" ::: "memory"); __builtin_amdgcn_sched_barrier(0);
#pragma unroll
    for (int c = 0; c < 8; ++c) { const bf16x8 vfr = (bf16x8){lo[c][0], lo[c][1], lo[c][2], lo[c][3], hi[c][0], hi[c][1], hi[c][2], hi[c][3]};
        o[c] = __builtin_amdgcn_mfma_f32_16x16x32_bf16(pf, vfr, o[c], 0, 0, 0); }
}
}
constexpr int NWAVES = 8;
constexpr int BATCH = 2, SEQ = 8192, DM = 4096, M = BATCH * SEQ;
constexpr int EVEN_IN = 10688, ZLD = 10752;
constexpr int Z_CQ = 9216, Z_CKV = 10112, Z_KPE = 10624;
constexpr int QRANK = 896, KVRANK = 512, MLA_H = 16, MLA_QK = 192, MLA_NOPE = 128, MLA_ROPE = 64;
constexpr int DIL_H = 24, DIL_HPG = 8, HD = 128;
constexpr int NA_H = 32, GRID_W = 64, NA_ROWS = 8, NA_COLS = 16, GRID_ROWS = SEQ / GRID_W;
constexpr int DFF = 11008, EVEN_MIX = 3072;
constexpr float NORM_EPS = 1e-6f, LOG2E = 1.4426950408889634f;
constexpr float QS_MLA = 0.07216878364870322f * LOG2E;
constexpr float QS_HD = 0.08838834764831845f * LOG2E;
constexpr size_t MiB = 1u << 20;
constexpr size_t WS_CTL = 0, CTL_ZERO_BYTES = 64 * 1024;
constexpr size_t WS_ROPE = 1 * MiB;
constexpr size_t WS_RSTD = 4 * MiB;
constexpr size_t WS_SS = 5 * MiB;
constexpr size_t WS_WIN = 16 * MiB, WS_WUQ = 100 * MiB, WS_WUKV = 106 * MiB, WS_WEOUT = 110 * MiB, WS_WQKV = 134 * MiB, WS_WOOUT = 230 * MiB;
constexpr size_t WS_WFFN = 262 * MiB, FFN_W_BYTES = 86 * MiB;
constexpr size_t WS_XB = 778 * MiB;
constexpr size_t WS_R = 906 * MiB;
constexpr size_t R_Z = 0, R_Q = 336 * MiB, R_KV = 432 * MiB, R_K = 560 * MiB, R_OMIX = 656 * MiB, R_CQN = 656 * MiB, R_CKVN = 688 * MiB;
constexpr size_t R_A = 0, R_H2 = 344 * MiB;
constexpr size_t R_QKV = 0, R_O = 384 * MiB;
constexpr size_t R_DPO = 752 * MiB, R_DPM = 848 * MiB;
constexpr size_t WS_END = WS_R + 852 * MiB;
static_assert((size_t)ZLD * DM * 2 <= 84 * MiB && (size_t)DFF * DM * 2 == 86 * MiB && (size_t)M * ZLD * 2 == 336 * MiB && (size_t)M * DFF * 2 == 344 * MiB, "ws map");
constexpr int CW_BAR = 4096;
constexpr int RING_BYTES = 131072, LDS_BYTES = 163840, LDSCTL_OFF = LDS_BYTES - 1024, MISC_OFF = LDSCTL_OFF + 320;
constexpr int NA_TB_OFF = RING_BYTES + 1024, NA_OST_OFF = NA_TB_OFF + 2048;

#define GAS __attribute__((address_space(1)))
#define LAS __attribute__((address_space(3)))
typedef unsigned short bf16;
typedef unsigned v4u __attribute__((ext_vector_type(4)));
typedef unsigned v2u __attribute__((ext_vector_type(2)));
typedef float f32x4 __attribute__((ext_vector_type(4)));
#define LDS_WAIT() asm volatile("s_waitcnt lgkmcnt(0)" ::: "memory")
#define VM_WAIT() asm volatile("s_waitcnt vmcnt(0)" ::: "memory")
__device__ __forceinline__ unsigned f2bf(float f) { unsigned u = __builtin_bit_cast(unsigned, f); return (u + 0x7fffu + ((u >> 16) & 1u)) >> 16; }
__device__ __forceinline__ unsigned pk2(float lo, float hi) { return f2bf(lo) | (f2bf(hi) << 16); }
__device__ __forceinline__ float bflo(unsigned w) { return __uint_as_float(w << 16); }
__device__ __forceinline__ float bfhi(unsigned w) { return __uint_as_float(w & 0xffff0000u); }
__device__ __forceinline__ void unpack8(const v4u w, float* f) { f[0] = bflo(w.x); f[1] = bfhi(w.x); f[2] = bflo(w.y); f[3] = bfhi(w.y); f[4] = bflo(w.z); f[5] = bfhi(w.z); f[6] = bflo(w.w); f[7] = bfhi(w.w); }
__device__ __forceinline__ v4u pack8(const float* f) { v4u w; w.x = pk2(f[0], f[1]); w.y = pk2(f[2], f[3]); w.z = pk2(f[4], f[5]); w.w = pk2(f[6], f[7]); return w; }
__device__ __forceinline__ float wave_sum(float v) {
#pragma unroll
    for (int o = 1; o < 64; o <<= 1) v += __shfl_xor(v, o);
    return v;
}
__device__ __forceinline__ float sum16(float v) {
#pragma unroll
    for (int o = 1; o < 16; o <<= 1) v += __shfl_xor(v, o);
    return v;
}

#define XB_TMO      128
#define XB_XCNT(j)  (256  + 64 * (j))
#define XB_XSUB(j)  (1280 + 64 * (j))
#define XB_XGEN(j)  (2304 + 64 * (j))
#define XB_TOP      3328
#define XB_TOPGEN   3392
#define XCD_BAR_WORDS 3456
#define XB_SPIN_CAP (1u << 20)
__device__ __forceinline__ unsigned xb_ld(unsigned* p)              { return __hip_atomic_load(p, __ATOMIC_RELAXED, __HIP_MEMORY_SCOPE_AGENT); }
__device__ __forceinline__ unsigned xb_add(unsigned* p, unsigned v) { return __hip_atomic_fetch_add(p, v, __ATOMIC_RELAXED, __HIP_MEMORY_SCOPE_AGENT); }
__device__ __forceinline__ unsigned xb_xcc_id() { return (unsigned)__builtin_amdgcn_s_getreg((3 << 11) | 20) & 0xFu; }
#define XB_SPIN(cond, bar) do { unsigned _sp = 0; while (cond) { __builtin_amdgcn_s_sleep(1); \
    if ((++_sp & 255u) == 0u) { if (xb_ld(&(bar)[XB_TMO])) break; if (_sp > XB_SPIN_CAP) { atomicAdd(&(bar)[XB_TMO], 1u); break; } } } } while (0)
struct XcdBarrier { unsigned* bar; unsigned x; volatile LAS unsigned* st; };
__device__ __forceinline__ XcdBarrier xcd_barrier_post(unsigned* bar, volatile LAS unsigned* st) {
    XcdBarrier b; b.bar = bar; b.x = xb_xcc_id(); b.st = st;
    if (threadIdx.x == 0) (void)xb_add(&bar[XB_XCNT(b.x)], 1u);
    return b;
}
__device__ __forceinline__ void xcd_barrier_complete(unsigned* bar, unsigned x, unsigned& nloc, unsigned& nx) {
    const unsigned G = gridDim.x * gridDim.y * gridDim.z;
    unsigned sum, cnt, mine, sp = 0u;
    for (;;) {
        sum = 0u; cnt = 0u; mine = 0u;
#pragma unroll
        for (unsigned j = 0; j < 16; ++j) { const unsigned c = xb_ld(&bar[XB_XCNT(j)]); sum += c; cnt += (c > 0u) ? 1u : 0u; mine = (j == x) ? c : mine; }
        if (sum == G) break;
        __builtin_amdgcn_s_sleep(1);
        if ((++sp & 255u) == 0u) { if (xb_ld(&bar[XB_TMO])) break; if (sp > XB_SPIN_CAP) { atomicAdd(&bar[XB_TMO], 1u); break; } }
    }
    nloc = mine > 0u ? mine : 1u; nx = cnt > 0u ? cnt : 1u;
}
__device__ __forceinline__ void xcd_barrier(const XcdBarrier& b) {
    asm volatile("s_waitcnt vmcnt(0)" ::: "memory");
    __syncthreads();
    if (threadIdx.x == 0) {
        unsigned* bar = b.bar;
        __builtin_amdgcn_s_waitcnt(0);
        unsigned nloc = b.st[0], nx = b.st[1];
        if (nloc == 0u) { xcd_barrier_complete(bar, b.x, nloc, nx); b.st[0] = nloc; b.st[1] = nx; }
        const unsigned old = xb_add(&bar[XB_XSUB(b.x)], 1u);
        const unsigned gen = old / nloc;
        if (old + 1u == (gen + 1u) * nloc) {
            __builtin_amdgcn_fence(__ATOMIC_RELEASE, "agent");
            asm volatile("s_waitcnt vmcnt(0)" ::: "memory");
            const unsigned og = xb_add(&bar[XB_TOP], 1u);
            const unsigned tg = og / nx;
            if (og + 1u == (tg + 1u) * nx) xb_add(&bar[XB_TOPGEN], 1u);
            else XB_SPIN(xb_ld(&bar[XB_TOPGEN]) == tg, bar);
            __builtin_amdgcn_fence(__ATOMIC_ACQUIRE, "agent");
            xb_add(&bar[XB_XGEN(b.x)], 1u);
            asm volatile("s_waitcnt vmcnt(0)" ::: "memory");
        } else {
            XB_SPIN(xb_ld(&bar[XB_XGEN(b.x)]) == gen, bar);
            __builtin_amdgcn_fence(__ATOMIC_ACQUIRE, "agent");
            asm volatile("s_waitcnt vmcnt(0)" ::: "memory");
        }
    }
    __syncthreads();
}

struct Args { const float* in[24]; float* out; unsigned char* ws; int ph_lo, ph_hi; };
struct Frame { LAS unsigned char* lds; int tid, lane, wave, gw, ngw, G; };

struct P0Item { const float* W; int K, N; bf16* dst; const float* gain; int mode, r; };
__device__ __forceinline__ void p0_item_load(const P0Item& t, float (&v)[32], int lane) {
    const int nblk = t.N / 32, kb = t.r / nblk, nb = t.r % nblk, k0 = 64 * kb, n0 = 32 * nb;
    const float* p = t.W + (size_t)(k0 + (lane >> 5)) * t.N + n0 + (lane & 31);
#pragma unroll
    for (int i = 0; i < 32; ++i) v[i] = p[(size_t)(2 * i) * t.N];
}
__device__ __forceinline__ void p0_item_store(const P0Item& t, const float (&v)[32], LAS float* scr, int lane) {
    const int nblk = t.N / 32, kb = t.r / nblk, nb = t.r % nblk, k0 = 64 * kb, n0 = 32 * nb;
    const int drow0 = (t.mode == 1) ? (n0 >= 1472 ? n0 - 1472 : n0 + 9216)
                    : (t.mode >= 2) ? ((n0 >> 7) * 256 + (n0 & 127) + (t.mode == 3 ? 128 : 0)) : n0;
#pragma unroll
    for (int i = 0; i < 32; ++i) { const int kk = 2 * i + (lane >> 5); scr[kk * 33 + (lane & 31)] = v[i]; }
    LDS_WAIT(); asm volatile("" ::: "memory");
    const int c = lane & 7;
    f32x4 ga = {1.f, 1.f, 1.f, 1.f}, gb = {1.f, 1.f, 1.f, 1.f};
    if (t.gain) { ga = *(const f32x4*)(t.gain + k0 + 8 * c); gb = *(const f32x4*)(t.gain + k0 + 8 * c + 4); }
#pragma unroll
    for (int j = 0; j < 4; ++j) { const int n = (lane >> 3) + 8 * j; const LAS float* sp = scr + (8 * c) * 33 + n;
        v4u o; o.x = pk2(sp[0 * 33] * ga[0], sp[1 * 33] * ga[1]); o.y = pk2(sp[2 * 33] * ga[2], sp[3 * 33] * ga[3]); o.z = pk2(sp[4 * 33] * gb[0], sp[5 * 33] * gb[1]); o.w = pk2(sp[6 * 33] * gb[2], sp[7 * 33] * gb[3]);
        *(v4u*)(t.dst + (size_t)(drow0 + n) * t.K + k0 + 8 * c) = o; }
    LDS_WAIT(); asm volatile("" ::: "memory");
}
#ifndef MLA_UNIT
#define MLA_UNIT mla::attn_unit_d
#endif
constexpr int N_PHASES = 20;
#ifndef LB2
#define LB2 2
#endif
__global__ void __launch_bounds__(NWAVES * 64, LB2) mk_fwd(Args args) {
    extern __shared__ __attribute__((aligned(16))) unsigned char lds[];
    Frame F;
    F.lds = (LAS unsigned char*)lds;
    F.tid = threadIdx.x; F.lane = F.tid & 63; F.wave = __builtin_amdgcn_readfirstlane(F.tid >> 6);
    F.G = gridDim.x; F.gw = blockIdx.x * NWAVES + F.wave; F.ngw = F.G * NWAVES;
    const int lane = F.lane, l15 = lane & 15, grp = lane >> 4;
    unsigned char* ws = args.ws;
    unsigned* ctl = (unsigned*)(ws + WS_CTL);
    const float* x_in = args.in[0]; float* out = args.out;
    float* cosA = (float*)(ws + WS_ROPE); float* sinA = cosA + SEQ * 16; float* cosB = sinA + SEQ * 16; float* sinB = cosB + SEQ * 32;
    float* rstd = (float*)(ws + WS_RSTD); float* ss = (float*)(ws + WS_SS);
    bf16* Win_t = (bf16*)(ws + WS_WIN); bf16* Wuq_t = (bf16*)(ws + WS_WUQ); bf16* Wukv_t = (bf16*)(ws + WS_WUKV); bf16* Weout_t = (bf16*)(ws + WS_WEOUT);
    bf16* Wqkv_t = (bf16*)(ws + WS_WQKV); bf16* Woout_t = (bf16*)(ws + WS_WOOUT);
    bf16* xb = (bf16*)(ws + WS_XB);
    unsigned char* R = ws + WS_R;
    bf16* zb = (bf16*)(R + R_Z); bf16* qb = (bf16*)(R + R_Q); bf16* kvb = (bf16*)(R + R_KV); bf16* kb = (bf16*)(R + R_K); bf16* omix = (bf16*)(R + R_OMIX);
    bf16* cqn = (bf16*)(R + R_CQN); bf16* ckvn = (bf16*)(R + R_CKVN);
    bf16* aedge = (bf16*)(R + R_A); bf16* uedge = aedge + (size_t)(M / 256) * 4 * DFF; bf16* h2b = (bf16*)(R + R_H2);
    bf16* qkvb = (bf16*)(R + R_QKV); bf16* ob = (bf16*)(R + R_O);
    bf16* dpo = (bf16*)(R + R_DPO); float* dpm = (float*)(R + R_DPM);
    bf16* xl0 = (bf16*)(ws + WS_WIN); bf16* xl1 = (bf16*)(R + R_DPO) - (size_t)8192 * DM;

    for (int u = F.tid; u < (LDS_BYTES - LDSCTL_OFF) / 4; u += NWAVES * 64) ((LAS unsigned*)(F.lds + LDSCTL_OFF))[u] = 0u;
    __syncthreads();
    const int lo = args.ph_lo, hi = args.ph_hi;
    XcdBarrier bar; bar.bar = ctl + CW_BAR; bar.x = 0; bar.st = nullptr;
    if (hi - lo > 1) bar = xcd_barrier_post(ctl + CW_BAR, (volatile LAS unsigned*)(F.lds + MISC_OFF) + 8);
#ifndef PH_MASK
#define PH_MASK 0xFFFFFu
#endif
#define IN(k) ((((PH_MASK) >> (k)) & 1u) && lo <= (k) && (k) < hi)
#define SEAM(k) do { if (IN(k) && IN((k) + 1)) xcd_barrier(bar); } while (0)

    if (IN(0)) {
        LAS float* scr = (LAS float*)(F.lds + F.wave * 16384);
        constexpr int I_WIN = (DM / 64) * (EVEN_IN / 32), I_UQ = (QRANK / 64) * (3072 / 32), I_UKV = (KVRANK / 64) * (4096 / 32), I_EOUT = (EVEN_MIX / 64) * (DM / 32);
        constexpr int I_QKV = (DM / 64) * (12288 / 32), I_OOUT = (DM / 64) * (DM / 32), I_GU = (DM / 64) * (DFF / 32), I_DN = (DFF / 64) * (DM / 32);
        constexpr int NITEMS = I_WIN + I_UQ + I_UKV + I_EOUT + I_QKV + I_OOUT + 2 * (2 * I_GU + I_DN);
#define P0_DECODE(it_, T_) do { int r = (it_); T_.gain = nullptr; T_.mode = 0; \
            if (r < I_WIN) { T_.W = args.in[2]; T_.K = DM; T_.N = EVEN_IN; T_.dst = Win_t; T_.gain = args.in[1]; T_.mode = 1; } \
            else if ((r -= I_WIN) < I_UQ) { T_.W = args.in[5]; T_.K = QRANK; T_.N = 3072; T_.dst = Wuq_t; T_.gain = args.in[3]; } \
            else if ((r -= I_UQ) < I_UKV) { T_.W = args.in[6]; T_.K = KVRANK; T_.N = 4096; T_.dst = Wukv_t; T_.gain = args.in[4]; } \
            else if ((r -= I_UKV) < I_EOUT) { T_.W = args.in[11]; T_.K = EVEN_MIX; T_.N = DM; T_.dst = Weout_t; } \
            else if ((r -= I_EOUT) < I_QKV) { T_.W = args.in[13]; T_.K = DM; T_.N = 12288; T_.dst = Wqkv_t; T_.gain = args.in[12]; } \
            else if ((r -= I_QKV) < I_OOUT) { T_.W = args.in[17]; T_.K = DM; T_.N = DM; T_.dst = Woout_t; } \
            else { r -= I_OOUT; const int layer = r / (2 * I_GU + I_DN); r -= layer * (2 * I_GU + I_DN); \
                bf16* wl = (bf16*)(ws + WS_WFFN + (size_t)layer * 3 * FFN_W_BYTES); \
                if (r < I_GU) { T_.W = args.in[19] + (size_t)layer * DM * DFF; T_.K = DM; T_.N = DFF; T_.dst = wl; T_.gain = args.in[18] + layer * DM; T_.mode = 2; } \
                else if ((r -= I_GU) < I_GU) { T_.W = args.in[20] + (size_t)layer * DM * DFF; T_.K = DM; T_.N = DFF; T_.dst = wl; T_.gain = args.in[18] + layer * DM; T_.mode = 3; } \
                else { r -= I_GU; T_.W = args.in[23] + (size_t)layer * DFF * DM; T_.K = DFF; T_.N = DM; T_.dst = (bf16*)((unsigned char*)wl + 2 * FFN_W_BYTES); } } \
            T_.r = r; } while (0)
        {
            float va[32], vb[32]; P0Item ta, tb_;
            int it = F.gw;
            if (it < NITEMS) { P0_DECODE(it, ta); p0_item_load(ta, va, lane); }
            while (it < NITEMS) {
                const int it1 = it + F.ngw, it2 = it1 + F.ngw;
                if (it1 < NITEMS) { P0_DECODE(it1, tb_); p0_item_load(tb_, vb, lane); }
                p0_item_store(ta, va, scr, lane);
                if (it1 >= NITEMS) break;
                if (it2 < NITEMS) { P0_DECODE(it2, ta); p0_item_load(ta, va, lane); }
                p0_item_store(tb_, vb, scr, lane);
                it = it2;
            }
        }
#undef P0_DECODE
        const int gtid = blockIdx.x * (NWAVES * 64) + F.tid, nthr = F.G * NWAVES * 64;
        for (int i = gtid; i < (ZLD - 10688) * DM / 8; i += nthr) ((v4u*)(Win_t + (size_t)10688 * DM))[i] = (v4u){0u, 0u, 0u, 0u};
        for (int i = gtid; i < SEQ * 48; i += nthr) {
            const bool isB = i >= SEQ * 16; const int ii = isB ? i - SEQ * 16 : i; const int pos = isB ? (ii >> 5) : (ii >> 4), k = isB ? (ii & 31) : (ii & 15);
            const double c1 = isB ? 0.6636012376960885 : 0.44036660267178046;
            double p = 1.0; for (int j = 0; j < k; ++j) p *= c1;
            const float inv = (float)p; const float ang = (float)pos * inv;
            const double rev = (double)ang * 0.15915494309189535; const float fr = (float)(rev - __builtin_rint(rev));
            const float sv = __builtin_amdgcn_sinf(fr), cv = __builtin_amdgcn_cosf(fr);
            if (isB) { cosB[ii] = cv; sinB[ii] = sv; } else { cosA[ii] = cv; sinA[ii] = sv; }
        }
#pragma unroll 2
        for (int row = F.gw; row < M; row += F.ngw) {
            const f32x4* xr = (const f32x4*)(x_in + (size_t)row * DM) + lane; v2u* xo = (v2u*)(xb + (size_t)row * DM) + lane; float s = 0.f;
#pragma unroll 4
            for (int j = 0; j < 16; ++j) { const f32x4 v = xr[64 * j]; s += (v.x * v.x + v.y * v.y) + (v.z * v.z + v.w * v.w); v2u w; w.x = pk2(v.x, v.y); w.y = pk2(v.z, v.w); xo[64 * j] = w; }
            s = wave_sum(s);
            if (lane == 0) rstd[row] = 1.0f / sqrtf(s * (1.0f / DM) + NORM_EPS);
        }
    }
    SEAM(0);
    if (IN(1)) {
        pg8::Gemm g{xb, Win_t, M, ZLD, DM, DM}; pg8::StaticOrder S; S.init(M, ZLD, F.G, (int)blockIdx.x);
        pg8::EpiHeadNorm E{zb, ZLD, rstd, args.in[9], args.in[10], QS_HD, 12, 12, (PG8_LAS float*)(F.lds + NA_TB_OFF), cosA, sinA, SEQ, ss};
        pg8::gemm_phase<pg8::EpiHeadNorm, pg8::StaticOrder, true, true>(F.lds, g, S, E);
    }
    SEAM(1);
    if (IN(3)) {
        {
            const int pm_lo = F.G == 256 ? 8 * ((int)blockIdx.x & 7) + (((int)blockIdx.x >> 3) & 7) : 0, pm_hi = F.G == 256 ? pm_lo + 1 : M / 256;
            for (int pmi = pm_lo; pmi < pm_hi; ++pmi) {
                const int row = pmi * 256 + (F.tid >> 1); const f32x4* sp = (const f32x4*)(ss + (size_t)row * 64) + ((F.tid & 1) ? 7 : 0);
                f32x4 a = sp[0] + sp[1] + sp[2] + sp[3]; if ((F.tid & 1) == 0) a += sp[4] + sp[5] + sp[6];
                const float tot = (a[0] + a[1]) + (a[2] + a[3]);
                rstd[((F.tid & 1) ? 2 * M : M) + row] = 1.0f / sqrtf(tot * ((F.tid & 1) ? 1.0f / KVRANK : 1.0f / QRANK) + NORM_EPS); }
            asm volatile("s_waitcnt vmcnt(0)" ::: "memory"); __syncthreads();
        }
        { pg8::Gemm g{zb + Z_CQ, Wuq_t, M, 3072, QRANK, ZLD}; pg8::StaticOrder S; S.init(M, 3072, F.G, (int)blockIdx.x); pg8::EpiScaleBf16 E{qb, 3072, rstd + M};
          pg8::gemm_phase<pg8::EpiScaleBf16, pg8::StaticOrder, true, true>(F.lds, g, S, E); }
        { pg8::Gemm g{zb + Z_CKV, Wukv_t, M, 4096, KVRANK, ZLD}; pg8::StaticOrder S; S.init(M, 4096, F.G, (int)blockIdx.x); pg8::EpiScaleBf16 E{kvb, 4096, rstd + 2 * M};
          pg8::gemm_phase<pg8::EpiScaleBf16, pg8::StaticOrder, true, true>(F.lds, g, S, E); }
        {
            WAT_LAS char* L = (WAT_LAS char*)F.lds;
            const int NU = BATCH * 3 * DIL_HPG * 64;
            const int u0 = (int)(((long)NU * blockIdx.x) / F.G), u1 = (int)(((long)NU * (blockIdx.x + 1)) / F.G);
            const int row16 = F.tid >> 4, ch16 = F.tid & 15, kso = wat::kst_off(row16, ch16), vso = wat::vst_off(row16, ch16);
            const int w = F.wave, q = lane & 15, g4 = lane >> 4, Rw = 32 * (w >> 1);
            v4u st[8];
#define DL_GEOM(u_) const int blk_ = (u_) & 63, j_ = ((u_) >> 6) & 7, bg_ = (u_) >> 9, g_ = bg_ % 3, b_ = bg_ / 3, sh_ = 2 * g_, d_ = 1 << sh_, Ld_ = SEQ >> sh_, \
            r_ = blk_ >> (6 - sh_), p0_ = (blk_ & ((64 >> sh_) - 1)) * 128, head_ = 8 * g_ + j_;
#define DL_LOAD(u_, s_) do { DL_GEOM(u_) const bf16* base_ = zb + (size_t)(b_ * SEQ + r_) * ZLD + ((s_) ? 6144 : 3072) + head_ * HD + ch16 * 8; \
            _Pragma("unroll") for (int k = 0; k < 8; ++k) { const int kp_ = min(max(p0_ - 64 + row16 + 32 * k, 0), Ld_ - 1); st[k] = *(const v4u*)(base_ + (size_t)(kp_ << sh_) * ZLD); } } while (0)
#define DL_WRITE(s_) do { WAT_LAS char* dd_ = L + (s_) * 65536 + ((s_) ? vso : kso); _Pragma("unroll") for (int k = 0; k < 8; ++k) *(WAT_LAS v4u*)(dd_ + k * 32 * 256) = st[k]; } while (0)
#define DL_END(un_, sn_, un2_, sn2_) do { if ((un_) < u1) { VM_WAIT(); DL_WRITE(sn_); } __syncthreads(); if ((un2_) < u1) DL_LOAD(un2_, sn2_); } while (0)
            if (u0 < u1) { DL_LOAD(u0, 0); VM_WAIT(); DL_WRITE(0); __syncthreads(); DL_LOAD(u0, 1); }
            for (int u = u0; u < u1; ++u) {
                DL_GEOM(u)
                wat::bf16x8 qf[4]; wat::f32x4 sc[5][2]; wat::bf16x8 pf[5]; wat::f32x4 o[8]; float linv = 0.f, mrow = 0.f, lrow = 0.f;
                const int qp = p0_ + 16 * w + q; const size_t qtok = (size_t)(b_ * SEQ + r_) + ((size_t)qp << sh_);
                {
                    const bf16* qptr = zb + qtok * ZLD + head_ * HD + 8 * g4;
#pragma unroll
                    for (int s = 0; s < 4; ++s) qf[s] = *(const wat::bf16x8*)(qptr + 32 * s);
#pragma unroll
                    for (int gi = 0; gi < 5; ++gi) wat::qk_group(sc[gi][0], sc[gi][1], L, Rw + 32 * gi, qf, lane);
                    float m = -1e30f;
#pragma unroll
                    for (int gi = 0; gi < 5; ++gi)
#pragma unroll
                        for (int j = 0; j < 8; ++j) { const int lr = Rw + 32 * gi + 8 * g4 + j, kp = p0_ - 64 + lr, dq = kp - qp; const bool ok = dq >= -64 && dq <= 64 && kp >= 0 && kp < Ld_;
                            const float v = ok ? sc[gi][j >> 2][j & 3] : -1e30f; sc[gi][j >> 2][j & 3] = v; m = fmaxf(m, v); }
                    m = fmaxf(m, __shfl_xor(m, 16)); m = fmaxf(m, __shfl_xor(m, 32));
                    float l = 0.f;
#pragma unroll
                    for (int gi = 0; gi < 5; ++gi) {
#pragma unroll
                        for (int j = 0; j < 8; ++j) { const float sv = sc[gi][j >> 2][j & 3]; const float v = sv > -1e29f ? __builtin_amdgcn_exp2f(sv - m) : 0.f; sc[gi][j >> 2][j & 3] = v; l += v; }
                        pf[gi] = wat::p_frag(sc[gi][0], sc[gi][1]); }
                    l += __shfl_xor(l, 16); l += __shfl_xor(l, 32); linv = 1.0f / l; mrow = m; lrow = l;
#pragma unroll
                    for (int c = 0; c < 8; ++c) o[c] = wat::f32x4{0.f, 0.f, 0.f, 0.f};
                }
                DL_END(u, 1, u + 1, 0);
                {
                    const unsigned vb = (unsigned)(uintptr_t)(L + 65536) + (unsigned)wat::vrd_base(Rw, lane);
                    wat::pv_group<0>(o, vb, pf[0]); wat::pv_group<8192>(o, vb, pf[1]); wat::pv_group<16384>(o, vb, pf[2]); wat::pv_group<24576>(o, vb, pf[3]); wat::pv_group<32768>(o, vb, pf[4]);
                    WAT_LAS char* ost = L + NA_OST_OFF + w * 2304;
                    float li[4];
#pragma unroll
                    for (int r = 0; r < 4; ++r) li[r] = __shfl(linv, 4 * g4 + r);
                    const size_t tok_r = (size_t)(b_ * SEQ + r_) + ((size_t)(p0_ + 16 * w + g4) << sh_);
#pragma unroll
                    for (int hf = 0; hf < 2; ++hf) {
#pragma unroll
                        for (int r = 0; r < 4; ++r)
#pragma unroll
                            for (int c = 0; c < 4; ++c) *(WAT_LAS unsigned short*)(ost + (4 * g4 + r) * 144 + (16 * c + q) * 2) = (unsigned short)(wat::cvtpk(o[4 * hf + c][r] * li[r], 0.f) & 0xffffu);
                        asm volatile("s_waitcnt lgkmcnt(0)" ::: "memory");
#pragma unroll
                        for (int k = 0; k < 2; ++k) { const int rq = g4 + 4 * (2 * k + (q >> 3)); const v4u v = *(const WAT_LAS v4u*)(ost + rq * 144 + (q & 7) * 16);
                            const size_t tk = tok_r + ((size_t)(4 * (2 * k + (q >> 3))) << sh_);
                            *(v4u*)(dpo + ((tk * DIL_HPG + j_) * 3 + g_) * HD + 64 * hf + (q & 7) * 8) = v; }
                        asm volatile("s_waitcnt lgkmcnt(0)" ::: "memory");
                    }
                    if (g4 == 0) { float* pmp = dpm + ((qtok * DIL_HPG + j_) * 3 + g_) * 2; pmp[0] = mrow; pmp[1] = lrow; }
                }
                DL_END(u + 1, 0, u + 1, 1);
            }
#undef DL_GEOM
#undef DL_LOAD
#undef DL_WRITE
#undef DL_END
        }
    }
    SEAM(3);
    if (IN(4)) {
        const float* qn = args.in[7]; const float* kn = args.in[8];
        float gq[12], gk[12];
#pragma unroll
        for (int k = 0; k < 3; ++k)
#pragma unroll
            for (int j = 0; j < 4; ++j) { gq[4 * k + j] = qn[64 * k + 4 * l15 + j] * QS_MLA; gk[4 * k + j] = kn[64 * k + 4 * l15 + j]; }
#pragma unroll 2
        for (int row = F.gw; row < M; row += F.ngw) {
            const int pos = row & (SEQ - 1);
            float cr[4], sr[4];
#pragma unroll
            for (int j = 0; j < 4; ++j) { cr[j] = cosB[pos * 32 + 4 * (l15 & 7) + j]; sr[j] = sinB[pos * 32 + 4 * (l15 & 7) + j]; if (l15 < 8) sr[j] = -sr[j]; }
            const v2u kpe = *(const v2u*)(zb + (size_t)row * ZLD + Z_KPE + 4 * l15);
#pragma unroll
            for (int it = 0; it < 4; ++it) {
                const int h = 4 * it + grp;
                {
                    const bf16* p = kvb + (size_t)row * 4096 + h * 256 + 4 * l15; v2u w[3];
                    w[0] = *(const v2u*)p; w[1] = *(const v2u*)(p + 64); w[2] = kpe;
                    float v[12];
#pragma unroll
                    for (int k = 0; k < 3; ++k) { v[4 * k] = bflo(w[k].x); v[4 * k + 1] = bfhi(w[k].x); v[4 * k + 2] = bflo(w[k].y); v[4 * k + 3] = bfhi(w[k].y); }
                    float s = 0.f;
#pragma unroll
                    for (int e = 0; e < 12; ++e) s += v[e] * v[e];
                    s = sum16(s); const float rs = 1.0f / sqrtf(s * (1.0f / MLA_QK) + NORM_EPS);
#pragma unroll
                    for (int e = 0; e < 12; ++e) v[e] = v[e] * rs * gk[e];
#pragma unroll
                    for (int j = 0; j < 4; ++j) { const float yp = __shfl_xor(v[8 + j], 8); v[8 + j] = v[8 + j] * cr[j] + yp * sr[j]; }
                    bf16* o_ = kb + (size_t)row * 3072 + h * MLA_QK + 4 * l15;
#pragma unroll
                    for (int k = 0; k < 3; ++k) { v2u o; o.x = pk2(v[4 * k], v[4 * k + 1]); o.y = pk2(v[4 * k + 2], v[4 * k + 3]); *(v2u*)(o_ + 64 * k) = o; }
                }
            }
#pragma unroll
            for (int it = 0; it < 2; ++it) {
                const int jh = 4 * it + grp; const size_t pb = ((size_t)row * DIL_HPG + jh) * 3;
                const float m0 = dpm[pb * 2 + 0], l0 = dpm[pb * 2 + 1], m1 = dpm[pb * 2 + 2], l1 = dpm[pb * 2 + 3], m2 = dpm[pb * 2 + 4], l2 = dpm[pb * 2 + 5];
                const float mm = fmaxf(m0, fmaxf(m1, m2)); const float w0 = __builtin_amdgcn_exp2f(m0 - mm) * l0, w1 = __builtin_amdgcn_exp2f(m1 - mm) * l1, w2 = __builtin_amdgcn_exp2f(m2 - mm) * l2;
                const float rw = 1.0f / (w0 + w1 + w2);
                float a0[8], a1[8], a2[8], x[8];
                unpack8(*(const v4u*)(dpo + (pb + 0) * HD + 8 * l15), a0); unpack8(*(const v4u*)(dpo + (pb + 1) * HD + 8 * l15), a1); unpack8(*(const v4u*)(dpo + (pb + 2) * HD + 8 * l15), a2);
#pragma unroll
                for (int j = 0; j < 8; ++j) x[j] = (w0 * a0[j] + w1 * a1[j] + w2 * a2[j]) * rw;
                *(v4u*)(omix + (size_t)row * 3072 + 2048 + jh * HD + 8 * l15) = pack8(x);
            }
        }
    }
    SEAM(4);
    if (IN(5)) {
        for (int i = 0; i * F.G + (int)blockIdx.x < BATCH * MLA_H * (SEQ / 256); ++i) {
            const int c = (int)blockIdx.x; int bh = i * 8 + (c & 7), qblk = c >> 3;
            if (F.G != 256) { const int u = i * F.G + c; bh = u >> 5; qblk = u & 31; }
            const int b = bh >> 4, h = bh & 15; const size_t r0 = (size_t)b * SEQ;
            MLA_UNIT(qb + (r0 + (size_t)qblk * 256) * 3072 + h * MLA_QK, kb + r0 * 3072 + h * MLA_QK, kvb + r0 * 4096 + h * 256 + 128,
                              omix + (r0 + (size_t)qblk * 256) * 3072 + h * HD, SEQ, (char*)lds, args.in[7], QS_MLA, NORM_EPS, cosB, sinB, qblk * 256);
        }
    }
    SEAM(5);
    if (IN(6)) {
        pg8::Gemm g{omix, Weout_t, M, DM, EVEN_MIX, EVEN_MIX}; pg8::StaticOrder S; S.init(M, DM, F.G, (int)blockIdx.x); pg8::EpiResidT<0> E{x_in, out, xb, xl0, xl1, ss, DM};
        pg8::gemm_phase<pg8::EpiResidT<0>, pg8::StaticOrder, true, true>(F.lds, g, S, E);
    }
    SEAM(6);
#define RSTD_PHASE() do { for (int row = F.gw; row < M; row += F.ngw) { const float s = wave_sum(ss[(size_t)row * 64 + lane]); if (lane == 0) rstd[row] = 1.0f / sqrtf(s * (1.0f / DM) + NORM_EPS); } } while (0)
#define RSTD_LOCAL() do { const int pm_lo = F.G == 256 ? 8 * ((int)blockIdx.x & 7) + (((int)blockIdx.x >> 3) & 7) : 0, pm_hi = F.G == 256 ? pm_lo + 1 : M / 256; \
        for (int pmi = pm_lo; pmi < pm_hi; ++pmi) { const int row = pmi * 256 + (F.tid >> 1); const f32x4* sp = (const f32x4*)(ss + (size_t)row * 64) + (F.tid & 1) * 8; \
            const f32x4 a = ((sp[0] + sp[1]) + (sp[2] + sp[3])) + ((sp[4] + sp[5]) + (sp[6] + sp[7])); float tot = (a[0] + a[1]) + (a[2] + a[3]); tot += __shfl_xor(tot, 1); \
            if ((F.tid & 1) == 0) rstd[row] = 1.0f / sqrtf(tot * (1.0f / DM) + NORM_EPS); } \
        asm volatile("s_waitcnt vmcnt(0)" ::: "memory"); __syncthreads(); } while (0)
#define FFN_GATEUP(layer) do { const bf16* wl = (const bf16*)(ws + WS_WFFN + (size_t)(layer) * 3 * FFN_W_BYTES); \
        pg8::Gemm g{xb, wl, M, 2 * DFF, DM, DM}; pg8::StaticOrder S; S.init(M, 2 * DFF, F.G, (int)blockIdx.x, DM / 64, (float*)(R + (size_t)(16 + 48 * (layer)) * MiB), ctl + 8192 + 2048 * (1 + (layer))); \
        pg8::EpiGateUp E{h2b, rstd, args.in[21] + (size_t)(layer) * 3 * DFF, args.in[22] + (size_t)(layer) * DFF, DFF, aedge, uedge, (PG8_LAS float*)(F.lds + NA_TB_OFF)}; \
        pg8::gemm_phase<pg8::EpiGateUp, pg8::StaticOrder, true, true, true>(F.lds, g, S, E); } while (0)
#define FFN_FIX(layer) do { const float* cwp = args.in[21] + (size_t)(layer) * 3 * DFF; const float* cbp = args.in[22] + (size_t)(layer) * DFF; \
        const int pm_lo = F.G == 256 ? 8 * ((int)blockIdx.x & 7) + (((int)blockIdx.x >> 3) & 7) : 0, pm_hi = F.G == 256 ? pm_lo + 1 : M / 256; \
        for (int i = pm_lo * 2 * (DFF / 8) + F.tid; i < pm_hi * 2 * (DFF / 8); i += NWAVES * 64) { const int c8 = i % (DFF / 8), e = (i / (DFF / 8)) & 1, pm = i / (2 * (DFF / 8)); const int ch = c8 * 8; \
            const int row = pm * 256 + (e ? 255 : 0), t = row & (SEQ - 1); const v4u z4 = {0u, 0u, 0u, 0u}; \
            const v4u cur = *(const v4u*)(aedge + ((size_t)pm * 4 + (e ? 3 : 0)) * DFF + ch); \
            const v4u prv = e ? *(const v4u*)(aedge + ((size_t)pm * 4 + 2) * DFF + ch) : (t > 0 ? *(const v4u*)(aedge + ((size_t)(pm - 1) * 4 + 3) * DFF + ch) : z4); \
            const v4u nxt = e ? (t < SEQ - 1 ? *(const v4u*)(aedge + ((size_t)(pm + 1) * 4 + 0) * DFF + ch) : z4) : *(const v4u*)(aedge + ((size_t)pm * 4 + 1) * DFF + ch); \
            const v4u upv = *(const v4u*)(uedge + ((size_t)pm * 2 + e) * DFF + ch); \
            const unsigned cu_[4] = {cur.x, cur.y, cur.z, cur.w}, pr_[4] = {prv.x, prv.y, prv.z, prv.w}, nx_[4] = {nxt.x, nxt.y, nxt.z, nxt.w}, up_[4] = {upv.x, upv.y, upv.z, upv.w}; \
            float hv[8]; \
            _Pragma("unroll") for (int j = 0; j < 8; ++j) { \
                const float fm = (j & 1) ? bfhi(pr_[j >> 1]) : bflo(pr_[j >> 1]), fz = (j & 1) ? bfhi(cu_[j >> 1]) : bflo(cu_[j >> 1]), fn = (j & 1) ? bfhi(nx_[j >> 1]) : bflo(nx_[j >> 1]), fu = (j & 1) ? bfhi(up_[j >> 1]) : bflo(up_[j >> 1]); \
                const float gg = cwp[ch + j] * fm + cwp[DFF + ch + j] * fz + cwp[2 * DFF + ch + j] * fn + cbp[ch + j]; \
                const float ee = __builtin_amdgcn_exp2f(-1.4426950408889634f * gg); hv[j] = gg * __builtin_amdgcn_rcpf(1.0f + ee) * fu; } \
            v4u o; o.x = pk2(hv[0], hv[1]); o.y = pk2(hv[2], hv[3]); o.z = pk2(hv[4], hv[5]); o.w = pk2(hv[6], hv[7]); \
            *(v4u*)(h2b + (size_t)row * DFF + ch) = o; } \
        asm volatile("s_waitcnt vmcnt(0)" ::: "memory"); __syncthreads(); } while (0)
#define FFN_DOWN(layer) do { const bf16* wl = (const bf16*)(ws + WS_WFFN + (size_t)(layer) * 3 * FFN_W_BYTES + 2 * FFN_W_BYTES); \
        pg8::Gemm g{h2b, wl, M, DM, DFF, DFF}; pg8::StaticOrder S; S.init(M, DM, F.G, (int)blockIdx.x); pg8::EpiResidT<(layer) == 0 ? 1 : 2> E{nullptr, out, xb, xl0, xl1, ss, DM}; \
        pg8::gemm_phase<pg8::EpiResidT<(layer) == 0 ? 1 : 2>, pg8::StaticOrder, true, true>(F.lds, g, S, E); } while (0)
    if (IN(8)) { RSTD_LOCAL(); FFN_GATEUP(0); }
    SEAM(8);
#if MK_CHECK
    if (IN(9)) FFN_FIX(0);
    if (IN(10)) FFN_DOWN(0);
#else
    if (IN(10)) { FFN_FIX(0); FFN_DOWN(0); }
#endif
    SEAM(10);
    if (IN(12)) {
        RSTD_LOCAL();
        pg8::Gemm g{xb, Wqkv_t, M, 12288, DM, DM}; pg8::StaticOrder S; S.init(M, 12288, F.G, (int)blockIdx.x); pg8::EpiHeadNorm E{qkvb, 12288, rstd, args.in[14], args.in[15], QS_HD, 16, 16, (PG8_LAS float*)(F.lds + NA_TB_OFF), nullptr, nullptr, SEQ};
        pg8::gemm_phase<pg8::EpiHeadNorm, pg8::StaticOrder, true, true>(F.lds, g, S, E);
    }
    SEAM(12);
    if (IN(14)) {
        const float* rpb = args.in[16];
        WAT_LAS char* L = (WAT_LAS char*)F.lds;
        WAT_LAS float* tb = (WAT_LAS float*)(L + NA_TB_OFF);
        const int NU = BATCH * NA_H * GRID_ROWS;
        const int u0 = (int)(((long)NU * blockIdx.x) / F.G), u1 = (int)(((long)NU * (blockIdx.x + 1)) / F.G);
        const int row16 = F.tid >> 4, ch16 = F.tid & 15, kso = wat::kst_off(row16, ch16), vso = wat::vst_off(row16, ch16);
        const int w = F.wave, q = lane & 15, g4 = lane >> 4;
        const int cg = w & 3, kc0 = min(max(16 * cg - 8, 0), 32), gc = 16 * cg + q, cs = min(max(gc - 8, 0), 48);
        unsigned vmask = 0;
#pragma unroll
        for (int j = 0; j < 8; ++j) { const int kc = kc0 + 8 * g4 + j; if (kc >= cs && kc < cs + 16) vmask |= 1u << j; }
        const int bcol = kc0 + 8 * g4 - gc + 15;
        v4u st[8]; int cur_h = -1;
#define NA_GEOM(u_, s_) const int bh_ = (u_) >> 7, i_ = (u_) & 127, b_ = bh_ >> 5, h_ = bh_ & 31, rs_ = min(max(i_ - 4, 0), GRID_ROWS - 8); \
        const bf16* src_ = qkvb + (size_t)(b_ * SEQ + (rs_ + 4 * ((s_) & 1)) * GRID_W + row16) * 12288 + ((s_) < 2 ? 4096 : 8192) + h_ * HD + ch16 * 8;
#define NA_LOAD(u_, s_) do { NA_GEOM(u_, s_) _Pragma("unroll") for (int k = 0; k < 8; ++k) st[k] = *(const v4u*)(src_ + (size_t)k * 32 * 12288); } while (0)
#define NA_WRITE(s_) do { WAT_LAS char* d_ = L + ((s_) & 1) * 65536 + ((s_) < 2 ? kso : vso); _Pragma("unroll") for (int k = 0; k < 8; ++k) *(WAT_LAS v4u*)(d_ + k * 32 * 256) = st[k]; } while (0)
#define NA_END(un_, sn_, un2_, sn2_) do { if ((un_) < u1) { VM_WAIT(); NA_WRITE(sn_); } __syncthreads(); if ((un2_) < u1) NA_LOAD(un2_, sn2_); } while (0)
        if (u0 < u1) { NA_LOAD(u0, 0); VM_WAIT(); NA_WRITE(0); __syncthreads(); NA_LOAD(u0, 1); }
        for (int u = u0; u < u1; ++u) {
            const int bh = u >> 7, gi = u & 127, b = bh >> 5, h = bh & 31, rs0 = min(max(gi - 4, 0), GRID_ROWS - 8);
            wat::bf16x8 qf[4]; wat::f32x4 sc[8][2]; wat::bf16x8 pf[8]; wat::f32x4 o[8]; float linv = 0.f;
            if (h != cur_h) { for (int t = F.tid; t < 465; t += NWAVES * 64) tb[t] = rpb[(size_t)h * 465 + t] * LOG2E; cur_h = h; }
            if (w < 4) {
                const bf16* qp = qkvb + (size_t)(b * SEQ + gi * GRID_W + gc) * 12288 + h * HD + 8 * g4;
#pragma unroll
                for (int s = 0; s < 4; ++s) qf[s] = *(const wat::bf16x8*)(qp + 32 * s);
#pragma unroll
                for (int g = 0; g < 4; ++g) wat::qk_group(sc[g][0], sc[g][1], L, g * 64 + kc0, qf, lane);
            }
            NA_END(u, 1, u, 2);
            if (w < 4) {
#pragma unroll
                for (int g = 0; g < 4; ++g) wat::qk_group(sc[4 + g][0], sc[4 + g][1], L + 65536, g * 64 + kc0, qf, lane);
                float m = -1e30f;
#pragma unroll
                for (int kr = 0; kr < 8; ++kr) { const WAT_LAS float* tr_ = tb + (rs0 + kr - gi + NA_ROWS - 1) * 31 + bcol;
#pragma unroll
                    for (int j = 0; j < 8; ++j) { const bool ok = (vmask >> j) & 1u; const float bias = ok ? tr_[j] : 0.f; const float v = ok ? sc[kr][j >> 2][j & 3] + bias : -1e30f; sc[kr][j >> 2][j & 3] = v; m = fmaxf(m, v); } }
                m = fmaxf(m, __shfl_xor(m, 16)); m = fmaxf(m, __shfl_xor(m, 32));
                float l = 0.f;
#pragma unroll
                for (int kr = 0; kr < 8; ++kr) {
#pragma unroll
                    for (int j = 0; j < 8; ++j) { const float v = ((vmask >> j) & 1u) ? __builtin_amdgcn_exp2f(sc[kr][j >> 2][j & 3] - m) : 0.f; sc[kr][j >> 2][j & 3] = v; l += v; }
                    pf[kr] = wat::p_frag(sc[kr][0], sc[kr][1]); }
                l += __shfl_xor(l, 16); l += __shfl_xor(l, 32); linv = 1.0f / l;
#pragma unroll
                for (int c = 0; c < 8; ++c) o[c] = wat::f32x4{0.f, 0.f, 0.f, 0.f};
            }
            NA_END(u, 2, u, 3);
            if (w < 4) {
                { const unsigned vb = (unsigned)(uintptr_t)L + (unsigned)wat::vrd_base(kc0, lane); wat::pv_group<0>(o, vb, pf[0]); wat::pv_group<16384>(o, vb, pf[1]); wat::pv_group<32768>(o, vb, pf[2]); wat::pv_group<49152>(o, vb, pf[3]); }
            }
            NA_END(u, 3, u + 1, 0);
            if (w < 4) {
                { const unsigned vb = (unsigned)(uintptr_t)(L + 65536) + (unsigned)wat::vrd_base(kc0, lane); wat::pv_group<0>(o, vb, pf[4]); wat::pv_group<16384>(o, vb, pf[5]); wat::pv_group<32768>(o, vb, pf[6]); wat::pv_group<49152>(o, vb, pf[7]); }
                WAT_LAS char* ost = L + NA_OST_OFF + w * 4352;
#pragma unroll
                for (int r = 0; r < 4; ++r) { const float li = __shfl(linv, 4 * g4 + r);
#pragma unroll
                    for (int c = 0; c < 8; ++c) *(WAT_LAS unsigned short*)(ost + (4 * g4 + r) * 272 + (16 * c + q) * 2) = (unsigned short)(wat::cvtpk(o[c][r] * li, 0.f) & 0xffffu); }
                asm volatile("s_waitcnt lgkmcnt(0)" ::: "memory");
#pragma unroll
                for (int k = 0; k < 4; ++k) { const int rq = g4 + 4 * k; const v4u v = *(const WAT_LAS v4u*)(ost + rq * 272 + q * 16);
                    *(v4u*)(ob + (size_t)(b * SEQ + gi * GRID_W + 16 * cg + rq) * DM + h * HD + q * 8) = v; }
            }
            NA_END(u + 1, 0, u + 1, 1);
        }
#undef NA_GEOM
#undef NA_LOAD
#undef NA_WRITE
#undef NA_END
    }
    SEAM(14);
    if (IN(15)) {
        pg8::Gemm g{ob, Woout_t, M, DM, DM, DM}; pg8::StaticOrder S; S.init(M, DM, F.G, (int)blockIdx.x); pg8::EpiResidT<1> E{nullptr, out, xb, xl0, xl1, ss, DM};
        pg8::gemm_phase<pg8::EpiResidT<1>, pg8::StaticOrder, true, true>(F.lds, g, S, E);
    }
    SEAM(15);
    if (IN(17)) { RSTD_LOCAL(); FFN_GATEUP(1); }
    SEAM(17);
#if MK_CHECK
    if (IN(18)) FFN_FIX(1);
    if (IN(19)) FFN_DOWN(1);
#else
    if (IN(19)) { FFN_FIX(1); FFN_DOWN(1); }
#endif
#undef IN
#undef SEAM
}

#if MK_CHECK
constexpr size_t WS_CHK = 9 * MiB;
constexpr int NS = 32;
__device__ const int g_rows[16] = {0, 1, 63, 64, 65, 127, 128, 4095, 4096, 8190, 8191, 8192, 8193, 8255, 16382, 16383};
__device__ __forceinline__ int srow(int i) { return i < 16 ? g_rows[i] : (int)(((unsigned)i * 2654435761u >> 9) % (unsigned)M); }
__device__ __forceinline__ int scol(int j, int N) { return j == 0 ? 0 : (j == 1 ? N - 1 : (int)(((unsigned)j * 2246822519u + 12345u) % (unsigned)N)); }
__device__ __forceinline__ float bf2f(bf16 b) { return __uint_as_float((unsigned)b << 16); }
__device__ __forceinline__ void chk_rec(unsigned* w, int c, float got, float ref, float scale) {
    float e = fabsf(got - ref) / (0.03f * (fabsf(ref) + scale)); if (!(e == e) || !(e < 1e30f)) e = 1e30f;
    atomicMax(&w[c], __float_as_uint(e));
}
__device__ __forceinline__ float dot_bf(const bf16* a, const bf16* b, int K) { float s = 0.f; for (int k = 0; k < K; ++k) s += bf2f(a[k]) * bf2f(b[k]); return s; }
__global__ void k_chk_gemm(const bf16* A, int lda, const bf16* Bt, int K, int N, const float* rs, const float* base, int base_ld, int base_by_sample,
                           const bf16* got_b, const float* got_f, int ldo, unsigned* w, int c, float scale) {
    const int i = blockIdx.x, j = threadIdx.x, row = srow(i), col = scol(j, N);
    float ref = dot_bf(A + (size_t)row * lda, Bt + (size_t)col * K, K); if (rs) ref *= rs[row];
    if (base) ref += base_by_sample == 2 ? bf2f(((const bf16*)base)[(size_t)i * base_ld + col]) : base[(size_t)(base_by_sample ? i : row) * base_ld + col];
    const float got = got_b ? bf2f(got_b[(size_t)row * ldo + col]) : got_f[(size_t)row * ldo + col];
    chk_rec(w, c, got, ref, scale);
}
__global__ void k_chk_copy(const unsigned char* src, size_t row_bytes, unsigned char* dst) {
    const int i = blockIdx.x, row = srow(i); for (size_t b = threadIdx.x * 4; b < row_bytes; b += blockDim.x * 4) *(unsigned*)(dst + (size_t)i * row_bytes + b) = *(const unsigned*)(src + (size_t)row * row_bytes + b);
}
__global__ void k_chk_rstd(const float* src, const float* rstd, const bf16* xb, unsigned* w, int c) {
    const int i = blockIdx.x * blockDim.x + threadIdx.x; if (i >= NS) return; const int row = srow(i); float s = 0.f;
    for (int k = 0; k < DM; ++k) { const float v = src[(size_t)row * DM + k]; s += v * v; }
    chk_rec(w, c, rstd[row], 1.0f / sqrtf(s / DM + NORM_EPS), 0.f);
    if (xb) for (int k = 0; k < DM; k += 97) chk_rec(w, c, bf2f(xb[(size_t)row * DM + k]), src[(size_t)row * DM + k], 0.01f);
}
__global__ void k_chk_w(const float* W, int K, int N, const bf16* dst, const float* gain, int mode, unsigned* w, int c) {
    const unsigned t = blockIdx.x * blockDim.x + threadIdx.x; const int k = (int)((t * 2654435761u >> 7) % (unsigned)K), n = scol((int)t, N);
    const int dr = (mode == 1) ? (n >= 1472 ? n - 1472 : n + 9216) : (mode >= 2 ? (n >> 7) * 256 + (n & 127) + (mode == 3 ? 128 : 0) : n); float ref = W[(size_t)k * N + n]; if (gain) ref *= gain[k];
    chk_rec(w, c, bf2f(dst[(size_t)dr * K + k]), ref, 1e-4f);
}
__global__ void k_chk_rope(const float* cosT, const float* sinT, int half, double c1, unsigned* w, int c) {
    const int t = blockIdx.x * blockDim.x + threadIdx.x; const int k = t % half; int pos = 1 + (int)(((unsigned)t * 2654435761u >> 8) % (unsigned)(SEQ - 1));
    double p = 1.0; for (int j = 0; j < k; ++j) p *= c1; const double th = (double)(float)p;
    double sn = 0, cs = 0, term = 1.0; for (int n = 0; n < 24; ++n) { if (n & 1) sn += ((n >> 1) & 1 ? -term : term); else cs += ((n >> 1) & 1 ? -term : term); term *= th / (n + 1); }
    chk_rec(w, c, cosT[1 * half + k], (float)cs, 0.02f); chk_rec(w, c, sinT[1 * half + k], (float)sn, 0.02f);
    chk_rec(w, c, cosT[k], 1.f, 0.02f); chk_rec(w, c, sinT[k], 0.f, 0.02f);
    const float ca = cosT[(pos - 1) * half + k], sa = sinT[(pos - 1) * half + k], c1f = cosT[half + k], s1f = sinT[half + k];
    chk_rec(w, c, cosT[pos * half + k], ca * c1f - sa * s1f, 0.03f); chk_rec(w, c, sinT[pos * half + k], sa * c1f + ca * s1f, 0.03f);
}
__global__ void k_chk_p2(const bf16* zc, const bf16* z, const bf16* cqn, const bf16* ckvn, const float* dqn, const float* dkn, const float* cosA, const float* sinA, unsigned* w, int c) {
    const int i = blockIdx.x, t = threadIdx.x, row = srow(i), pos = row & (SEQ - 1); const bf16* src = zc + (size_t)i * ZLD;
    if (false) { const bf16* p = src + t * HD; float s = 0.f; for (int d = 0; d < HD; ++d) s += bf2f(p[d]) * bf2f(p[d]);
        const float rs = 1.0f / sqrtf(s / HD + NORM_EPS); const float* g = t < 24 ? dqn : dkn; const float qs = t < 24 ? QS_HD : 1.f;
        for (int d = 0; d < HD; ++d) { float y = bf2f(p[d]) * rs * g[d];
            if (d < 16) y = y * cosA[pos * 16 + d] - bf2f(p[d + 16]) * rs * g[d + 16] * sinA[pos * 16 + d];
            else if (d < 32) y = y * cosA[pos * 16 + d - 16] + bf2f(p[d - 16]) * rs * g[d - 16] * sinA[pos * 16 + d - 16];
            chk_rec(w, c, bf2f(z[(size_t)row * ZLD + t * HD + d]), y * qs, 0.05f * qs); } }
    else if (t == 48) { float s = 0.f; for (int d = 0; d < QRANK; ++d) s += bf2f(src[Z_CQ + d]) * bf2f(src[Z_CQ + d]); const float rs = 1.0f / sqrtf(s / QRANK + NORM_EPS);
        for (int d = 0; d < QRANK; ++d) chk_rec(w, c, bf2f(cqn[(size_t)row * QRANK + d]), bf2f(src[Z_CQ + d]) * rs, 0.05f); }
    else if (t == 49) { float s = 0.f; for (int d = 0; d < KVRANK; ++d) s += bf2f(src[Z_CKV + d]) * bf2f(src[Z_CKV + d]); const float rs = 1.0f / sqrtf(s / KVRANK + NORM_EPS);
        for (int d = 0; d < KVRANK; ++d) chk_rec(w, c, bf2f(ckvn[(size_t)row * KVRANK + d]), bf2f(src[Z_CKV + d]) * rs, 0.05f); }
}
__global__ void k_chk_p4(const bf16* qc, bf16* qn_out, const bf16* kv, const bf16* z, const bf16* kout, const float* qn, const float* kn, const float* cosB, const float* sinB, unsigned* w, int c) {
    const int i = blockIdx.x, t = threadIdx.x, row = srow(i), pos = row & (SEQ - 1), h = t & 15; const bool isk = t >= 16;
    float s = 0.f;
    for (int d = 0; d < MLA_QK; ++d) { const float v = isk ? (d < 128 ? bf2f(kv[(size_t)row * 4096 + h * 256 + d]) : bf2f(z[(size_t)row * ZLD + Z_KPE + d - 128])) : bf2f(qc[(size_t)i * 3072 + h * MLA_QK + d]); s += v * v; }
    const float rs = 1.0f / sqrtf(s / MLA_QK + NORM_EPS); const float* g = isk ? kn : qn; const float qs = isk ? 1.f : QS_MLA;
    for (int d = 0; d < MLA_QK; ++d) {
        auto val = [&](int dd) { return (isk ? (dd < 128 ? bf2f(kv[(size_t)row * 4096 + h * 256 + dd]) : bf2f(z[(size_t)row * ZLD + Z_KPE + dd - 128])) : bf2f(qc[(size_t)i * 3072 + h * MLA_QK + dd])) * rs * g[dd]; };
        float y = val(d);
        if (d >= 128 && d < 160) y = y * cosB[pos * 32 + d - 128] - val(d + 32) * sinB[pos * 32 + d - 128];
        else if (d >= 160) y = y * cosB[pos * 32 + d - 160] + val(d - 32) * sinB[pos * 32 + d - 160];
        if (!isk) { qn_out[(size_t)i * 3072 + h * MLA_QK + d] = (bf16)f2bf(y * qs); continue; }
        chk_rec(w, c, bf2f(kout[(size_t)row * 3072 + h * MLA_QK + d]), y * qs, 0.05f * qs); }
}
__global__ void k_chk_mla(const bf16* q, const bf16* k, const bf16* kv, const bf16* omix, unsigned* w, int c) {
    const int i = blockIdx.x, t = threadIdx.x, row = srow(i), b0 = row & ~(SEQ - 1), h = (i * 7 + 3) & 15, d = (t * 37 + i) & 127;
    const bf16* qp = q + (size_t)i * 3072 + h * MLA_QK; float m = -1e30f;
    for (int key = 0; key < SEQ; ++key) m = fmaxf(m, dot_bf(qp, k + (size_t)(b0 + key) * 3072 + h * MLA_QK, MLA_QK));
    float l = 0.f, o = 0.f, o2 = 0.f;
    for (int key = 0; key < SEQ; ++key) { const float p = exp2f(dot_bf(qp, k + (size_t)(b0 + key) * 3072 + h * MLA_QK, MLA_QK) - m); const float v = bf2f(kv[(size_t)(b0 + key) * 4096 + h * 256 + 128 + d]); l += p; o += p * v; o2 += p * v * v; }
    chk_rec(w, c, bf2f(omix[(size_t)row * 3072 + h * HD + d]), o / l, 0.5f * sqrtf(o2 / l) * 0.1f + 1e-3f);
}
__global__ void k_chk_dil(const bf16* z, const bf16* omix, unsigned* w, int c) {
    const int i = blockIdx.x, t = threadIdx.x, row = srow(i), b0 = row & ~(SEQ - 1), pos = row & (SEQ - 1), j = (i * 5 + 1) & 7, d = (t * 37 + i) & 127;
    float m = -1e30f;
    for (int g = 0; g < 3; ++g) { const int dl = 1 << (2 * g), head = 8 * g + j; for (int tt = -64; tt <= 64; ++tt) { const int kp = pos + dl * tt; if (kp < 0 || kp >= SEQ) continue;
        m = fmaxf(m, dot_bf(z + (size_t)row * ZLD + head * HD, z + (size_t)(b0 + kp) * ZLD + 3072 + head * HD, HD)); } }
    float l = 0.f, o = 0.f;
    for (int g = 0; g < 3; ++g) { const int dl = 1 << (2 * g), head = 8 * g + j; for (int tt = -64; tt <= 64; ++tt) { const int kp = pos + dl * tt; if (kp < 0 || kp >= SEQ) continue;
        const float p = exp2f(dot_bf(z + (size_t)row * ZLD + head * HD, z + (size_t)(b0 + kp) * ZLD + 3072 + head * HD, HD) - m); l += p; o += p * bf2f(z[(size_t)(b0 + kp) * ZLD + 6144 + head * HD + d]); } }
    chk_rec(w, c, bf2f(omix[(size_t)row * 3072 + 2048 + j * HD + d]), o / l, 0.02f);
}
__global__ void k_chk_na(const bf16* qkv, const float* rpb, const bf16* ob, unsigned* w, int c) {
    const int i = blockIdx.x, t = threadIdx.x, row = srow(i), b0 = row & ~(SEQ - 1), pos = row & (SEQ - 1), gi = pos >> 6, gc = pos & 63, h = (i * 11 + 5) & 31, d = (t * 37 + i) & 127;
    const int rs0 = min(max(gi - 4, 0), GRID_ROWS - 8), cs0 = min(max(gc - 8, 0), 48); float m = -1e30f;
    for (int kr = 0; kr < 8; ++kr) for (int kc = 0; kc < 16; ++kc) { const int key = b0 + (rs0 + kr) * 64 + cs0 + kc;
        m = fmaxf(m, dot_bf(qkv + (size_t)row * 12288 + h * HD, qkv + (size_t)key * 12288 + 4096 + h * HD, HD) + rpb[(size_t)h * 465 + (rs0 + kr - gi + 7) * 31 + (cs0 + kc - gc + 15)] * LOG2E); }
    float l = 0.f, o = 0.f;
    for (int kr = 0; kr < 8; ++kr) for (int kc = 0; kc < 16; ++kc) { const int key = b0 + (rs0 + kr) * 64 + cs0 + kc;
        const float p = exp2f(dot_bf(qkv + (size_t)row * 12288 + h * HD, qkv + (size_t)key * 12288 + 4096 + h * HD, HD) + rpb[(size_t)h * 465 + (rs0 + kr - gi + 7) * 31 + (cs0 + kc - gc + 15)] * LOG2E - m);
        l += p; o += p * bf2f(qkv[(size_t)key * 12288 + 8192 + h * HD + d]); }
    chk_rec(w, c, bf2f(ob[(size_t)row * DM + h * HD + d]), o / l, 0.03f);
}
__global__ void k_chk_p13(const bf16* qc, const bf16* qkv, const float* qn, const float* kn, unsigned* w, int c) {
    const int i = blockIdx.x, t = threadIdx.x, row = srow(i); const bf16* p = qc + (size_t)i * 12288 + t * HD; float s = 0.f;
    for (int d = 0; d < HD; ++d) s += bf2f(p[d]) * bf2f(p[d]);
    const float rs = 1.0f / sqrtf(s / HD + NORM_EPS); const float* g = t < 32 ? qn : kn; const float qs = t < 32 ? QS_HD : 1.f;
    for (int d = 0; d < HD; ++d) chk_rec(w, c, bf2f(qkv[(size_t)row * 12288 + t * HD + d]), bf2f(p[d]) * rs * g[d] * qs, 0.05f * qs);
}
__global__ void k_chk_qkvn(const bf16* xb, const bf16* Wt, const float* rstd, const bf16* qkv, const float* qn, const float* kn, unsigned* w, int c) {
    const int i = blockIdx.x, t = threadIdx.x, row = srow(i), head = (t * 7 + i) % 96, d = (t * 37 + i * 5) & 127; float s = 0.f, mine = 0.f;
    for (int dd = 0; dd < HD; ++dd) { const float v = dot_bf(xb + (size_t)row * DM, Wt + (size_t)(head * HD + dd) * DM, DM) * rstd[row]; s += v * v; if (dd == d) mine = v; }
    float ref = mine; if (head < 64) { const float rs = 1.0f / sqrtf(s / HD + NORM_EPS); ref = mine * rs * (head < 32 ? qn[d] * QS_HD : kn[d]); }
    chk_rec(w, c, bf2f(qkv[(size_t)row * 12288 + head * HD + d]), ref, head < 32 ? 0.05f * QS_HD : 0.05f);
}
__global__ void k_chk_zn(const bf16* xb, const bf16* Wt, const float* rstd, const bf16* z, const float* dqn, const float* dkn, const float* cosA, const float* sinA, unsigned* w, int c) {
    const int i = blockIdx.x, t = threadIdx.x, row = srow(i), pos = row & (SEQ - 1);
    if (t < 48) { const int d = (t * 37 + i * 5) & 127; const int dp = d < 16 ? d + 16 : (d < 32 ? d - 16 : d); float s = 0.f, mine = 0.f, other = 0.f;
        for (int dd = 0; dd < HD; ++dd) { const float v = dot_bf(xb + (size_t)row * DM, Wt + (size_t)(t * HD + dd) * DM, DM) * rstd[row]; s += v * v; if (dd == d) mine = v; if (dd == dp) other = v; }
        const float rs = 1.0f / sqrtf(s / HD + NORM_EPS); const float* g = t < 24 ? dqn : dkn; const float qs = t < 24 ? QS_HD : 1.f;
        float y = mine * rs * g[d]; const float yo = other * rs * g[dp];
        if (d < 16) y = y * cosA[pos * 16 + d] - yo * sinA[pos * 16 + d]; else if (d < 32) y = y * cosA[pos * 16 + d - 16] + yo * sinA[pos * 16 + d - 16];
        chk_rec(w, c, bf2f(z[(size_t)row * ZLD + t * HD + d]), y * qs, 0.05f * qs); }
    else { const int col = 6144 + scol(t, 10688 - 6144); const float ref = dot_bf(xb + (size_t)row * DM, Wt + (size_t)col * DM, DM) * rstd[row]; chk_rec(w, c, bf2f(z[(size_t)row * ZLD + col]), ref, 0.05f); }
}
__global__ void k_chk_up(const bf16* xb, const bf16* Wgu, const float* rstd, const float* cw, const float* cb, const bf16* h2, unsigned* w, int c) {
    const int i = blockIdx.x, j = threadIdx.x, col = scol(j, DFF); int row = srow(i); if (i & 1) row = (row & ~255) + ((i & 2) ? 255 : 0) + ((i & 4) ? ((i & 2) ? -1 : 1) : 0);
    const int cls = i < 16 ? 42 + i : 58 + (i & 1);
    const int t = row & (SEQ - 1); const bf16* wg = Wgu + (size_t)((col >> 7) * 256 + (col & 127)) * DM; const bf16* wu = wg + (size_t)128 * DM;
    const bool edge = (row & 255) == 0 || (row & 255) == 255;
    auto rd = [&](float v) { return edge ? __uint_as_float(f2bf(v) << 16) : v; };
    const float up = rd(dot_bf(xb + (size_t)row * DM, wu, DM) * rstd[row]);
    float g = cb[col] + cw[DFF + col] * rd(dot_bf(xb + (size_t)row * DM, wg, DM) * rstd[row]);
    if (t > 0) g += cw[col] * rd(dot_bf(xb + (size_t)(row - 1) * DM, wg, DM) * rstd[row - 1]); if (t < SEQ - 1) g += cw[2 * DFF + col] * rd(dot_bf(xb + (size_t)(row + 1) * DM, wg, DM) * rstd[row + 1]);
    const float ref = g / (1.0f + expf(-g)) * up;
    chk_rec(w, cls, bf2f(h2[(size_t)row * DFF + col]), ref, 0.05f);
}
__global__ void k_chk_rq(const bf16* z, const float* rq, const float* rkv, unsigned* w, int c) {
    const int i = blockIdx.x * blockDim.x + threadIdx.x; if (i >= NS) return; const int row = srow(i); const bf16* src = z + (size_t)row * ZLD; float s = 0.f, t = 0.f;
    for (int d = 0; d < QRANK; ++d) s += bf2f(src[Z_CQ + d]) * bf2f(src[Z_CQ + d]);
    for (int d = 0; d < KVRANK; ++d) t += bf2f(src[Z_CKV + d]) * bf2f(src[Z_CKV + d]);
    chk_rec(w, c, rq[row], 1.0f / sqrtf(s / QRANK + NORM_EPS), 0.f); chk_rec(w, c, rkv[row], 1.0f / sqrtf(t / KVRANK + NORM_EPS), 0.f);
}
__global__ void k_chk_final(unsigned* w, float* out) {
    if (threadIdx.x != 0 || blockIdx.x != 0) return;
    for (int c = 0; c < 64; ++c) { const float e = __uint_as_float(w[c]); if (e > 1.0f) { int b = 0; float x = e; while (x >= 10.f && b < 20) { x *= 0.1f; ++b; } float V = (float)(10 + c) * 100.f; for (int q = 0; q < b; ++q) V *= 10.f; out[0] = V; return; } }
}
#endif
#ifndef MK_ONE_LAUNCH
#define MK_ONE_LAUNCH 1
#endif
extern "C" void kernel_launch(void* const* d_in, const int* in_sizes, int n_in, void* d_out, int out_size, void* d_ws, size_t ws_size, hipStream_t stream) {
    static int grid = 0;
    if (grid == 0) {
        const long long want[24] = {(long long)M * DM, DM, (long long)DM * EVEN_IN, QRANK, KVRANK, (long long)QRANK * 3072, (long long)KVRANK * 4096, MLA_QK, MLA_QK, HD, HD, (long long)EVEN_MIX * DM,
                                    DM, (long long)DM * 12288, HD, HD, (long long)NA_H * 15 * 31, (long long)DM * DM, 2 * DM, 2LL * DM * DFF, 2LL * DM * DFF, 2 * 3 * DFF, 2 * DFF, 2LL * DFF * DM};
        bool sizes_ok = n_in == 24; for (int i = 0; sizes_ok && i < 24; ++i) if ((long long)in_sizes[i] != want[i]) { fprintf(stderr, "kernel_launch: input %d has %d elements, expected %lld\n", i, in_sizes[i], want[i]); sizes_ok = false; }
        if (!sizes_ok || out_size != M * DM || ws_size < WS_END) { fprintf(stderr, "kernel_launch: unexpected shapes: n_in %d in0 %d out %d ws %zu (need %zu)\n", n_in, n_in > 0 ? in_sizes[0] : -1, out_size, ws_size, (size_t)WS_END); grid = -1; return; }
        int dev = 0, cus = 0, per_cu = 0;
        if (hipGetDevice(&dev) != hipSuccess || hipDeviceGetAttribute(&cus, hipDeviceAttributeMultiprocessorCount, dev) != hipSuccess) { grid = -1; return; }
        if (hipFuncSetAttribute((const void*)mk_fwd, hipFuncAttributeMaxDynamicSharedMemorySize, LDS_BYTES) != hipSuccess) { fprintf(stderr, "kernel_launch: hipFuncSetAttribute failed\n"); grid = -1; return; }
        if (hipOccupancyMaxActiveBlocksPerMultiprocessor(&per_cu, (const void*)mk_fwd, NWAVES * 64, LDS_BYTES) != hipSuccess || per_cu < 1) fprintf(stderr, "kernel_launch: occupancy query reports %d\n", per_cu);
        (void)hipGetLastError();
        grid = cus;
    }
    if (grid < 0) return;
    if (hipMemsetAsync((char*)d_ws + WS_CTL, 0, CTL_ZERO_BYTES, stream) != hipSuccess) return;
    Args a{};
    for (int i = 0; i < 24; ++i) a.in[i] = (const float*)d_in[i];
    a.out = (float*)d_out; a.ws = (unsigned char*)d_ws;
#if MK_ONE_LAUNCH
    a.ph_lo = 0; a.ph_hi = N_PHASES;
    hipLaunchKernelGGL(mk_fwd, dim3(grid), dim3(NWAVES * 64), LDS_BYTES, stream, a);
#else
#if MK_CHECK
    unsigned char* ws = (unsigned char*)d_ws; unsigned* cw = (unsigned*)(ws + WS_CHK); (void)hipMemsetAsync(cw, 0, 256, stream);
    bf16* cp_z = (bf16*)(ws + WS_CHK + 1 * MiB); bf16* cp_q = (bf16*)(ws + WS_CHK + 2 * MiB); float* cp_out = (float*)(ws + WS_CHK + 3 * MiB); bf16* cp_qkv = (bf16*)(ws + WS_CHK + 4 * MiB); bf16* cp_qn = (bf16*)(ws + WS_CHK + 5 * MiB);
    float* cosA = (float*)(ws + WS_ROPE); float* sinA = cosA + SEQ * 16; float* cosB = sinA + SEQ * 16; float* sinB = cosB + SEQ * 32;
    float* rstd = (float*)(ws + WS_RSTD); bf16* xb = (bf16*)(ws + WS_XB); unsigned char* R = ws + WS_R;
    bf16* zb = (bf16*)(R + R_Z); bf16* qb = (bf16*)(R + R_Q); bf16* kvb = (bf16*)(R + R_KV); bf16* kb = (bf16*)(R + R_K); bf16* omix = (bf16*)(R + R_OMIX);
    bf16* cqn = (bf16*)(R + R_CQN); bf16* ckvn = (bf16*)(R + R_CKVN); bf16* h2b = (bf16*)(R + R_H2); bf16* qkvb = (bf16*)(R + R_QKV); bf16* ob = (bf16*)(R + R_O);
    bf16* Win_t = (bf16*)(ws + WS_WIN); bf16* Wuq_t = (bf16*)(ws + WS_WUQ); bf16* Wukv_t = (bf16*)(ws + WS_WUKV); bf16* Weout_t = (bf16*)(ws + WS_WEOUT); bf16* Wqkv_t = (bf16*)(ws + WS_WQKV); bf16* Woout_t = (bf16*)(ws + WS_WOOUT);
    float* out = (float*)d_out; const float* const* in = a.in;
    auto WL = [&](int layer, int which) { return (bf16*)(ws + WS_WFFN + (size_t)layer * 3 * FFN_W_BYTES + (size_t)which * FFN_W_BYTES); };
#endif
    for (int p = 0; p < N_PHASES; ++p) {
#if MK_CHECK
        if (p == 2) k_chk_copy<<<NS, 256, 0, stream>>>((const unsigned char*)zb, (size_t)ZLD * 2, (unsigned char*)cp_z);
        if (p == 4) k_chk_copy<<<NS, 256, 0, stream>>>((const unsigned char*)qb, (size_t)3072 * 2, (unsigned char*)cp_q);
        if (p == 10 || p == 15 || p == 19) k_chk_copy<<<NS, 256, 0, stream>>>((const unsigned char*)xb, (size_t)DM * 2, (unsigned char*)cp_out);
#endif
        a.ph_lo = p; a.ph_hi = p + 1; hipLaunchKernelGGL(mk_fwd, dim3(grid), dim3(NWAVES * 64), LDS_BYTES, stream, a);
#if MK_CHECK
        const int c = 2 * p;
        if (p == 0) {
            k_chk_w<<<4, 64, 0, stream>>>(in[2], DM, EVEN_IN, Win_t, in[1], 1, cw, c); k_chk_w<<<4, 64, 0, stream>>>(in[5], QRANK, 3072, Wuq_t, in[3], 0, cw, c); k_chk_w<<<4, 64, 0, stream>>>(in[6], KVRANK, 4096, Wukv_t, in[4], 0, cw, c);
            k_chk_w<<<4, 64, 0, stream>>>(in[11], EVEN_MIX, DM, Weout_t, nullptr, 0, cw, c); k_chk_w<<<4, 64, 0, stream>>>(in[13], DM, 12288, Wqkv_t, in[12], 0, cw, c); k_chk_w<<<4, 64, 0, stream>>>(in[17], DM, DM, Woout_t, nullptr, 0, cw, c);
            for (int l = 0; l < 2; ++l) { k_chk_w<<<4, 64, 0, stream>>>(in[19] + (size_t)l * DM * DFF, DM, DFF, WL(l, 0), in[18] + l * DM, 2, cw, c); k_chk_w<<<4, 64, 0, stream>>>(in[20] + (size_t)l * DM * DFF, DM, DFF, WL(l, 0), in[18] + l * DM, 3, cw, c);
                k_chk_w<<<4, 64, 0, stream>>>(in[23] + (size_t)l * DFF * DM, DFF, DM, WL(l, 2), nullptr, 0, cw, c); }
            k_chk_rstd<<<1, 64, 0, stream>>>(in[0], rstd, xb, cw, c + 1);
            k_chk_rope<<<8, 64, 0, stream>>>(cosA, sinA, 16, 0.44036660267178046, cw, 40); k_chk_rope<<<8, 64, 0, stream>>>(cosB, sinB, 32, 0.6636012376960885, cw, 41);
        }
        if (p == 1) k_chk_zn<<<NS, 64, 0, stream>>>(xb, Win_t, rstd, zb, in[9], in[10], cosA, sinA, cw, c);
        if (p == 3) { k_chk_rq<<<1, 64, 0, stream>>>(zb, rstd + M, rstd + 2 * M, cw, 4);
                      k_chk_gemm<<<NS, 64, 0, stream>>>(zb + Z_CQ, ZLD, Wuq_t, QRANK, 3072, rstd + M, nullptr, 0, 0, qb, nullptr, 3072, cw, c, 0.05f);
                      k_chk_gemm<<<NS, 64, 0, stream>>>(zb + Z_CKV, ZLD, Wukv_t, KVRANK, 4096, rstd + 2 * M, nullptr, 0, 0, kvb, nullptr, 4096, cw, c + 1, 0.05f); }
        if (p == 4) k_chk_p4<<<NS, 32, 0, stream>>>(cp_q, cp_qn, kvb, zb, kb, in[7], in[8], cosB, sinB, cw, c);
        if (p == 5) { k_chk_mla<<<NS, 8, 0, stream>>>(cp_qn, kb, kvb, omix, cw, c); k_chk_dil<<<NS, 8, 0, stream>>>(zb, omix, cw, c + 1); }
        if (p == 6) k_chk_gemm<<<NS, 64, 0, stream>>>(omix, EVEN_MIX, Weout_t, EVEN_MIX, DM, nullptr, in[0], DM, 0, nullptr, out, DM, cw, c, 0.05f);
        if (p == 8 || p == 12 || p == 17) k_chk_rstd<<<1, 64, 0, stream>>>(out, rstd, xb, cw, c + 1);
        if (p == 9 || p == 18) { const int l = p == 9 ? 0 : 1; k_chk_up<<<NS, 64, 0, stream>>>(xb, WL(l, 0), rstd, in[21] + (size_t)l * 3 * DFF, in[22] + (size_t)l * DFF, h2b, cw, c); }
        if (p == 10 || p == 19) k_chk_gemm<<<NS, 64, 0, stream>>>(h2b, DFF, WL(p == 10 ? 0 : 1, 2), DFF, DM, nullptr, cp_out, DM, 2, nullptr, out, DM, cw, c, 0.05f);
        if (p == 12) k_chk_qkvn<<<NS, 64, 0, stream>>>(xb, Wqkv_t, rstd, qkvb, in[14], in[15], cw, c);
        if (p == 14) k_chk_na<<<NS, 8, 0, stream>>>(qkvb, in[16], ob, cw, c);
        if (p == 15) k_chk_gemm<<<NS, 64, 0, stream>>>(ob, DM, Woout_t, DM, DM, nullptr, cp_out, DM, 2, nullptr, out, DM, cw, c, 0.05f);
#endif
    }
#if MK_CHECK
    k_chk_final<<<1, 64, 0, stream>>>(cw, out);
#endif
#endif
    const hipError_t le = hipPeekAtLastError();
    if (le != hipSuccess) fprintf(stderr, "kernel_launch: launch failed: %s\n", hipGetErrorName(le));
}
```

```cpp
#include <hip/hip_runtime.h>
#include <cstdio>
#include <cstdint>
#ifndef MK_CHECK
#define MK_CHECK 0
#endif
namespace pg8 {
#define PG8_LAS __attribute__((address_space(3)))
typedef unsigned short bf16_t;
typedef short bf16x8 __attribute__((ext_vector_type(8)));
typedef float f32x4 __attribute__((ext_vector_type(4)));
typedef unsigned u32x4 __attribute__((ext_vector_type(4)));
typedef unsigned u32x2 __attribute__((ext_vector_type(2)));
constexpr int BM = 256, BK = 64, HALF = 128, HTB = HALF * BK * 2  , STAGE_BYTES = 8 * HTB, NXCD = 8, WGM = 8;

__host__ __device__ __forceinline__ int lds_byte(int r, int c) { const int st = (r >> 4) * 2 + (c >> 5), rr = r & 15, cc = c & 31, ob = rr * 64 + cc * 2; return st * 1024 + (ob ^ (((ob >> 9) & 1) << 5)); }
__host__ __device__ __forceinline__ void stage_rc(int b, int& R, int& C) { const int st = b / 1024, sb = b % 1024, swz = sb ^ (((sb >> 9) & 1) << 5); R = (st >> 1) * 16 + swz / 64; C = (st & 1) * 32 + (swz % 64) / 2; }
__host__ __device__ __forceinline__ int perm32(int rho) { const int n = rho >> 4, i = rho & 15; return 8 * (i >> 2) + 4 * n + (i & 3); }

struct Unit { int pm, pn, kb, kn, role, slot; };
struct Gemm { const bf16_t* A; const bf16_t* Bt; int M, N, K, lda; };

struct StaticOrder {
    int nM, nN, nwg, G, c, ntk; float* scr; unsigned* flg;
    __host__ __device__ void init(int M, int N, int G_, int c_, int ntk_ = 0, float* scr_ = nullptr, unsigned* flg_ = nullptr) { nM = M / BM; nN = N / BM; nwg = nM * nN; G = G_; c = c_; ntk = ntk_; scr = scr_; flg = flg_; }
    __host__ __device__ bool next(int i, Unit& u) const {
        long L = (long)i * G + c; u.kb = 0; u.kn = ntk; u.role = 0; u.slot = 0;
        if (scr != nullptr) { const int full = nwg / G, rem = nwg - full * G;
            if (rem > 0 && 2 * rem <= G && i == full) {
                if (c < rem) { u.role = 1; u.kn = ntk / 2; u.slot = c; }
                else if (c < 2 * rem) { L -= rem; u.role = 2; u.kb = ntk / 2; u.kn = ntk - ntk / 2; u.slot = c - rem; }
                else return false; } }
        if (L >= nwg) return false;
        int wgid = (int)L; { const int q = nwg / NXCD, r = nwg % NXCD, xcd = wgid % NXCD, off = wgid / NXCD; wgid = (xcd < r ? xcd * (q + 1) : r * (q + 1) + (xcd - r) * q) + off; }
        const int nig = WGM * nN, gid = wgid / nig, fm = gid * WGM, gsz = (nM - fm) < WGM ? (nM - fm) : WGM;
        u.pm = fm + ((wgid % nig) % gsz); u.pn = (wgid % nig) / gsz; return true;
    }
    __device__ __forceinline__ void a_ready(const Unit&) const {}
    __device__ __forceinline__ void done(const Unit&) const {}
};

__device__ __forceinline__ unsigned cvt_pk_bf16(float lo, float hi) { unsigned r; asm volatile("v_cvt_pk_bf16_f32 %0, %1, %2" : "=v"(r) : "v"(lo), "v"(hi)); return r; }
__device__ __forceinline__ float bf_lo(unsigned w) { return __uint_as_float(w << 16); }
__device__ __forceinline__ float bf_hi(unsigned w) { return __uint_as_float(w & 0xffff0000u); }

struct EpiScaleBf16 {
    static constexpr bool PERM = true, AFTER_DRAIN = false;
    bf16_t* O; int ldc; const float* rstd;
    __device__ __forceinline__ void operator()(const f32x4 (&acc)[2][2][4][2], const Unit& u, int wr, int wc, int fr, int fq) const {
        const int row0 = u.pm * BM + wr * 64 + fr, col0 = u.pn * BM + wc * 32 + 8 * fq;
#pragma unroll
        for (int ai = 0; ai < 2; ++ai)
#pragma unroll
            for (int m = 0; m < 4; ++m) { const int row = row0 + ai * HALF + m * 16; const float s = rstd ? rstd[row] : 1.f; bf16_t* rowp = O + (size_t)row * ldc + col0;
#pragma unroll
                for (int bj = 0; bj < 2; ++bj) { const f32x4 v0 = acc[ai][bj][m][0] * s, v1 = acc[ai][bj][m][1] * s;
                    u32x4 w; w.x = cvt_pk_bf16(v0[0], v0[1]); w.y = cvt_pk_bf16(v0[2], v0[3]); w.z = cvt_pk_bf16(v1[0], v1[1]); w.w = cvt_pk_bf16(v1[2], v1[3]);
                    *(u32x4*)(rowp + bj * HALF) = w; } }
    }
};
struct EpiHeadNorm {
    static constexpr bool PERM = true, AFTER_DRAIN = false;
    bf16_t* O; int ldc; const float* rstd; const float* qn; const float* kn; float qscale; int ntq, ntk; PG8_LAS float* ex;
    const float* rcos; const float* rsin; int seq;
    float* ssq = nullptr;
    template <int AI, int MM, int BJ> __device__ __forceinline__ void put(unsigned wb, float s) const { asm volatile("ds_write_b32 %0, %1 offset:%2" :: "v"(wb), "v"(s), "i"((AI * 1024 + MM * 128 + BJ * 4) * 4) : "memory"); }
    template <int AI, int MM, int BJ> __device__ __forceinline__ f32x4 get(unsigned rb) const { f32x4 p; asm volatile("ds_read_b128 %0, %1 offset:%2" : "=&v"(p) : "v"(rb), "i"((AI * 1024 + MM * 128 + BJ * 4) * 4) : "memory"); return p; }
    template <int AI, int MM> __device__ __forceinline__ void part(const f32x4 (&acc)[2][2][4][2], unsigned wb, int fq) const {
#pragma unroll
        for (int bj = 0; bj < 2; ++bj) { const f32x4 v0 = acc[AI][bj][MM][0], v1 = acc[AI][bj][MM][1];
            float s = (v0[0] * v0[0] + v0[1] * v0[1]) + (v0[2] * v0[2] + v0[3] * v0[3]) + (v1[0] * v1[0] + v1[1] * v1[1]) + (v1[2] * v1[2] + v1[3] * v1[3]);
            s += __shfl_xor(s, 16); s += __shfl_xor(s, 32);
            if (fq == 0) { if (bj == 0) put<AI, MM, 0>(wb, s); else put<AI, MM, 1>(wb, s); } }
    }
    template <int AI, int MM> __device__ __forceinline__ void fin(const f32x4 (&acc)[2][2][4][2], unsigned rb, int row, int col0, const float* gp, float gs, int wc, int fq) const {
        bf16_t* rowp = O + (size_t)row * ldc + col0; const float rsv = rstd[row], r2 = rsv * rsv;
        const f32x4 g0 = *(const f32x4*)gp * gs, g1 = *(const f32x4*)(gp + 4) * gs;
        const f32x4 pa = get<AI, MM, 0>(rb), pb = get<AI, MM, 1>(rb);
        asm volatile("s_waitcnt lgkmcnt(0)" ::: "memory"); __builtin_amdgcn_sched_barrier(0);
#pragma unroll
        for (int bj = 0; bj < 2; ++bj) { const f32x4 p = bj ? pb : pa;
            const float tot = ((p[0] + p[1]) + (p[2] + p[3])) * r2;
            const float hn = rsv / sqrtf(tot * (1.0f / 128.0f) + 1e-6f);
            f32x4 v0 = acc[AI][bj][MM][0] * hn * g0, v1 = acc[AI][bj][MM][1] * hn * g1;
            if (rcos != nullptr && wc == 0) {
                const int pos = row & (seq - 1); const float* cp = rcos + pos * 16 + 8 * (fq & 1); const float* sp = rsin + pos * 16 + 8 * (fq & 1);
                const f32x4 c0 = *(const f32x4*)cp, c1 = *(const f32x4*)(cp + 4); f32x4 s0 = *(const f32x4*)sp, s1 = *(const f32x4*)(sp + 4);
                if (fq < 2) { s0 = -s0; s1 = -s1; }
                f32x4 p0, p1;
#pragma unroll
                for (int e = 0; e < 4; ++e) { p0[e] = __shfl_xor(v0[e], 32); p1[e] = __shfl_xor(v1[e], 32); }
                v0 = v0 * c0 + p0 * s0; v1 = v1 * c1 + p1 * s1; }
            u32x4 w; w.x = cvt_pk_bf16(v0[0], v0[1]); w.y = cvt_pk_bf16(v0[2], v0[3]); w.z = cvt_pk_bf16(v1[0], v1[1]); w.w = cvt_pk_bf16(v1[2], v1[3]);
            *(u32x4*)(rowp + bj * HALF) = w; }
    }
    __device__ __forceinline__ void operator()(const f32x4 (&acc)[2][2][4][2], const Unit& u, int wr, int wc, int fr, int fq) const {
        const int row0 = u.pm * BM + wr * 64 + fr, col0 = u.pn * BM + wc * 32 + 8 * fq; const int type = u.pn < ntq ? 0 : (u.pn < ntq + ntk ? 1 : 2);
        if (type < 2) {
            const unsigned rb = (unsigned)(uintptr_t)ex + (unsigned)((wr * 64 + fr) * 8 * 4), wb = rb + (unsigned)(wc * 4);
            part<0, 0>(acc, wb, fq); part<0, 1>(acc, wb, fq); part<0, 2>(acc, wb, fq); part<0, 3>(acc, wb, fq); part<1, 0>(acc, wb, fq); part<1, 1>(acc, wb, fq); part<1, 2>(acc, wb, fq); part<1, 3>(acc, wb, fq);
            asm volatile("s_waitcnt lgkmcnt(0)" ::: "memory"); __builtin_amdgcn_s_barrier(); asm volatile("" ::: "memory");
            const float* gp = (type == 0 ? qn : kn) + wc * 32 + 8 * fq; const float gs = type == 0 ? qscale : 1.0f;
            fin<0, 0>(acc, rb, row0, col0, gp, gs, wc, fq); fin<0, 1>(acc, rb, row0 + 16, col0, gp, gs, wc, fq); fin<0, 2>(acc, rb, row0 + 32, col0, gp, gs, wc, fq); fin<0, 3>(acc, rb, row0 + 48, col0, gp, gs, wc, fq);
            fin<1, 0>(acc, rb, row0 + HALF, col0, gp, gs, wc, fq); fin<1, 1>(acc, rb, row0 + HALF + 16, col0, gp, gs, wc, fq); fin<1, 2>(acc, rb, row0 + HALF + 32, col0, gp, gs, wc, fq); fin<1, 3>(acc, rb, row0 + HALF + 48, col0, gp, gs, wc, fq);
        } else {
#pragma unroll
            for (int ai = 0; ai < 2; ++ai)
#pragma unroll
                for (int m = 0; m < 4; ++m) { const int row = row0 + ai * HALF + m * 16; bf16_t* rowp = O + (size_t)row * ldc + col0; const float sc = rstd[row];
#pragma unroll
                    for (int bj = 0; bj < 2; ++bj) { const f32x4 v0 = acc[ai][bj][m][0] * sc, v1 = acc[ai][bj][m][1] * sc;
                        u32x4 w; w.x = cvt_pk_bf16(v0[0], v0[1]); w.y = cvt_pk_bf16(v0[2], v0[3]); w.z = cvt_pk_bf16(v1[0], v1[1]); w.w = cvt_pk_bf16(v1[2], v1[3]);
                        *(u32x4*)(rowp + bj * HALF) = w;
                        if (ssq != nullptr && u.pn >= 36) { float sq = (v0[0] * v0[0] + v0[1] * v0[1]) + (v0[2] * v0[2] + v0[3] * v0[3]) + (v1[0] * v1[0] + v1[1] * v1[1]) + (v1[2] * v1[2] + v1[3] * v1[3]);
                            sq += __shfl_xor(sq, 16); sq += __shfl_xor(sq, 32);
                            if (fq == 0) ssq[(size_t)row * 64 + (u.pn - 36) * 8 + bj * 4 + wc] = sq; } } }
        }
    }
};
#ifndef RESID_LOW
#define RESID_LOW 0
#endif
template <int MODE> struct EpiResidT {
    static constexpr bool PERM = true, AFTER_DRAIN = false;
    const float* basef; float* outf; bf16_t* xb; bf16_t* xl0; bf16_t* xl1; float* ss; int ldc;
    __device__ __forceinline__ void operator()(const f32x4 (&acc)[2][2][4][2], const Unit& u, int wr, int wc, int fr, int fq) const {
        const int row0 = u.pm * BM + wr * 64 + fr, col0 = u.pn * BM + wc * 32 + 8 * fq; bf16_t* xl = u.pm < 32 ? xl0 : xl1;
#pragma unroll
        for (int ai = 0; ai < 2; ++ai)
#pragma unroll
            for (int m = 0; m < 4; ++m) { const int row = row0 + ai * HALF + m * 16; const size_t off = (size_t)row * ldc + col0; float s = 0.f;
#pragma unroll
                for (int bj = 0; bj < 2; ++bj) { f32x4 b0, b1;
                    if constexpr (MODE == 0) { b0 = *(const f32x4*)(basef + off + bj * HALF); b1 = *(const f32x4*)(basef + off + bj * HALF + 4); }
                    else { const u32x4 hb = *(const u32x4*)(xb + off + bj * HALF); u32x4 lb = {0u, 0u, 0u, 0u}; if constexpr (RESID_LOW) lb = *(const u32x4*)(xl + off + bj * HALF);
                        b0[0] = bf_lo(hb.x) + bf_lo(lb.x); b0[1] = bf_hi(hb.x) + bf_hi(lb.x); b0[2] = bf_lo(hb.y) + bf_lo(lb.y); b0[3] = bf_hi(hb.y) + bf_hi(lb.y);
                        b1[0] = bf_lo(hb.z) + bf_lo(lb.z); b1[1] = bf_hi(hb.z) + bf_hi(lb.z); b1[2] = bf_lo(hb.w) + bf_lo(lb.w); b1[3] = bf_hi(hb.w) + bf_hi(lb.w); }
                    const f32x4 v0 = b0 + acc[ai][bj][m][0], v1 = b1 + acc[ai][bj][m][1];
                    if constexpr (MODE == 2 || MK_CHECK) { *(f32x4*)(outf + off + bj * HALF) = v0; *(f32x4*)(outf + off + bj * HALF + 4) = v1; }
                    if constexpr (MODE != 2) {
                        u32x4 w; w.x = cvt_pk_bf16(v0[0], v0[1]); w.y = cvt_pk_bf16(v0[2], v0[3]); w.z = cvt_pk_bf16(v1[0], v1[1]); w.w = cvt_pk_bf16(v1[2], v1[3]);
                        u32x4 l; l.x = cvt_pk_bf16(v0[0] - bf_lo(w.x), v0[1] - bf_hi(w.x)); l.y = cvt_pk_bf16(v0[2] - bf_lo(w.y), v0[3] - bf_hi(w.y));
                                 l.z = cvt_pk_bf16(v1[0] - bf_lo(w.z), v1[1] - bf_hi(w.z)); l.w = cvt_pk_bf16(v1[2] - bf_lo(w.w), v1[3] - bf_hi(w.w));
                        *(u32x4*)(xb + off + bj * HALF) = w; if constexpr (RESID_LOW) *(u32x4*)(xl + off + bj * HALF) = l;
                        s += (v0[0] * v0[0] + v0[1] * v0[1]) + (v0[2] * v0[2] + v0[3] * v0[3]) + (v1[0] * v1[0] + v1[1] * v1[1]) + (v1[2] * v1[2] + v1[3] * v1[3]); } }
                if constexpr (MODE != 2) { s += __shfl_xor(s, 16); s += __shfl_xor(s, 32);
                    if (fq == 0) ss[(size_t)row * 64 + u.pn * 4 + wc] = s; } }
    }
};
struct EpiUpConv {
    static constexpr bool PERM = true, AFTER_DRAIN = false;
    const bf16_t* a; bf16_t* h2; const float* rstd; const float* cw; const float* cb; int ldc; int seq;
    __device__ __forceinline__ void operator()(const f32x4 (&acc)[2][2][4][2], const Unit& u, int wr, int wc, int fr, int fq) const {
        const int row0 = u.pm * BM + wr * 64 + fr, col0 = u.pn * BM + wc * 32 + 8 * fq;
#pragma unroll
        for (int bj = 0; bj < 2; ++bj) { const int c = col0 + bj * HALF;
            float w0[8], w1[8], w2[8], b[8];
#pragma unroll
            for (int h = 0; h < 2; ++h) { const f32x4 t0 = *(const f32x4*)(cw + c + 4 * h), t1 = *(const f32x4*)(cw + ldc + c + 4 * h), t2 = *(const f32x4*)(cw + 2 * ldc + c + 4 * h), t3 = *(const f32x4*)(cb + c + 4 * h);
#pragma unroll
                for (int j = 0; j < 4; ++j) { w0[4 * h + j] = t0[j]; w1[4 * h + j] = t1[j]; w2[4 * h + j] = t2[j]; b[4 * h + j] = t3[j]; } }
#pragma unroll
            for (int ai = 0; ai < 2; ++ai)
#pragma unroll
                for (int m = 0; m < 4; ++m) { const int row = row0 + ai * HALF + m * 16; const int t = row & (seq - 1); const float s = rstd[row];
                    const bf16_t* ap = a + (size_t)row * ldc + c;
                    const u32x4 z4 = {0u, 0u, 0u, 0u};
                    const u32x4 a0 = *(const u32x4*)ap; const u32x4 am = t > 0 ? *(const u32x4*)(ap - ldc) : z4; const u32x4 an = t < seq - 1 ? *(const u32x4*)(ap + ldc) : z4;
                    float hv[8];
#pragma unroll
                    for (int j = 0; j < 8; ++j) { const unsigned wm = am[j >> 1], wz = a0[j >> 1], wn = an[j >> 1];
                        const float fm = (j & 1) ? bf_hi(wm) : bf_lo(wm), fz = (j & 1) ? bf_hi(wz) : bf_lo(wz), fn = (j & 1) ? bf_hi(wn) : bf_lo(wn);
                        const float g = w0[j] * fm + w1[j] * fz + w2[j] * fn + b[j];
                        const float e = __builtin_amdgcn_exp2f(-1.4426950408889634f * g);
                        const float sg = g * __builtin_amdgcn_rcpf(1.0f + e);
                        const float up = (j < 4 ? acc[ai][bj][m][0][j & 3] : acc[ai][bj][m][1][j & 3]) * s;
                        hv[j] = sg * up; }
                    u32x4 w; w.x = cvt_pk_bf16(hv[0], hv[1]); w.y = cvt_pk_bf16(hv[2], hv[3]); w.z = cvt_pk_bf16(hv[4], hv[5]); w.w = cvt_pk_bf16(hv[6], hv[7]);
                    *(u32x4*)(h2 + (size_t)row * ldc + c) = w; } }
    }
};
template <int CTRL> __device__ __forceinline__ float dpp_rot(float v) { return __builtin_bit_cast(float, __builtin_amdgcn_update_dpp(0, __builtin_bit_cast(int, v), CTRL, 0xF, 0xF, false)); }
struct EpiGateUp {
    static constexpr bool PERM = true, AFTER_DRAIN = false;
    bf16_t* h2; const float* rstd; const float* cw; const float* cb; int ldc; bf16_t* aedge; bf16_t* uedge; PG8_LAS float* ex;
    __device__ __forceinline__ void operator()(const f32x4 (&acc)[2][2][4][2], const Unit& u, int wr, int wc, int fr, int fq) const {
        const int row0 = u.pm * BM + wr * 64 + fr, ch = u.pn * HALF + wc * 32 + 8 * fq;
        f32x4 av[2][4][2], uv[2][4][2];
#pragma unroll
        for (int ai = 0; ai < 2; ++ai)
#pragma unroll
            for (int m = 0; m < 4; ++m) { const float r = rstd[row0 + ai * HALF + m * 16];
                av[ai][m][0] = acc[ai][0][m][0] * r; av[ai][m][1] = acc[ai][0][m][1] * r; uv[ai][m][0] = acc[ai][1][m][0] * r; uv[ai][m][1] = acc[ai][1][m][1] * r; }
        const unsigned eb = (unsigned)(uintptr_t)ex + (unsigned)((wc * 4 + fq) * 32);
#pragma unroll
        for (int ai = 0; ai < 2; ++ai) { const int gidx = 2 * ai + wr;
            if (fr == 0) { const unsigned a0 = eb + (unsigned)((gidx * 2 + 0) * 512);
                asm volatile("ds_write_b128 %0, %1\n\tds_write_b128 %0, %2 offset:16" :: "v"(a0), "v"(av[ai][0][0]), "v"(av[ai][0][1]) : "memory"); }
            if (fr == 15) { const unsigned a1 = eb + (unsigned)((gidx * 2 + 1) * 512);
                asm volatile("ds_write_b128 %0, %1\n\tds_write_b128 %0, %2 offset:16" :: "v"(a1), "v"(av[ai][3][0]), "v"(av[ai][3][1]) : "memory"); } }
        asm volatile("s_waitcnt lgkmcnt(0)" ::: "memory"); __builtin_amdgcn_s_barrier(); asm volatile("" ::: "memory");
        unsigned pk[2][4][2][2];
#pragma unroll
        for (int h = 0; h < 2; ++h) {
            const f32x4 w0 = *(const f32x4*)(cw + ch + 4 * h), w1 = *(const f32x4*)(cw + ldc + ch + 4 * h), w2 = *(const f32x4*)(cw + 2 * ldc + ch + 4 * h), bb = *(const f32x4*)(cb + ch + 4 * h);
#pragma unroll
            for (int ai = 0; ai < 2; ++ai) { const int gidx = 2 * ai + wr;
                f32x4 rrp, nx;
                { const unsigned ap = eb + (unsigned)(((gidx > 0 ? gidx - 1 : 0) * 2 + 1) * 512 + 16 * h), an = eb + (unsigned)(((gidx < 3 ? gidx + 1 : 3) * 2 + 0) * 512 + 16 * h);
                  asm volatile("ds_read_b128 %0, %2\n\tds_read_b128 %1, %3\n\ts_waitcnt lgkmcnt(0)" : "=&v"(rrp), "=&v"(nx) : "v"(ap), "v"(an) : "memory"); }
                f32x4 rlc;
#pragma unroll
                for (int j = 0; j < 4; ++j) rlc[j] = dpp_rot<0x12F>(av[ai][0][h][j]);
#pragma unroll
                for (int m = 0; m < 4; ++m) { const int row = row0 + ai * HALF + m * 16;
                    float hv[4];
#pragma unroll
                    for (int j = 0; j < 4; ++j) { const float cur = av[ai][m][h][j];
                        const float rr = dpp_rot<0x121>(cur);
                        float rln;
                        if (m < 3) rln = dpp_rot<0x12F>(av[ai][m + 1][h][j]); else rln = nx[j];
                        const float prev = fr != 0 ? rr : rrp[j], next = fr != 15 ? rlc[j] : rln;
                        rrp[j] = rr; rlc[j] = rln;
                        const float g = w0[j] * prev + w1[j] * cur + w2[j] * next + bb[j];
                        const float e = __builtin_amdgcn_exp2f(-1.4426950408889634f * g);
                        hv[j] = g * __builtin_amdgcn_rcpf(1.0f + e) * uv[ai][m][h][j]; }
                    pk[ai][m][h][0] = cvt_pk_bf16(hv[0], hv[1]); pk[ai][m][h][1] = cvt_pk_bf16(hv[2], hv[3]);
                    if ((m == 0 && gidx == 0 && fr < 2) || (m == 3 && gidx == 3 && fr >= 14)) {
                        const int e4 = (m == 0) ? fr : fr - 12;
                        u32x2 w; w.x = cvt_pk_bf16(av[ai][m][h][0], av[ai][m][h][1]); w.y = cvt_pk_bf16(av[ai][m][h][2], av[ai][m][h][3]);
                        *(u32x2*)(aedge + ((size_t)u.pm * 4 + e4) * ldc + ch + 4 * h) = w;
                        if (e4 == 0 || e4 == 3) { u32x2 wu; wu.x = cvt_pk_bf16(uv[ai][m][h][0], uv[ai][m][h][1]); wu.y = cvt_pk_bf16(uv[ai][m][h][2], uv[ai][m][h][3]);
                            *(u32x2*)(uedge + ((size_t)u.pm * 2 + (e4 == 3 ? 1 : 0)) * ldc + ch + 4 * h) = wu; } }
                    if (h == 1) { const bool first = (m == 0 && gidx == 0 && fr == 0), last = (m == 3 && gidx == 3 && fr == 15);
                        if (!first && !last) { u32x4 w; w.x = pk[ai][m][0][0]; w.y = pk[ai][m][0][1]; w.z = pk[ai][m][1][0]; w.w = pk[ai][m][1][1];
                            *(u32x4*)(h2 + (size_t)row * ldc + ch) = w; } }
                } }
        }
    }
};
template <class Epi, class Sched, bool ALIGN_EPI = false, bool SP2 = false, bool SPLITK = false>
__device__ __forceinline__ void gemm_phase(PG8_LAS unsigned char* lds, const Gemm g, const Sched& S, const Epi& E) {
    const int tid = threadIdx.x, wid = __builtin_amdgcn_readfirstlane(tid >> 6), lane = tid & 63, wr = wid >> 2, wc = wid & 3, fr = lane & 15, fq = lane >> 4;
    const int K = g.K, nt = K / BK;
    unsigned voffA[2], voffB[2];
#pragma unroll
    for (int i = 0; i < 2; ++i) { int R, C; stage_rc(tid * 16 + i * 8192, R, C); const int Rb = Epi::PERM ? ((R & ~31) + perm32(R & 31)) : R;
        voffA[i] = (unsigned)(R * g.lda + C) * 2u; voffB[i] = (unsigned)(Rb * K + C) * 2u; }
    const size_t kstep = (size_t)(BK * 2);
    const size_t hstepB = (size_t)HALF * K * 2, hstepA = (size_t)HALF * g.lda * 2;
    const size_t tstepB = 2 * hstepB, tstepA = 2 * hstepA;
    const unsigned ldsw = (unsigned)wid * 1024u;
    const int aoff = lds_byte(wr * 64 + fr, fq * 8), boff = lds_byte(wc * 32 + fr, fq * 8);
#define PG8_SA(b, h) (((b) * 2 + (h)) * HTB)
#define PG8_SB(b, h) ((4 + (b) * 2 + (h)) * HTB)
#define PG8_STAGE(bufoff, gbase, voff) do { _Pragma("unroll") for (int _i = 0; _i < 2; ++_i) \
        __builtin_amdgcn_global_load_lds((const unsigned*)((const char*)(gbase) + (voff)[_i]), (PG8_LAS unsigned*)(lds + (bufoff) + ldsw + _i * 8192), 16, 0, 0); } while (0)
#define PG8_LDA(dst, b, h) do { _Pragma("unroll") for (int m = 0; m < 4; ++m) _Pragma("unroll") for (int k = 0; k < 2; ++k) dst[m][k] = *(const PG8_LAS bf16x8*)(lds + PG8_SA(b, h) + aoff + m * 2048 + k * 1024); } while (0)
#define PG8_LDB(dst, b, h) do { _Pragma("unroll") for (int n = 0; n < 2; ++n) _Pragma("unroll") for (int k = 0; k < 2; ++k) dst[n][k] = *(const PG8_LAS bf16x8*)(lds + PG8_SB(b, h) + boff + n * 2048 + k * 1024); } while (0)
#define PG8_MMA(ai, bj, At, Bt) do { __builtin_amdgcn_s_setprio(1); _Pragma("unroll") for (int m = 0; m < 4; ++m) _Pragma("unroll") for (int n = 0; n < 2; ++n) _Pragma("unroll") for (int k = 0; k < 2; ++k) \
        acc[ai][bj][m][n] = __builtin_amdgcn_mfma_f32_16x16x32_bf16(Bt[n][k], At[m][k], acc[ai][bj][m][n], 0, 0, 0); __builtin_amdgcn_s_setprio(0); } while (0)
#define PG8_WAIT_V(n) asm volatile("s_waitcnt vmcnt(" #n ")" ::: "memory")
#define PG8_WAIT_L(n) asm volatile("s_waitcnt lgkmcnt(" #n ")" ::: "memory")
#define PG8_BAR __builtin_amdgcn_s_barrier()
#define PG8_SCHED __builtin_amdgcn_sched_barrier(0)
    Unit cur, nxt; int ui = 0;
    if (!S.next(0, cur)) return;
    f32x4 acc[2][2][4][2];
#pragma unroll
    for (int a = 0; a < 2; ++a)
#pragma unroll
        for (int b = 0; b < 2; ++b)
#pragma unroll
            for (int m = 0; m < 4; ++m)
#pragma unroll
                for (int n = 0; n < 2; ++n) acc[a][b][m][n] = (f32x4){0.f, 0.f, 0.f, 0.f};
    bf16x8 At[4][2], B0[2][2], B1[2][2];
    const char* cA = (const char*)g.A + (size_t)cur.pm * tstepA; const char* cB = (const char*)g.Bt + (size_t)cur.pn * tstepB;
    if constexpr (SPLITK) { cA += (size_t)cur.kb * kstep; cB += (size_t)cur.kb * kstep; }
    S.a_ready(cur);
    if constexpr (SP2) {
        PG8_STAGE(PG8_SB(0, 0), cB, voffB); PG8_STAGE(PG8_SB(0, 1), cB + hstepB, voffB); PG8_STAGE(PG8_SA(0, 0), cA, voffA); PG8_STAGE(PG8_SA(0, 1), cA + hstepA, voffA);
        if (wr == 1) PG8_BAR;
        PG8_WAIT_V(2); PG8_BAR;
        PG8_STAGE(PG8_SB(1, 0), cB + kstep, voffB); PG8_STAGE(PG8_SA(1, 0), cA + kstep, voffA); PG8_STAGE(PG8_SB(1, 1), cB + hstepB + kstep, voffB);
        PG8_WAIT_V(6); PG8_BAR;
    } else {
        PG8_STAGE(PG8_SB(0, 0), cB, voffB); PG8_STAGE(PG8_SA(0, 0), cA, voffA); PG8_STAGE(PG8_SB(0, 1), cB + hstepB, voffB); PG8_STAGE(PG8_SA(0, 1), cA + hstepA, voffA);
        if (wr == 1) PG8_BAR;
        PG8_WAIT_V(4); PG8_BAR;
        PG8_STAGE(PG8_SB(1, 0), cB + kstep, voffB); PG8_STAGE(PG8_SA(1, 0), cA + kstep, voffA); PG8_STAGE(PG8_SB(1, 1), cB + hstepB + kstep, voffB);
        PG8_WAIT_V(6); PG8_BAR;
    }
    for (;;) {
        const bool has_next = S.next(ui + 1, nxt);
        const char* nA = has_next ? (const char*)g.A + (size_t)nxt.pm * tstepA : cA; const char* nB = has_next ? (const char*)g.Bt + (size_t)nxt.pn * tstepB : cB;
        if constexpr (SPLITK) { if (has_next) { nA += (size_t)nxt.kb * kstep; nB += (size_t)nxt.kb * kstep; } }
        const int ntc = SPLITK ? cur.kn : nt;
        for (int t = 0; t < ntc; t += 2) {
            const bool last = (t == ntc - 2);
            const char* a1 = cA + (size_t)(t + 1) * kstep;
            const char* a2 = last ? nA : cA + (size_t)(t + 2) * kstep; const char* b2 = last ? nB : cB + (size_t)(t + 2) * kstep;
            const char* a3 = a2 + kstep; const char* b3 = b2 + kstep;
            if (last && has_next) S.a_ready(nxt);
            if constexpr (SP2) {
            PG8_LDB(B0, 0, 0); PG8_LDB(B1, 0, 1); PG8_SCHED; PG8_LDA(At, 0, 0); PG8_STAGE(PG8_SA(1, 1), a1 + hstepA, voffA);
            PG8_WAIT_V(8); PG8_WAIT_L(0); PG8_BAR; PG8_MMA(0, 0, At, B0); PG8_MMA(0, 1, At, B1); PG8_BAR; PG8_SCHED;
            PG8_LDA(At, 0, 1); PG8_STAGE(PG8_SB(0, 0), b2, voffB); PG8_STAGE(PG8_SB(0, 1), b2 + hstepB, voffB); PG8_STAGE(PG8_SA(0, 0), a2, voffA);
            PG8_WAIT_V(8); PG8_WAIT_L(0); PG8_BAR; PG8_MMA(1, 0, At, B0); PG8_MMA(1, 1, At, B1); PG8_BAR; PG8_SCHED;
            PG8_LDB(B0, 1, 0); PG8_LDB(B1, 1, 1); PG8_SCHED; PG8_LDA(At, 1, 0); PG8_STAGE(PG8_SA(0, 1), a2 + hstepA, voffA);
            PG8_WAIT_V(8); PG8_WAIT_L(0); PG8_BAR; PG8_MMA(0, 0, At, B0); PG8_MMA(0, 1, At, B1); PG8_BAR; PG8_SCHED;
            PG8_LDA(At, 1, 1); PG8_STAGE(PG8_SB(1, 0), b3, voffB); PG8_STAGE(PG8_SB(1, 1), b3 + hstepB, voffB); PG8_STAGE(PG8_SA(1, 0), a3, voffA);
            PG8_WAIT_V(8); PG8_WAIT_L(0); PG8_BAR; PG8_MMA(1, 0, At, B0); PG8_MMA(1, 1, At, B1); PG8_BAR; PG8_SCHED;
            } else {
            PG8_LDB(B0, 0, 0); PG8_SCHED; PG8_LDA(At, 0, 0); PG8_STAGE(PG8_SA(1, 1), a1 + hstepA, voffA);
            PG8_WAIT_L(8); PG8_BAR; PG8_WAIT_L(0); PG8_MMA(0, 0, At, B0); PG8_BAR; PG8_SCHED;
            PG8_LDB(B1, 0, 1); PG8_STAGE(PG8_SB(0, 0), b2, voffB);
            PG8_BAR; PG8_WAIT_L(0); PG8_MMA(0, 1, At, B1); PG8_BAR;
            PG8_LDA(At, 0, 1); PG8_STAGE(PG8_SA(0, 0), a2, voffA);
            PG8_BAR; PG8_WAIT_L(0); PG8_MMA(1, 0, At, B0); PG8_BAR; PG8_SCHED;
            PG8_STAGE(PG8_SB(0, 1), b2 + hstepB, voffB);
            PG8_WAIT_V(6); PG8_BAR; PG8_MMA(1, 1, At, B1); PG8_BAR;
            PG8_LDB(B0, 1, 0); PG8_SCHED; PG8_LDA(At, 1, 0); PG8_STAGE(PG8_SA(0, 1), a2 + hstepA, voffA);
            PG8_WAIT_L(8); PG8_BAR; PG8_WAIT_L(0); PG8_MMA(0, 0, At, B0); PG8_BAR; PG8_SCHED;
            PG8_LDB(B1, 1, 1); PG8_STAGE(PG8_SB(1, 0), b3, voffB);
            PG8_BAR; PG8_WAIT_L(0); PG8_MMA(0, 1, At, B1); PG8_BAR;
            PG8_LDA(At, 1, 1); PG8_STAGE(PG8_SA(1, 0), a3, voffA);
            PG8_BAR; PG8_WAIT_L(0); PG8_MMA(1, 0, At, B0); PG8_BAR; PG8_SCHED;
            PG8_STAGE(PG8_SB(1, 1), b3 + hstepB, voffB);
            PG8_WAIT_V(6); PG8_BAR; PG8_MMA(1, 1, At, B1); PG8_BAR;
            }
        }
        if constexpr (ALIGN_EPI) { if (wr == 0) PG8_BAR; }
        if constexpr (SPLITK) {
            if (cur.role == 2) {
                const __amdgpu_buffer_rsrc_t rs = __builtin_amdgcn_make_buffer_rsrc((void*)(S.scr + (size_t)cur.slot * 65536), 0, 65536 * 4, 0x00020000);
#pragma unroll
                for (int a = 0; a < 2; ++a)
#pragma unroll
                    for (int b = 0; b < 2; ++b)
#pragma unroll
                        for (int m = 0; m < 4; ++m)
#pragma unroll
                            for (int n = 0; n < 2; ++n)
                                __builtin_amdgcn_raw_buffer_store_b128(__builtin_bit_cast(u32x4, acc[a][b][m][n]), rs, (unsigned)(((wid * 32 + ((a * 2 + b) * 4 + m) * 2 + n) * 64 + lane) * 16), 0, 16);
                PG8_WAIT_V(0); PG8_BAR;
                if (tid == 0) __hip_atomic_store(S.flg + cur.slot * 16, 1u, __ATOMIC_RELAXED, __HIP_MEMORY_SCOPE_AGENT);
            } else {
                if (cur.role == 1) {
                    if (tid == 0) { unsigned spn = 0; while (__hip_atomic_load(S.flg + cur.slot * 16, __ATOMIC_RELAXED, __HIP_MEMORY_SCOPE_AGENT) == 0u) { __builtin_amdgcn_s_sleep(1); if (++spn > (1u << 22)) break; }
                        __builtin_amdgcn_fence(__ATOMIC_ACQUIRE, "agent"); }
                    PG8_WAIT_V(0); PG8_BAR;
                    const float* sp = S.scr + (size_t)cur.slot * 65536 + (size_t)(wid * 32 * 64 + lane) * 4;
#pragma unroll
                    for (int a = 0; a < 2; ++a)
#pragma unroll
                        for (int b = 0; b < 2; ++b) { f32x4 tq[4][2];
#pragma unroll
                            for (int m = 0; m < 4; ++m)
#pragma unroll
                                for (int n = 0; n < 2; ++n) tq[m][n] = *(const f32x4*)(sp + (size_t)((((a * 2 + b) * 4 + m) * 2 + n) * 64) * 4);
#pragma unroll
                            for (int m = 0; m < 4; ++m)
#pragma unroll
                                for (int n = 0; n < 2; ++n) acc[a][b][m][n] += tq[m][n]; }
                }
                E(acc, cur, wr, wc, fr, fq); S.done(cur);
            }
        } else
        if constexpr (!Epi::AFTER_DRAIN) { E(acc, cur, wr, wc, fr, fq); S.done(cur); }
        if (!has_next) break;
#pragma unroll
        for (int a = 0; a < 2; ++a)
#pragma unroll
            for (int b = 0; b < 2; ++b)
#pragma unroll
                for (int m = 0; m < 4; ++m)
#pragma unroll
                    for (int n = 0; n < 2; ++n) acc[a][b][m][n] = (f32x4){0.f, 0.f, 0.f, 0.f};
        cur = nxt; cA = nA; cB = nB; ++ui;
        if constexpr (ALIGN_EPI) { if (wr == 1) PG8_BAR; }
    }
    PG8_WAIT_V(0);
    if constexpr (!ALIGN_EPI) { if (wr == 0) PG8_BAR; }
    PG8_BAR;
    if constexpr (Epi::AFTER_DRAIN) { E.fused(acc, cur, wr, wc, fr, fq, lds, wid, lane); S.done(cur); }
#undef PG8_SA
#undef PG8_SB
#undef PG8_STAGE
#undef PG8_LDA
#undef PG8_LDB
#undef PG8_MMA
#undef PG8_WAIT_V
#undef PG8_WAIT_L
#undef PG8_BAR
#undef PG8_SCHED
}
}

namespace mla {
typedef unsigned short bf16;
using bf16x8 = __attribute__((ext_vector_type(8))) short;
using s16x4  = __attribute__((ext_vector_type(4))) short;
using f32x16 = __attribute__((ext_vector_type(16))) float;
using u32x4  = __attribute__((ext_vector_type(4))) unsigned;
constexpr int DQK = 192, DV = 128, NW = 8, QBLK = 32, KVBLK = 64;
constexpr int LDQ = 3072, LDK = 3072, LDV = 4096, LDO = 3072;
constexpr float THR = 11.5f;
constexpr int SHM_V = KVBLK * DV * 2, SHM_K = KVBLK * DQK * 2, SHM_ATTN = 2 * SHM_V + 2 * SHM_K + NW * 64 * 4;
#define MLA_SBAR() __builtin_amdgcn_sched_barrier(0)
#ifndef MLA_QG
#define MLA_QG 4
#endif
__device__ __forceinline__ int crow(int r, int hi) { return (r & 3) + 8 * (r >> 2) + 4 * hi; }
__device__ __forceinline__ unsigned cvtpk(float lo, float hi) { unsigned r; asm volatile("v_cvt_pk_bf16_f32 %0, %1, %2" : "=v"(r) : "v"(lo), "v"(hi)); return r; }
__device__ __forceinline__ void partialSM(f32x16& p0, f32x16& p1, float& m_reg, float& mn, float& alpha) {
  float pmax = p0[0];
#pragma unroll
  for (int r = 1; r < 16; ++r) pmax = fmaxf(pmax, p0[r]);
#pragma unroll
  for (int r = 0; r < 16; ++r) pmax = fmaxf(pmax, p1[r]);
  { auto rr = __builtin_amdgcn_permlane32_swap(__float_as_uint(pmax), __float_as_uint(pmax), false, false);
    pmax = fmaxf(__uint_as_float(rr[0]), __uint_as_float(rr[1])); }
  if (__builtin_expect(__all(pmax - m_reg <= THR), 1)) { mn = m_reg; alpha = 1.f; }
  else { mn = fmaxf(m_reg, pmax); alpha = __builtin_amdgcn_exp2f(m_reg - mn); m_reg = mn; }
#pragma unroll
  for (int r = 0; r < 16; ++r) p0[r] = p0[r] - mn;
#pragma unroll
  for (int r = 0; r < 16; ++r) p1[r] = p1[r] - mn;
#pragma unroll
  for (int r = 0; r < 16; ++r) p0[r] = __builtin_amdgcn_exp2f(p0[r]);
}
__device__ __forceinline__ void finishSM(f32x16& p0, f32x16& p1, float alpha, float& l_reg, bf16x8& pa0, bf16x8& pa1, bf16x8& pa2, bf16x8& pa3) {
#pragma unroll
  for (int r = 0; r < 16; ++r) p1[r] = __builtin_amdgcn_exp2f(p1[r]);
  float ps = 0;
#pragma unroll
  for (int r = 0; r < 16; ++r) ps += p0[r];
#pragma unroll
  for (int r = 0; r < 16; ++r) ps += p1[r];
  { auto rr = __builtin_amdgcn_permlane32_swap(__float_as_uint(ps), __float_as_uint(ps), false, false);
    ps = __uint_as_float(rr[0]) + __uint_as_float(rr[1]); }
  l_reg = l_reg * alpha + ps;
#define MLA_PK4(P, BASE, OUT) do { unsigned a0 = cvtpk(P[BASE + 0], P[BASE + 1]), a1 = cvtpk(P[BASE + 2], P[BASE + 3]);   \
    unsigned b0 = cvtpk(P[BASE + 4], P[BASE + 5]), b1 = cvtpk(P[BASE + 6], P[BASE + 7]);                              \
    auto r0 = __builtin_amdgcn_permlane32_swap(a0, b0, false, false); auto r1 = __builtin_amdgcn_permlane32_swap(a1, b1, false, false); \
    u32x4 w = {r0[0], r1[0], r0[1], r1[1]}; OUT = *reinterpret_cast<bf16x8*>(&w); } while (0)
  MLA_PK4(p0, 0, pa0); MLA_PK4(p0, 8, pa1); MLA_PK4(p1, 0, pa2); MLA_PK4(p1, 8, pa3);
#undef MLA_PK4
}
__device__ __forceinline__ int v_st(int k, int c) { const int kk = (k & ~0xC) | ((k & 4) << 1) | ((k & 8) >> 1); return ((kk >> 3) * 4 + (c >> 5)) * 512 + ((kk & 7) * 32 + (c & 31)) * 2; }
__device__ __forceinline__ int v_rd_base(int lane) { return ((lane & 3) << 3) | (((lane >> 2) & 3) << 6) | (((lane >> 4) & 1) << 5) | (((lane >> 5) & 1) << 8); }
constexpr int v_rd_off(int d0, int ks, int half) { return d0 * 512 + ks * 4096 + half * 2048; }
template <int OFF> __device__ __forceinline__ s16x4 tr_read(int vb) {
  s16x4 r; asm volatile("ds_read_b64_tr_b16 %0, %1 offset:%2" : "=&v"(r) : "v"(vb), "i"(OFF) : "memory"); return r;
}
template <int D0> __device__ __forceinline__ void pv_one(f32x16& od, int vb, bf16x8 pa0, bf16x8 pa1, bf16x8 pa2, bf16x8 pa3) {
  const s16x4 l0 = tr_read<v_rd_off(D0, 0, 0)>(vb), h0 = tr_read<v_rd_off(D0, 0, 1)>(vb), l1 = tr_read<v_rd_off(D0, 1, 0)>(vb), h1 = tr_read<v_rd_off(D0, 1, 1)>(vb);
  const s16x4 l2 = tr_read<v_rd_off(D0, 2, 0)>(vb), h2 = tr_read<v_rd_off(D0, 2, 1)>(vb), l3 = tr_read<v_rd_off(D0, 3, 0)>(vb), h3 = tr_read<v_rd_off(D0, 3, 1)>(vb);
  asm volatile("s_waitcnt lgkmcnt(0)" ::: "memory"); MLA_SBAR();
#define MLA_PK(L, H) (bf16x8){L[0], L[1], L[2], L[3], H[0], H[1], H[2], H[3]}
  od = __builtin_amdgcn_mfma_f32_32x32x16_bf16(pa0, MLA_PK(l0, h0), od, 0, 0, 0);
  od = __builtin_amdgcn_mfma_f32_32x32x16_bf16(pa1, MLA_PK(l1, h1), od, 0, 0, 0);
  od = __builtin_amdgcn_mfma_f32_32x32x16_bf16(pa2, MLA_PK(l2, h2), od, 0, 0, 0);
  od = __builtin_amdgcn_mfma_f32_32x32x16_bf16(pa3, MLA_PK(l3, h3), od, 0, 0, 0);
#undef MLA_PK
}
__device__ __forceinline__ void pv_d0(f32x16* o, int vb, bf16x8 pa0, bf16x8 pa1, bf16x8 pa2, bf16x8 pa3) {
  pv_one<0>(o[0], vb, pa0, pa1, pa2, pa3); pv_one<1>(o[1], vb, pa0, pa1, pa2, pa3); pv_one<2>(o[2], vb, pa0, pa1, pa2, pa3); pv_one<3>(o[3], vb, pa0, pa1, pa2, pa3);
}
constexpr int SHM_ATTN3 = 3 * SHM_V + 2 * SHM_K + NW * 64 * 4;
__device__ __forceinline__ void attn_unit_d(const bf16* __restrict__ Qb, const bf16* __restrict__ Kh, const bf16* __restrict__ Vh, bf16* __restrict__ Ob, int seq, char* lds,
                                            const float* __restrict__ qgain, float qscale, float qeps, const float* __restrict__ cosT, const float* __restrict__ sinT, int pos0) {
  typedef __attribute__((address_space(3))) unsigned las_u32;
  const int tid = threadIdx.x, wid = tid >> 6, wu = __builtin_amdgcn_readfirstlane(tid >> 6), lane = tid & 63, r32 = lane & 31, hi = lane >> 5, grp = wid >> 2;
  char* V_lds = lds; char* K_lds = lds + 3 * SHM_V;
  float* ws = (float*)(lds + 3 * SHM_V + 2 * SHM_K) + wid * 64; float* li_l = ws; float* al_l = ws + 32;
  char* Q_lds = lds + SHM_ATTN3 + wid * 4096;
  float m_reg = -1e30f, l_reg = 0; f32x16 o[4] = {}; bf16x8 qr[8];
  const bf16* Qw = Qb + (long)(wid * QBLK + r32) * LDQ + hi * 8;
  const int qsw = (r32 >> 1) & 7; char* qrow = Q_lds + r32 * 128;
  {
    bf16x8 raw[12];
#pragma unroll
    for (int d0 = 0; d0 < 12; ++d0) raw[d0] = *reinterpret_cast<const bf16x8*>(Qw + d0 * 16);
    float ssq = 0.f;
#pragma unroll
    for (int d0 = 0; d0 < 12; ++d0)
#pragma unroll
      for (int e = 0; e < 8; ++e) { const float x = __uint_as_float((unsigned)(unsigned short)raw[d0][e] << 16); ssq += x * x; }
    ssq += __shfl_xor(ssq, 32);
    const float rsq = qscale / sqrtf(ssq * (1.0f / 192.0f) + qeps);
#pragma unroll
    for (int d0 = 0; d0 < 8; ++d0) { const float* gp = qgain + 16 * d0 + 8 * hi; float y[8];
#pragma unroll
      for (int e = 0; e < 8; ++e) y[e] = __uint_as_float((unsigned)(unsigned short)raw[d0][e] << 16) * rsq * gp[e];
      u32x4 w; w.x = cvtpk(y[0], y[1]); w.y = cvtpk(y[2], y[3]); w.z = cvtpk(y[4], y[5]); w.w = cvtpk(y[6], y[7]); qr[d0] = __builtin_bit_cast(bf16x8, w); }
    const int pos = pos0 + wid * QBLK + r32;
#pragma unroll
    for (int dr = 0; dr < 2; ++dr) { const int i0 = 16 * dr + 8 * hi; const float* g1 = qgain + 128 + i0; const float* g2 = qgain + 160 + i0; const float* cp = cosT + pos * 32 + i0; const float* sp = sinT + pos * 32 + i0;
      float y1[8], y2[8];
#pragma unroll
      for (int e = 0; e < 8; ++e) { const float a = __uint_as_float((unsigned)(unsigned short)raw[8 + dr][e] << 16) * rsq * g1[e], b = __uint_as_float((unsigned)(unsigned short)raw[10 + dr][e] << 16) * rsq * g2[e];
        y1[e] = a * cp[e] - b * sp[e]; y2[e] = b * cp[e] + a * sp[e]; }
      u32x4 w1, w2; w1.x = cvtpk(y1[0], y1[1]); w1.y = cvtpk(y1[2], y1[3]); w1.z = cvtpk(y1[4], y1[5]); w1.w = cvtpk(y1[6], y1[7]); w2.x = cvtpk(y2[0], y2[1]); w2.y = cvtpk(y2[2], y2[3]); w2.z = cvtpk(y2[4], y2[5]); w2.w = cvtpk(y2[6], y2[7]);
      *reinterpret_cast<bf16x8*>(qrow + (((2 * dr + hi) ^ qsw) << 4)) = __builtin_bit_cast(bf16x8, w1);
      *reinterpret_cast<bf16x8*>(qrow + (((2 * (dr + 2) + hi) ^ qsw) << 4)) = __builtin_bit_cast(bf16x8, w2); }
  }
  int ksrc[3], vsrc[2];
#pragma unroll
  for (int k = 0; k < 3; ++k) { const int o_ = (wid + 8 * k) * 1024 + lane * 16, r_ = o_ / 384, sc_ = (o_ - r_ * 384) >> 4, c_ = (sc_ & ~7) | ((sc_ & 7) ^ ((r_ >> 1) & 7)); ksrc[k] = (r_ * LDK + c_ * 8) * 2; }
#pragma unroll
  for (int k = 0; k < 2; ++k) { const int o_ = (wid + 8 * k) * 1024 + lane * 16, sub_ = o_ >> 9, w_ = (o_ & 511) >> 1, kk_ = (sub_ >> 2) * 8 + (w_ >> 5), key_ = (kk_ & ~0xC) | ((kk_ & 4) << 1) | ((kk_ & 8) >> 1);
    vsrc[k] = (key_ * LDV + (sub_ & 3) * 32 + (w_ & 31)) * 2; }
  const int vb0 = (int)(uintptr_t)V_lds + v_rd_base(lane);
  const __amdgpu_buffer_rsrc_t krs = __builtin_amdgcn_make_buffer_rsrc((void*)Kh, 0, seq * LDK * 2, 0x00020000);
  const __amdgpu_buffer_rsrc_t vrs = __builtin_amdgcn_make_buffer_rsrc((void*)Vh, 0, seq * LDV * 2, 0x00020000);
#define MLD_ISSUE(k0, bk, bv) do { \
    _Pragma("unroll") for (int k = 0; k < 3; ++k) __builtin_amdgcn_raw_ptr_buffer_load_lds(krs, (las_u32*)(K_lds + (bk) * SHM_K + (wu + 8 * k) * 1024), 16, ksrc[k], (k0) * LDK * 2, 0, 0); \
    _Pragma("unroll") for (int k = 0; k < 2; ++k) __builtin_amdgcn_raw_ptr_buffer_load_lds(vrs, (las_u32*)(V_lds + (bv) * SHM_V + (wu + 8 * k) * 1024), 16, vsrc[k], (k0) * LDV * 2, 0, 0); } while (0)
#define MLD_RD(d0_, A0_, A1_, QF_) do { const int c_ = 2 * (d0_) + hi; const int off_ = (c_ ^ sw) << 4; A0_ = *reinterpret_cast<const bf16x8*>(kb_ + off_); A1_ = *reinterpret_cast<const bf16x8*>(kb_ + 32 * 384 + off_); \
      if ((d0_) >= 8) QF_ = *reinterpret_cast<const bf16x8*>(qrow + (((2 * ((d0_) - 8) + hi) ^ qsw) << 4)); else QF_ = qr[(d0_) < 8 ? (d0_) : 0]; } while (0)
#define MLD_MM(A0_, A1_, QF_) do { p0 = __builtin_amdgcn_mfma_f32_32x32x16_bf16(A0_, QF_, p0, 0, 0, 0); p1 = __builtin_amdgcn_mfma_f32_32x32x16_bf16(A1_, QF_, p1, 0, 0, 0); } while (0)
#define MLD_S(t_) do { const int b_ = (t_) & 1; f32x16 p0 = f32x16{}, p1 = f32x16{}; \
      { const int sw = (r32 >> 1) & 7; const char* kb_ = K_lds + b_ * SHM_K + r32 * 384; \
        bf16x8 xa0, xa1, xq, ya0, ya1, yq; \
        MLD_RD(0, xa0, xa1, xq); __builtin_amdgcn_s_setprio(1); \
        MLD_RD(1, ya0, ya1, yq); MLA_SBAR(); MLD_MM(xa0, xa1, xq); MLA_SBAR(); \
        MLD_RD(2, xa0, xa1, xq); MLA_SBAR(); MLD_MM(ya0, ya1, yq); MLA_SBAR(); \
        MLD_RD(3, ya0, ya1, yq); MLA_SBAR(); MLD_MM(xa0, xa1, xq); MLA_SBAR(); \
        MLD_RD(4, xa0, xa1, xq); MLA_SBAR(); MLD_MM(ya0, ya1, yq); MLA_SBAR(); \
        MLD_RD(5, ya0, ya1, yq); MLA_SBAR(); MLD_MM(xa0, xa1, xq); MLA_SBAR(); \
        MLD_RD(6, xa0, xa1, xq); MLA_SBAR(); MLD_MM(ya0, ya1, yq); MLA_SBAR(); \
        MLD_RD(7, ya0, ya1, yq); MLA_SBAR(); MLD_MM(xa0, xa1, xq); MLA_SBAR(); \
        MLD_RD(8, xa0, xa1, xq); MLA_SBAR(); MLD_MM(ya0, ya1, yq); MLA_SBAR(); \
        MLD_RD(9, ya0, ya1, yq); MLA_SBAR(); MLD_MM(xa0, xa1, xq); MLA_SBAR(); \
        MLD_RD(10, xa0, xa1, xq); MLA_SBAR(); MLD_MM(ya0, ya1, yq); MLA_SBAR(); \
        MLD_RD(11, ya0, ya1, yq); MLA_SBAR(); MLD_MM(xa0, xa1, xq); MLA_SBAR(); \
        MLD_MM(ya0, ya1, yq); __builtin_amdgcn_s_setprio(0); } \
      float mn; partialSM(p0, p1, m_reg, mn, al); finishSM(p0, p1, al, l_reg, pa0, pa1, pa2, pa3); } while (0)
#define MLD_O(vslot_) do { if (__any(al < 1.f)) { if (hi == 0) al_l[r32] = al; asm volatile("s_waitcnt lgkmcnt(0)" ::: "memory"); \
        _Pragma("unroll") for (int d = 0; d < 4; ++d) _Pragma("unroll") for (int r = 0; r < 16; ++r) o[d][r] *= al_l[crow(r, hi)]; } \
      MLA_SBAR(); __builtin_amdgcn_s_setprio(1); pv_d0(o, vb0 + (vslot_) * SHM_V, pa0, pa1, pa2, pa3); __builtin_amdgcn_s_setprio(0); } while (0)
  const int NT = seq / KVBLK;
  MLD_ISSUE(0, 0, 0); asm volatile("s_waitcnt vmcnt(0)" ::: "memory"); __syncthreads();
  bf16x8 pa0 = {}, pa1 = {}, pa2 = {}, pa3 = {}; float al = 1.f;
  int vs_cur = 0;
  for (int j = 0; j <= NT; ++j) {
    const int vs_prev = vs_cur == 0 ? 2 : vs_cur - 1, vs_next = vs_cur == 2 ? 0 : vs_cur + 1;
    if (j + 1 < NT) MLD_ISSUE((j + 1) * KVBLK, (j + 1) & 1, vs_next);
    if (grp == 0) { if (j < NT) { MLD_S(j); MLD_O(vs_cur); } }
    else { if (j > 0) MLD_O(vs_prev); if (j < NT) MLD_S(j); }
    asm volatile("s_waitcnt vmcnt(0)" ::: "memory");
    __syncthreads();
    vs_cur = vs_next;
  }
  if (hi == 0) li_l[r32] = l_reg; asm volatile("s_waitcnt lgkmcnt(0)" ::: "memory");
  float rli[16];
#pragma unroll
  for (int r = 0; r < 16; ++r) rli[r] = __builtin_amdgcn_rcpf(li_l[crow(r, hi)]);
  bf16* Ow = Ob + (long)(wid * QBLK) * LDO;
#pragma unroll
  for (int r = 0; r < 16; ++r) { const int orow = crow(r, hi);
#pragma unroll
    for (int d0 = 0; d0 < 4; ++d0) Ow[(long)orow * LDO + d0 * 32 + r32] = (bf16)(cvtpk(o[d0][r] * rli[r], 0.f) & 0xffffu); }
  asm volatile("s_waitcnt vmcnt(0)" ::: "memory");
  __syncthreads();
#undef MLD_ISSUE
#undef MLD_S
#undef MLD_RD
#undef MLD_MM
#undef MLD_O
}
}
namespace wat {
typedef unsigned short bf16;
using bf16x8 = __attribute__((ext_vector_type(8))) short;
using s16x4  = __attribute__((ext_vector_type(4))) short;
using f32x4  = __attribute__((ext_vector_type(4))) float;
using u32x4  = __attribute__((ext_vector_type(4))) unsigned;
#define WAT_LAS __attribute__((address_space(3)))
__device__ __forceinline__ unsigned cvtpk(float lo, float hi) { unsigned r; asm volatile("v_cvt_pk_bf16_f32 %0, %1, %2" : "=v"(r) : "v"(lo), "v"(hi)); return r; }
__device__ __forceinline__ int kst_off(int row, int ch) { return row * 256 + ((ch ^ ((row & 3) | (((row >> 3) & 3) << 2))) << 4); }
__device__ __forceinline__ int vst_off(int row, int ch) { return (row >> 4) * 4096 + ((row >> 2) & 1) * 2048 + (ch >> 1) * 256 + ((row >> 3) & 1) * 128 + (row & 3) * 32 + (ch & 1) * 16; }
__device__ __forceinline__ int vrd_base(int R0, int lane) { const int g4 = lane >> 4, qa = (lane & 15) >> 2, p = lane & 3, gg = g4 + ((R0 >> 3) & 1); return ((R0 >> 4) + (gg >> 1)) * 4096 + (gg & 1) * 128 + qa * 32 + p * 8; }
__device__ __forceinline__ void qk_group(f32x4& sc0, f32x4& sc1, const WAT_LAS char* Kb, int Rg, const bf16x8* qf, int lane) {
    const int a = lane & 15, g4 = lane >> 4; const int row = Rg + 8 * (a >> 2) + (a & 3); const int xk = (row & 3) | (((row >> 3) & 3) << 2);
    const WAT_LAS char* p = Kb + row * 256;
    sc0 = f32x4{0.f, 0.f, 0.f, 0.f}; sc1 = f32x4{0.f, 0.f, 0.f, 0.f};
#pragma unroll
    for (int s = 0; s < 4; ++s) { const int off = ((4 * s + g4) ^ xk) << 4;
        const bf16x8 k0 = *(const WAT_LAS bf16x8*)(p + off), k1 = *(const WAT_LAS bf16x8*)(p + 4 * 256 + off);
        sc0 = __builtin_amdgcn_mfma_f32_16x16x32_bf16(k0, qf[s], sc0, 0, 0, 0);
        sc1 = __builtin_amdgcn_mfma_f32_16x16x32_bf16(k1, qf[s], sc1, 0, 0, 0); }
}
__device__ __forceinline__ bf16x8 p_frag(const f32x4 p0, const f32x4 p1) { u32x4 w = {cvtpk(p0[0], p0[1]), cvtpk(p0[2], p0[3]), cvtpk(p1[0], p1[1]), cvtpk(p1[2], p1[3])}; return *reinterpret_cast<bf16x8*>(&w); }
template <int OFF> __device__ __forceinline__ s16x4 tr_read(unsigned addr) { s16x4 r; asm volatile("ds_read_b64_tr_b16 %0, %1 offset:%2" : "=&v"(r) : "v"(addr), "i"(OFF) : "memory"); return r; }
template <int GOFF> __device__ __forceinline__ void pv_group(f32x4* o, unsigned vb, const bf16x8 pf) {
    s16x4 lo[8], hi[8];
#define WAT_TR(c) lo[c] = tr_read<GOFF + (c) * 256>(vb); hi[c] = tr_read<GOFF + 2048 + (c) * 256>(vb);
    WAT_TR(0) WAT_TR(1) WAT_TR(2) WAT_TR(3) WAT_TR(4) WAT_TR(5) WAT_TR(6) WAT_TR(7)
#undef WAT_TR
    asm volatile("s_waitcnt lgkmcnt(0)" ::: "memory"); __builtin_amdgcn_sched_barrier(0);
#pragma unroll
    for (int c = 0; c < 8; ++c) { const bf16x8 vfr = (bf16x8){lo[c][0], lo[c][1], lo[c][2], lo[c][3], hi[c][0], hi[c][1], hi[c][2], hi[c][3]};
        o[c] = __builtin_amdgcn_mfma_f32_16x16x32_bf16(pf, vfr, o[c], 0, 0, 0); }
}
}
constexpr int NWAVES = 8;
constexpr int BATCH = 2, SEQ = 8192, DM = 4096, M = BATCH * SEQ;
constexpr int EVEN_IN = 10688, ZLD = 10752;
constexpr int Z_CQ = 9216, Z_CKV = 10112, Z_KPE = 10624;
constexpr int QRANK = 896, KVRANK = 512, MLA_H = 16, MLA_QK = 192, MLA_NOPE = 128, MLA_ROPE = 64;
constexpr int DIL_H = 24, DIL_HPG = 8, HD = 128;
constexpr int NA_H = 32, GRID_W = 64, NA_ROWS = 8, NA_COLS = 16, GRID_ROWS = SEQ / GRID_W;
constexpr int DFF = 11008, EVEN_MIX = 3072;
constexpr float NORM_EPS = 1e-6f, LOG2E = 1.4426950408889634f;
constexpr float QS_MLA = 0.07216878364870322f * LOG2E;
constexpr float QS_HD = 0.08838834764831845f * LOG2E;
constexpr size_t MiB = 1u << 20;
constexpr size_t WS_CTL = 0, CTL_ZERO_BYTES = 64 * 1024;
constexpr size_t WS_ROPE = 1 * MiB;
constexpr size_t WS_RSTD = 4 * MiB;
constexpr size_t WS_SS = 5 * MiB;
constexpr size_t WS_WIN = 16 * MiB, WS_WUQ = 100 * MiB, WS_WUKV = 106 * MiB, WS_WEOUT = 110 * MiB, WS_WQKV = 134 * MiB, WS_WOOUT = 230 * MiB;
constexpr size_t WS_WFFN = 262 * MiB, FFN_W_BYTES = 86 * MiB;
constexpr size_t WS_XB = 778 * MiB;
constexpr size_t WS_R = 906 * MiB;
constexpr size_t R_Z = 0, R_Q = 336 * MiB, R_KV = 432 * MiB, R_K = 560 * MiB, R_OMIX = 656 * MiB, R_CQN = 656 * MiB, R_CKVN = 688 * MiB;
constexpr size_t R_A = 0, R_H2 = 344 * MiB;
constexpr size_t R_QKV = 0, R_O = 384 * MiB;
constexpr size_t R_DPO = 752 * MiB, R_DPM = 848 * MiB;
constexpr size_t WS_END = WS_R + 852 * MiB;
static_assert((size_t)ZLD * DM * 2 <= 84 * MiB && (size_t)DFF * DM * 2 == 86 * MiB && (size_t)M * ZLD * 2 == 336 * MiB && (size_t)M * DFF * 2 == 344 * MiB, "ws map");
constexpr int CW_BAR = 4096;
constexpr int RING_BYTES = 131072, LDS_BYTES = 163840, LDSCTL_OFF = LDS_BYTES - 1024, MISC_OFF = LDSCTL_OFF + 320;
constexpr int NA_TB_OFF = RING_BYTES + 1024, NA_OST_OFF = NA_TB_OFF + 2048;

#define GAS __attribute__((address_space(1)))
#define LAS __attribute__((address_space(3)))
typedef unsigned short bf16;
typedef unsigned v4u __attribute__((ext_vector_type(4)));
typedef unsigned v2u __attribute__((ext_vector_type(2)));
typedef float f32x4 __attribute__((ext_vector_type(4)));
#define LDS_WAIT() asm volatile("s_waitcnt lgkmcnt(0)" ::: "memory")
#define VM_WAIT() asm volatile("s_waitcnt vmcnt(0)" ::: "memory")
__device__ __forceinline__ unsigned f2bf(float f) { unsigned u = __builtin_bit_cast(unsigned, f); return (u + 0x7fffu + ((u >> 16) & 1u)) >> 16; }
__device__ __forceinline__ unsigned pk2(float lo, float hi) { return f2bf(lo) | (f2bf(hi) << 16); }
__device__ __forceinline__ float bflo(unsigned w) { return __uint_as_float(w << 16); }
__device__ __forceinline__ float bfhi(unsigned w) { return __uint_as_float(w & 0xffff0000u); }
__device__ __forceinline__ void unpack8(const v4u w, float* f) { f[0] = bflo(w.x); f[1] = bfhi(w.x); f[2] = bflo(w.y); f[3] = bfhi(w.y); f[4] = bflo(w.z); f[5] = bfhi(w.z); f[6] = bflo(w.w); f[7] = bfhi(w.w); }
__device__ __forceinline__ v4u pack8(const float* f) { v4u w; w.x = pk2(f[0], f[1]); w.y = pk2(f[2], f[3]); w.z = pk2(f[4], f[5]); w.w = pk2(f[6], f[7]); return w; }
__device__ __forceinline__ float wave_sum(float v) {
#pragma unroll
    for (int o = 1; o < 64; o <<= 1) v += __shfl_xor(v, o);
    return v;
}
__device__ __forceinline__ float sum16(float v) {
#pragma unroll
    for (int o = 1; o < 16; o <<= 1) v += __shfl_xor(v, o);
    return v;
}

#define XB_TMO      128
#define XB_XCNT(j)  (256  + 64 * (j))
#define XB_XSUB(j)  (1280 + 64 * (j))
#define XB_XGEN(j)  (2304 + 64 * (j))
#define XB_TOP      3328
#define XB_TOPGEN   3392
#define XCD_BAR_WORDS 3456
#define XB_SPIN_CAP (1u << 20)
__device__ __forceinline__ unsigned xb_ld(unsigned* p)              { return __hip_atomic_load(p, __ATOMIC_RELAXED, __HIP_MEMORY_SCOPE_AGENT); }
__device__ __forceinline__ unsigned xb_add(unsigned* p, unsigned v) { return __hip_atomic_fetch_add(p, v, __ATOMIC_RELAXED, __HIP_MEMORY_SCOPE_AGENT); }
__device__ __forceinline__ unsigned xb_xcc_id() { return (unsigned)__builtin_amdgcn_s_getreg((3 << 11) | 20) & 0xFu; }
#define XB_SPIN(cond, bar) do { unsigned _sp = 0; while (cond) { __builtin_amdgcn_s_sleep(1); \
    if ((++_sp & 255u) == 0u) { if (xb_ld(&(bar)[XB_TMO])) break; if (_sp > XB_SPIN_CAP) { atomicAdd(&(bar)[XB_TMO], 1u); break; } } } } while (0)
struct XcdBarrier { unsigned* bar; unsigned x; volatile LAS unsigned* st; };
__device__ __forceinline__ XcdBarrier xcd_barrier_post(unsigned* bar, volatile LAS unsigned* st) {
    XcdBarrier b; b.bar = bar; b.x = xb_xcc_id(); b.st = st;
    if (threadIdx.x == 0) (void)xb_add(&bar[XB_XCNT(b.x)], 1u);
    return b;
}
__device__ __forceinline__ void xcd_barrier_complete(unsigned* bar, unsigned x, unsigned& nloc, unsigned& nx) {
    const unsigned G = gridDim.x * gridDim.y * gridDim.z;
    unsigned sum, cnt, mine, sp = 0u;
    for (;;) {
        sum = 0u; cnt = 0u; mine = 0u;
#pragma unroll
        for (unsigned j = 0; j < 16; ++j) { const unsigned c = xb_ld(&bar[XB_XCNT(j)]); sum += c; cnt += (c > 0u) ? 1u : 0u; mine = (j == x) ? c : mine; }
        if (sum == G) break;
        __builtin_amdgcn_s_sleep(1);
        if ((++sp & 255u) == 0u) { if (xb_ld(&bar[XB_TMO])) break; if (sp > XB_SPIN_CAP) { atomicAdd(&bar[XB_TMO], 1u); break; } }
    }
    nloc = mine > 0u ? mine : 1u; nx = cnt > 0u ? cnt : 1u;
}
__device__ __forceinline__ void xcd_barrier(const XcdBarrier& b) {
    asm volatile("s_waitcnt vmcnt(0)" ::: "memory");
    __syncthreads();
    if (threadIdx.x == 0) {
        unsigned* bar = b.bar;
        __builtin_amdgcn_s_waitcnt(0);
        unsigned nloc = b.st[0], nx = b.st[1];
        if (nloc == 0u) { xcd_barrier_complete(bar, b.x, nloc, nx); b.st[0] = nloc; b.st[1] = nx; }
        const unsigned old = xb_add(&bar[XB_XSUB(b.x)], 1u);
        const unsigned gen = old / nloc;
        if (old + 1u == (gen + 1u) * nloc) {
            __builtin_amdgcn_fence(__ATOMIC_RELEASE, "agent");
            asm volatile("s_waitcnt vmcnt(0)" ::: "memory");
            const unsigned og = xb_add(&bar[XB_TOP], 1u);
            const unsigned tg = og / nx;
            if (og + 1u == (tg + 1u) * nx) xb_add(&bar[XB_TOPGEN], 1u);
            else XB_SPIN(xb_ld(&bar[XB_TOPGEN]) == tg, bar);
            __builtin_amdgcn_fence(__ATOMIC_ACQUIRE, "agent");
            xb_add(&bar[XB_XGEN(b.x)], 1u);
            asm volatile("s_waitcnt vmcnt(0)" ::: "memory");
        } else {
            XB_SPIN(xb_ld(&bar[XB_XGEN(b.x)]) == gen, bar);
            __builtin_amdgcn_fence(__ATOMIC_ACQUIRE, "agent");
            asm volatile("s_waitcnt vmcnt(0)" ::: "memory");
        }
    }
    __syncthreads();
}

struct Args { const float* in[24]; float* out; unsigned char* ws; int ph_lo, ph_hi; };
struct Frame { LAS unsigned char* lds; int tid, lane, wave, gw, ngw, G; };

struct P0Item { const float* W; int K, N; bf16* dst; const float* gain; int mode, r; };
__device__ __forceinline__ void p0_item_load(const P0Item& t, float (&v)[32], int lane) {
    const int nblk = t.N / 32, kb = t.r / nblk, nb = t.r % nblk, k0 = 64 * kb, n0 = 32 * nb;
    const float* p = t.W + (size_t)(k0 + (lane >> 5)) * t.N + n0 + (lane & 31);
#pragma unroll
    for (int i = 0; i < 32; ++i) v[i] = p[(size_t)(2 * i) * t.N];
}
__device__ __forceinline__ void p0_item_store(const P0Item& t, const float (&v)[32], LAS float* scr, int lane) {
    const int nblk = t.N / 32, kb = t.r / nblk, nb = t.r % nblk, k0 = 64 * kb, n0 = 32 * nb;
    const int drow0 = (t.mode == 1) ? (n0 >= 1472 ? n0 - 1472 : n0 + 9216)
                    : (t.mode >= 2) ? ((n0 >> 7) * 256 + (n0 & 127) + (t.mode == 3 ? 128 : 0)) : n0;
#pragma unroll
    for (int i = 0; i < 32; ++i) { const int kk = 2 * i + (lane >> 5); scr[kk * 33 + (lane & 31)] = v[i]; }
    LDS_WAIT(); asm volatile("" ::: "memory");
    const int c = lane & 7;
    f32x4 ga = {1.f, 1.f, 1.f, 1.f}, gb = {1.f, 1.f, 1.f, 1.f};
    if (t.gain) { ga = *(const f32x4*)(t.gain + k0 + 8 * c); gb = *(const f32x4*)(t.gain + k0 + 8 * c + 4); }
#pragma unroll
    for (int j = 0; j < 4; ++j) { const int n = (lane >> 3) + 8 * j; const LAS float* sp = scr + (8 * c) * 33 + n;
        v4u o; o.x = pk2(sp[0 * 33] * ga[0], sp[1 * 33] * ga[1]); o.y = pk2(sp[2 * 33] * ga[2], sp[3 * 33] * ga[3]); o.z = pk2(sp[4 * 33] * gb[0], sp[5 * 33] * gb[1]); o.w = pk2(sp[6 * 33] * gb[2], sp[7 * 33] * gb[3]);
        *(v4u*)(t.dst + (size_t)(drow0 + n) * t.K + k0 + 8 * c) = o; }
    LDS_WAIT(); asm volatile("" ::: "memory");
}
#ifndef MLA_UNIT
#define MLA_UNIT mla::attn_unit_d
#endif
constexpr int N_PHASES = 20;
#ifndef LB2
#define LB2 2
#endif
__global__ void __launch_bounds__(NWAVES * 64, LB2) mk_fwd(Args args) {
    extern __shared__ __attribute__((aligned(16))) unsigned char lds[];
    Frame F;
    F.lds = (LAS unsigned char*)lds;
    F.tid = threadIdx.x; F.lane = F.tid & 63; F.wave = __builtin_amdgcn_readfirstlane(F.tid >> 6);
    F.G = gridDim.x; F.gw = blockIdx.x * NWAVES + F.wave; F.ngw = F.G * NWAVES;
    const int lane = F.lane, l15 = lane & 15, grp = lane >> 4;
    unsigned char* ws = args.ws;
    unsigned* ctl = (unsigned*)(ws + WS_CTL);
    const float* x_in = args.in[0]; float* out = args.out;
    float* cosA = (float*)(ws + WS_ROPE); float* sinA = cosA + SEQ * 16; float* cosB = sinA + SEQ * 16; float* sinB = cosB + SEQ * 32;
    float* rstd = (float*)(ws + WS_RSTD); float* ss = (float*)(ws + WS_SS);
    bf16* Win_t = (bf16*)(ws + WS_WIN); bf16* Wuq_t = (bf16*)(ws + WS_WUQ); bf16* Wukv_t = (bf16*)(ws + WS_WUKV); bf16* Weout_t = (bf16*)(ws + WS_WEOUT);
    bf16* Wqkv_t = (bf16*)(ws + WS_WQKV); bf16* Woout_t = (bf16*)(ws + WS_WOOUT);
    bf16* xb = (bf16*)(ws + WS_XB);
    unsigned char* R = ws + WS_R;
    bf16* zb = (bf16*)(R + R_Z); bf16* qb = (bf16*)(R + R_Q); bf16* kvb = (bf16*)(R + R_KV); bf16* kb = (bf16*)(R + R_K); bf16* omix = (bf16*)(R + R_OMIX);
    bf16* cqn = (bf16*)(R + R_CQN); bf16* ckvn = (bf16*)(R + R_CKVN);
    bf16* aedge = (bf16*)(R + R_A); bf16* uedge = aedge + (size_t)(M / 256) * 4 * DFF; bf16* h2b = (bf16*)(R + R_H2);
    bf16* qkvb = (bf16*)(R + R_QKV); bf16* ob = (bf16*)(R + R_O);
    bf16* dpo = (bf16*)(R + R_DPO); float* dpm = (float*)(R + R_DPM);
    bf16* xl0 = (bf16*)(ws + WS_WIN); bf16* xl1 = (bf16*)(R + R_DPO) - (size_t)8192 * DM;

    for (int u = F.tid; u < (LDS_BYTES - LDSCTL_OFF) / 4; u += NWAVES * 64) ((LAS unsigned*)(F.lds + LDSCTL_OFF))[u] = 0u;
    __syncthreads();
    const int lo = args.ph_lo, hi = args.ph_hi;
    XcdBarrier bar; bar.bar = ctl + CW_BAR; bar.x = 0; bar.st = nullptr;
    if (hi - lo > 1) bar = xcd_barrier_post(ctl + CW_BAR, (volatile LAS unsigned*)(F.lds + MISC_OFF) + 8);
#ifndef PH_MASK
#define PH_MASK 0xFFFFFu
#endif
#define IN(k) ((((PH_MASK) >> (k)) & 1u) && lo <= (k) && (k) < hi)
#define SEAM(k) do { if (IN(k) && IN((k) + 1)) xcd_barrier(bar); } while (0)

    if (IN(0)) {
        LAS float* scr = (LAS float*)(F.lds + F.wave * 16384);
        constexpr int I_WIN = (DM / 64) * (EVEN_IN / 32), I_UQ = (QRANK / 64) * (3072 / 32), I_UKV = (KVRANK / 64) * (4096 / 32), I_EOUT = (EVEN_MIX / 64) * (DM / 32);
        constexpr int I_QKV = (DM / 64) * (12288 / 32), I_OOUT = (DM / 64) * (DM / 32), I_GU = (DM / 64) * (DFF / 32), I_DN = (DFF / 64) * (DM / 32);
        constexpr int NITEMS = I_WIN + I_UQ + I_UKV + I_EOUT + I_QKV + I_OOUT + 2 * (2 * I_GU + I_DN);
#define P0_DECODE(it_, T_) do { int r = (it_); T_.gain = nullptr; T_.mode = 0; \
            if (r < I_WIN) { T_.W = args.in[2]; T_.K = DM; T_.N = EVEN_IN; T_.dst = Win_t; T_.gain = args.in[1]; T_.mode = 1; } \
            else if ((r -= I_WIN) < I_UQ) { T_.W = args.in[5]; T_.K = QRANK; T_.N = 3072; T_.dst = Wuq_t; T_.gain = args.in[3]; } \
            else if ((r -= I_UQ) < I_UKV) { T_.W = args.in[6]; T_.K = KVRANK; T_.N = 4096; T_.dst = Wukv_t; T_.gain = args.in[4]; } \
            else if ((r -= I_UKV) < I_EOUT) { T_.W = args.in[11]; T_.K = EVEN_MIX; T_.N = DM; T_.dst = Weout_t; } \
            else if ((r -= I_EOUT) < I_QKV) { T_.W = args.in[13]; T_.K = DM; T_.N = 12288; T_.dst = Wqkv_t; T_.gain = args.in[12]; } \
            else if ((r -= I_QKV) < I_OOUT) { T_.W = args.in[17]; T_.K = DM; T_.N = DM; T_.dst = Woout_t; } \
            else { r -= I_OOUT; const int layer = r / (2 * I_GU + I_DN); r -= layer * (2 * I_GU + I_DN); \
                bf16* wl = (bf16*)(ws + WS_WFFN + (size_t)layer * 3 * FFN_W_BYTES); \
                if (r < I_GU) { T_.W = args.in[19] + (size_t)layer * DM * DFF; T_.K = DM; T_.N = DFF; T_.dst = wl; T_.gain = args.in[18] + layer * DM; T_.mode = 2; } \
                else if ((r -= I_GU) < I_GU) { T_.W = args.in[20] + (size_t)layer * DM * DFF; T_.K = DM; T_.N = DFF; T_.dst = wl; T_.gain = args.in[18] + layer * DM; T_.mode = 3; } \
                else { r -= I_GU; T_.W = args.in[23] + (size_t)layer * DFF * DM; T_.K = DFF; T_.N = DM; T_.dst = (bf16*)((unsigned char*)wl + 2 * FFN_W_BYTES); } } \
            T_.r = r; } while (0)
        {
            float va[32], vb[32]; P0Item ta, tb_;
            int it = F.gw;
            if (it < NITEMS) { P0_DECODE(it, ta); p0_item_load(ta, va, lane); }
            while (it < NITEMS) {
                const int it1 = it + F.ngw, it2 = it1 + F.ngw;
                if (it1 < NITEMS) { P0_DECODE(it1, tb_); p0_item_load(tb_, vb, lane); }
                p0_item_store(ta, va, scr, lane);
                if (it1 >= NITEMS) break;
                if (it2 < NITEMS) { P0_DECODE(it2, ta); p0_item_load(ta, va, lane); }
                p0_item_store(tb_, vb, scr, lane);
                it = it2;
            }
        }
#undef P0_DECODE
        const int gtid = blockIdx.x * (NWAVES * 64) + F.tid, nthr = F.G * NWAVES * 64;
        for (int i = gtid; i < (ZLD - 10688) * DM / 8; i += nthr) ((v4u*)(Win_t + (size_t)10688 * DM))[i] = (v4u){0u, 0u, 0u, 0u};
        for (int i = gtid; i < SEQ * 48; i += nthr) {
            const bool isB = i >= SEQ * 16; const int ii = isB ? i - SEQ * 16 : i; const int pos = isB ? (ii >> 5) : (ii >> 4), k = isB ? (ii & 31) : (ii & 15);
            const double c1 = isB ? 0.6636012376960885 : 0.44036660267178046;
            double p = 1.0; for (int j = 0; j < k; ++j) p *= c1;
            const float inv = (float)p; const float ang = (float)pos * inv;
            const double rev = (double)ang * 0.15915494309189535; const float fr = (float)(rev - __builtin_rint(rev));
            const float sv = __builtin_amdgcn_sinf(fr), cv = __builtin_amdgcn_cosf(fr);
            if (isB) { cosB[ii] = cv; sinB[ii] = sv; } else { cosA[ii] = cv; sinA[ii] = sv; }
        }
#pragma unroll 2
        for (int row = F.gw; row < M; row += F.ngw) {
            const f32x4* xr = (const f32x4*)(x_in + (size_t)row * DM) + lane; v2u* xo = (v2u*)(xb + (size_t)row * DM) + lane; float s = 0.f;
#pragma unroll 4
            for (int j = 0; j < 16; ++j) { const f32x4 v = xr[64 * j]; s += (v.x * v.x + v.y * v.y) + (v.z * v.z + v.w * v.w); v2u w; w.x = pk2(v.x, v.y); w.y = pk2(v.z, v.w); xo[64 * j] = w; }
            s = wave_sum(s);
            if (lane == 0) rstd[row] = 1.0f / sqrtf(s * (1.0f / DM) + NORM_EPS);
        }
    }
    SEAM(0);
    if (IN(1)) {
        pg8::Gemm g{xb, Win_t, M, ZLD, DM, DM}; pg8::StaticOrder S; S.init(M, ZLD, F.G, (int)blockIdx.x);
        pg8::EpiHeadNorm E{zb, ZLD, rstd, args.in[9], args.in[10], QS_HD, 12, 12, (PG8_LAS float*)(F.lds + NA_TB_OFF), cosA, sinA, SEQ, ss};
        pg8::gemm_phase<pg8::EpiHeadNorm, pg8::StaticOrder, true, true>(F.lds, g, S, E);
    }
    SEAM(1);
    if (IN(3)) {
        {
            const int pm_lo = F.G == 256 ? 8 * ((int)blockIdx.x & 7) + (((int)blockIdx.x >> 3) & 7) : 0, pm_hi = F.G == 256 ? pm_lo + 1 : M / 256;
            for (int pmi = pm_lo; pmi < pm_hi; ++pmi) {
                const int row = pmi * 256 + (F.tid >> 1); const f32x4* sp = (const f32x4*)(ss + (size_t)row * 64) + ((F.tid & 1) ? 7 : 0);
                f32x4 a = sp[0] + sp[1] + sp[2] + sp[3]; if ((F.tid & 1) == 0) a += sp[4] + sp[5] + sp[6];
                const float tot = (a[0] + a[1]) + (a[2] + a[3]);
                rstd[((F.tid & 1) ? 2 * M : M) + row] = 1.0f / sqrtf(tot * ((F.tid & 1) ? 1.0f / KVRANK : 1.0f / QRANK) + NORM_EPS); }
            asm volatile("s_waitcnt vmcnt(0)" ::: "memory"); __syncthreads();
        }
        { pg8::Gemm g{zb + Z_CQ, Wuq_t, M, 3072, QRANK, ZLD}; pg8::StaticOrder S; S.init(M, 3072, F.G, (int)blockIdx.x); pg8::EpiScaleBf16 E{qb, 3072, rstd + M};
          pg8::gemm_phase<pg8::EpiScaleBf16, pg8::StaticOrder, true, true>(F.lds, g, S, E); }
        { pg8::Gemm g{zb + Z_CKV, Wukv_t, M, 4096, KVRANK, ZLD}; pg8::StaticOrder S; S.init(M, 4096, F.G, (int)blockIdx.x); pg8::EpiScaleBf16 E{kvb, 4096, rstd + 2 * M};
          pg8::gemm_phase<pg8::EpiScaleBf16, pg8::StaticOrder, true, true>(F.lds, g, S, E); }
        {
            WAT_LAS char* L = (WAT_LAS char*)F.lds;
            const int NU = BATCH * 3 * DIL_HPG * 64;
            const int u0 = (int)(((long)NU * blockIdx.x) / F.G), u1 = (int)(((long)NU * (blockIdx.x + 1)) / F.G);
            const int row16 = F.tid >> 4, ch16 = F.tid & 15, kso = wat::kst_off(row16, ch16), vso = wat::vst_off(row16, ch16);
            const int w = F.wave, q = lane & 15, g4 = lane >> 4, Rw = 32 * (w >> 1);
            v4u st[8];
#define DL_GEOM(u_) const int blk_ = (u_) & 63, j_ = ((u_) >> 6) & 7, bg_ = (u_) >> 9, g_ = bg_ % 3, b_ = bg_ / 3, sh_ = 2 * g_, d_ = 1 << sh_, Ld_ = SEQ >> sh_, \
            r_ = blk_ >> (6 - sh_), p0_ = (blk_ & ((64 >> sh_) - 1)) * 128, head_ = 8 * g_ + j_;
#define DL_LOAD(u_, s_) do { DL_GEOM(u_) const bf16* base_ = zb + (size_t)(b_ * SEQ + r_) * ZLD + ((s_) ? 6144 : 3072) + head_ * HD + ch16 * 8; \
            _Pragma("unroll") for (int k = 0; k < 8; ++k) { const int kp_ = min(max(p0_ - 64 + row16 + 32 * k, 0), Ld_ - 1); st[k] = *(const v4u*)(base_ + (size_t)(kp_ << sh_) * ZLD); } } while (0)
#define DL_WRITE(s_) do { WAT_LAS char* dd_ = L + (s_) * 65536 + ((s_) ? vso : kso); _Pragma("unroll") for (int k = 0; k < 8; ++k) *(WAT_LAS v4u*)(dd_ + k * 32 * 256) = st[k]; } while (0)
#define DL_END(un_, sn_, un2_, sn2_) do { if ((un_) < u1) { VM_WAIT(); DL_WRITE(sn_); } __syncthreads(); if ((un2_) < u1) DL_LOAD(un2_, sn2_); } while (0)
            if (u0 < u1) { DL_LOAD(u0, 0); VM_WAIT(); DL_WRITE(0); __syncthreads(); DL_LOAD(u0, 1); }
            for (int u = u0; u < u1; ++u) {
                DL_GEOM(u)
                wat::bf16x8 qf[4]; wat::f32x4 sc[5][2]; wat::bf16x8 pf[5]; wat::f32x4 o[8]; float linv = 0.f, mrow = 0.f, lrow = 0.f;
                const int qp = p0_ + 16 * w + q; const size_t qtok = (size_t)(b_ * SEQ + r_) + ((size_t)qp << sh_);
                {
                    const bf16* qptr = zb + qtok * ZLD + head_ * HD + 8 * g4;
#pragma unroll
                    for (int s = 0; s < 4; ++s) qf[s] = *(const wat::bf16x8*)(qptr + 32 * s);
#pragma unroll
                    for (int gi = 0; gi < 5; ++gi) wat::qk_group(sc[gi][0], sc[gi][1], L, Rw + 32 * gi, qf, lane);
                    float m = -1e30f;
#pragma unroll
                    for (int gi = 0; gi < 5; ++gi)
#pragma unroll
                        for (int j = 0; j < 8; ++j) { const int lr = Rw + 32 * gi + 8 * g4 + j, kp = p0_ - 64 + lr, dq = kp - qp; const bool ok = dq >= -64 && dq <= 64 && kp >= 0 && kp < Ld_;
                            const float v = ok ? sc[gi][j >> 2][j & 3] : -1e30f; sc[gi][j >> 2][j & 3] = v; m = fmaxf(m, v); }
                    m = fmaxf(m, __shfl_xor(m, 16)); m = fmaxf(m, __shfl_xor(m, 32));
                    float l = 0.f;
#pragma unroll
                    for (int gi = 0; gi < 5; ++gi) {
#pragma unroll
                        for (int j = 0; j < 8; ++j) { const float sv = sc[gi][j >> 2][j & 3]; const float v = sv > -1e29f ? __builtin_amdgcn_exp2f(sv - m) : 0.f; sc[gi][j >> 2][j & 3] = v; l += v; }
                        pf[gi] = wat::p_frag(sc[gi][0], sc[gi][1]); }
                    l += __shfl_xor(l, 16); l += __shfl_xor(l, 32); linv = 1.0f / l; mrow = m; lrow = l;
#pragma unroll
                    for (int c = 0; c < 8; ++c) o[c] = wat::f32x4{0.f, 0.f, 0.f, 0.f};
                }
                DL_END(u, 1, u + 1, 0);
                {
                    const unsigned vb = (unsigned)(uintptr_t)(L + 65536) + (unsigned)wat::vrd_base(Rw, lane);
                    wat::pv_group<0>(o, vb, pf[0]); wat::pv_group<8192>(o, vb, pf[1]); wat::pv_group<16384>(o, vb, pf[2]); wat::pv_group<24576>(o, vb, pf[3]); wat::pv_group<32768>(o, vb, pf[4]);
                    WAT_LAS char* ost = L + NA_OST_OFF + w * 2304;
                    float li[4];
#pragma unroll
                    for (int r = 0; r < 4; ++r) li[r] = __shfl(linv, 4 * g4 + r);
                    const size_t tok_r = (size_t)(b_ * SEQ + r_) + ((size_t)(p0_ + 16 * w + g4) << sh_);
#pragma unroll
                    for (int hf = 0; hf < 2; ++hf) {
#pragma unroll
                        for (int r = 0; r < 4; ++r)
#pragma unroll
                            for (int c = 0; c < 4; ++c) *(WAT_LAS unsigned short*)(ost + (4 * g4 + r) * 144 + (16 * c + q) * 2) = (unsigned short)(wat::cvtpk(o[4 * hf + c][r] * li[r], 0.f) & 0xffffu);
                        asm volatile("s_waitcnt lgkmcnt(0)" ::: "memory");
#pragma unroll
                        for (int k = 0; k < 2; ++k) { const int rq = g4 + 4 * (2 * k + (q >> 3)); const v4u v = *(const WAT_LAS v4u*)(ost + rq * 144 + (q & 7) * 16);
                            const size_t tk = tok_r + ((size_t)(4 * (2 * k + (q >> 3))) << sh_);
                            *(v4u*)(dpo + ((tk * DIL_HPG + j_) * 3 + g_) * HD + 64 * hf + (q & 7) * 8) = v; }
                        asm volatile("s_waitcnt lgkmcnt(0)" ::: "memory");
                    }
                    if (g4 == 0) { float* pmp = dpm + ((qtok * DIL_HPG + j_) * 3 + g_) * 2; pmp[0] = mrow; pmp[1] = lrow; }
                }
                DL_END(u + 1, 0, u + 1, 1);
            }
#undef DL_GEOM
#undef DL_LOAD
#undef DL_WRITE
#undef DL_END
        }
    }
    SEAM(3);
    if (IN(4)) {
        const float* qn = args.in[7]; const float* kn = args.in[8];
        float gq[12], gk[12];
#pragma unroll
        for (int k = 0; k < 3; ++k)
#pragma unroll
            for (int j = 0; j < 4; ++j) { gq[4 * k + j] = qn[64 * k + 4 * l15 + j] * QS_MLA; gk[4 * k + j] = kn[64 * k + 4 * l15 + j]; }
#pragma unroll 2
        for (int row = F.gw; row < M; row += F.ngw) {
            const int pos = row & (SEQ - 1);
            float cr[4], sr[4];
#pragma unroll
            for (int j = 0; j < 4; ++j) { cr[j] = cosB[pos * 32 + 4 * (l15 & 7) + j]; sr[j] = sinB[pos * 32 + 4 * (l15 & 7) + j]; if (l15 < 8) sr[j] = -sr[j]; }
            const v2u kpe = *(const v2u*)(zb + (size_t)row * ZLD + Z_KPE + 4 * l15);
#pragma unroll
            for (int it = 0; it < 4; ++it) {
                const int h = 4 * it + grp;
                {
                    const bf16* p = kvb + (size_t)row * 4096 + h * 256 + 4 * l15; v2u w[3];
                    w[0] = *(const v2u*)p; w[1] = *(const v2u*)(p + 64); w[2] = kpe;
                    float v[12];
#pragma unroll
                    for (int k = 0; k < 3; ++k) { v[4 * k] = bflo(w[k].x); v[4 * k + 1] = bfhi(w[k].x); v[4 * k + 2] = bflo(w[k].y); v[4 * k + 3] = bfhi(w[k].y); }
                    float s = 0.f;
#pragma unroll
                    for (int e = 0; e < 12; ++e) s += v[e] * v[e];
                    s = sum16(s); const float rs = 1.0f / sqrtf(s * (1.0f / MLA_QK) + NORM_EPS);
#pragma unroll
                    for (int e = 0; e < 12; ++e) v[e] = v[e] * rs * gk[e];
#pragma unroll
                    for (int j = 0; j < 4; ++j) { const float yp = __shfl_xor(v[8 + j], 8); v[8 + j] = v[8 + j] * cr[j] + yp * sr[j]; }
                    bf16* o_ = kb + (size_t)row * 3072 + h * MLA_QK + 4 * l15;
#pragma unroll
                    for (int k = 0; k < 3; ++k) { v2u o; o.x = pk2(v[4 * k], v[4 * k + 1]); o.y = pk2(v[4 * k + 2], v[4 * k + 3]); *(v2u*)(o_ + 64 * k) = o; }
                }
            }
#pragma unroll
            for (int it = 0; it < 2; ++it) {
                const int jh = 4 * it + grp; const size_t pb = ((size_t)row * DIL_HPG + jh) * 3;
                const float m0 = dpm[pb * 2 + 0], l0 = dpm[pb * 2 + 1], m1 = dpm[pb * 2 + 2], l1 = dpm[pb * 2 + 3], m2 = dpm[pb * 2 + 4], l2 = dpm[pb * 2 + 5];
                const float mm = fmaxf(m0, fmaxf(m1, m2)); const float w0 = __builtin_amdgcn_exp2f(m0 - mm) * l0, w1 = __builtin_amdgcn_exp2f(m1 - mm) * l1, w2 = __builtin_amdgcn_exp2f(m2 - mm) * l2;
                const float rw = 1.0f / (w0 + w1 + w2);
                float a0[8], a1[8], a2[8], x[8];
                unpack8(*(const v4u*)(dpo + (pb + 0) * HD + 8 * l15), a0); unpack8(*(const v4u*)(dpo + (pb + 1) * HD + 8 * l15), a1); unpack8(*(const v4u*)(dpo + (pb + 2) * HD + 8 * l15), a2);
#pragma unroll
                for (int j = 0; j < 8; ++j) x[j] = (w0 * a0[j] + w1 * a1[j] + w2 * a2[j]) * rw;
                *(v4u*)(omix + (size_t)row * 3072 + 2048 + jh * HD + 8 * l15) = pack8(x);
            }
        }
    }
    SEAM(4);
    if (IN(5)) {
        for (int i = 0; i * F.G + (int)blockIdx.x < BATCH * MLA_H * (SEQ / 256); ++i) {
            const int c = (int)blockIdx.x; int bh = i * 8 + (c & 7), qblk = c >> 3;
            if (F.G != 256) { const int u = i * F.G + c; bh = u >> 5; qblk = u & 31; }
            const int b = bh >> 4, h = bh & 15; const size_t r0 = (size_t)b * SEQ;
            MLA_UNIT(qb + (r0 + (size_t)qblk * 256) * 3072 + h * MLA_QK, kb + r0 * 3072 + h * MLA_QK, kvb + r0 * 4096 + h * 256 + 128,
                              omix + (r0 + (size_t)qblk * 256) * 3072 + h * HD, SEQ, (char*)lds, args.in[7], QS_MLA, NORM_EPS, cosB, sinB, qblk * 256);
        }
    }
    SEAM(5);
    if (IN(6)) {
        pg8::Gemm g{omix, Weout_t, M, DM, EVEN_MIX, EVEN_MIX}; pg8::StaticOrder S; S.init(M, DM, F.G, (int)blockIdx.x); pg8::EpiResidT<0> E{x_in, out, xb, xl0, xl1, ss, DM};
        pg8::gemm_phase<pg8::EpiResidT<0>, pg8::StaticOrder, true, true>(F.lds, g, S, E);
    }
    SEAM(6);
#define RSTD_PHASE() do { for (int row = F.gw; row < M; row += F.ngw) { const float s = wave_sum(ss[(size_t)row * 64 + lane]); if (lane == 0) rstd[row] = 1.0f / sqrtf(s * (1.0f / DM) + NORM_EPS); } } while (0)
#define RSTD_LOCAL() do { const int pm_lo = F.G == 256 ? 8 * ((int)blockIdx.x & 7) + (((int)blockIdx.x >> 3) & 7) : 0, pm_hi = F.G == 256 ? pm_lo + 1 : M / 256; \
        for (int pmi = pm_lo; pmi < pm_hi; ++pmi) { const int row = pmi * 256 + (F.tid >> 1); const f32x4* sp = (const f32x4*)(ss + (size_t)row * 64) + (F.tid & 1) * 8; \
            const f32x4 a = ((sp[0] + sp[1]) + (sp[2] + sp[3])) + ((sp[4] + sp[5]) + (sp[6] + sp[7])); float tot = (a[0] + a[1]) + (a[2] + a[3]); tot += __shfl_xor(tot, 1); \
            if ((F.tid & 1) == 0) rstd[row] = 1.0f / sqrtf(tot * (1.0f / DM) + NORM_EPS); } \
        asm volatile("s_waitcnt vmcnt(0)" ::: "memory"); __syncthreads(); } while (0)
#define FFN_GATEUP(layer) do { const bf16* wl = (const bf16*)(ws + WS_WFFN + (size_t)(layer) * 3 * FFN_W_BYTES); \
        pg8::Gemm g{xb, wl, M, 2 * DFF, DM, DM}; pg8::StaticOrder S; S.init(M, 2 * DFF, F.G, (int)blockIdx.x, DM / 64, (float*)(R + (size_t)(16 + 48 * (layer)) * MiB), ctl + 8192 + 2048 * (1 + (layer))); \
        pg8::EpiGateUp E{h2b, rstd, args.in[21] + (size_t)(layer) * 3 * DFF, args.in[22] + (size_t)(layer) * DFF, DFF, aedge, uedge, (PG8_LAS float*)(F.lds + NA_TB_OFF)}; \
        pg8::gemm_phase<pg8::EpiGateUp, pg8::StaticOrder, true, true, true>(F.lds, g, S, E); } while (0)
#define FFN_FIX(layer) do { const float* cwp = args.in[21] + (size_t)(layer) * 3 * DFF; const float* cbp = args.in[22] + (size_t)(layer) * DFF; \
        const int pm_lo = F.G == 256 ? 8 * ((int)blockIdx.x & 7) + (((int)blockIdx.x >> 3) & 7) : 0, pm_hi = F.G == 256 ? pm_lo + 1 : M / 256; \
        for (int i = pm_lo * 2 * (DFF / 8) + F.tid; i < pm_hi * 2 * (DFF / 8); i += NWAVES * 64) { const int c8 = i % (DFF / 8), e = (i / (DFF / 8)) & 1, pm = i / (2 * (DFF / 8)); const int ch = c8 * 8; \
            const int row = pm * 256 + (e ? 255 : 0), t = row & (SEQ - 1); const v4u z4 = {0u, 0u, 0u, 0u}; \
            const v4u cur = *(const v4u*)(aedge + ((size_t)pm * 4 + (e ? 3 : 0)) * DFF + ch); \
            const v4u prv = e ? *(const v4u*)(aedge + ((size_t)pm * 4 + 2) * DFF + ch) : (t > 0 ? *(const v4u*)(aedge + ((size_t)(pm - 1) * 4 + 3) * DFF + ch) : z4); \
            const v4u nxt = e ? (t < SEQ - 1 ? *(const v4u*)(aedge + ((size_t)(pm + 1) * 4 + 0) * DFF + ch) : z4) : *(const v4u*)(aedge + ((size_t)pm * 4 + 1) * DFF + ch); \
            const v4u upv = *(const v4u*)(uedge + ((size_t)pm * 2 + e) * DFF + ch); \
            const unsigned cu_[4] = {cur.x, cur.y, cur.z, cur.w}, pr_[4] = {prv.x, prv.y, prv.z, prv.w}, nx_[4] = {nxt.x, nxt.y, nxt.z, nxt.w}, up_[4] = {upv.x, upv.y, upv.z, upv.w}; \
            float hv[8]; \
            _Pragma("unroll") for (int j = 0; j < 8; ++j) { \
                const float fm = (j & 1) ? bfhi(pr_[j >> 1]) : bflo(pr_[j >> 1]), fz = (j & 1) ? bfhi(cu_[j >> 1]) : bflo(cu_[j >> 1]), fn = (j & 1) ? bfhi(nx_[j >> 1]) : bflo(nx_[j >> 1]), fu = (j & 1) ? bfhi(up_[j >> 1]) : bflo(up_[j >> 1]); \
                const float gg = cwp[ch + j] * fm + cwp[DFF + ch + j] * fz + cwp[2 * DFF + ch + j] * fn + cbp[ch + j]; \
                const float ee = __builtin_amdgcn_exp2f(-1.4426950408889634f * gg); hv[j] = gg * __builtin_amdgcn_rcpf(1.0f + ee) * fu; } \
            v4u o; o.x = pk2(hv[0], hv[1]); o.y = pk2(hv[2], hv[3]); o.z = pk2(hv[4], hv[5]); o.w = pk2(hv[6], hv[7]); \
            *(v4u*)(h2b + (size_t)row * DFF + ch) = o; } \
        asm volatile("s_waitcnt vmcnt(0)" ::: "memory"); __syncthreads(); } while (0)
#define FFN_DOWN(layer) do { const bf16* wl = (const bf16*)(ws + WS_WFFN + (size_t)(layer) * 3 * FFN_W_BYTES + 2 * FFN_W_BYTES); \
        pg8::Gemm g{h2b, wl, M, DM, DFF, DFF}; pg8::StaticOrder S; S.init(M, DM, F.G, (int)blockIdx.x); pg8::EpiResidT<(layer) == 0 ? 1 : 2> E{nullptr, out, xb, xl0, xl1, ss, DM}; \
        pg8::gemm_phase<pg8::EpiResidT<(layer) == 0 ? 1 : 2>, pg8::StaticOrder, true, true>(F.lds, g, S, E); } while (0)
    if (IN(8)) { RSTD_LOCAL(); FFN_GATEUP(0); }
    SEAM(8);
#if MK_CHECK
    if (IN(9)) FFN_FIX(0);
    if (IN(10)) FFN_DOWN(0);
#else
    if (IN(10)) { FFN_FIX(0); FFN_DOWN(0); }
#endif
    SEAM(10);
    if (IN(12)) {
        RSTD_LOCAL();
        pg8::Gemm g{xb, Wqkv_t, M, 12288, DM, DM}; pg8::StaticOrder S; S.init(M, 12288, F.G, (int)blockIdx.x); pg8::EpiHeadNorm E{qkvb, 12288, rstd, args.in[14], args.in[15], QS_HD, 16, 16, (PG8_LAS float*)(F.lds + NA_TB_OFF), nullptr, nullptr, SEQ};
        pg8::gemm_phase<pg8::EpiHeadNorm, pg8::StaticOrder, true, true>(F.lds, g, S, E);
    }
    SEAM(12);
    if (IN(14)) {
        const float* rpb = args.in[16];
        WAT_LAS char* L = (WAT_LAS char*)F.lds;
        WAT_LAS float* tb = (WAT_LAS float*)(L + NA_TB_OFF);
        const int NU = BATCH * NA_H * GRID_ROWS;
        const int u0 = (int)(((long)NU * blockIdx.x) / F.G), u1 = (int)(((long)NU * (blockIdx.x + 1)) / F.G);
        const int row16 = F.tid >> 4, ch16 = F.tid & 15, kso = wat::kst_off(row16, ch16), vso = wat::vst_off(row16, ch16);
        const int w = F.wave, q = lane & 15, g4 = lane >> 4;
        const int cg = w & 3, kc0 = min(max(16 * cg - 8, 0), 32), gc = 16 * cg + q, cs = min(max(gc - 8, 0), 48);
        unsigned vmask = 0;
#pragma unroll
        for (int j = 0; j < 8; ++j) { const int kc = kc0 + 8 * g4 + j; if (kc >= cs && kc < cs + 16) vmask |= 1u << j; }
        const int bcol = kc0 + 8 * g4 - gc + 15;
        v4u st[8]; int cur_h = -1;
#define NA_GEOM(u_, s_) const int bh_ = (u_) >> 7, i_ = (u_) & 127, b_ = bh_ >> 5, h_ = bh_ & 31, rs_ = min(max(i_ - 4, 0), GRID_ROWS - 8); \
        const bf16* src_ = qkvb + (size_t)(b_ * SEQ + (rs_ + 4 * ((s_) & 1)) * GRID_W + row16) * 12288 + ((s_) < 2 ? 4096 : 8192) + h_ * HD + ch16 * 8;
#define NA_LOAD(u_, s_) do { NA_GEOM(u_, s_) _Pragma("unroll") for (int k = 0; k < 8; ++k) st[k] = *(const v4u*)(src_ + (size_t)k * 32 * 12288); } while (0)
#define NA_WRITE(s_) do { WAT_LAS char* d_ = L + ((s_) & 1) * 65536 + ((s_) < 2 ? kso : vso); _Pragma("unroll") for (int k = 0; k < 8; ++k) *(WAT_LAS v4u*)(d_ + k * 32 * 256) = st[k]; } while (0)
#define NA_END(un_, sn_, un2_, sn2_) do { if ((un_) < u1) { VM_WAIT(); NA_WRITE(sn_); } __syncthreads(); if ((un2_) < u1) NA_LOAD(un2_, sn2_); } while (0)
        if (u0 < u1) { NA_LOAD(u0, 0); VM_WAIT(); NA_WRITE(0); __syncthreads(); NA_LOAD(u0, 1); }
        for (int u = u0; u < u1; ++u) {
            const int bh = u >> 7, gi = u & 127, b = bh >> 5, h = bh & 31, rs0 = min(max(gi - 4, 0), GRID_ROWS - 8);
            wat::bf16x8 qf[4]; wat::f32x4 sc[8][2]; wat::bf16x8 pf[8]; wat::f32x4 o[8]; float linv = 0.f;
            if (h != cur_h) { for (int t = F.tid; t < 465; t += NWAVES * 64) tb[t] = rpb[(size_t)h * 465 + t] * LOG2E; cur_h = h; }
            if (w < 4) {
                const bf16* qp = qkvb + (size_t)(b * SEQ + gi * GRID_W + gc) * 12288 + h * HD + 8 * g4;
#pragma unroll
                for (int s = 0; s < 4; ++s) qf[s] = *(const wat::bf16x8*)(qp + 32 * s);
#pragma unroll
                for (int g = 0; g < 4; ++g) wat::qk_group(sc[g][0], sc[g][1], L, g * 64 + kc0, qf, lane);
            }
            NA_END(u, 1, u, 2);
            if (w < 4) {
#pragma unroll
                for (int g = 0; g < 4; ++g) wat::qk_group(sc[4 + g][0], sc[4 + g][1], L + 65536, g * 64 + kc0, qf, lane);
                float m = -1e30f;
#pragma unroll
                for (int kr = 0; kr < 8; ++kr) { const WAT_LAS float* tr_ = tb + (rs0 + kr - gi + NA_ROWS - 1) * 31 + bcol;
#pragma unroll
                    for (int j = 0; j < 8; ++j) { const bool ok = (vmask >> j) & 1u; const float bias = ok ? tr_[j] : 0.f; const float v = ok ? sc[kr][j >> 2][j & 3] + bias : -1e30f; sc[kr][j >> 2][j & 3] = v; m = fmaxf(m, v); } }
                m = fmaxf(m, __shfl_xor(m, 16)); m = fmaxf(m, __shfl_xor(m, 32));
                float l = 0.f;
#pragma unroll
                for (int kr = 0; kr < 8; ++kr) {
#pragma unroll
                    for (int j = 0; j < 8; ++j) { const float v = ((vmask >> j) & 1u) ? __builtin_amdgcn_exp2f(sc[kr][j >> 2][j & 3] - m) : 0.f; sc[kr][j >> 2][j & 3] = v; l += v; }
                    pf[kr] = wat::p_frag(sc[kr][0], sc[kr][1]); }
                l += __shfl_xor(l, 16); l += __shfl_xor(l, 32); linv = 1.0f / l;
#pragma unroll
                for (int c = 0; c < 8; ++c) o[c] = wat::f32x4{0.f, 0.f, 0.f, 0.f};
            }
            NA_END(u, 2, u, 3);
            if (w < 4) {
                { const unsigned vb = (unsigned)(uintptr_t)L + (unsigned)wat::vrd_base(kc0, lane); wat::pv_group<0>(o, vb, pf[0]); wat::pv_group<16384>(o, vb, pf[1]); wat::pv_group<32768>(o, vb, pf[2]); wat::pv_group<49152>(o, vb, pf[3]); }
            }
            NA_END(u, 3, u + 1, 0);
            if (w < 4) {
                { const unsigned vb = (unsigned)(uintptr_t)(L + 65536) + (unsigned)wat::vrd_base(kc0, lane); wat::pv_group<0>(o, vb, pf[4]); wat::pv_group<16384>(o, vb, pf[5]); wat::pv_group<32768>(o, vb, pf[6]); wat::pv_group<49152>(o, vb, pf[7]); }
                WAT_LAS char* ost = L + NA_OST_OFF + w * 4352;
#pragma unroll
                for (int r = 0; r < 4; ++r) { const float li = __shfl(linv, 4 * g4 + r);
#pragma unroll
                    for (int c = 0; c < 8; ++c) *(WAT_LAS unsigned short*)(ost + (4 * g4 + r) * 272 + (16 * c + q) * 2) = (unsigned short)(wat::cvtpk(o[c][r] * li, 0.f) & 0xffffu); }
                asm volatile("s_waitcnt lgkmcnt(0)" ::: "memory");
#pragma unroll
                for (int k = 0; k < 4; ++k) { const int rq = g4 + 4 * k; const v4u v = *(const WAT_LAS v4u*)(ost + rq * 272 + q * 16);
                    *(v4u*)(ob + (size_t)(b * SEQ + gi * GRID_W + 16 * cg + rq) * DM + h * HD + q * 8) = v; }
            }
            NA_END(u + 1, 0, u + 1, 1);
        }
#undef NA_GEOM
#undef NA_LOAD
#undef NA_WRITE
#undef NA_END
    }
    SEAM(14);
    if (IN(15)) {
        pg8::Gemm g{ob, Woout_t, M, DM, DM, DM}; pg8::StaticOrder S; S.init(M, DM, F.G, (int)blockIdx.x); pg8::EpiResidT<1> E{nullptr, out, xb, xl0, xl1, ss, DM};
        pg8::gemm_phase<pg8::EpiResidT<1>, pg8::StaticOrder, true, true>(F.lds, g, S, E);
    }
    SEAM(15);
    if (IN(17)) { RSTD_LOCAL(); FFN_GATEUP(1); }
    SEAM(17);
#if MK_CHECK
    if (IN(18)) FFN_FIX(1);
    if (IN(19)) FFN_DOWN(1);
#else
    if (IN(19)) { FFN_FIX(1); FFN_DOWN(1); }
#endif
#undef IN
#undef SEAM
}

#if MK_CHECK
constexpr size_t WS_CHK = 9 * MiB;
constexpr int NS = 32;
__device__ const int g_rows[16] = {0, 1, 63, 64, 65, 127, 128, 4095, 4096, 8190, 8191, 8192, 8193, 8255, 16382, 16383};
__device__ __forceinline__ int srow(int i) { return i < 16 ? g_rows[i] : (int)(((unsigned)i * 2654435761u >> 9) % (unsigned)M); }
__device__ __forceinline__ int scol(int j, int N) { return j == 0 ? 0 : (j == 1 ? N - 1 : (int)(((unsigned)j * 2246822519u + 12345u) % (unsigned)N)); }
__device__ __forceinline__ float bf2f(bf16 b) { return __uint_as_float((unsigned)b << 16); }
__device__ __forceinline__ void chk_rec(unsigned* w, int c, float got, float ref, float scale) {
    float e = fabsf(got - ref) / (0.03f * (fabsf(ref) + scale)); if (!(e == e) || !(e < 1e30f)) e = 1e30f;
    atomicMax(&w[c], __float_as_uint(e));
}
__device__ __forceinline__ float dot_bf(const bf16* a, const bf16* b, int K) { float s = 0.f; for (int k = 0; k < K; ++k) s += bf2f(a[k]) * bf2f(b[k]); return s; }
__global__ void k_chk_gemm(const bf16* A, int lda, const bf16* Bt, int K, int N, const float* rs, const float* base, int base_ld, int base_by_sample,
                           const bf16* got_b, const float* got_f, int ldo, unsigned* w, int c, float scale) {
    const int i = blockIdx.x, j = threadIdx.x, row = srow(i), col = scol(j, N);
    float ref = dot_bf(A + (size_t)row * lda, Bt + (size_t)col * K, K); if (rs) ref *= rs[row];
    if (base) ref += base_by_sample == 2 ? bf2f(((const bf16*)base)[(size_t)i * base_ld + col]) : base[(size_t)(base_by_sample ? i : row) * base_ld + col];
    const float got = got_b ? bf2f(got_b[(size_t)row * ldo + col]) : got_f[(size_t)row * ldo + col];
    chk_rec(w, c, got, ref, scale);
}
__global__ void k_chk_copy(const unsigned char* src, size_t row_bytes, unsigned char* dst) {
    const int i = blockIdx.x, row = srow(i); for (size_t b = threadIdx.x * 4; b < row_bytes; b += blockDim.x * 4) *(unsigned*)(dst + (size_t)i * row_bytes + b) = *(const unsigned*)(src + (size_t)row * row_bytes + b);
}
__global__ void k_chk_rstd(const float* src, const float* rstd, const bf16* xb, unsigned* w, int c) {
    const int i = blockIdx.x * blockDim.x + threadIdx.x; if (i >= NS) return; const int row = srow(i); float s = 0.f;
    for (int k = 0; k < DM; ++k) { const float v = src[(size_t)row * DM + k]; s += v * v; }
    chk_rec(w, c, rstd[row], 1.0f / sqrtf(s / DM + NORM_EPS), 0.f);
    if (xb) for (int k = 0; k < DM; k += 97) chk_rec(w, c, bf2f(xb[(size_t)row * DM + k]), src[(size_t)row * DM + k], 0.01f);
}
__global__ void k_chk_w(const float* W, int K, int N, const bf16* dst, const float* gain, int mode, unsigned* w, int c) {
    const unsigned t = blockIdx.x * blockDim.x + threadIdx.x; const int k = (int)((t * 2654435761u >> 7) % (unsigned)K), n = scol((int)t, N);
    const int dr = (mode == 1) ? (n >= 1472 ? n - 1472 : n + 9216) : (mode >= 2 ? (n >> 7) * 256 + (n & 127) + (mode == 3 ? 128 : 0) : n); float ref = W[(size_t)k * N + n]; if (gain) ref *= gain[k];
    chk_rec(w, c, bf2f(dst[(size_t)dr * K + k]), ref, 1e-4f);
}
__global__ void k_chk_rope(const float* cosT, const float* sinT, int half, double c1, unsigned* w, int c) {
    const int t = blockIdx.x * blockDim.x + threadIdx.x; const int k = t % half; int pos = 1 + (int)(((unsigned)t * 2654435761u >> 8) % (unsigned)(SEQ - 1));
    double p = 1.0; for (int j = 0; j < k; ++j) p *= c1; const double th = (double)(float)p;
    double sn = 0, cs = 0, term = 1.0; for (int n = 0; n < 24; ++n) { if (n & 1) sn += ((n >> 1) & 1 ? -term : term); else cs += ((n >> 1) & 1 ? -term : term); term *= th / (n + 1); }
    chk_rec(w, c, cosT[1 * half + k], (float)cs, 0.02f); chk_rec(w, c, sinT[1 * half + k], (float)sn, 0.02f);
    chk_rec(w, c, cosT[k], 1.f, 0.02f); chk_rec(w, c, sinT[k], 0.f, 0.02f);
    const float ca = cosT[(pos - 1) * half + k], sa = sinT[(pos - 1) * half + k], c1f = cosT[half + k], s1f = sinT[half + k];
    chk_rec(w, c, cosT[pos * half + k], ca * c1f - sa * s1f, 0.03f); chk_rec(w, c, sinT[pos * half + k], sa * c1f + ca * s1f, 0.03f);
}
__global__ void k_chk_p2(const bf16* zc, const bf16* z, const bf16* cqn, const bf16* ckvn, const float* dqn, const float* dkn, const float* cosA, const float* sinA, unsigned* w, int c) {
    const int i = blockIdx.x, t = threadIdx.x, row = srow(i), pos = row & (SEQ - 1); const bf16* src = zc + (size_t)i * ZLD;
    if (false) { const bf16* p = src + t * HD; float s = 0.f; for (int d = 0; d < HD; ++d) s += bf2f(p[d]) * bf2f(p[d]);
        const float rs = 1.0f / sqrtf(s / HD + NORM_EPS); const float* g = t < 24 ? dqn : dkn; const float qs = t < 24 ? QS_HD : 1.f;
        for (int d = 0; d < HD; ++d) { float y = bf2f(p[d]) * rs * g[d];
            if (d < 16) y = y * cosA[pos * 16 + d] - bf2f(p[d + 16]) * rs * g[d + 16] * sinA[pos * 16 + d];
            else if (d < 32) y = y * cosA[pos * 16 + d - 16] + bf2f(p[d - 16]) * rs * g[d - 16] * sinA[pos * 16 + d - 16];
            chk_rec(w, c, bf2f(z[(size_t)row * ZLD + t * HD + d]), y * qs, 0.05f * qs); } }
    else if (t == 48) { float s = 0.f; for (int d = 0; d < QRANK; ++d) s += bf2f(src[Z_CQ + d]) * bf2f(src[Z_CQ + d]); const float rs = 1.0f / sqrtf(s / QRANK + NORM_EPS);
        for (int d = 0; d < QRANK; ++d) chk_rec(w, c, bf2f(cqn[(size_t)row * QRANK + d]), bf2f(src[Z_CQ + d]) * rs, 0.05f); }
    else if (t == 49) { float s = 0.f; for (int d = 0; d < KVRANK; ++d) s += bf2f(src[Z_CKV + d]) * bf2f(src[Z_CKV + d]); const float rs = 1.0f / sqrtf(s / KVRANK + NORM_EPS);
        for (int d = 0; d < KVRANK; ++d) chk_rec(w, c, bf2f(ckvn[(size_t)row * KVRANK + d]), bf2f(src[Z_CKV + d]) * rs, 0.05f); }
}
__global__ void k_chk_p4(const bf16* qc, bf16* qn_out, const bf16* kv, const bf16* z, const bf16* kout, const float* qn, const float* kn, const float* cosB, const float* sinB, unsigned* w, int c) {
    const int i = blockIdx.x, t = threadIdx.x, row = srow(i), pos = row & (SEQ - 1), h = t & 15; const bool isk = t >= 16;
    float s = 0.f;
    for (int d = 0; d < MLA_QK; ++d) { const float v = isk ? (d < 128 ? bf2f(kv[(size_t)row * 4096 + h * 256 + d]) : bf2f(z[(size_t)row * ZLD + Z_KPE + d - 128])) : bf2f(qc[(size_t)i * 3072 + h * MLA_QK + d]); s += v * v; }
    const float rs = 1.0f / sqrtf(s / MLA_QK + NORM_EPS); const float* g = isk ? kn : qn; const float qs = isk ? 1.f : QS_MLA;
    for (int d = 0; d < MLA_QK; ++d) {
        auto val = [&](int dd) { return (isk ? (dd < 128 ? bf2f(kv[(size_t)row * 4096 + h * 256 + dd]) : bf2f(z[(size_t)row * ZLD + Z_KPE + dd - 128])) : bf2f(qc[(size_t)i * 3072 + h * MLA_QK + dd])) * rs * g[dd]; };
        float y = val(d);
        if (d >= 128 && d < 160) y = y * cosB[pos * 32 + d - 128] - val(d + 32) * sinB[pos * 32 + d - 128];
        else if (d >= 160) y = y * cosB[pos * 32 + d - 160] + val(d - 32) * sinB[pos * 32 + d - 160];
        if (!isk) { qn_out[(size_t)i * 3072 + h * MLA_QK + d] = (bf16)f2bf(y * qs); continue; }
        chk_rec(w, c, bf2f(kout[(size_t)row * 3072 + h * MLA_QK + d]), y * qs, 0.05f * qs); }
}
__global__ void k_chk_mla(const bf16* q, const bf16* k, const bf16* kv, const bf16* omix, unsigned* w, int c) {
    const int i = blockIdx.x, t = threadIdx.x, row = srow(i), b0 = row & ~(SEQ - 1), h = (i * 7 + 3) & 15, d = (t * 37 + i) & 127;
    const bf16* qp = q + (size_t)i * 3072 + h * MLA_QK; float m = -1e30f;
    for (int key = 0; key < SEQ; ++key) m = fmaxf(m, dot_bf(qp, k + (size_t)(b0 + key) * 3072 + h * MLA_QK, MLA_QK));
    float l = 0.f, o = 0.f, o2 = 0.f;
    for (int key = 0; key < SEQ; ++key) { const float p = exp2f(dot_bf(qp, k + (size_t)(b0 + key) * 3072 + h * MLA_QK, MLA_QK) - m); const float v = bf2f(kv[(size_t)(b0 + key) * 4096 + h * 256 + 128 + d]); l += p; o += p * v; o2 += p * v * v; }
    chk_rec(w, c, bf2f(omix[(size_t)row * 3072 + h * HD + d]), o / l, 0.5f * sqrtf(o2 / l) * 0.1f + 1e-3f);
}
__global__ void k_chk_dil(const bf16* z, const bf16* omix, unsigned* w, int c) {
    const int i = blockIdx.x, t = threadIdx.x, row = srow(i), b0 = row & ~(SEQ - 1), pos = row & (SEQ - 1), j = (i * 5 + 1) & 7, d = (t * 37 + i) & 127;
    float m = -1e30f;
    for (int g = 0; g < 3; ++g) { const int dl = 1 << (2 * g), head = 8 * g + j; for (int tt = -64; tt <= 64; ++tt) { const int kp = pos + dl * tt; if (kp < 0 || kp >= SEQ) continue;
        m = fmaxf(m, dot_bf(z + (size_t)row * ZLD + head * HD, z + (size_t)(b0 + kp) * ZLD + 3072 + head * HD, HD)); } }
    float l = 0.f, o = 0.f;
    for (int g = 0; g < 3; ++g) { const int dl = 1 << (2 * g), head = 8 * g + j; for (int tt = -64; tt <= 64; ++tt) { const int kp = pos + dl * tt; if (kp < 0 || kp >= SEQ) continue;
        const float p = exp2f(dot_bf(z + (size_t)row * ZLD + head * HD, z + (size_t)(b0 + kp) * ZLD + 3072 + head * HD, HD) - m); l += p; o += p * bf2f(z[(size_t)(b0 + kp) * ZLD + 6144 + head * HD + d]); } }
    chk_rec(w, c, bf2f(omix[(size_t)row * 3072 + 2048 + j * HD + d]), o / l, 0.02f);
}
__global__ void k_chk_na(const bf16* qkv, const float* rpb, const bf16* ob, unsigned* w, int c) {
    const int i = blockIdx.x, t = threadIdx.x, row = srow(i), b0 = row & ~(SEQ - 1), pos = row & (SEQ - 1), gi = pos >> 6, gc = pos & 63, h = (i * 11 + 5) & 31, d = (t * 37 + i) & 127;
    const int rs0 = min(max(gi - 4, 0), GRID_ROWS - 8), cs0 = min(max(gc - 8, 0), 48); float m = -1e30f;
    for (int kr = 0; kr < 8; ++kr) for (int kc = 0; kc < 16; ++kc) { const int key = b0 + (rs0 + kr) * 64 + cs0 + kc;
        m = fmaxf(m, dot_bf(qkv + (size_t)row * 12288 + h * HD, qkv + (size_t)key * 12288 + 4096 + h * HD, HD) + rpb[(size_t)h * 465 + (rs0 + kr - gi + 7) * 31 + (cs0 + kc - gc + 15)] * LOG2E); }
    float l = 0.f, o = 0.f;
    for (int kr = 0; kr < 8; ++kr) for (int kc = 0; kc < 16; ++kc) { const int key = b0 + (rs0 + kr) * 64 + cs0 + kc;
        const float p = exp2f(dot_bf(qkv + (size_t)row * 12288 + h * HD, qkv + (size_t)key * 12288 + 4096 + h * HD, HD) + rpb[(size_t)h * 465 + (rs0 + kr - gi + 7) * 31 + (cs0 + kc - gc + 15)] * LOG2E - m);
        l += p; o += p * bf2f(qkv[(size_t)key * 12288 + 8192 + h * HD + d]); }
    chk_rec(w, c, bf2f(ob[(size_t)row * DM + h * HD + d]), o / l, 0.03f);
}
__global__ void k_chk_p13(const bf16* qc, const bf16* qkv, const float* qn, const float* kn, unsigned* w, int c) {
    const int i = blockIdx.x, t = threadIdx.x, row = srow(i); const bf16* p = qc + (size_t)i * 12288 + t * HD; float s = 0.f;
    for (int d = 0; d < HD; ++d) s += bf2f(p[d]) * bf2f(p[d]);
    const float rs = 1.0f / sqrtf(s / HD + NORM_EPS); const float* g = t < 32 ? qn : kn; const float qs = t < 32 ? QS_HD : 1.f;
    for (int d = 0; d < HD; ++d) chk_rec(w, c, bf2f(qkv[(size_t)row * 12288 + t * HD + d]), bf2f(p[d]) * rs * g[d] * qs, 0.05f * qs);
}
__global__ void k_chk_qkvn(const bf16* xb, const bf16* Wt, const float* rstd, const bf16* qkv, const float* qn, const float* kn, unsigned* w, int c) {
    const int i = blockIdx.x, t = threadIdx.x, row = srow(i), head = (t * 7 + i) % 96, d = (t * 37 + i * 5) & 127; float s = 0.f, mine = 0.f;
    for (int dd = 0; dd < HD; ++dd) { const float v = dot_bf(xb + (size_t)row * DM, Wt + (size_t)(head * HD + dd) * DM, DM) * rstd[row]; s += v * v; if (dd == d) mine = v; }
    float ref = mine; if (head < 64) { const float rs = 1.0f / sqrtf(s / HD + NORM_EPS); ref = mine * rs * (head < 32 ? qn[d] * QS_HD : kn[d]); }
    chk_rec(w, c, bf2f(qkv[(size_t)row * 12288 + head * HD + d]), ref, head < 32 ? 0.05f * QS_HD : 0.05f);
}
__global__ void k_chk_zn(const bf16* xb, const bf16* Wt, const float* rstd, const bf16* z, const float* dqn, const float* dkn, const float* cosA, const float* sinA, unsigned* w, int c) {
    const int i = blockIdx.x, t = threadIdx.x, row = srow(i), pos = row & (SEQ - 1);
    if (t < 48) { const int d = (t * 37 + i * 5) & 127; const int dp = d < 16 ? d + 16 : (d < 32 ? d - 16 : d); float s = 0.f, mine = 0.f, other = 0.f;
        for (int dd = 0; dd < HD; ++dd) { const float v = dot_bf(xb + (size_t)row * DM, Wt + (size_t)(t * HD + dd) * DM, DM) * rstd[row]; s += v * v; if (dd == d) mine = v; if (dd == dp) other = v; }
        const float rs = 1.0f / sqrtf(s / HD + NORM_EPS); const float* g = t < 24 ? dqn : dkn; const float qs = t < 24 ? QS_HD : 1.f;
        float y = mine * rs * g[d]; const float yo = other * rs * g[dp];
        if (d < 16) y = y * cosA[pos * 16 + d] - yo * sinA[pos * 16 + d]; else if (d < 32) y = y * cosA[pos * 16 + d - 16] + yo * sinA[pos * 16 + d - 16];
        chk_rec(w, c, bf2f(z[(size_t)row * ZLD + t * HD + d]), y * qs, 0.05f * qs); }
    else { const int col = 6144 + scol(t, 10688 - 6144); const float ref = dot_bf(xb + (size_t)row * DM, Wt + (size_t)col * DM, DM) * rstd[row]; chk_rec(w, c, bf2f(z[(size_t)row * ZLD + col]), ref, 0.05f); }
}
__global__ void k_chk_up(const bf16* xb, const bf16* Wgu, const float* rstd, const float* cw, const float* cb, const bf16* h2, unsigned* w, int c) {
    const int i = blockIdx.x, j = threadIdx.x, col = scol(j, DFF); int row = srow(i); if (i & 1) row = (row & ~255) + ((i & 2) ? 255 : 0) + ((i & 4) ? ((i & 2) ? -1 : 1) : 0);
    const int cls = i < 16 ? 42 + i : 58 + (i & 1);
    const int t = row & (SEQ - 1); const bf16* wg = Wgu + (size_t)((col >> 7) * 256 + (col & 127)) * DM; const bf16* wu = wg + (size_t)128 * DM;
    const bool edge = (row & 255) == 0 || (row & 255) == 255;
    auto rd = [&](float v) { return edge ? __uint_as_float(f2bf(v) << 16) : v; };
    const float up = rd(dot_bf(xb + (size_t)row * DM, wu, DM) * rstd[row]);
    float g = cb[col] + cw[DFF + col] * rd(dot_bf(xb + (size_t)row * DM, wg, DM) * rstd[row]);
    if (t > 0) g += cw[col] * rd(dot_bf(xb + (size_t)(row - 1) * DM, wg, DM) * rstd[row - 1]); if (t < SEQ - 1) g += cw[2 * DFF + col] * rd(dot_bf(xb + (size_t)(row + 1) * DM, wg, DM) * rstd[row + 1]);
    const float ref = g / (1.0f + expf(-g)) * up;
    chk_rec(w, cls, bf2f(h2[(size_t)row * DFF + col]), ref, 0.05f);
}
__global__ void k_chk_rq(const bf16* z, const float* rq, const float* rkv, unsigned* w, int c) {
    const int i = blockIdx.x * blockDim.x + threadIdx.x; if (i >= NS) return; const int row = srow(i); const bf16* src = z + (size_t)row * ZLD; float s = 0.f, t = 0.f;
    for (int d = 0; d < QRANK; ++d) s += bf2f(src[Z_CQ + d]) * bf2f(src[Z_CQ + d]);
    for (int d = 0; d < KVRANK; ++d) t += bf2f(src[Z_CKV + d]) * bf2f(src[Z_CKV + d]);
    chk_rec(w, c, rq[row], 1.0f / sqrtf(s / QRANK + NORM_EPS), 0.f); chk_rec(w, c, rkv[row], 1.0f / sqrtf(t / KVRANK + NORM_EPS), 0.f);
}
__global__ void k_chk_final(unsigned* w, float* out) {
    if (threadIdx.x != 0 || blockIdx.x != 0) return;
    for (int c = 0; c < 64; ++c) { const float e = __uint_as_float(w[c]); if (e > 1.0f) { int b = 0; float x = e; while (x >= 10.f && b < 20) { x *= 0.1f; ++b; } float V = (float)(10 + c) * 100.f; for (int q = 0; q < b; ++q) V *= 10.f; out[0] = V; return; } }
}
#endif
#ifndef MK_ONE_LAUNCH
#define MK_ONE_LAUNCH 1
#endif
extern "C" void kernel_launch(void* const* d_in, const int* in_sizes, int n_in, void* d_out, int out_size, void* d_ws, size_t ws_size, hipStream_t stream) {
    static int grid = 0;
    if (grid == 0) {
        const long long want[24] = {(long long)M * DM, DM, (long long)DM * EVEN_IN, QRANK, KVRANK, (long long)QRANK * 3072, (long long)KVRANK * 4096, MLA_QK, MLA_QK, HD, HD, (long long)EVEN_MIX * DM,
                                    DM, (long long)DM * 12288, HD, HD, (long long)NA_H * 15 * 31, (long long)DM * DM, 2 * DM, 2LL * DM * DFF, 2LL * DM * DFF, 2 * 3 * DFF, 2 * DFF, 2LL * DFF * DM};
        bool sizes_ok = n_in == 24; for (int i = 0; sizes_ok && i < 24; ++i) if ((long long)in_sizes[i] != want[i]) { fprintf(stderr, "kernel_launch: input %d has %d elements, expected %lld\n", i, in_sizes[i], want[i]); sizes_ok = false; }
        if (!sizes_ok || out_size != M * DM || ws_size < WS_END) { fprintf(stderr, "kernel_launch: unexpected shapes: n_in %d in0 %d out %d ws %zu (need %zu)\n", n_in, n_in > 0 ? in_sizes[0] : -1, out_size, ws_size, (size_t)WS_END); grid = -1; return; }
        int dev = 0, cus = 0, per_cu = 0;
        if (hipGetDevice(&dev) != hipSuccess || hipDeviceGetAttribute(&cus, hipDeviceAttributeMultiprocessorCount, dev) != hipSuccess) { grid = -1; return; }
        if (hipFuncSetAttribute((const void*)mk_fwd, hipFuncAttributeMaxDynamicSharedMemorySize, LDS_BYTES) != hipSuccess) { fprintf(stderr, "kernel_launch: hipFuncSetAttribute failed\n"); grid = -1; return; }
        if (hipOccupancyMaxActiveBlocksPerMultiprocessor(&per_cu, (const void*)mk_fwd, NWAVES * 64, LDS_BYTES) != hipSuccess || per_cu < 1) fprintf(stderr, "kernel_launch: occupancy query reports %d\n", per_cu);
        (void)hipGetLastError();
        grid = cus;
    }
    if (grid < 0) return;
    if (hipMemsetAsync((char*)d_ws + WS_CTL, 0, CTL_ZERO_BYTES, stream) != hipSuccess) return;
    Args a{};
    for (int i = 0; i < 24; ++i) a.in[i] = (const float*)d_in[i];
    a.out = (float*)d_out; a.ws = (unsigned char*)d_ws;
#if MK_ONE_LAUNCH
    a.ph_lo = 0; a.ph_hi = N_PHASES;
    hipLaunchKernelGGL(mk_fwd, dim3(grid), dim3(NWAVES * 64), LDS_BYTES, stream, a);
#else
#if MK_CHECK
    unsigned char* ws = (unsigned char*)d_ws; unsigned* cw = (unsigned*)(ws + WS_CHK); (void)hipMemsetAsync(cw, 0, 256, stream);
    bf16* cp_z = (bf16*)(ws + WS_CHK + 1 * MiB); bf16* cp_q = (bf16*)(ws + WS_CHK + 2 * MiB); float* cp_out = (float*)(ws + WS_CHK + 3 * MiB); bf16* cp_qkv = (bf16*)(ws + WS_CHK + 4 * MiB); bf16* cp_qn = (bf16*)(ws + WS_CHK + 5 * MiB);
    float* cosA = (float*)(ws + WS_ROPE); float* sinA = cosA + SEQ * 16; float* cosB = sinA + SEQ * 16; float* sinB = cosB + SEQ * 32;
    float* rstd = (float*)(ws + WS_RSTD); bf16* xb = (bf16*)(ws + WS_XB); unsigned char* R = ws + WS_R;
    bf16* zb = (bf16*)(R + R_Z); bf16* qb = (bf16*)(R + R_Q); bf16* kvb = (bf16*)(R + R_KV); bf16* kb = (bf16*)(R + R_K); bf16* omix = (bf16*)(R + R_OMIX);
    bf16* cqn = (bf16*)(R + R_CQN); bf16* ckvn = (bf16*)(R + R_CKVN); bf16* h2b = (bf16*)(R + R_H2); bf16* qkvb = (bf16*)(R + R_QKV); bf16* ob = (bf16*)(R + R_O);
    bf16* Win_t = (bf16*)(ws + WS_WIN); bf16* Wuq_t = (bf16*)(ws + WS_WUQ); bf16* Wukv_t = (bf16*)(ws + WS_WUKV); bf16* Weout_t = (bf16*)(ws + WS_WEOUT); bf16* Wqkv_t = (bf16*)(ws + WS_WQKV); bf16* Woout_t = (bf16*)(ws + WS_WOOUT);
    float* out = (float*)d_out; const float* const* in = a.in;
    auto WL = [&](int layer, int which) { return (bf16*)(ws + WS_WFFN + (size_t)layer * 3 * FFN_W_BYTES + (size_t)which * FFN_W_BYTES); };
#endif
    for (int p = 0; p < N_PHASES; ++p) {
#if MK_CHECK
        if (p == 2) k_chk_copy<<<NS, 256, 0, stream>>>((const unsigned char*)zb, (size_t)ZLD * 2, (unsigned char*)cp_z);
        if (p == 4) k_chk_copy<<<NS, 256, 0, stream>>>((const unsigned char*)qb, (size_t)3072 * 2, (unsigned char*)cp_q);
        if (p == 10 || p == 15 || p == 19) k_chk_copy<<<NS, 256, 0, stream>>>((const unsigned char*)xb, (size_t)DM * 2, (unsigned char*)cp_out);
#endif
        a.ph_lo = p; a.ph_hi = p + 1; hipLaunchKernelGGL(mk_fwd, dim3(grid), dim3(NWAVES * 64), LDS_BYTES, stream, a);
#if MK_CHECK
        const int c = 2 * p;
        if (p == 0) {
            k_chk_w<<<4, 64, 0, stream>>>(in[2], DM, EVEN_IN, Win_t, in[1], 1, cw, c); k_chk_w<<<4, 64, 0, stream>>>(in[5], QRANK, 3072, Wuq_t, in[3], 0, cw, c); k_chk_w<<<4, 64, 0, stream>>>(in[6], KVRANK, 4096, Wukv_t, in[4], 0, cw, c);
            k_chk_w<<<4, 64, 0, stream>>>(in[11], EVEN_MIX, DM, Weout_t, nullptr, 0, cw, c); k_chk_w<<<4, 64, 0, stream>>>(in[13], DM, 12288, Wqkv_t, in[12], 0, cw, c); k_chk_w<<<4, 64, 0, stream>>>(in[17], DM, DM, Woout_t, nullptr, 0, cw, c);
            for (int l = 0; l < 2; ++l) { k_chk_w<<<4, 64, 0, stream>>>(in[19] + (size_t)l * DM * DFF, DM, DFF, WL(l, 0), in[18] + l * DM, 2, cw, c); k_chk_w<<<4, 64, 0, stream>>>(in[20] + (size_t)l * DM * DFF, DM, DFF, WL(l, 0), in[18] + l * DM, 3, cw, c);
                k_chk_w<<<4, 64, 0, stream>>>(in[23] + (size_t)l * DFF * DM, DFF, DM, WL(l, 2), nullptr, 0, cw, c); }
            k_chk_rstd<<<1, 64, 0, stream>>>(in[0], rstd, xb, cw, c + 1);
            k_chk_rope<<<8, 64, 0, stream>>>(cosA, sinA, 16, 0.44036660267178046, cw, 40); k_chk_rope<<<8, 64, 0, stream>>>(cosB, sinB, 32, 0.6636012376960885, cw, 41);
        }
        if (p == 1) k_chk_zn<<<NS, 64, 0, stream>>>(xb, Win_t, rstd, zb, in[9], in[10], cosA, sinA, cw, c);
        if (p == 3) { k_chk_rq<<<1, 64, 0, stream>>>(zb, rstd + M, rstd + 2 * M, cw, 4);
                      k_chk_gemm<<<NS, 64, 0, stream>>>(zb + Z_CQ, ZLD, Wuq_t, QRANK, 3072, rstd + M, nullptr, 0, 0, qb, nullptr, 3072, cw, c, 0.05f);
                      k_chk_gemm<<<NS, 64, 0, stream>>>(zb + Z_CKV, ZLD, Wukv_t, KVRANK, 4096, rstd + 2 * M, nullptr, 0, 0, kvb, nullptr, 4096, cw, c + 1, 0.05f); }
        if (p == 4) k_chk_p4<<<NS, 32, 0, stream>>>(cp_q, cp_qn, kvb, zb, kb, in[7], in[8], cosB, sinB, cw, c);
        if (p == 5) { k_chk_mla<<<NS, 8, 0, stream>>>(cp_qn, kb, kvb, omix, cw, c); k_chk_dil<<<NS, 8, 0, stream>>>(zb, omix, cw, c + 1); }
        if (p == 6) k_chk_gemm<<<NS, 64, 0, stream>>>(omix, EVEN_MIX, Weout_t, EVEN_MIX, DM, nullptr, in[0], DM, 0, nullptr, out, DM, cw, c, 0.05f);
        if (p == 8 || p == 12 || p == 17) k_chk_rstd<<<1, 64, 0, stream>>>(out, rstd, xb, cw, c + 1);
        if (p == 9 || p == 18) { const int l = p == 9 ? 0 : 1; k_chk_up<<<NS, 64, 0, stream>>>(xb, WL(l, 0), rstd, in[21] + (size_t)l * 3 * DFF, in[22] + (size_t)l * DFF, h2b, cw, c); }
        if (p == 10 || p == 19) k_chk_gemm<<<NS, 64, 0, stream>>>(h2b, DFF, WL(p == 10 ? 0 : 1, 2), DFF, DM, nullptr, cp_out, DM, 2, nullptr, out, DM, cw, c, 0.05f);
        if (p == 12) k_chk_qkvn<<<NS, 64, 0, stream>>>(xb, Wqkv_t, rstd, qkvb, in[14], in[15], cw, c);
        if (p == 14) k_chk_na<<<NS, 8, 0, stream>>>(qkvb, in[16], ob, cw, c);
        if (p == 15) k_chk_gemm<<<NS, 64, 0, stream>>>(ob, DM, Woout_t, DM, DM, nullptr, cp_out, DM, 2, nullptr, out, DM, cw, c, 0.05f);
#endif
    }
#if MK_CHECK
    k_chk_final<<<1, 64, 0, stream>>>(cw, out);
#endif
#endif
    const hipError_t le = hipPeekAtLastError();
    if (le != hipSuccess) fprintf(stderr, "kernel_launch: launch failed: %s\n", hipGetErrorName(le));
}
```
